# Optimizing an MI355X kernel written in HIP

```python
import numpy as np
import jax
import jax.numpy as jnp
from jax import lax

D_MODEL = 1024
BATCH = 8
SEQ = 8192
DEPTH = 2
DEC_BATCH = 8
DEC_SEQ = 32
PAST_LEN = 4096

CHUNK = 64
Q_BLOCK = 128
N_EVEN = (DEPTH + 1) // 2
N_ODD = DEPTH // 2
RET_H = 4
RET_D = 128
RET_W = RET_H * RET_D
ROPE_BASE = 10000.0
FOX_H = 8
FOX_D = 64
FOX_W = FOX_H * FOX_D
AB_IN = 4 * RET_W + 3 * FOX_W + FOX_H
AB_OUT = RET_W + FOX_W
S5_GROUP = 16
S5_G = D_MODEL // S5_GROUP
S5_P = 64
DT_MIN = 1e-3
DT_MAX = 1e-1
MEM_LEN = 256
X_H = 4
X_D = D_MODEL // X_H
D_FF = 4 * D_MODEL
EPS = 1e-6
NEG_INF = -1e30
F32 = jnp.float32

kernel_name = 'hybrid_retention_fox_s5_stream_step'


def _rmsnorm(x, w):
    xf = x.astype(F32)
    y = xf * lax.rsqrt(jnp.mean(xf * xf, axis=-1, keepdims=True) + EPS)
    return y * w.astype(F32)


def _rotary(x, pos):
    half = x.shape[-1] // 2
    inv = ROPE_BASE ** (-jnp.arange(half, dtype=F32) / half)
    ang = pos.astype(F32)[:, None] * inv[None, :]
    cos = jnp.cos(ang)[None, :, None, :]
    sin = jnp.sin(ang)[None, :, None, :]
    xf = x.astype(F32)
    x1, x2 = xf[..., :half], xf[..., half:]
    return jnp.concatenate([x1 * cos - x2 * sin, x2 * cos + x1 * sin], axis=-1)


def _head_groupnorm(o, w):
    mu = jnp.mean(o, axis=-1, keepdims=True)
    var = jnp.mean(jnp.square(o - mu), axis=-1, keepdims=True)
    return (o - mu) * lax.rsqrt(var + EPS) * w.astype(F32)


def _retention(q, k, v, s0, chunk):
    B, T, H, d = q.shape
    n = T // chunk
    qc = q.reshape(B, n, chunk, H, d)
    kc = k.reshape(B, n, chunk, H, d)
    vc = v.reshape(B, n, chunk, H, d)
    lg = jnp.log(1.0 - 2.0 ** (-5.0 - jnp.arange(H, dtype=F32)))
    idx = jnp.arange(chunk, dtype=F32)
    dec_in = jnp.exp(lg[:, None, None] * jnp.abs(idx[:, None] - idx[None, :]))
    w_q = jnp.exp(lg[None, :] * (idx[:, None] + 1.0))
    w_k = jnp.exp(lg[None, :] * (chunk - 1.0 - idx[:, None]))
    scores = jnp.einsum('bnihd,bnjhd->bnhij', qc, kc) * dec_in
    intra = jnp.einsum('bnhij,bnjhe->bnihe', scores, vc)
    kv = jnp.einsum('bnjhd,bnjhe->nbhde', kc * w_k[:, :, None], vc)
    decay_chunk = jnp.exp(lg * chunk)[None, :, None, None]

    def step(s, kv_c):
        return s * decay_chunk + kv_c, s

    s_fin, s_before = lax.scan(step, s0, kv)
    inter = jnp.einsum('bnihd,nbhde->bnihe', qc * w_q[:, :, None], s_before)
    return (intra + inter).reshape(B, T, H, d), s_fin


def _fox_attend(q, k, v, cq, ck, qpos, kpos):
    s = jnp.einsum('bqhd,bkhd->bhqk', q, k).astype(F32) * (FOX_D ** -0.5)
    s = s + jnp.swapaxes(cq, 1, 2)[..., :, None] - jnp.swapaxes(ck, 1, 2)[..., None, :]
    s = jnp.where(kpos[None, :] <= qpos[:, None], s, NEG_INF)
    p = jax.nn.softmax(s, axis=-1)
    return jnp.einsum('bhqk,bkhd->bqhd', p.astype(v.dtype), v)


def _fox_prompt(q, k, v, logf):
    B, T, H, Dh = q.shape
    c = jnp.cumsum(logf, axis=1)
    kpos = jnp.arange(T)

    def block(i):
        start = i * Q_BLOCK
        qb = lax.dynamic_slice_in_dim(q, start, Q_BLOCK, axis=1)
        cb = lax.dynamic_slice_in_dim(c, start, Q_BLOCK, axis=1)
        return _fox_attend(qb, k, v, cb, c, start + jnp.arange(Q_BLOCK), kpos)

    out = lax.map(block, jnp.arange(T // Q_BLOCK))
    return jnp.moveaxis(out, 0, 1).reshape(B, T, H, Dh)


def _fox_sample(q, k, v, logf, k_past, v_past, logf_past):
    L = q.shape[1]
    P = k_past.shape[1]
    k_all = jnp.concatenate([k_past.astype(k.dtype), k], axis=1)
    v_all = jnp.concatenate([v_past.astype(v.dtype), v], axis=1)
    c = jnp.cumsum(jnp.concatenate([logf_past.astype(F32), logf], axis=1), axis=1)
    return _fox_attend(q, k_all, v_all, c[:, P:], c, P + jnp.arange(L), jnp.arange(P + L))


def _ab_mixer(h, pos, p, e, st):
    B, T, _ = h.shape
    z = h @ p['w_in_ab'][e]
    splits = [RET_W, 2 * RET_W, 3 * RET_W, 4 * RET_W,
              4 * RET_W + FOX_W, 4 * RET_W + 2 * FOX_W, 4 * RET_W + 3 * FOX_W]
    rq, rk, rv, rg, fq, fk, fv, fl = jnp.split(z, splits, axis=-1)
    rq = _rotary(rq.reshape(B, T, RET_H, RET_D), pos)
    rk = _rotary(rk.reshape(B, T, RET_H, RET_D), pos) * (RET_D ** -0.5)
    rv = rv.reshape(B, T, RET_H, RET_D).astype(F32)
    if st is None:
        s0 = jnp.zeros((B, RET_H, RET_D, RET_D), F32)
        blk = CHUNK
    else:
        s0 = st['ret'][e].astype(F32)
        blk = T
    ro, s_new = _retention(rq, rk, rv, s0, blk)
    ro = _head_groupnorm(ro, p['ret_gn_w'][e]).reshape(B, T, RET_W) * jax.nn.silu(rg.astype(F32))
    fq = fq.reshape(B, T, FOX_H, FOX_D)
    fk = fk.reshape(B, T, FOX_H, FOX_D)
    fv = fv.reshape(B, T, FOX_H, FOX_D)
    logf = jax.nn.log_sigmoid(fl.astype(F32) + p['b_fox_f'][e].astype(F32))
    if st is None:
        fo = _fox_prompt(fq, fk, fv, logf)
    else:
        fo = _fox_sample(fq, fk, fv, logf, st['fox_k'][e], st['fox_v'][e], st['fox_logf'][e])
    mixed = jnp.concatenate([ro.astype(h.dtype), fo.reshape(B, T, FOX_W).astype(h.dtype)], axis=-1)
    return mixed @ p['w_out_ab'][e], (s_new, fk, fv, logf)


def _s5_discretize(lam_re, lam_im, log_dt, b_re, b_im):
    lam_re = lam_re.astype(F32)
    lam_im = lam_im.astype(F32)
    dt = jnp.exp(log_dt.astype(F32))[:, None]
    mag = jnp.exp(lam_re * dt)
    a_re = mag * jnp.cos(lam_im * dt)
    a_im = mag * jnp.sin(lam_im * dt)
    den = lam_re * lam_re + lam_im * lam_im
    num_re = a_re - 1.0
    f_re = (num_re * lam_re + a_im * lam_im) / den
    f_im = (a_im * lam_re - num_re * lam_im) / den
    b_re = b_re.astype(F32)
    b_im = b_im.astype(F32)
    bb_re = f_re[..., None] * b_re - f_im[..., None] * b_im
    bb_im = f_re[..., None] * b_im + f_im[..., None] * b_re
    return a_re, a_im, bb_re, bb_im


def _s5_combine(e1, e2):
    a1r, a1i, b1r, b1i = e1
    a2r, a2i, b2r, b2i = e2
    return (a2r * a1r - a2i * a1i, a2r * a1i + a2i * a1r,
            a2r * b1r - a2i * b1i + b2r, a2r * b1i + a2i * b1r + b2i)


def _s5_mixer(h, p, o, st):
    B, T, _ = h.shape
    u = (h @ p['w_in_c'][o]).astype(F32).reshape(B, T, S5_G, S5_GROUP)
    a_re, a_im, bb_re, bb_im = _s5_discretize(p['s5_lambda_re'][o], p['s5_lambda_im'][o],
                                              p['s5_log_dt'][o], p['s5_b_re'][o], p['s5_b_im'][o])
    bu_re = jnp.einsum('gpc,btgc->btgp', bb_re, u)
    bu_im = jnp.einsum('gpc,btgc->btgp', bb_im, u)
    if st is not None:
        x0_re = st['s5_re'][o].astype(F32)
        x0_im = st['s5_im'][o].astype(F32)
        bu_re = bu_re.at[:, 0].add(a_re * x0_re - a_im * x0_im)
        bu_im = bu_im.at[:, 0].add(a_re * x0_im + a_im * x0_re)
    A_re = jnp.broadcast_to(a_re, bu_re.shape)
    A_im = jnp.broadcast_to(a_im, bu_im.shape)
    _, _, xr, xi = lax.associative_scan(_s5_combine, (A_re, A_im, bu_re, bu_im), axis=1)
    c_re = p['s5_c_re'][o].astype(F32)
    c_im = p['s5_c_im'][o].astype(F32)
    y = (jnp.einsum('gcp,btgp->btgc', c_re, xr) - jnp.einsum('gcp,btgp->btgc', c_im, xi)
         + p['s5_d'][o].astype(F32) * u)
    y = y.reshape(B, T, D_MODEL).astype(h.dtype)
    g = y @ p['w_glu'][o]
    out = g[..., :D_MODEL] * jax.nn.sigmoid(g[..., D_MODEL:])
    return out, (xr[:, -1], xi[:, -1])


def _memory_kv(mem, norm_w, w_k, w_v):
    B, M, _ = mem.shape
    m = _rmsnorm(mem, norm_w).astype(mem.dtype)
    return (m @ w_k).reshape(B, M, X_H, X_D), (m @ w_v).reshape(B, M, X_H, X_D)


def _cross_attn(h, mk, mv, w_q, w_o):
    B, T, _ = h.shape
    q = (h @ w_q).reshape(B, T, X_H, X_D)
    s = jnp.einsum('bthd,bmhd->bhtm', q, mk.astype(q.dtype)).astype(F32) * (X_D ** -0.5)
    pr = jax.nn.softmax(s, axis=-1)
    o = jnp.einsum('bhtm,bmhd->bthd', pr.astype(h.dtype), mv.astype(h.dtype))
    return o.reshape(B, T, D_MODEL) @ w_o


def _sq_relu_mlp(h, w_up, w_down):
    return jnp.square(jax.nn.relu(h @ w_up)) @ w_down


def _run_group(x, pos, p, mem=None, st=None):
    dt = x.dtype
    new = {'ret': [], 'fox_k': [], 'fox_v': [], 'fox_logf': [], 's5_re': [], 's5_im': [],
           'mem_k': [], 'mem_v': []}
    for layer in range(DEPTH):
        g = p['norm_w'][layer]
        h = _rmsnorm(x, g[0]).astype(dt)
        if layer % 2 == 0:
            mix, (s_ret, fk, fv, flf) = _ab_mixer(h, pos, p, layer // 2, st)
            new['ret'].append(s_ret)
            new['fox_k'].append(fk)
            new['fox_v'].append(fv)
            new['fox_logf'].append(flf)
        else:
            mix, (sr, si) = _s5_mixer(h, p, layer // 2, st)
            new['s5_re'].append(sr)
            new['s5_im'].append(si)
        x = x + _rmsnorm(mix, g[1]).astype(dt)
        h = _rmsnorm(x, g[2]).astype(dt)
        if st is None:
            mk, mv = _memory_kv(mem, p['mem_norm_w'][layer], p['w_xk'][layer], p['w_xv'][layer])
            new['mem_k'].append(mk)
            new['mem_v'].append(mv)
        else:
            mk, mv = st['mem_k'][layer], st['mem_v'][layer]
        x = x + _rmsnorm(_cross_attn(h, mk, mv, p['w_xq'][layer], p['w_xo'][layer]), g[3]).astype(dt)
        h = _rmsnorm(x, g[4]).astype(dt)
        x = x + _rmsnorm(_sq_relu_mlp(h, p['w_up'][layer], p['w_down'][layer]), g[5]).astype(dt)
    return x, new


def setup_inputs(seed: int = 0) -> dict:
    key = jax.random.key(seed)
    ks = jax.random.split(key, 40)

    def nrm(i, shape, scale=1.0):
        return jax.random.normal(ks[i], shape, F32) * scale

    n = jnp.arange(S5_P, dtype=F32)
    return {
        'x_prompt': nrm(0, (BATCH, SEQ, D_MODEL)),
        'x_sample': nrm(1, (DEC_BATCH, DEC_SEQ, D_MODEL)),
        'cache_ret_state': nrm(2, (N_EVEN, DEC_BATCH, RET_H, RET_D, RET_D), 0.5),
        'cache_fox_k': nrm(3, (N_EVEN, DEC_BATCH, PAST_LEN, FOX_H, FOX_D)),
        'cache_fox_v': nrm(4, (N_EVEN, DEC_BATCH, PAST_LEN, FOX_H, FOX_D)),
        'cache_fox_logf': jax.nn.log_sigmoid(2.5 + nrm(5, (N_EVEN, DEC_BATCH, PAST_LEN, FOX_H))),
        'state_s5_re': nrm(6, (N_ODD, DEC_BATCH, S5_G, S5_P), 0.1),
        'state_s5_im': nrm(7, (N_ODD, DEC_BATCH, S5_G, S5_P), 0.1),
        'cache_mem_k': nrm(8, (DEPTH, DEC_BATCH, MEM_LEN, X_H, X_D)),
        'cache_mem_v': nrm(9, (DEPTH, DEC_BATCH, MEM_LEN, X_H, X_D)),
        'mem_prompt': nrm(10, (BATCH, MEM_LEN, D_MODEL)),
        'norm_w': 1.0 + nrm(11, (DEPTH, 6, D_MODEL), 0.05),
        'w_in_ab': nrm(12, (N_EVEN, D_MODEL, AB_IN), D_MODEL ** -0.5),
        'b_fox_f': jax.random.uniform(ks[13], (N_EVEN, FOX_H), F32, 1.0, 4.0),
        'ret_gn_w': 1.0 + nrm(14, (N_EVEN, RET_H, RET_D), 0.05),
        'w_out_ab': nrm(15, (N_EVEN, AB_OUT, D_MODEL), AB_OUT ** -0.5),
        'w_in_c': nrm(16, (N_ODD, D_MODEL, D_MODEL), D_MODEL ** -0.5),
        's5_lambda_re': -0.5 + nrm(17, (N_ODD, S5_G, S5_P), 0.01),
        's5_lambda_im': jnp.pi * n + nrm(18, (N_ODD, S5_G, S5_P), 0.01),
        's5_log_dt': jax.random.uniform(ks[19], (N_ODD, S5_G), F32, float(np.log(DT_MIN)), float(np.log(DT_MAX))),
        's5_b_re': nrm(20, (N_ODD, S5_G, S5_P, S5_GROUP), (2.0 * S5_GROUP) ** -0.5),
        's5_b_im': nrm(21, (N_ODD, S5_G, S5_P, S5_GROUP), (2.0 * S5_GROUP) ** -0.5),
        's5_c_re': nrm(22, (N_ODD, S5_G, S5_GROUP, S5_P), (2.0 * S5_P) ** -0.5),
        's5_c_im': nrm(23, (N_ODD, S5_G, S5_GROUP, S5_P), (2.0 * S5_P) ** -0.5),
        's5_d': nrm(24, (N_ODD, S5_G, S5_GROUP)),
        'w_glu': nrm(25, (N_ODD, D_MODEL, 2 * D_MODEL), D_MODEL ** -0.5),
        'mem_norm_w': 1.0 + nrm(26, (DEPTH, D_MODEL), 0.05),
        'w_xq': nrm(27, (DEPTH, D_MODEL, D_MODEL), D_MODEL ** -0.5),
        'w_xk': nrm(28, (DEPTH, D_MODEL, D_MODEL), D_MODEL ** -0.5),
        'w_xv': nrm(29, (DEPTH, D_MODEL, D_MODEL), D_MODEL ** -0.5),
        'w_xo': nrm(30, (DEPTH, D_MODEL, D_MODEL), D_MODEL ** -0.5),
        'w_up': nrm(31, (DEPTH, D_MODEL, D_FF), D_MODEL ** -0.5),
        'w_down': nrm(32, (DEPTH, D_FF, D_MODEL), D_FF ** -0.5),
    }


def reference(x_prompt, x_sample, cache_ret_state, cache_fox_k, cache_fox_v, cache_fox_logf,
              state_s5_re, state_s5_im, cache_mem_k, cache_mem_v, mem_prompt,
              norm_w, w_in_ab, b_fox_f, ret_gn_w, w_out_ab, w_in_c,
              s5_lambda_re, s5_lambda_im, s5_log_dt, s5_b_re, s5_b_im, s5_c_re, s5_c_im, s5_d, w_glu,
              mem_norm_w, w_xq, w_xk, w_xv, w_xo, w_up, w_down):
    p = {'norm_w': norm_w, 'w_in_ab': w_in_ab, 'b_fox_f': b_fox_f, 'ret_gn_w': ret_gn_w,
         'w_out_ab': w_out_ab, 'w_in_c': w_in_c, 's5_lambda_re': s5_lambda_re,
         's5_lambda_im': s5_lambda_im, 's5_log_dt': s5_log_dt, 's5_b_re': s5_b_re, 's5_b_im': s5_b_im,
         's5_c_re': s5_c_re, 's5_c_im': s5_c_im, 's5_d': s5_d, 'w_glu': w_glu,
         'mem_norm_w': mem_norm_w, 'w_xq': w_xq, 'w_xk': w_xk, 'w_xv': w_xv, 'w_xo': w_xo,
         'w_up': w_up, 'w_down': w_down}
    st = {'ret': cache_ret_state, 'fox_k': cache_fox_k, 'fox_v': cache_fox_v,
          'fox_logf': cache_fox_logf, 's5_re': state_s5_re, 's5_im': state_s5_im,
          'mem_k': cache_mem_k, 'mem_v': cache_mem_v}
    pos_prompt = jnp.arange(x_prompt.shape[1])
    pos_sample = cache_fox_k.shape[2] + jnp.arange(x_sample.shape[1])
    y_prompt, np_ = _run_group(x_prompt, pos_prompt, p, mem=mem_prompt)
    y_sample, ns_ = _run_group(x_sample, pos_sample, p, st=st)
    return (y_prompt, y_sample,
            jnp.stack(np_['ret']), jnp.stack(ns_['ret']),
            jnp.stack(np_['fox_k']), jnp.stack(np_['fox_v']), jnp.stack(np_['fox_logf']),
            jnp.stack(ns_['fox_k']), jnp.stack(ns_['fox_v']), jnp.stack(ns_['fox_logf']),
            jnp.stack(np_['s5_re']), jnp.stack(np_['s5_im']),
            jnp.stack(ns_['s5_re']), jnp.stack(ns_['s5_im']),
            jnp.stack(np_['mem_k']), jnp.stack(np_['mem_v']))
```

```cpp
#include <hip/hip_runtime.h>
#include <hip/hip_cooperative_groups.h>
#include <cstdio>
#include <cstdint>
namespace cg = cooperative_groups;
namespace pg8 {
#define PG8_LAS __attribute__((address_space(3)))
typedef unsigned short bf16_t;
typedef short bf16x8 __attribute__((ext_vector_type(8)));
typedef float f32x4 __attribute__((ext_vector_type(4)));
typedef unsigned u32x4 __attribute__((ext_vector_type(4)));
constexpr int BM = 256, BK = 64, HALF = 128, HTB = HALF * BK * 2  , STAGE_BYTES = 8 * HTB, NXCD = 8, WGM = 8;

__host__ __device__ __forceinline__ int lds_byte(int r, int c) { const int st = (r >> 4) * 2 + (c >> 5), rr = r & 15, cc = c & 31, ob = rr * 64 + cc * 2; return st * 1024 + (ob ^ (((ob >> 9) & 1) << 5)); }
__host__ __device__ __forceinline__ void stage_rc(int b, int& R, int& C) { const int st = b / 1024, sb = b % 1024, swz = sb ^ (((sb >> 9) & 1) << 5); R = (st >> 1) * 16 + swz / 64; C = (st & 1) * 32 + (swz % 64) / 2; }
__host__ __device__ __forceinline__ int perm32(int rho) { const int n = rho >> 4, i = rho & 15; return 8 * (i >> 2) + 4 * n + (i & 3); }

struct Unit { int pm, pn; };
struct Gemm { const bf16_t* A; const bf16_t* Bt; int M, N, K; };

struct StaticOrder {
    int nM, nN, nwg, G, c;
    __host__ __device__ void init(int M, int N, int G_, int c_) { nM = M / BM; nN = N / BM; nwg = nM * nN; G = G_; c = c_; }
    __host__ __device__ bool next(int i, Unit& u) const {
        const long L = (long)i * G + c; if (L >= nwg) return false;
        int wgid = (int)L; { const int q = nwg / NXCD, r = nwg % NXCD, xcd = wgid % NXCD, off = wgid / NXCD; wgid = (xcd < r ? xcd * (q + 1) : r * (q + 1) + (xcd - r) * q) + off; }
        const int nig = WGM * nN, gid = wgid / nig, fm = gid * WGM, gsz = (nM - fm) < WGM ? (nM - fm) : WGM;
        u.pm = fm + ((wgid % nig) % gsz); u.pn = (wgid % nig) / gsz; return true;
    }
    __device__ __forceinline__ void a_ready(const Unit&) const {}
    __device__ __forceinline__ void done(const Unit&) const {}
};

template <class Epi, class Sched, bool ALIGN_EPI = false, bool SP2 = false>
__device__ __forceinline__ void gemm_phase(PG8_LAS unsigned char* lds, const Gemm g, const Sched& S, const Epi& E) {
    int tid_l = threadIdx.x; asm volatile("" : "+v"(tid_l)); const int tid = tid_l, wid = __builtin_amdgcn_readfirstlane(tid >> 6), lane = tid & 63, wr = wid >> 2, wc = wid & 3, fr = lane & 15, fq = lane >> 4;
    const int K = g.K, nt = K / BK;
    unsigned voffA[2], voffB[2];
#pragma unroll
    for (int i = 0; i < 2; ++i) { int R, C; stage_rc(tid * 16 + i * 8192, R, C); const int Rb = Epi::PERM ? ((R & ~31) + perm32(R & 31)) : R;
        voffA[i] = (unsigned)(R * K + C) * 2u; voffB[i] = (unsigned)(Rb * K + C) * 2u; }
    const size_t kstep = (size_t)(BK * 2);
    const size_t hstep = (size_t)HALF * K * 2;
    const size_t tstep = 2 * hstep;
    const unsigned ldsw = (unsigned)wid * 1024u;
    const int aoff = lds_byte(wr * 64 + fr, fq * 8), boff = lds_byte(wc * 32 + fr, fq * 8);
#define PG8_SA(b, h) (((b) * 2 + (h)) * HTB)
#define PG8_SB(b, h) ((4 + (b) * 2 + (h)) * HTB)
#define PG8_STAGE(bufoff, gbase, voff) do { _Pragma("unroll") for (int _i = 0; _i < 2; ++_i) \
        __builtin_amdgcn_global_load_lds((const unsigned*)((const char*)(gbase) + (voff)[_i]), (PG8_LAS unsigned*)(lds + (bufoff) + ldsw + _i * 8192), 16, 0, 0); } while (0)
#define PG8_LDA(dst, b, h) do { _Pragma("unroll") for (int m = 0; m < 4; ++m) _Pragma("unroll") for (int k = 0; k < 2; ++k) dst[m][k] = *(const PG8_LAS bf16x8*)(lds + PG8_SA(b, h) + aoff + m * 2048 + k * 1024); } while (0)
#define PG8_LDB(dst, b, h) do { _Pragma("unroll") for (int n = 0; n < 2; ++n) _Pragma("unroll") for (int k = 0; k < 2; ++k) dst[n][k] = *(const PG8_LAS bf16x8*)(lds + PG8_SB(b, h) + boff + n * 2048 + k * 1024); } while (0)
#define PG8_MMA(ai, bj, At, Bt) do { __builtin_amdgcn_s_setprio(1); _Pragma("unroll") for (int m = 0; m < 4; ++m) _Pragma("unroll") for (int n = 0; n < 2; ++n) _Pragma("unroll") for (int k = 0; k < 2; ++k) \
        acc[ai][bj][m][n] = __builtin_amdgcn_mfma_f32_16x16x32_bf16(Bt[n][k], At[m][k], acc[ai][bj][m][n], 0, 0, 0); __builtin_amdgcn_s_setprio(0); } while (0)
#define PG8_WAIT_V(n) asm volatile("s_waitcnt vmcnt(" #n ")" ::: "memory")
#define PG8_WAIT_L(n) asm volatile("s_waitcnt lgkmcnt(" #n ")" ::: "memory")
#define PG8_BAR __builtin_amdgcn_s_barrier()
#define PG8_SCHED __builtin_amdgcn_sched_barrier(0)
    Unit cur, nxt; int ui = 0;
    if (!S.next(0, cur)) return;
    f32x4 acc[2][2][4][2];
#pragma unroll
    for (int a = 0; a < 2; ++a)
#pragma unroll
        for (int b = 0; b < 2; ++b)
#pragma unroll
            for (int m = 0; m < 4; ++m)
#pragma unroll
                for (int n = 0; n < 2; ++n) acc[a][b][m][n] = (f32x4){0.f, 0.f, 0.f, 0.f};
    bf16x8 At[4][2], B0[2][2], B1[2][2];
    const char* cA = (const char*)g.A + (size_t)cur.pm * tstep; const char* cB = (const char*)g.Bt + (size_t)cur.pn * tstep;
    S.a_ready(cur);
    if constexpr (SP2) {
        PG8_STAGE(PG8_SB(0, 0), cB, voffB); PG8_STAGE(PG8_SB(0, 1), cB + hstep, voffB); PG8_STAGE(PG8_SA(0, 0), cA, voffA); PG8_STAGE(PG8_SA(0, 1), cA + hstep, voffA);
        if (wr == 1) PG8_BAR;
        PG8_WAIT_V(2); PG8_BAR;
        PG8_STAGE(PG8_SB(1, 0), cB + kstep, voffB); PG8_STAGE(PG8_SA(1, 0), cA + kstep, voffA); PG8_STAGE(PG8_SB(1, 1), cB + hstep + kstep, voffB);
        PG8_WAIT_V(6); PG8_BAR;
    } else {
        PG8_STAGE(PG8_SB(0, 0), cB, voffB); PG8_STAGE(PG8_SA(0, 0), cA, voffA); PG8_STAGE(PG8_SB(0, 1), cB + hstep, voffB); PG8_STAGE(PG8_SA(0, 1), cA + hstep, voffA);
        if (wr == 1) PG8_BAR;
        PG8_WAIT_V(4); PG8_BAR;
        PG8_STAGE(PG8_SB(1, 0), cB + kstep, voffB); PG8_STAGE(PG8_SA(1, 0), cA + kstep, voffA); PG8_STAGE(PG8_SB(1, 1), cB + hstep + kstep, voffB);
        PG8_WAIT_V(6); PG8_BAR;
    }
    for (;;) {
        const bool has_next = S.next(ui + 1, nxt);
        const char* nA = has_next ? (const char*)g.A + (size_t)nxt.pm * tstep : cA; const char* nB = has_next ? (const char*)g.Bt + (size_t)nxt.pn * tstep : cB;
        for (int t = 0; t < nt; t += 2) {
            const bool last = (t == nt - 2);
            const char* a1 = cA + (size_t)(t + 1) * kstep;
            const char* a2 = last ? nA : cA + (size_t)(t + 2) * kstep; const char* b2 = last ? nB : cB + (size_t)(t + 2) * kstep;
            const char* a3 = a2 + kstep; const char* b3 = b2 + kstep;
            if (last && has_next) S.a_ready(nxt);
            if constexpr (SP2) {
            PG8_LDB(B0, 0, 0); PG8_LDB(B1, 0, 1); PG8_SCHED; PG8_LDA(At, 0, 0); PG8_STAGE(PG8_SA(1, 1), a1 + hstep, voffA);
            PG8_WAIT_V(8); PG8_WAIT_L(0); PG8_BAR; PG8_MMA(0, 0, At, B0); PG8_MMA(0, 1, At, B1); PG8_BAR; PG8_SCHED;
            PG8_LDA(At, 0, 1); PG8_STAGE(PG8_SB(0, 0), b2, voffB); PG8_STAGE(PG8_SB(0, 1), b2 + hstep, voffB); PG8_STAGE(PG8_SA(0, 0), a2, voffA);
            PG8_WAIT_V(8); PG8_WAIT_L(0); PG8_BAR; PG8_MMA(1, 0, At, B0); PG8_MMA(1, 1, At, B1); PG8_BAR; PG8_SCHED;
            PG8_LDB(B0, 1, 0); PG8_LDB(B1, 1, 1); PG8_SCHED; PG8_LDA(At, 1, 0); PG8_STAGE(PG8_SA(0, 1), a2 + hstep, voffA);
            PG8_WAIT_V(8); PG8_WAIT_L(0); PG8_BAR; PG8_MMA(0, 0, At, B0); PG8_MMA(0, 1, At, B1); PG8_BAR; PG8_SCHED;
            PG8_LDA(At, 1, 1); PG8_STAGE(PG8_SB(1, 0), b3, voffB); PG8_STAGE(PG8_SB(1, 1), b3 + hstep, voffB); PG8_STAGE(PG8_SA(1, 0), a3, voffA);
            PG8_WAIT_V(8); PG8_WAIT_L(0); PG8_BAR; PG8_MMA(1, 0, At, B0); PG8_MMA(1, 1, At, B1); PG8_BAR; PG8_SCHED;
            } else {
            PG8_LDB(B0, 0, 0); PG8_SCHED; PG8_LDA(At, 0, 0); PG8_STAGE(PG8_SA(1, 1), a1 + hstep, voffA);
            PG8_WAIT_L(8); PG8_BAR; PG8_WAIT_L(0); PG8_MMA(0, 0, At, B0); PG8_BAR; PG8_SCHED;
            PG8_LDB(B1, 0, 1); PG8_STAGE(PG8_SB(0, 0), b2, voffB);
            PG8_BAR; PG8_WAIT_L(0); PG8_MMA(0, 1, At, B1); PG8_BAR;
            PG8_LDA(At, 0, 1); PG8_STAGE(PG8_SA(0, 0), a2, voffA);
            PG8_BAR; PG8_WAIT_L(0); PG8_MMA(1, 0, At, B0); PG8_BAR; PG8_SCHED;
            PG8_STAGE(PG8_SB(0, 1), b2 + hstep, voffB);
            PG8_WAIT_V(6); PG8_BAR; PG8_MMA(1, 1, At, B1); PG8_BAR;
            PG8_LDB(B0, 1, 0); PG8_SCHED; PG8_LDA(At, 1, 0); PG8_STAGE(PG8_SA(0, 1), a2 + hstep, voffA);
            PG8_WAIT_L(8); PG8_BAR; PG8_WAIT_L(0); PG8_MMA(0, 0, At, B0); PG8_BAR; PG8_SCHED;
            PG8_LDB(B1, 1, 1); PG8_STAGE(PG8_SB(1, 0), b3, voffB);
            PG8_BAR; PG8_WAIT_L(0); PG8_MMA(0, 1, At, B1); PG8_BAR;
            PG8_LDA(At, 1, 1); PG8_STAGE(PG8_SA(1, 0), a3, voffA);
            PG8_BAR; PG8_WAIT_L(0); PG8_MMA(1, 0, At, B0); PG8_BAR; PG8_SCHED;
            PG8_STAGE(PG8_SB(1, 1), b3 + hstep, voffB);
            PG8_WAIT_V(6); PG8_BAR; PG8_MMA(1, 1, At, B1); PG8_BAR;
            }
        }
        if constexpr (ALIGN_EPI) { if (wr == 0) PG8_BAR; }
        if constexpr (!Epi::AFTER_DRAIN) { E(acc, cur, wr, wc, fr, fq); S.done(cur); }
        if (!has_next) break;
#pragma unroll
        for (int a = 0; a < 2; ++a)
#pragma unroll
            for (int b = 0; b < 2; ++b)
#pragma unroll
                for (int m = 0; m < 4; ++m)
#pragma unroll
                    for (int n = 0; n < 2; ++n) acc[a][b][m][n] = (f32x4){0.f, 0.f, 0.f, 0.f};
        cur = nxt; cA = nA; cB = nB; ++ui;
        if constexpr (ALIGN_EPI) { if (wr == 1) PG8_BAR; }
    }
    PG8_WAIT_V(0);
    if constexpr (!ALIGN_EPI) { if (wr == 0) PG8_BAR; }
    PG8_BAR;
    if constexpr (Epi::AFTER_DRAIN) { E.fused(acc, cur, wr, wc, fr, fq, lds, wid, lane); S.done(cur); }
#undef PG8_SA
#undef PG8_SB
#undef PG8_STAGE
#undef PG8_LDA
#undef PG8_LDB
#undef PG8_MMA
#undef PG8_WAIT_V
#undef PG8_WAIT_L
#undef PG8_BAR
#undef PG8_SCHED
}
}

#define LAS __attribute__((address_space(3)))
typedef unsigned short bf16_t;
typedef short bf16x8 __attribute__((ext_vector_type(8)));
typedef short s16x4 __attribute__((ext_vector_type(4)));
typedef float f32x4 __attribute__((ext_vector_type(4)));
typedef float f32x2 __attribute__((ext_vector_type(2)));
typedef float f32x16 __attribute__((ext_vector_type(16)));
typedef unsigned u32x4 __attribute__((ext_vector_type(4)));
typedef unsigned u32x2 __attribute__((ext_vector_type(2)));
typedef __bf16 bf16x2_t __attribute__((ext_vector_type(2)));
using pg8::Unit;

__device__ __forceinline__ unsigned pk2(float lo, float hi) { f32x2 v = {lo, hi}; bf16x2_t b = __builtin_convertvector(v, bf16x2_t); return __builtin_bit_cast(unsigned, b); }
__device__ __forceinline__ float bflo(unsigned w) { return __uint_as_float(w << 16); }
__device__ __forceinline__ float bfhi(unsigned w) { return __uint_as_float(w & 0xffff0000u); }
__device__ __forceinline__ bf16_t f2bf(float f) { return (bf16_t)(pk2(f, 0.f) & 0xffffu); }
__device__ __forceinline__ float ex2(float x) { return __builtin_amdgcn_exp2f(x); }
__device__ __forceinline__ float wave_sum(float v) {
#pragma unroll
    for (int o = 1; o < 64; o <<= 1) v += __shfl_xor(v, o);
    return v;
}
#define LDSBAR() asm volatile("s_waitcnt lgkmcnt(0)" ::: "memory")
#define MFMA32(a, b, c) __builtin_amdgcn_mfma_f32_32x32x16_bf16((a), (b), (c), 0, 0, 0)
#define MFMA16(a, b, c) __builtin_amdgcn_mfma_f32_16x16x32_bf16((a), (b), (c), 0, 0, 0)

constexpr int DM = 1024, RP = 65536, RS = 256, R = RP + RS, T = 8192, TS = 32, PAST = 4096, TKS = PAST + TS;
constexpr float LOG2E = 1.4426950408889634f;
constexpr float EPS = 1e-6f;
constexpr size_t O_Y = 0, O_RSP = (size_t)R * 1024, O_RSS = O_RSP + 524288, O_FKP = O_RSS + 524288, O_FVP = O_FKP + (size_t)RP * 512,
                 O_LFP = O_FVP + (size_t)RP * 512, O_FKS = O_LFP + (size_t)RP * 8, O_FVS = O_FKS + 131072, O_LFS = O_FVS + 131072,
                 O_S5RP = O_LFS + 2048, O_S5IP = O_S5RP + 32768, O_S5RS = O_S5IP + 32768, O_S5IS = O_S5RS + 32768, O_MK = O_S5IS + 32768,
                 O_MV = O_MK + 4194304, O_END = O_MV + 4194304;
constexpr size_t MiB = 1u << 20;
constexpr size_t WS_W = 1 * MiB, WS_ROPE = 65 * MiB, WS_C2P = 69 * MiB, WS_C2S = 71 * MiB, WS_MEMN = 73 * MiB, WS_MEMK = 81 * MiB, WS_MEMVT = 97 * MiB,
                 WS_S5T = 113 * MiB, WS_LE = 114 * MiB, WS_KVS = 118 * MiB, WS_A = 120 * MiB, WS_B = 249 * MiB, WS_C = 763 * MiB, WS_FKS = 892 * MiB,
                 WS_FVTS = 925 * MiB, WS_END = 960 * MiB;
constexpr size_t W_AB = 0, W_OUT = W_AB + 3840 * 1024, W_INC = W_OUT + 1048576, W_GLU = W_INC + 1048576, W_XQ = W_GLU + 2097152, W_XKV = W_XQ + 2097152,
                 W_XO = W_XKV + 4194304, W_UP = W_XO + 2097152, W_DN = W_UP + 8388608, W_ENDE = W_DN + 8388608;
static_assert(W_ENDE * 2 <= 64 * MiB, "weights region");
constexpr size_t B_RQ = 0, B_RK = (size_t)R * 512, B_RG = 2 * (size_t)R * 512, B_FQ = 3 * (size_t)R * 512, B_FK = 4 * (size_t)R * 512, B_KT = 5 * (size_t)R * 512,
                 B_VT = B_KT + (size_t)RP * 512, B_FVT = B_VT + (size_t)RP * 512, B_KTS = B_FVT + (size_t)RP * 512, B_VTS = B_KTS + 131072, B_ENDE = B_VTS + 131072;
static_assert(B_ENDE * 2 <= 514 * MiB, "region B");
constexpr size_t B_X2 = 129 * MiB / 2;
constexpr int LDS_BYTES = 139264;

struct Params {
    const float* in[33];
    float* out;
    unsigned char* ws;
};

template <int ACT  > struct EpiPlain {
    static constexpr bool PERM = true, AFTER_DRAIN = false;
    bf16_t* O; int ldc; float scale;
    __device__ __forceinline__ void operator()(const f32x4 (&acc)[2][2][4][2], const Unit& u, int wr, int wc, int fr, int fq) const {
        asm volatile("" : "+v"(fr), "+v"(fq));
        bf16_t* base = O + (size_t)(u.pm * 256 + wr * 64 + fr) * ldc + u.pn * 256 + wc * 32 + fq * 8;
#pragma unroll
        for (int ai = 0; ai < 2; ++ai)
#pragma unroll
            for (int m = 0; m < 4; ++m) {
                bf16_t* rp = base + (size_t)(ai * 128 + m * 16) * ldc;
#pragma unroll
                for (int bj = 0; bj < 2; ++bj) {
                    f32x4 v0 = acc[ai][bj][m][0], v1 = acc[ai][bj][m][1];
                    if (ACT == 1) { v0.x = fmaxf(v0.x, 0.f); v0.y = fmaxf(v0.y, 0.f); v0.z = fmaxf(v0.z, 0.f); v0.w = fmaxf(v0.w, 0.f); v0 = v0 * v0;
                                    v1.x = fmaxf(v1.x, 0.f); v1.y = fmaxf(v1.y, 0.f); v1.z = fmaxf(v1.z, 0.f); v1.w = fmaxf(v1.w, 0.f); v1 = v1 * v1; }
                    else { v0 = v0 * scale; v1 = v1 * scale; }
                    u32x4 w; w.x = pk2(v0.x, v0.y); w.y = pk2(v0.z, v0.w); w.z = pk2(v1.x, v1.y); w.w = pk2(v1.z, v1.w);
                    *(u32x4*)(rp + bj * 128) = w;
                }
            }
    }
};
struct EpiGlu {
    static constexpr bool PERM = false, AFTER_DRAIN = false;
    bf16_t* O;
    __device__ __forceinline__ void operator()(const f32x4 (&acc)[2][2][4][2], const Unit& u, int wr, int wc, int fr, int fq) const {
        asm volatile("" : "+v"(fr), "+v"(fq));
#pragma unroll
        for (int ai = 0; ai < 2; ++ai)
#pragma unroll
            for (int m = 0; m < 4; ++m) {
                const int row = u.pm * 256 + ai * 128 + wr * 64 + m * 16 + fr;
                bf16_t* rp = O + (size_t)row * 1024 + u.pn * 128 + wc * 32 + fq * 4;
#pragma unroll
                for (int n = 0; n < 2; ++n) {
                    const f32x4 a = acc[ai][0][m][n], g = acc[ai][1][m][n];
                    f32x4 v;
                    v.x = a.x / (1.f + __expf(-g.x)); v.y = a.y / (1.f + __expf(-g.y)); v.z = a.z / (1.f + __expf(-g.z)); v.w = a.w / (1.f + __expf(-g.w));
                    u32x2 w; w.x = pk2(v.x, v.y); w.y = pk2(v.z, v.w);
                    *(u32x2*)(rp + n * 16) = w;
                }
            }
    }
};
struct EpiMemKV {
    static constexpr bool PERM = false, AFTER_DRAIN = false;
    float* oK; float* oV; bf16_t* mk; bf16_t* mvt; int layer;
    __device__ __forceinline__ void operator()(const f32x4 (&acc)[2][2][4][2], const Unit& u, int wr, int wc, int fr, int fq) const {
        asm volatile("" : "+v"(fr), "+v"(fq));
        const bool isv = u.pn >= 4;
#pragma unroll
        for (int ai = 0; ai < 2; ++ai)
#pragma unroll
            for (int m = 0; m < 4; ++m) {
                const int row = u.pm * 256 + ai * 128 + wr * 64 + m * 16 + fr;
                const int b = row >> 8, mm = row & 255;
#pragma unroll
                for (int bj = 0; bj < 2; ++bj)
#pragma unroll
                    for (int n = 0; n < 2; ++n) {
                        const int col = (u.pn & 3) * 256 + bj * 128 + wc * 32 + n * 16 + fq * 4;
                        const f32x4 v = acc[ai][bj][m][n];
                        if (!isv) {
                            *(f32x4*)(oK + ((size_t)layer * 2048 + row) * 1024 + col) = v;
                            u32x2 w; w.x = pk2(v.x, v.y); w.y = pk2(v.z, v.w);
                            *(u32x2*)(mk + ((size_t)(layer * 16 + b) * 256 + mm) * 1024 + col) = w;
                        } else {
                            *(f32x4*)(oV + ((size_t)layer * 2048 + row) * 1024 + col) = v;
                            bf16_t* p = mvt + ((size_t)(layer * 16 + b) * 1024 + col) * 256 + mm;
                            p[0] = f2bf(v.x); p[256] = f2bf(v.y); p[512] = f2bf(v.z); p[768] = f2bf(v.w);
                        }
                    }
            }
    }
};
__device__ __forceinline__ float logsig(float x) { return x >= 0.f ? -log1pf(__expf(-x)) : x - log1pf(__expf(x)); }
struct EpiAB {
    static constexpr bool PERM = false, AFTER_DRAIN = false;
    bf16_t* B;
    bf16_t* fks; bf16_t* fvts;
    float* out; const float* rope; const float* bfox;
    __device__ __forceinline__ void operator()(const f32x4 (&acc)[2][2][4][2], const Unit& u, int wr, int wc, int fr, int fq) const {
        asm volatile("" : "+v"(fr), "+v"(fq));
        switch (u.pn >> 1) {
            case 0: body<0>(acc, u, wr, wc, fr, fq); break; case 1: body<1>(acc, u, wr, wc, fr, fq); break; case 2: body<2>(acc, u, wr, wc, fr, fq); break;
            case 3: body<3>(acc, u, wr, wc, fr, fq); break; case 4: body<4>(acc, u, wr, wc, fr, fq); break; case 5: body<5>(acc, u, wr, wc, fr, fq); break;
            case 6: body<6>(acc, u, wr, wc, fr, fq); break; default: body<7>(acc, u, wr, wc, fr, fq); break;
        }
    }
    template <int sect> __device__ __forceinline__ void body(const f32x4 (&acc)[2][2][4][2], const Unit& u, int wr, int wc, int fr, int fq) const {
        rowgrp<sect, 0, 0>(acc, u, wr, wc, fr, fq); rowgrp<sect, 0, 1>(acc, u, wr, wc, fr, fq); rowgrp<sect, 0, 2>(acc, u, wr, wc, fr, fq); rowgrp<sect, 0, 3>(acc, u, wr, wc, fr, fq);
        rowgrp<sect, 1, 0>(acc, u, wr, wc, fr, fq); rowgrp<sect, 1, 1>(acc, u, wr, wc, fr, fq); rowgrp<sect, 1, 2>(acc, u, wr, wc, fr, fq); rowgrp<sect, 1, 3>(acc, u, wr, wc, fr, fq);
    }
    template <int sect, int ai, int m> __device__ __forceinline__ void rowgrp(const f32x4 (&acc)[2][2][4][2], const Unit& u, int wr, int wc, int fr, int fq) const {
        const int pn = u.pn;
            {
                const int row = u.pm * 256 + ai * 128 + wr * 64 + m * 16 + fr;
                const bool samp = row >= RP;
                const int rr = row - RP;
                const int b = samp ? (rr >> 5) : (row >> 13);
                const int t = samp ? (rr & 31) : (row & 8191);
                const int pos = samp ? PAST + t : t;
#pragma unroll
                for (int bj = 0; bj < 2; ++bj)
#pragma unroll
                    for (int n = 0; n < 2; ++n) {
                        const int sec = (pn & 1) * 256 + bj * 128 + wc * 32 + n * 16 + fq * 4;
                        f32x4 v = acc[ai][bj][m][n];
                        if constexpr (sect <= 1) {
                            const int hd = sec >> 7, w = sec & 127, i0 = w >> 1;
                            const f32x4 cs = *(const f32x4*)(rope + ((size_t)pos * 64 + i0) * 2);
                            f32x4 o;
                            o.x = v.x * cs.x - v.y * cs.y; o.y = v.y * cs.x + v.x * cs.y;
                            o.z = v.z * cs.z - v.w * cs.w; o.w = v.w * cs.z + v.z * cs.w;
                            if constexpr (sect == 0) {
                                u32x2 wv; wv.x = pk2(o.x, o.y); wv.y = pk2(o.z, o.w);
                                *(u32x2*)(B + B_RQ + (size_t)row * 512 + sec) = wv;
                            } else {
                                o = o * 0.08838834764831845f;
                                u32x2 wv; wv.x = pk2(o.x, o.y); wv.y = pk2(o.z, o.w);
                                *(u32x2*)(B + B_RK + (size_t)row * 512 + sec) = wv;
                                const float lg2 = __log2f(1.f - ex2((float)(-5 - hd)));
                                if (!samp) {
                                    const int j = t & 63; const float wk = ex2(lg2 * (float)(63 - j));
                                    bf16_t* p = B + B_KT + ((size_t)((b * 4 + hd) * 128 + (t >> 6)) * 128 + w) * 64 + j;
                                    p[0] = f2bf(o.x * wk); p[64] = f2bf(o.y * wk); p[128] = f2bf(o.z * wk); p[192] = f2bf(o.w * wk);
                                } else {
                                    const float wk = ex2(lg2 * (float)(31 - t));
                                    bf16_t* p = B + B_KTS + ((size_t)(b * 4 + hd) * 128 + w) * 32 + t;
                                    p[0] = f2bf(o.x * wk); p[32] = f2bf(o.y * wk); p[64] = f2bf(o.z * wk); p[96] = f2bf(o.w * wk);
                                }
                            }
                        } else if constexpr (sect == 2) {
                            const int hd = sec >> 7, w = sec & 127;
                            if (!samp) {
                                bf16_t* p = B + B_VT + ((size_t)((b * 4 + hd) * 128 + (t >> 6)) * 128 + w) * 64 + (t & 63);
                                p[0] = f2bf(v.x); p[64] = f2bf(v.y); p[128] = f2bf(v.z); p[192] = f2bf(v.w);
                            } else {
                                bf16_t* p = B + B_VTS + ((size_t)(b * 4 + hd) * 128 + w) * 32 + t;
                                p[0] = f2bf(v.x); p[32] = f2bf(v.y); p[64] = f2bf(v.z); p[96] = f2bf(v.w);
                            }
                        } else if constexpr (sect == 3) {
                            f32x4 o; o.x = v.x / (1.f + __expf(-v.x)); o.y = v.y / (1.f + __expf(-v.y)); o.z = v.z / (1.f + __expf(-v.z)); o.w = v.w / (1.f + __expf(-v.w));
                            u32x2 wv; wv.x = pk2(o.x, o.y); wv.y = pk2(o.z, o.w);
                            *(u32x2*)(B + B_RG + (size_t)row * 512 + sec) = wv;
                        } else if constexpr (sect == 4) {
                            const f32x4 o = v * (0.125f * LOG2E);
                            u32x2 wv; wv.x = pk2(o.x, o.y); wv.y = pk2(o.z, o.w);
                            *(u32x2*)(B + B_FQ + (size_t)row * 512 + sec) = wv;
                        } else if constexpr (sect == 5) {
                            u32x2 wv; wv.x = pk2(v.x, v.y); wv.y = pk2(v.z, v.w);
                            if (!samp) { *(f32x4*)(out + O_FKP + (size_t)row * 512 + sec) = v; *(u32x2*)(B + B_FK + (size_t)row * 512 + sec) = wv; }
                            else { *(f32x4*)(out + O_FKS + (size_t)rr * 512 + sec) = v; *(u32x2*)(fks + ((size_t)b * TKS + PAST + t) * 512 + sec) = wv; }
                        } else if constexpr (sect == 6) {
                            if (!samp) {
                                *(f32x4*)(out + O_FVP + (size_t)row * 512 + sec) = v;
                                bf16_t* p = B + B_FVT + ((size_t)b * 512 + sec) * T + t;
                                p[0] = f2bf(v.x); p[T] = f2bf(v.y); p[2 * T] = f2bf(v.z); p[3 * T] = f2bf(v.w);
                            } else {
                                *(f32x4*)(out + O_FVS + (size_t)rr * 512 + sec) = v;
                                bf16_t* p = fvts + ((size_t)b * 512 + sec) * TKS + PAST + t;
                                p[0] = f2bf(v.x); p[TKS] = f2bf(v.y); p[2 * TKS] = f2bf(v.z); p[3 * TKS] = f2bf(v.w);
                            }
                        } else {
                            if (sec < 8) {
                                const f32x4 bb = *(const f32x4*)(bfox + sec);
                                f32x4 o; o.x = logsig(v.x + bb.x); o.y = logsig(v.y + bb.y); o.z = logsig(v.z + bb.z); o.w = logsig(v.w + bb.w);
                                if (!samp) *(f32x4*)(out + O_LFP + (size_t)row * 8 + sec) = o;
                                else *(f32x4*)(out + O_LFS + (size_t)rr * 8 + sec) = o;
                            }
                        }
                    }
                asm volatile("" ::: "memory");
            }
    }
};

__device__ __forceinline__ void wtrans(const float* __restrict__ src, int K, int Ns, bf16_t* dst, int Nd, int mode, int gtid, int gsz) {
    const int items = Nd * (K >> 3);
    for (int it = gtid; it < items; it += gsz) {
        const int n = it % Nd, k0 = (it / Nd) << 3;
        int col = n; bool z = false;
        if (mode == 1) { if (n < 1024) { const int w = n & 127; col = (n & ~127) + (w >> 1) + 64 * (w & 1); } else if (n >= 3592) z = true; }
        else if (mode == 2) { col = ((n >> 7) & 1) * 1024 + (n >> 8) * 128 + (n & 127); }
        const float* s = src + (size_t)k0 * Ns + (z ? 0 : col);
        float v0 = s[0], v1 = s[(size_t)Ns], v2 = s[2 * (size_t)Ns], v3 = s[3 * (size_t)Ns], v4 = s[4 * (size_t)Ns], v5 = s[5 * (size_t)Ns], v6 = s[6 * (size_t)Ns], v7 = s[7 * (size_t)Ns];
        u32x4 o; o.x = pk2(v0, v1); o.y = pk2(v2, v3); o.z = pk2(v4, v5); o.w = pk2(v6, v7);
        if (z) o = (u32x4){0u, 0u, 0u, 0u};
        *(u32x4*)(dst + (size_t)n * K + k0) = o;
    }
}
__device__ __forceinline__ void ttrans(const float* __restrict__ src, int rows, int C, bf16_t* dst, size_t dpitch, int gtid, int gsz) {
    const int items = C * (rows >> 3);
    for (int it = gtid; it < items; it += gsz) {
        const int c = it % C, r0 = (it / C) << 3;
        const float* s = src + (size_t)r0 * C + c;
        float v0 = s[0], v1 = s[(size_t)C], v2 = s[2 * (size_t)C], v3 = s[3 * (size_t)C], v4 = s[4 * (size_t)C], v5 = s[5 * (size_t)C], v6 = s[6 * (size_t)C], v7 = s[7 * (size_t)C];
        u32x4 o; o.x = pk2(v0, v1); o.y = pk2(v2, v3); o.z = pk2(v4, v5); o.w = pk2(v6, v7);
        *(u32x4*)(dst + (size_t)c * dpitch + r0) = o;
    }
}
__device__ __forceinline__ void cvt8(const float* __restrict__ s, bf16_t* d) {
    const f32x4 a = *(const f32x4*)s, b = *(const f32x4*)(s + 4);
    u32x4 o; o.x = pk2(a.x, a.y); o.y = pk2(a.z, a.w); o.z = pk2(b.x, b.y); o.w = pk2(b.z, b.w);
    *(u32x4*)d = o;
}
__device__ __forceinline__ void norm_row(const float* xr, const float* g, bf16_t* orow, int lane) {
    f32x4 v[4]; float s = 0.f;
#pragma unroll
    for (int j = 0; j < 4; ++j) { v[j] = ((const f32x4*)xr)[lane + 64 * j]; s += (v[j].x * v[j].x + v[j].y * v[j].y) + (v[j].z * v[j].z + v[j].w * v[j].w); }
    const float rstd = rsqrtf(wave_sum(s) * (1.f / 1024.f) + EPS);
#pragma unroll
    for (int j = 0; j < 4; ++j) { const f32x4 gg = ((const f32x4*)g)[lane + 64 * j]; const f32x4 o = v[j] * rstd * gg; u32x2 w; w.x = pk2(o.x, o.y); w.y = pk2(o.z, o.w); ((u32x2*)orow)[lane + 64 * j] = w; }
}
__device__ __forceinline__ void resnorm_phase(const bf16_t* mix, const float* xp, const float* xs, const float* ga, const float* gb, float* xout, bf16_t* h, int gw, int ngw, int lane) {
    for (int row = gw; row < R; row += ngw) {
        const float* xr = row < RP ? xp + (size_t)row * 1024 : xs + (size_t)(row - RP) * 1024;
        f32x4 xv[4], mv[4]; float s = 0.f;
#pragma unroll
        for (int j = 0; j < 4; ++j) {
            xv[j] = ((const f32x4*)xr)[lane + 64 * j];
            const u32x2 w = ((const u32x2*)(mix + (size_t)row * 1024))[lane + 64 * j];
            mv[j] = (f32x4){bflo(w.x), bfhi(w.x), bflo(w.y), bfhi(w.y)};
            s += (mv[j].x * mv[j].x + mv[j].y * mv[j].y) + (mv[j].z * mv[j].z + mv[j].w * mv[j].w);
        }
        const float rm = rsqrtf(wave_sum(s) * (1.f / 1024.f) + EPS);
        float s2 = 0.f;
#pragma unroll
        for (int j = 0; j < 4; ++j) {
            const f32x4 gg = ((const f32x4*)ga)[lane + 64 * j];
            xv[j] = xv[j] + mv[j] * rm * gg;
            ((f32x4*)(xout + (size_t)row * 1024))[lane + 64 * j] = xv[j];
            s2 += (xv[j].x * xv[j].x + xv[j].y * xv[j].y) + (xv[j].z * xv[j].z + xv[j].w * xv[j].w);
        }
        if (gb) {
            const float rx = rsqrtf(wave_sum(s2) * (1.f / 1024.f) + EPS);
#pragma unroll
            for (int j = 0; j < 4; ++j) { const f32x4 gg = ((const f32x4*)gb)[lane + 64 * j]; const f32x4 o = xv[j] * rx * gg; u32x2 w; w.x = pk2(o.x, o.y); w.y = pk2(o.z, o.w); ((u32x2*)(h + (size_t)row * 1024))[lane + 64 * j] = w; }
        }
    }
}

__device__ __forceinline__ float ret_lg2(int h) { return __log2f(1.f - ex2((float)(-5 - h))); }
__device__ __forceinline__ void ret_passA(const Params& P, int wid, int lane) {
    bf16_t* B = (bf16_t*)(P.ws + WS_B);
    bf16_t* KV = (bf16_t*)(P.ws + WS_C);
    bf16_t* KVS = (bf16_t*)(P.ws + WS_KVS);
    const int l32 = lane & 31, hh = lane >> 5;
    const int mt = wid >> 1, nt0 = (wid & 1) * 2;
    for (int u = blockIdx.x; u < 4096 + 32; u += gridDim.x) {
        const bool samp = u >= 4096;
        f32x16 d0 = {}, d1 = {};
        if (!samp) {
            const bf16_t* vt = B + B_VT + (size_t)u * 8192; const bf16_t* kt = B + B_KT + (size_t)u * 8192;
#pragma unroll
            for (int ks = 0; ks < 4; ++ks) {
                const bf16x8 a = *(const bf16x8*)(vt + (32 * mt + l32) * 64 + 16 * ks + 8 * hh);
                const bf16x8 b0 = *(const bf16x8*)(kt + (32 * nt0 + l32) * 64 + 16 * ks + 8 * hh);
                const bf16x8 b1 = *(const bf16x8*)(kt + (32 * nt0 + 32 + l32) * 64 + 16 * ks + 8 * hh);
                d0 = MFMA32(a, b0, d0); d1 = MFMA32(a, b1, d1);
            }
            bf16_t* o = KV + (size_t)u * 16384;
#pragma unroll
            for (int r = 0; r < 16; ++r) { const int e = 32 * mt + (r & 3) + 8 * (r >> 2) + 4 * hh; o[e * 128 + 32 * nt0 + l32] = f2bf(d0[r]); o[e * 128 + 32 * nt0 + 32 + l32] = f2bf(d1[r]); }
        } else {
            const int bh = u - 4096, hd = bh & 3;
            const bf16_t* vt = B + B_VTS + (size_t)bh * 4096; const bf16_t* kt = B + B_KTS + (size_t)bh * 4096;
#pragma unroll
            for (int ks = 0; ks < 2; ++ks) {
                const bf16x8 a = *(const bf16x8*)(vt + (32 * mt + l32) * 32 + 16 * ks + 8 * hh);
                const bf16x8 b0 = *(const bf16x8*)(kt + (32 * nt0 + l32) * 32 + 16 * ks + 8 * hh);
                const bf16x8 b1 = *(const bf16x8*)(kt + (32 * nt0 + 32 + l32) * 32 + 16 * ks + 8 * hh);
                d0 = MFMA32(a, b0, d0); d1 = MFMA32(a, b1, d1);
            }
            const float g32 = ex2(ret_lg2(hd) * 32.f);
            const float* s0 = P.in[2] + (size_t)bh * 16384; float* so = P.out + O_RSS + (size_t)bh * 16384; bf16_t* sb = KVS + (size_t)bh * 16384;
#pragma unroll
            for (int r = 0; r < 16; ++r) {
                const int e = 32 * mt + (r & 3) + 8 * (r >> 2) + 4 * hh;
#pragma unroll
                for (int q = 0; q < 2; ++q) {
                    const int dp = 32 * nt0 + 32 * q + l32, d = (dp >> 1) + 64 * (dp & 1);
                    const float s = s0[d * 128 + e];
                    so[d * 128 + e] = s * g32 + (q ? d1[r] : d0[r]);
                    sb[e * 128 + dp] = f2bf(s);
                }
            }
        }
    }
}
__device__ __forceinline__ void ret_passB(const Params& P, int tid) {
    unsigned* KV = (unsigned*)(P.ws + WS_C);
    for (int i = blockIdx.x * 512 + tid; i < 32 * 8192; i += gridDim.x * 512) {
        const int bh = i >> 13, idx = i & 8191;
        const float dec = ex2(ret_lg2(bh & 3) * 64.f);
        unsigned* p = KV + (size_t)bh * 128 * 8192 + idx;
        float s0 = 0.f, s1 = 0.f;
        for (int n0 = 0; n0 < 128; n0 += 16) {
            unsigned v[16];
#pragma unroll
            for (int k = 0; k < 16; ++k) v[k] = p[(size_t)(n0 + k) * 8192];
#pragma unroll
            for (int k = 0; k < 16; ++k) { p[(size_t)(n0 + k) * 8192] = pk2(s0, s1); s0 = s0 * dec + bflo(v[k]); s1 = s1 * dec + bfhi(v[k]); }
        }
        const int e = idx >> 6, dp = (idx & 63) * 2;
        float* so = P.out + O_RSP + (size_t)bh * 16384;
        so[(dp >> 1) * 128 + e] = s0;
        so[((dp >> 1) + 64) * 128 + e] = s1;
    }
}
template <int L> __device__ __forceinline__ void ret_unitC(const Params& P, LAS float* red, int bh, int n, int wid, int lane) {
    const bf16_t* B = (const bf16_t*)(P.ws + WS_B);
    const int l32 = lane & 31, hh = lane >> 5, hd = bh & 3, b = bh >> 2;
    const int et = wid >> 1, it = wid & 1;
    const bool act = (L == 64) || (it == 0);
    const int row0 = (L == 64) ? (b * T + n * 64) : (RP + b * 32);
    const bf16_t* sbef = (L == 64) ? (const bf16_t*)(P.ws + WS_C) + (size_t)(bh * 128 + n) * 16384 : (const bf16_t*)(P.ws + WS_KVS) + (size_t)bh * 16384;
    const bf16_t* vt = (L == 64) ? B + B_VT + (size_t)(bh * 128 + n) * 8192 : B + B_VTS + (size_t)bh * 4096;
    const float lg2 = ret_lg2(hd);
    const int i = 32 * it + l32;
    f32x16 acc = {};
    float s1 = 0.f, s2 = 0.f;
    if (act) {
        bf16x8 qf[8];
#pragma unroll
        for (int ks = 0; ks < 8; ++ks) qf[ks] = *(const bf16x8*)(B + B_RQ + (size_t)(row0 + i) * 512 + hd * 128 + 16 * ks + 8 * hh);
#pragma unroll
        for (int ks = 0; ks < 8; ++ks) { const bf16x8 a = *(const bf16x8*)(sbef + (32 * et + l32) * 128 + 16 * ks + 8 * hh); acc = MFMA32(a, qf[ks], acc); }
        acc = acc * ex2(lg2 * (float)(i + 1));
#pragma unroll
        for (int jt = 0; jt < L / 32; ++jt) {
            f32x16 sc = {};
#pragma unroll
            for (int ks = 0; ks < 8; ++ks) { const bf16x8 a = *(const bf16x8*)(B + B_RK + (size_t)(row0 + 32 * jt + l32) * 512 + hd * 128 + 16 * ks + 8 * hh); sc = MFMA32(a, qf[ks], sc); }
#pragma unroll
            for (int r = 0; r < 16; ++r) { const int j = 32 * jt + (r & 3) + 8 * (r >> 2) + 4 * hh; const int dd = i > j ? i - j : j - i; sc[r] = sc[r] * ex2(lg2 * (float)dd); }
#pragma unroll
            for (int s = 0; s < 2; ++s) {
                u32x4 pw; pw.x = pk2(sc[8 * s], sc[8 * s + 1]); pw.y = pk2(sc[8 * s + 2], sc[8 * s + 3]); pw.z = pk2(sc[8 * s + 4], sc[8 * s + 5]); pw.w = pk2(sc[8 * s + 6], sc[8 * s + 7]);
                const bf16x8 pf = __builtin_bit_cast(bf16x8, pw);
                const bf16_t* vb = vt + (32 * et + l32) * L + 32 * jt + 16 * s + 4 * hh;
                const u32x2 lo = *(const u32x2*)vb, hi = *(const u32x2*)(vb + 8);
                const u32x4 vw = {lo.x, lo.y, hi.x, hi.y};
                acc = MFMA32(__builtin_bit_cast(bf16x8, vw), pf, acc);
            }
        }
#pragma unroll
        for (int r = 0; r < 16; ++r) { s1 += acc[r]; s2 += acc[r] * acc[r]; }
        s1 += __shfl_xor(s1, 32); s2 += __shfl_xor(s2, 32);
        if (hh == 0) { red[et * 64 + i] = s1; red[256 + et * 64 + i] = s2; }
    }
    __syncthreads();
    if (act) {
        const float t1 = red[i] + red[64 + i] + red[128 + i] + red[192 + i];
        const float t2 = red[256 + i] + red[320 + i] + red[384 + i] + red[448 + i];
        const float mu = t1 * (1.f / 128.f), var = fmaxf(t2 * (1.f / 128.f) - mu * mu, 0.f), rstd = rsqrtf(var + EPS);
        const float* gw = P.in[14] + hd * 128;
        bf16_t* mixed = (bf16_t*)(P.ws + WS_A);
#pragma unroll
        for (int g = 0; g < 4; ++g) {
            const int e = 32 * et + 8 * g + 4 * hh;
            const f32x4 w4 = *(const f32x4*)(gw + e);
            const u32x2 gt = *(const u32x2*)(B + B_RG + (size_t)(row0 + i) * 512 + hd * 128 + e);
            f32x4 o;
            o.x = (acc[4 * g] - mu) * rstd * w4.x * bflo(gt.x); o.y = (acc[4 * g + 1] - mu) * rstd * w4.y * bfhi(gt.x);
            o.z = (acc[4 * g + 2] - mu) * rstd * w4.z * bflo(gt.y); o.w = (acc[4 * g + 3] - mu) * rstd * w4.w * bfhi(gt.y);
            u32x2 w; w.x = pk2(o.x, o.y); w.y = pk2(o.z, o.w);
            *(u32x2*)(mixed + (size_t)(row0 + i) * 1024 + hd * 128 + e) = w;
        }
    }
    __syncthreads();
}

struct FoxUnit { const bf16_t* Q; const bf16_t* K; const bf16_t* VT; const float* c2; bf16_t* O; int vtp, qpos0, nq, ntiles, Tk; };
constexpr int FOX_BUF = 18432, FOX_VOFF = 9216, FOX_COFF = 17920;
__device__ __forceinline__ void fox_unit(LAS unsigned char* lds, const FoxUnit U, int tid, int wid, int lane) {
    const int l32 = lane & 31, hh = lane >> 5;
    const bool active = wid * 32 < U.nq;
    bf16x8 qf[4];
#pragma unroll
    for (int s = 0; s < 4; ++s) qf[s] = active ? *(const bf16x8*)(U.Q + (size_t)(wid * 32 + l32) * 512 + 16 * s + 8 * hh) : (bf16x8){0, 0, 0, 0, 0, 0, 0, 0};
    const int wq_lo = U.qpos0 + wid * 32, wq_hi = wq_lo + 31, qpos = wq_lo + l32;
    float m = -INFINITY, l = 0.f; f32x16 o0 = {}, o1 = {};
    const int srow = tid >> 3, sch = tid & 7;
    u32x4 kr, vr; float cr = 0.f;
#define FOX_LOAD(t) do { int key_ = (t) * 64 + srow; key_ = key_ < U.Tk ? key_ : U.Tk - 1; kr = *(const u32x4*)(U.K + (size_t)key_ * 512 + sch * 8); \
        vr = *(const u32x4*)(U.VT + (size_t)srow * U.vtp + (t) * 64 + sch * 8); \
        if (tid < 64) { int kc_ = (t) * 64 + tid; kc_ = kc_ < U.Tk ? kc_ : U.Tk - 1; cr = U.c2[kc_]; } } while (0)
#define FOX_STORE(bi) do { LAS unsigned char* kb_ = lds + (bi) * FOX_BUF; *(LAS u32x4*)(kb_ + srow * 144 + sch * 16) = kr; \
        *(LAS u32x2*)(kb_ + FOX_VOFF + srow * 136 + sch * 16) = (u32x2){vr.x, vr.y}; *(LAS u32x2*)(kb_ + FOX_VOFF + srow * 136 + sch * 16 + 8) = (u32x2){vr.z, vr.w}; \
        if (tid < 64) *(LAS float*)(kb_ + FOX_COFF + tid * 4) = -cr; } while (0)
    FOX_LOAD(0); FOX_STORE(0);
    __syncthreads();
    for (int t = 0; t < U.ntiles; ++t) {
        const bool more = t + 1 < U.ntiles;
        if (more) FOX_LOAD(t + 1);
        if (active && t * 64 <= wq_hi) {
            LAS unsigned char* kb = lds + (t & 1) * FOX_BUF;
            f32x16 p0, p1;
#pragma unroll
            for (int g = 0; g < 4; ++g) {
                const f32x4 c0 = *(LAS f32x4*)(kb + FOX_COFF + (8 * g + 4 * hh) * 4), c1 = *(LAS f32x4*)(kb + FOX_COFF + (32 + 8 * g + 4 * hh) * 4);
                p0[4 * g] = c0.x; p0[4 * g + 1] = c0.y; p0[4 * g + 2] = c0.z; p0[4 * g + 3] = c0.w;
                p1[4 * g] = c1.x; p1[4 * g + 1] = c1.y; p1[4 * g + 2] = c1.z; p1[4 * g + 3] = c1.w;
            }
#pragma unroll
            for (int s = 0; s < 4; ++s) {
                const bf16x8 a0 = *(LAS bf16x8*)(kb + l32 * 144 + (2 * s + hh) * 16), a1 = *(LAS bf16x8*)(kb + (32 + l32) * 144 + (2 * s + hh) * 16);
                p0 = MFMA32(a0, qf[s], p0); p1 = MFMA32(a1, qf[s], p1);
            }
            if (t * 64 + 63 > wq_lo) {
#pragma unroll
                for (int r = 0; r < 16; ++r) { const int key = t * 64 + (r & 3) + 8 * (r >> 2) + 4 * hh; if (key > qpos) p0[r] = -INFINITY; if (key + 32 > qpos) p1[r] = -INFINITY; }
            }
            float mx = fmaxf(p0[0], p1[0]);
#pragma unroll
            for (int r = 1; r < 16; ++r) mx = fmaxf(mx, fmaxf(p0[r], p1[r]));
            mx = fmaxf(mx, __shfl_xor(mx, 32));
            const float mn = fmaxf(m, mx), alpha = ex2(m - mn); m = mn;
            float rs = 0.f;
#pragma unroll
            for (int r = 0; r < 16; ++r) { p0[r] = ex2(p0[r] - mn); p1[r] = ex2(p1[r] - mn); rs += p0[r] + p1[r]; }
            l = l * alpha + rs; o0 = o0 * alpha; o1 = o1 * alpha;
#pragma unroll
            for (int s = 0; s < 4; ++s) {
                u32x4 pw;
                if (s < 2) { pw.x = pk2(p0[8 * s], p0[8 * s + 1]); pw.y = pk2(p0[8 * s + 2], p0[8 * s + 3]); pw.z = pk2(p0[8 * s + 4], p0[8 * s + 5]); pw.w = pk2(p0[8 * s + 6], p0[8 * s + 7]); }
                else { const int q = 8 * (s - 2); pw.x = pk2(p1[q], p1[q + 1]); pw.y = pk2(p1[q + 2], p1[q + 3]); pw.z = pk2(p1[q + 4], p1[q + 5]); pw.w = pk2(p1[q + 6], p1[q + 7]); }
                const bf16x8 pf = __builtin_bit_cast(bf16x8, pw);
                LAS unsigned char* vb = kb + FOX_VOFF + l32 * 136 + (16 * s + 4 * hh) * 2;
                const u32x2 a = *(LAS u32x2*)vb, b = *(LAS u32x2*)(vb + 16), c = *(LAS u32x2*)(vb + 32 * 136), d = *(LAS u32x2*)(vb + 32 * 136 + 16);
                const u32x4 v0 = {a.x, a.y, b.x, b.y}, v1 = {c.x, c.y, d.x, d.y};
                o0 = MFMA32(__builtin_bit_cast(bf16x8, v0), pf, o0); o1 = MFMA32(__builtin_bit_cast(bf16x8, v1), pf, o1);
            }
        }
        if (more) FOX_STORE((t + 1) & 1);
        __syncthreads();
    }
#undef FOX_LOAD
#undef FOX_STORE
    if (active) {
        const float inv = 1.f / (l + __shfl_xor(l, 32));
        bf16_t* op = U.O + (size_t)(wid * 32 + l32) * 1024 + 4 * hh;
#pragma unroll
        for (int g = 0; g < 4; ++g) {
            u32x2 w; w.x = pk2(o0[4 * g] * inv, o0[4 * g + 1] * inv); w.y = pk2(o0[4 * g + 2] * inv, o0[4 * g + 3] * inv); *(u32x2*)(op + 8 * g) = w;
            w.x = pk2(o1[4 * g] * inv, o1[4 * g + 1] * inv); w.y = pk2(o1[4 * g + 2] * inv, o1[4 * g + 3] * inv); *(u32x2*)(op + 32 + 8 * g) = w;
        }
    }
}
__device__ __forceinline__ void fox_phase(const Params& P, LAS unsigned char* lds, int tid, int wid, int lane) {
    const bf16_t* B = (const bf16_t*)(P.ws + WS_B);
    bf16_t* mixed = (bf16_t*)(P.ws + WS_A);
    for (int it = blockIdx.x; it < 1024 + 64; it += gridDim.x) {
        if (it < 1024) {
            const int bh = it >> 4, pi = it & 15, b = bh >> 3, hd = bh & 7;
#pragma unroll 1
            for (int k = 0; k < 2; ++k) {
                const int qb = k ? 31 - pi : pi;
                FoxUnit U;
                U.Q = B + B_FQ + (size_t)(b * T + qb * 256) * 512 + hd * 64; U.K = B + B_FK + (size_t)b * T * 512 + hd * 64;
                U.VT = B + B_FVT + (size_t)(b * 512 + hd * 64) * T; U.c2 = (const float*)(P.ws + WS_C2P) + (size_t)bh * T;
                U.O = mixed + (size_t)(b * T + qb * 256) * 1024 + 512 + hd * 64; U.vtp = T; U.qpos0 = qb * 256; U.nq = 256; U.ntiles = 4 * (qb + 1); U.Tk = T;
                fox_unit(lds, U, tid, wid, lane);
            }
        } else {
            const int bh = it - 1024, b = bh >> 3, hd = bh & 7;
            FoxUnit U;
            U.Q = B + B_FQ + (size_t)(RP + b * 32) * 512 + hd * 64; U.K = (const bf16_t*)(P.ws + WS_FKS) + (size_t)b * TKS * 512 + hd * 64;
            U.VT = (const bf16_t*)(P.ws + WS_FVTS) + (size_t)(b * 512 + hd * 64) * TKS; U.c2 = (const float*)(P.ws + WS_C2S) + (size_t)bh * TKS;
            U.O = mixed + (size_t)(RP + b * 32) * 1024 + 512 + hd * 64; U.vtp = TKS; U.qpos0 = PAST; U.nq = 32; U.ntiles = 65; U.Tk = TKS;
            fox_unit(lds, U, tid, wid, lane);
        }
    }
}

constexpr int XA_BUF = 16896;
__device__ __forceinline__ void xattn_unit(LAS unsigned char* lds, const bf16_t* Q, const bf16_t* Kb, const bf16_t* VTb, bf16_t* O, int nwaves, int tid, int wid, int lane) {
    const int l32 = lane & 31, hh = lane >> 5;
    const bool active = wid < nwaves;
    bf16x8 qf[16];
#pragma unroll
    for (int s = 0; s < 16; ++s) qf[s] = active ? *(const bf16x8*)(Q + (size_t)(wid * 32 + l32) * 1024 + 16 * s + 8 * hh) : (bf16x8){0, 0, 0, 0, 0, 0, 0, 0};
    f32x16 S[4];
    bf16x8 pf[16];
    float m1 = 0.f, l1 = 0.f, a1 = 0.f, a2 = 0.f;
    u32x4 r0, r1;
    const int i0 = tid, i1 = tid + 512;
    const bf16_t* g0 = Kb + (size_t)(i0 >> 5) * 1024 + (i0 & 31) * 8; const bf16_t* g1 = Kb + (size_t)(i1 >> 5) * 1024 + (i1 & 31) * 8;
    const bf16_t* h0 = VTb + (size_t)(i0 >> 5) * 256 + (i0 & 31) * 8; const bf16_t* h1 = VTb + (size_t)(i1 >> 5) * 256 + (i1 & 31) * 8;
#define XA_LOAD(tt) do { if ((tt) < 8) { r0 = *(const u32x4*)g0; r1 = *(const u32x4*)g1; g0 += 32 * 1024; g1 += 32 * 1024; asm volatile("" : "+v"(g0), "+v"(g1)); } \
        else { r0 = *(const u32x4*)h0; r1 = *(const u32x4*)h1; h0 += 32 * 256; h1 += 32 * 256; asm volatile("" : "+v"(h0), "+v"(h1)); } } while (0)
#define XA_STORE(bi) do { LAS unsigned char* b_ = lds + (bi) * XA_BUF; *(LAS u32x4*)(b_ + (i0 >> 5) * 528 + (i0 & 31) * 16) = r0; *(LAS u32x4*)(b_ + (i1 >> 5) * 528 + (i1 & 31) * 16) = r1; } while (0)
#define XA_HALF(hf, mm, ll) do { float mx_ = S[0][0]; \
        _Pragma("unroll") for (int k = 0; k < 4; ++k) _Pragma("unroll") for (int r = 0; r < 16; ++r) mx_ = fmaxf(mx_, S[k][r]); \
        mx_ = fmaxf(mx_, __shfl_xor(mx_, 32)); float l_ = 0.f; \
        _Pragma("unroll") for (int k = 0; k < 4; ++k) { \
            _Pragma("unroll") for (int r = 0; r < 16; ++r) { S[k][r] = ex2(S[k][r] - mx_); l_ += S[k][r]; } \
            _Pragma("unroll") for (int s = 0; s < 2; ++s) { u32x4 pw; pw.x = pk2(S[k][8 * s], S[k][8 * s + 1]); pw.y = pk2(S[k][8 * s + 2], S[k][8 * s + 3]); pw.z = pk2(S[k][8 * s + 4], S[k][8 * s + 5]); pw.w = pk2(S[k][8 * s + 6], S[k][8 * s + 7]); \
                pf[8 * (hf) + 2 * k + s] = __builtin_bit_cast(bf16x8, pw); } } \
        mm = mx_; ll = l_ + __shfl_xor(l_, 32); } while (0)
    XA_LOAD(0); XA_STORE(0);
    __syncthreads();
#pragma unroll
    for (int tt = 0; tt < 16; ++tt) {
        if (tt + 1 < 16) XA_LOAD(tt + 1);
        LAS unsigned char* buf = lds + (tt & 1) * XA_BUF;
        if (active) {
            if (tt < 8) {
                f32x16 s = {};
#pragma unroll
                for (int k = 0; k < 16; ++k) { const bf16x8 a = *(LAS bf16x8*)(buf + l32 * 528 + (2 * k + hh) * 16); s = MFMA32(a, qf[k], s); }
                S[tt & 3] = s;
                if (tt == 3) XA_HALF(0, m1, l1);
                if (tt == 7) {
                    float m2, l2; XA_HALF(1, m2, l2);
                    const float mm = fmaxf(m1, m2); a1 = ex2(m1 - mm); a2 = ex2(m2 - mm);
                    const float inv = 1.f / (a1 * l1 + a2 * l2); a1 *= inv; a2 *= inv;
                }
            } else {
                f32x16 o1 = {}, o2 = {};
#pragma unroll
                for (int k = 0; k < 16; ++k) {
                    LAS unsigned char* vb = buf + l32 * 528 + (16 * k + 4 * hh) * 2;
                    const u32x2 a = *(LAS u32x2*)vb, b = *(LAS u32x2*)(vb + 16);
                    const u32x4 vw = {a.x, a.y, b.x, b.y};
                    if (k < 8) o1 = MFMA32(__builtin_bit_cast(bf16x8, vw), pf[k], o1); else o2 = MFMA32(__builtin_bit_cast(bf16x8, vw), pf[k], o2);
                }
                bf16_t* op = O + (size_t)(wid * 32 + l32) * 1024 + 32 * (tt - 8) + 4 * hh;
#pragma unroll
                for (int g = 0; g < 4; ++g) { u32x2 w; w.x = pk2(o1[4 * g] * a1 + o2[4 * g] * a2, o1[4 * g + 1] * a1 + o2[4 * g + 1] * a2); w.y = pk2(o1[4 * g + 2] * a1 + o2[4 * g + 2] * a2, o1[4 * g + 3] * a1 + o2[4 * g + 3] * a2); *(u32x2*)(op + 8 * g) = w; }
            }
        }
        if (tt + 1 < 16) XA_STORE((tt + 1) & 1);
        __syncthreads();
    }
#undef XA_HALF
#undef XA_LOAD
#undef XA_STORE
}
__device__ __forceinline__ void xattn_phase(const Params& P, LAS unsigned char* lds, int layer, int tid, int wid, int lane) {
    const bf16_t* XQ = (const bf16_t*)(P.ws + WS_B);
    bf16_t* XO = (bf16_t*)(P.ws + WS_B) + B_X2;
    const bf16_t* MK = (const bf16_t*)(P.ws + WS_MEMK); const bf16_t* MVT = (const bf16_t*)(P.ws + WS_MEMVT);
    for (int it = blockIdx.x; it < 1024 + 32; it += gridDim.x) {
        int row0, set, hd, nw;
        if (it < 1024) { const int pm = it >> 2; hd = it & 3; row0 = pm * 256; set = layer * 16 + (pm >> 5); nw = 8; }
        else { const int q = it - 1024, b = q >> 2; hd = q & 3; row0 = RP + b * 32; set = layer * 16 + 8 + b; nw = 1; }
        xattn_unit(lds, XQ + (size_t)row0 * 1024 + hd * 256, MK + (size_t)set * 262144 + hd * 256, MVT + ((size_t)set * 1024 + hd * 256) * 256, XO + (size_t)row0 * 1024 + hd * 256, nw, tid, wid, lane);
    }
}

__device__ __forceinline__ void s5_run(LAS unsigned char* wl, const bf16_t* U, bf16_t* Y, int row0, int L, int g, f32x2 a, float& xr, float& xi, bool outp,
                                       const bf16_t* SB5, const bf16_t* SC5, const float* s5d, int lane) {
    const int l32 = lane & 31, hh = lane >> 5, l16 = lane & 15, q4 = lane >> 4;
    bf16x8 bfr[4], cfr[4];
#pragma unroll
    for (int k = 0; k < 4; ++k) { bfr[k] = *(const bf16x8*)(SB5 + ((size_t)(g * 4 + k) * 64 + lane) * 8); cfr[k] = *(const bf16x8*)(SC5 + ((size_t)(g * 4 + k) * 64 + lane) * 8); }
    const f32x4 dv = *(const f32x4*)(s5d + g * 16 + 4 * q4);
    for (int sc = 0; sc < L / 32; ++sc) {
        const int r0 = row0 + sc * 32;
        const bf16x8 uf = *(const bf16x8*)(U + (size_t)(r0 + l32) * 1024 + g * 16 + 8 * hh);
        const f32x16 z = {};
        const f32x16 d0 = MFMA32(uf, bfr[0], z), d1 = MFMA32(uf, bfr[1], z), d2 = MFMA32(uf, bfr[2], z), d3 = MFMA32(uf, bfr[3], z);
#pragma unroll
        for (int r = 0; r < 16; ++r) {
            const int tok = (r & 3) + 8 * (r >> 2) + 4 * hh;
            *(LAS f32x2*)(wl + tok * 528 + l32 * 8) = (f32x2){d0[r], d2[r]};
            *(LAS f32x2*)(wl + tok * 528 + (32 + l32) * 8) = (f32x2){d1[r], d3[r]};
        }
        LDSBAR();
#pragma unroll 8
        for (int t = 0; t < 32; ++t) {
            const f32x2 bu = *(LAS f32x2*)(wl + t * 528 + lane * 8);
            const float nr = a.x * xr - a.y * xi + bu.x, ni = a.x * xi + a.y * xr + bu.y;
            xr = nr; xi = ni;
            if (outp) { asm volatile("" ::: "memory"); *(LAS float*)(wl + t * 528 + lane * 4) = __uint_as_float(pk2(xr, xi)); }
        }
        LDSBAR();
        if (outp) {
#pragma unroll
            for (int tb = 0; tb < 2; ++tb) {
                f32x4 acc = {0.f, 0.f, 0.f, 0.f};
#pragma unroll
                for (int ks = 0; ks < 4; ++ks) { const bf16x8 xf = *(LAS bf16x8*)(wl + (16 * tb + l16) * 528 + (32 * ks + 8 * q4) * 2); acc = MFMA16(cfr[ks], xf, acc); }
                const size_t off = (size_t)(r0 + 16 * tb + l16) * 1024 + g * 16 + 4 * q4;
                const u32x2 uu = *(const u32x2*)(U + off);
                f32x4 y; y.x = acc.x + dv.x * bflo(uu.x); y.y = acc.y + dv.y * bfhi(uu.x); y.z = acc.z + dv.z * bflo(uu.y); y.w = acc.w + dv.w * bfhi(uu.y);
                u32x2 w; w.x = pk2(y.x, y.y); w.y = pk2(y.z, y.w);
                *(u32x2*)(Y + off) = w;
            }
        }
        LDSBAR();
    }
}
constexpr int S5_NSEG = 16, S5_LSEG = 512;
__device__ __forceinline__ void s5_phase(const Params& P, LAS unsigned char* lds, int pass, int wid, int lane) {
    const bf16_t* U = (const bf16_t*)(P.ws + WS_B);
    bf16_t* Y = (bf16_t*)(P.ws + WS_B) + B_X2;
    const f32x2* S5A = (const f32x2*)(P.ws + WS_S5T); const f32x2* S5AL = S5A + 4096;
    const bf16_t* SB5 = (const bf16_t*)(P.ws + WS_S5T + 65536); const bf16_t* SC5 = SB5 + 131072;
    f32x2* LE = (f32x2*)(P.ws + WS_LE);
    LAS unsigned char* wl = lds + wid * 16896;
    const int nunits = (pass == 1) ? 8 * (S5_NSEG - 1) * 8 : 8 * S5_NSEG * 8 + 64;
    for (int it = blockIdx.x; it < nunits; it += gridDim.x) {
        if (pass == 1) {
            const int g8 = it & 7, seg = (it >> 3) % (S5_NSEG - 1), b = (it >> 3) / (S5_NSEG - 1), g = g8 * 8 + wid;
            float xr = 0.f, xi = 0.f;
            s5_run(wl, U, Y, b * T + seg * S5_LSEG, S5_LSEG, g, S5A[g * 64 + lane], xr, xi, false, SB5, SC5, P.in[24], lane);
            LE[((size_t)(b * S5_NSEG + seg) * 64 + g) * 64 + lane] = (f32x2){xr, xi};
        } else if (it < 8 * S5_NSEG * 8) {
            const int g8 = it & 7, seg = (it >> 3) & (S5_NSEG - 1), b = it >> 7, g = g8 * 8 + wid;
            const f32x2 aL = S5AL[g * 64 + lane];
            float xr = 0.f, xi = 0.f;
            for (int s = 0; s < seg; ++s) { const f32x2 le = LE[((size_t)(b * S5_NSEG + s) * 64 + g) * 64 + lane]; const float nr = aL.x * xr - aL.y * xi + le.x, ni = aL.x * xi + aL.y * xr + le.y; xr = nr; xi = ni; }
            s5_run(wl, U, Y, b * T + seg * S5_LSEG, S5_LSEG, g, S5A[g * 64 + lane], xr, xi, true, SB5, SC5, P.in[24], lane);
            if (seg == S5_NSEG - 1) { P.out[O_S5RP + (size_t)(b * 64 + g) * 64 + lane] = xr; P.out[O_S5IP + (size_t)(b * 64 + g) * 64 + lane] = xi; }
        } else {
            const int q = it - 8 * S5_NSEG * 8, g8 = q & 7, b = q >> 3, g = g8 * 8 + wid;
            float xr = P.in[6][(size_t)(b * 64 + g) * 64 + lane], xi = P.in[7][(size_t)(b * 64 + g) * 64 + lane];
            s5_run(wl, U, Y, RP + b * 32, 32, g, S5A[g * 64 + lane], xr, xi, true, SB5, SC5, P.in[24], lane);
            P.out[O_S5RS + (size_t)(b * 64 + g) * 64 + lane] = xr; P.out[O_S5IS + (size_t)(b * 64 + g) * 64 + lane] = xi;
        }
    }
}

__device__ __forceinline__ void prologue(const Params& P, int tid, int wid, int lane) {
    const int gtid = blockIdx.x * 512 + tid, gsz = gridDim.x * 512;
    const int gw = blockIdx.x * 8 + wid, ngw = gridDim.x * 8;
    bf16_t* W = (bf16_t*)(P.ws + WS_W);
    wtrans(P.in[12], 1024, 3592, W + W_AB, 3840, 1, gtid, gsz);
    wtrans(P.in[15], 1024, 1024, W + W_OUT, 1024, 0, gtid, gsz);
    wtrans(P.in[16], 1024, 1024, W + W_INC, 1024, 0, gtid, gsz);
    wtrans(P.in[25], 1024, 2048, W + W_GLU, 2048, 2, gtid, gsz);
    for (int l = 0; l < 2; ++l) {
        wtrans(P.in[27] + (size_t)l * 1048576, 1024, 1024, W + W_XQ + (size_t)l * 1048576, 1024, 0, gtid, gsz);
        wtrans(P.in[28] + (size_t)l * 1048576, 1024, 1024, W + W_XKV + (size_t)l * 2097152, 1024, 0, gtid, gsz);
        wtrans(P.in[29] + (size_t)l * 1048576, 1024, 1024, W + W_XKV + (size_t)l * 2097152 + 1048576, 1024, 0, gtid, gsz);
        wtrans(P.in[30] + (size_t)l * 1048576, 1024, 1024, W + W_XO + (size_t)l * 1048576, 1024, 0, gtid, gsz);
        wtrans(P.in[31] + (size_t)l * 4194304, 1024, 4096, W + W_UP + (size_t)l * 4194304, 4096, 0, gtid, gsz);
        wtrans(P.in[32] + (size_t)l * 4194304, 4096, 1024, W + W_DN + (size_t)l * 4194304, 1024, 0, gtid, gsz);
    }
    {
        float* rope = (float*)(P.ws + WS_ROPE);
        for (int i = gtid; i < 8192 * 64; i += gsz) {
            const int pos = i >> 6, k = i & 63;
            const double inv = exp2(-(double)k * (13.287712379549449 / 64.0));
            const double ang = (double)pos * inv;
            rope[2 * i] = (float)cos(ang); rope[2 * i + 1] = (float)sin(ang);
        }
    }
    {
        f32x2* S5A = (f32x2*)(P.ws + WS_S5T); f32x2* S5AL = S5A + 4096;
        bf16_t* SB5 = (bf16_t*)(P.ws + WS_S5T + 65536); bf16_t* SC5 = SB5 + 131072;
        for (int i = gtid; i < 4096; i += gsz) {
            const int g = i >> 6, p = i & 63;
            const double lr = P.in[17][i], li = P.in[18][i], dt = exp((double)P.in[19][g]);
            const double mag = exp(lr * dt), ar = mag * cos(li * dt), ai = mag * sin(li * dt);
            S5A[i] = (f32x2){(float)ar, (float)ai};
            const double magL = exp(lr * dt * S5_LSEG);
            S5AL[i] = (f32x2){(float)(magL * cos(li * dt * S5_LSEG)), (float)(magL * sin(li * dt * S5_LSEG))};
            const double den = lr * lr + li * li, nre = ar - 1.0;
            const double fr = (nre * lr + ai * li) / den, fi = (ai * lr - nre * li) / den;
            const float* br = P.in[20] + (size_t)i * 16; const float* bi = P.in[21] + (size_t)i * 16;
#pragma unroll
            for (int part = 0; part < 2; ++part)
#pragma unroll
                for (int h2 = 0; h2 < 2; ++h2) {
                    float v[8];
#pragma unroll
                    for (int k = 0; k < 8; ++k) { const int c = 8 * h2 + k; v[k] = part == 0 ? (float)(fr * br[c] - fi * bi[c]) : (float)(fr * bi[c] + fi * br[c]); }
                    u32x4 o; o.x = pk2(v[0], v[1]); o.y = pk2(v[2], v[3]); o.z = pk2(v[4], v[5]); o.w = pk2(v[6], v[7]);
                    const int kb = 2 * part + (p >> 5), ln = (p & 31) + 32 * h2;
                    *(u32x4*)(SB5 + ((size_t)(g * 4 + kb) * 64 + ln) * 8) = o;
                }
        }
        for (int i = gtid; i < 64 * 4 * 64; i += gsz) {
            const int ln = i & 63, ks = (i >> 6) & 3, g = i >> 8;
            const int c = ln & 15;
            float v[8];
#pragma unroll
            for (int k = 0; k < 8; ++k) { const int kidx = 32 * ks + 8 * (ln >> 4) + k, p = kidx >> 1; v[k] = (kidx & 1) ? -P.in[23][((size_t)g * 16 + c) * 64 + p] : P.in[22][((size_t)g * 16 + c) * 64 + p]; }
            u32x4 o; o.x = pk2(v[0], v[1]); o.y = pk2(v[2], v[3]); o.z = pk2(v[4], v[5]); o.w = pk2(v[6], v[7]);
            *(u32x4*)(SC5 + (size_t)i * 8) = o;
        }
    }
    {
        bf16_t* FKS = (bf16_t*)(P.ws + WS_FKS); bf16_t* FVTS = (bf16_t*)(P.ws + WS_FVTS);
        for (int i = gtid; i < 8 * PAST * 64; i += gsz) { const int b = i / (PAST * 64), r = i % (PAST * 64); cvt8(P.in[3] + (size_t)i * 8, FKS + (size_t)b * TKS * 512 + (size_t)r * 8); }
        for (int b = 0; b < 8; ++b) ttrans(P.in[4] + (size_t)b * PAST * 512, PAST, 512, FVTS + (size_t)b * 512 * TKS, TKS, gtid, gsz);
        bf16_t* MK = (bf16_t*)(P.ws + WS_MEMK); bf16_t* MVT = (bf16_t*)(P.ws + WS_MEMVT);
        for (int i = gtid; i < 2 * 8 * 32768; i += gsz) { const int lb = i >> 15, r = i & 32767, l = lb >> 3, b = lb & 7; cvt8(P.in[8] + (size_t)i * 8, MK + (size_t)(l * 16 + 8 + b) * 262144 + (size_t)r * 8); }
        for (int lb = 0; lb < 16; ++lb) { const int l = lb >> 3, b = lb & 7; ttrans(P.in[9] + (size_t)lb * 262144, 256, 1024, MVT + (size_t)(l * 16 + 8 + b) * 262144, 256, gtid, gsz); }
    }
    {
        bf16_t* H = (bf16_t*)(P.ws + WS_A); bf16_t* MEMN = (bf16_t*)(P.ws + WS_MEMN);
        for (int row = gw; row < R + 4096; row += ngw) {
            if (row < R) { const float* xr = row < RP ? P.in[0] + (size_t)row * 1024 : P.in[1] + (size_t)(row - RP) * 1024; norm_row(xr, P.in[11], H + (size_t)row * 1024, lane); }
            else { const int q = row - R, l = q >> 11, r = q & 2047; norm_row(P.in[10] + (size_t)r * 1024, P.in[26] + l * 1024, MEMN + (size_t)q * 1024, lane); }
        }
    }
}
__device__ __forceinline__ void cumsum_task(const Params& P, int q, int lane) {
    const bool samp = q >= 64; const int bh = q & 63, b = bh >> 3, hd = bh & 7;
    const int n = samp ? TKS : T;
    float* dst = samp ? (float*)(P.ws + WS_C2S) + (size_t)bh * TKS : (float*)(P.ws + WS_C2P) + (size_t)bh * T;
    float carry = 0.f;
    for (int base = 0; base < n; base += 64) {
        const int idx = base + lane; float v = 0.f;
        if (idx < n) {
            if (!samp) v = P.out[O_LFP + ((size_t)b * T + idx) * 8 + hd];
            else v = idx < PAST ? P.in[5][((size_t)b * PAST + idx) * 8 + hd] : P.out[O_LFS + ((size_t)b * 32 + idx - PAST) * 8 + hd];
        }
#pragma unroll
        for (int o = 1; o < 64; o <<= 1) { const float t = __shfl_up(v, o); if (lane >= o) v += t; }
        if (idx < n) dst[idx] = (carry + v) * LOG2E;
        carry += __shfl(v, 63);
    }
}

template <class Epi> __device__ __forceinline__ void run_gemm(LAS unsigned char* lds, const bf16_t* A, const bf16_t* Bt, int M, int N, int K, const Epi& E) {
    pg8::Gemm g{A, Bt, M, N, K}; pg8::StaticOrder S; S.init(M, N, (int)gridDim.x, (int)blockIdx.x);
    pg8::gemm_phase<Epi, pg8::StaticOrder, true, true>(lds, g, S, E);
}

#define PHASE_BEGIN if (ph >= ph_lo && ph < ph_hi) { int tid = threadIdx.x; asm volatile("" : "+v"(tid)); const int lane = tid & 63, wid = __builtin_amdgcn_readfirstlane(tid >> 6); const int gw = blockIdx.x * 8 + wid, ngw = gridDim.x * 8; (void)lane; (void)gw; (void)ngw;
#define PHASE_END   if (ph + 1 < ph_hi) grid.sync(); } ++ph;
template <int layer> __device__ __forceinline__ void layer_phases(const Params& P, LAS unsigned char* lds, cg::grid_group& grid, int& ph, int ph_lo, int ph_hi, bf16_t* W, bf16_t* A, bf16_t* B, bf16_t* C, float* xo, float* xo_s) {
        const float* nw = P.in[11] + layer * 6144;
        if constexpr (layer == 1) {
            PHASE_BEGIN { EpiPlain<0> E{B, 1024, 1.f}; run_gemm(lds, A, W + W_INC, R, 1024, 1024, E); } PHASE_END
            PHASE_BEGIN s5_phase(P, lds, 1, wid, lane); PHASE_END
            PHASE_BEGIN s5_phase(P, lds, 2, wid, lane); PHASE_END
            PHASE_BEGIN { EpiGlu E{C}; run_gemm(lds, B + B_X2, W + W_GLU, R, 2048, 1024, E); } PHASE_END
            PHASE_BEGIN resnorm_phase(C, xo, xo_s, nw + 1024, nw + 2048, xo, A, gw, ngw, lane); PHASE_END
        }
        PHASE_BEGIN { EpiPlain<0> E{B, 1024, 0.0625f * LOG2E}; run_gemm(lds, A, W + W_XQ + (size_t)layer * 1048576, R, 1024, 1024, E); } PHASE_END
        PHASE_BEGIN xattn_phase(P, lds, layer, tid, wid, lane); PHASE_END
        PHASE_BEGIN { EpiPlain<0> E{C, 1024, 1.f}; run_gemm(lds, B + B_X2, W + W_XO + (size_t)layer * 1048576, R, 1024, 1024, E); } PHASE_END
        PHASE_BEGIN resnorm_phase(C, xo, xo_s, nw + 3072, nw + 4096, xo, A, gw, ngw, lane); PHASE_END
        PHASE_BEGIN { EpiPlain<1> E{B, 4096, 1.f}; run_gemm(lds, A, W + W_UP + (size_t)layer * 4194304, R, 4096, 1024, E); } PHASE_END
        PHASE_BEGIN { EpiPlain<0> E{C, 1024, 1.f}; run_gemm(lds, B, W + W_DN + (size_t)layer * 4194304, R, 1024, 4096, E); } PHASE_END
        PHASE_BEGIN resnorm_phase(C, xo, xo_s, nw + 5120, layer == 0 ? nw + 6144 : nullptr, xo, A, gw, ngw, lane); PHASE_END
    }
__global__ void __launch_bounds__(512) mega_fwd(Params P, int ph_lo, int ph_hi) {
    extern __shared__ __attribute__((aligned(16))) unsigned char lds_raw[];
    LAS unsigned char* lds = (LAS unsigned char*)lds_raw;
    cg::grid_group grid = cg::this_grid();
    bf16_t* W = (bf16_t*)(P.ws + WS_W);
    bf16_t* A = (bf16_t*)(P.ws + WS_A);
    bf16_t* B = (bf16_t*)(P.ws + WS_B);
    bf16_t* C = (bf16_t*)(P.ws + WS_C);
    float* xo = P.out; float* xo_s = P.out + (size_t)RP * 1024;
    int ph = 0;

    PHASE_BEGIN prologue(P, tid, wid, lane); PHASE_END
    PHASE_BEGIN {
        EpiAB E{B, (bf16_t*)(P.ws + WS_FKS), (bf16_t*)(P.ws + WS_FVTS), P.out, (const float*)(P.ws + WS_ROPE), P.in[13]};
        run_gemm(lds, A, W + W_AB, R, 3840, 1024, E);
        for (int l = 0; l < 2; ++l) {
            EpiMemKV E2{P.out + O_MK, P.out + O_MV, (bf16_t*)(P.ws + WS_MEMK), (bf16_t*)(P.ws + WS_MEMVT), l};
            run_gemm(lds, (const bf16_t*)(P.ws + WS_MEMN) + (size_t)l * 2048 * 1024, W + W_XKV + (size_t)l * 2097152, 2048, 2048, 1024, E2);
        }
    } PHASE_END
    PHASE_BEGIN { ret_passA(P, wid, lane); if (blockIdx.x < 16) cumsum_task(P, blockIdx.x * 8 + wid, lane); } PHASE_END
    PHASE_BEGIN ret_passB(P, tid); PHASE_END
    PHASE_BEGIN {
        LAS float* red = (LAS float*)lds;
        for (int u = blockIdx.x; u < 4096 + 32; u += gridDim.x) { if (u < 4096) ret_unitC<64>(P, red, u >> 7, u & 127, wid, lane); else ret_unitC<32>(P, red, u - 4096, 0, wid, lane); }
        __syncthreads();
        fox_phase(P, lds, tid, wid, lane);
    } PHASE_END
    PHASE_BEGIN { EpiPlain<0> E{C, 1024, 1.f}; run_gemm(lds, A, W + W_OUT, R, 1024, 1024, E); } PHASE_END
    PHASE_BEGIN resnorm_phase(C, P.in[0], P.in[1], P.in[11] + 1024, P.in[11] + 2048, xo, A, gw, ngw, lane); PHASE_END
    layer_phases<0>(P, lds, grid, ph, ph_lo, ph_hi, W, A, B, C, xo, xo_s);
    layer_phases<1>(P, lds, grid, ph, ph_lo, ph_hi, W, A, B, C, xo, xo_s);
}

extern "C" void kernel_launch(void* const* d_in, const int* in_sizes, int n_in, void* d_out, int out_size, void* d_ws, size_t ws_size, hipStream_t stream) {
    static int grid = 0;
    if (grid == 0) {
        if (n_in != 33 || (size_t)out_size != O_END || ws_size < WS_END) { fprintf(stderr, "kernel_launch: unexpected shapes n_in %d out %d ws %zu\n", n_in, out_size, ws_size); grid = -1; return; }
        int dev = 0, cus = 0, per_cu = 0;
        hipGetDevice(&dev);
        hipDeviceGetAttribute(&cus, hipDeviceAttributeMultiprocessorCount, dev);
        if (hipFuncSetAttribute((const void*)mega_fwd, hipFuncAttributeMaxDynamicSharedMemorySize, LDS_BYTES) != hipSuccess) { fprintf(stderr, "kernel_launch: hipFuncSetAttribute failed\n"); grid = -1; return; }
        if (hipOccupancyMaxActiveBlocksPerMultiprocessor(&per_cu, (const void*)mega_fwd, 512, LDS_BYTES) != hipSuccess || per_cu < 1) { fprintf(stderr, "kernel_launch: occupancy query %d\n", per_cu); per_cu = 1; (void)hipGetLastError(); }
        grid = cus * per_cu;
    }
    if (grid < 0) return;
    Params p{};
    for (int i = 0; i < 33; ++i) p.in[i] = (const float*)d_in[i];
    p.out = (float*)d_out; p.ws = (unsigned char*)d_ws;
    int lo = 0, hi = 1000;
    void* args[] = {&p, &lo, &hi};
    hipError_t e = hipLaunchCooperativeKernel((const void*)mega_fwd, dim3(grid), dim3(512), args, LDS_BYTES, stream);
    if (e != hipSuccess) fprintf(stderr, "cooperative launch failed: %s (grid %d)\n", hipGetErrorString(e), grid);
}
```

```cpp
#include <hip/hip_runtime.h>
#include <hip/hip_cooperative_groups.h>
#include <cstdio>
#include <cstdint>
namespace cg = cooperative_groups;
namespace pg8 {
#define PG8_LAS __attribute__((address_space(3)))
typedef unsigned short bf16_t;
typedef short bf16x8 __attribute__((ext_vector_type(8)));
typedef float f32x4 __attribute__((ext_vector_type(4)));
typedef unsigned u32x4 __attribute__((ext_vector_type(4)));
constexpr int BM = 256, BK = 64, HALF = 128, HTB = HALF * BK * 2  , STAGE_BYTES = 8 * HTB, NXCD = 8, WGM = 8;

__host__ __device__ __forceinline__ int lds_byte(int r, int c) { const int st = (r >> 4) * 2 + (c >> 5), rr = r & 15, cc = c & 31, ob = rr * 64 + cc * 2; return st * 1024 + (ob ^ (((ob >> 9) & 1) << 5)); }
__host__ __device__ __forceinline__ void stage_rc(int b, int& R, int& C) { const int st = b / 1024, sb = b % 1024, swz = sb ^ (((sb >> 9) & 1) << 5); R = (st >> 1) * 16 + swz / 64; C = (st & 1) * 32 + (swz % 64) / 2; }
__host__ __device__ __forceinline__ int perm32(int rho) { const int n = rho >> 4, i = rho & 15; return 8 * (i >> 2) + 4 * n + (i & 3); }

struct Unit { int pm, pn; };
struct Gemm { const bf16_t* A; const bf16_t* Bt; int M, N, K; };

struct StaticOrder {
    int nM, nN, nwg, G, c;
    __host__ __device__ void init(int M, int N, int G_, int c_) { nM = M / BM; nN = N / BM; nwg = nM * nN; G = G_; c = c_; }
    __host__ __device__ bool next(int i, Unit& u) const {
        const long L = (long)i * G + c; if (L >= nwg) return false;
        int wgid = (int)L; { const int q = nwg / NXCD, r = nwg % NXCD, xcd = wgid % NXCD, off = wgid / NXCD; wgid = (xcd < r ? xcd * (q + 1) : r * (q + 1) + (xcd - r) * q) + off; }
        const int nig = WGM * nN, gid = wgid / nig, fm = gid * WGM, gsz = (nM - fm) < WGM ? (nM - fm) : WGM;
        u.pm = fm + ((wgid % nig) % gsz); u.pn = (wgid % nig) / gsz; return true;
    }
    __device__ __forceinline__ void a_ready(const Unit&) const {}
    __device__ __forceinline__ void done(const Unit&) const {}
};

template <class Epi, class Sched, bool ALIGN_EPI = false, bool SP2 = false>
__device__ __forceinline__ void gemm_phase(PG8_LAS unsigned char* lds, const Gemm g, const Sched& S, const Epi& E) {
    int tid_l = threadIdx.x; asm volatile("" : "+v"(tid_l)); const int tid = tid_l, wid = __builtin_amdgcn_readfirstlane(tid >> 6), lane = tid & 63, wr = wid >> 2, wc = wid & 3, fr = lane & 15, fq = lane >> 4;
    const int K = g.K, nt = K / BK;
    unsigned voffA[2], voffB[2];
#pragma unroll
    for (int i = 0; i < 2; ++i) { int R, C; stage_rc(tid * 16 + i * 8192, R, C); const int Rb = Epi::PERM ? ((R & ~31) + perm32(R & 31)) : R;
        voffA[i] = (unsigned)(R * K + C) * 2u; voffB[i] = (unsigned)(Rb * K + C) * 2u; }
    const size_t kstep = (size_t)(BK * 2);
    const size_t hstep = (size_t)HALF * K * 2;
    const size_t tstep = 2 * hstep;
    const unsigned ldsw = (unsigned)wid * 1024u;
    const int aoff = lds_byte(wr * 64 + fr, fq * 8), boff = lds_byte(wc * 32 + fr, fq * 8);
#define PG8_SA(b, h) (((b) * 2 + (h)) * HTB)
#define PG8_SB(b, h) ((4 + (b) * 2 + (h)) * HTB)
#define PG8_STAGE(bufoff, gbase, voff) do { _Pragma("unroll") for (int _i = 0; _i < 2; ++_i) \
        __builtin_amdgcn_global_load_lds((const unsigned*)((const char*)(gbase) + (voff)[_i]), (PG8_LAS unsigned*)(lds + (bufoff) + ldsw + _i * 8192), 16, 0, 0); } while (0)
#define PG8_LDA(dst, b, h) do { _Pragma("unroll") for (int m = 0; m < 4; ++m) _Pragma("unroll") for (int k = 0; k < 2; ++k) dst[m][k] = *(const PG8_LAS bf16x8*)(lds + PG8_SA(b, h) + aoff + m * 2048 + k * 1024); } while (0)
#define PG8_LDB(dst, b, h) do { _Pragma("unroll") for (int n = 0; n < 2; ++n) _Pragma("unroll") for (int k = 0; k < 2; ++k) dst[n][k] = *(const PG8_LAS bf16x8*)(lds + PG8_SB(b, h) + boff + n * 2048 + k * 1024); } while (0)
#define PG8_MMA(ai, bj, At, Bt) do { __builtin_amdgcn_s_setprio(1); _Pragma("unroll") for (int m = 0; m < 4; ++m) _Pragma("unroll") for (int n = 0; n < 2; ++n) _Pragma("unroll") for (int k = 0; k < 2; ++k) \
        acc[ai][bj][m][n] = __builtin_amdgcn_mfma_f32_16x16x32_bf16(Bt[n][k], At[m][k], acc[ai][bj][m][n], 0, 0, 0); __builtin_amdgcn_s_setprio(0); } while (0)
#define PG8_WAIT_V(n) asm volatile("s_waitcnt vmcnt(" #n ")" ::: "memory")
#define PG8_WAIT_L(n) asm volatile("s_waitcnt lgkmcnt(" #n ")" ::: "memory")
#define PG8_BAR __builtin_amdgcn_s_barrier()
#define PG8_SCHED __builtin_amdgcn_sched_barrier(0)
    Unit cur, nxt; int ui = 0;
    if (!S.next(0, cur)) return;
    f32x4 acc[2][2][4][2];
#pragma unroll
    for (int a = 0; a < 2; ++a)
#pragma unroll
        for (int b = 0; b < 2; ++b)
#pragma unroll
            for (int m = 0; m < 4; ++m)
#pragma unroll
                for (int n = 0; n < 2; ++n) acc[a][b][m][n] = (f32x4){0.f, 0.f, 0.f, 0.f};
    bf16x8 At[4][2], B0[2][2], B1[2][2];
    const char* cA = (const char*)g.A + (size_t)cur.pm * tstep; const char* cB = (const char*)g.Bt + (size_t)cur.pn * tstep;
    S.a_ready(cur);
    if constexpr (SP2) {
        PG8_STAGE(PG8_SB(0, 0), cB, voffB); PG8_STAGE(PG8_SB(0, 1), cB + hstep, voffB); PG8_STAGE(PG8_SA(0, 0), cA, voffA); PG8_STAGE(PG8_SA(0, 1), cA + hstep, voffA);
        if (wr == 1) PG8_BAR;
        PG8_WAIT_V(2); PG8_BAR;
        PG8_STAGE(PG8_SB(1, 0), cB + kstep, voffB); PG8_STAGE(PG8_SA(1, 0), cA + kstep, voffA); PG8_STAGE(PG8_SB(1, 1), cB + hstep + kstep, voffB);
        PG8_WAIT_V(6); PG8_BAR;
    } else {
        PG8_STAGE(PG8_SB(0, 0), cB, voffB); PG8_STAGE(PG8_SA(0, 0), cA, voffA); PG8_STAGE(PG8_SB(0, 1), cB + hstep, voffB); PG8_STAGE(PG8_SA(0, 1), cA + hstep, voffA);
        if (wr == 1) PG8_BAR;
        PG8_WAIT_V(4); PG8_BAR;
        PG8_STAGE(PG8_SB(1, 0), cB + kstep, voffB); PG8_STAGE(PG8_SA(1, 0), cA + kstep, voffA); PG8_STAGE(PG8_SB(1, 1), cB + hstep + kstep, voffB);
        PG8_WAIT_V(6); PG8_BAR;
    }
    for (;;) {
        const bool has_next = S.next(ui + 1, nxt);
        const char* nA = has_next ? (const char*)g.A + (size_t)nxt.pm * tstep : cA; const char* nB = has_next ? (const char*)g.Bt + (size_t)nxt.pn * tstep : cB;
        for (int t = 0; t < nt; t += 2) {
            const bool last = (t == nt - 2);
            const char* a1 = cA + (size_t)(t + 1) * kstep;
            const char* a2 = last ? nA : cA + (size_t)(t + 2) * kstep; const char* b2 = last ? nB : cB + (size_t)(t + 2) * kstep;
            const char* a3 = a2 + kstep; const char* b3 = b2 + kstep;
            if (last && has_next) S.a_ready(nxt);
            if constexpr (SP2) {
            PG8_LDB(B0, 0, 0); PG8_LDB(B1, 0, 1); PG8_SCHED; PG8_LDA(At, 0, 0); PG8_STAGE(PG8_SA(1, 1), a1 + hstep, voffA);
            PG8_WAIT_V(8); PG8_WAIT_L(0); PG8_BAR; PG8_MMA(0, 0, At, B0); PG8_MMA(0, 1, At, B1); PG8_BAR; PG8_SCHED;
            PG8_LDA(At, 0, 1); PG8_STAGE(PG8_SB(0, 0), b2, voffB); PG8_STAGE(PG8_SB(0, 1), b2 + hstep, voffB); PG8_STAGE(PG8_SA(0, 0), a2, voffA);
            PG8_WAIT_V(8); PG8_WAIT_L(0); PG8_BAR; PG8_MMA(1, 0, At, B0); PG8_MMA(1, 1, At, B1); PG8_BAR; PG8_SCHED;
            PG8_LDB(B0, 1, 0); PG8_LDB(B1, 1, 1); PG8_SCHED; PG8_LDA(At, 1, 0); PG8_STAGE(PG8_SA(0, 1), a2 + hstep, voffA);
            PG8_WAIT_V(8); PG8_WAIT_L(0); PG8_BAR; PG8_MMA(0, 0, At, B0); PG8_MMA(0, 1, At, B1); PG8_BAR; PG8_SCHED;
            PG8_LDA(At, 1, 1); PG8_STAGE(PG8_SB(1, 0), b3, voffB); PG8_STAGE(PG8_SB(1, 1), b3 + hstep, voffB); PG8_STAGE(PG8_SA(1, 0), a3, voffA);
            PG8_WAIT_V(8); PG8_WAIT_L(0); PG8_BAR; PG8_MMA(1, 0, At, B0); PG8_MMA(1, 1, At, B1); PG8_BAR; PG8_SCHED;
            } else {
            PG8_LDB(B0, 0, 0); PG8_SCHED; PG8_LDA(At, 0, 0); PG8_STAGE(PG8_SA(1, 1), a1 + hstep, voffA);
            PG8_WAIT_L(8); PG8_BAR; PG8_WAIT_L(0); PG8_MMA(0, 0, At, B0); PG8_BAR; PG8_SCHED;
            PG8_LDB(B1, 0, 1); PG8_STAGE(PG8_SB(0, 0), b2, voffB);
            PG8_BAR; PG8_WAIT_L(0); PG8_MMA(0, 1, At, B1); PG8_BAR;
            PG8_LDA(At, 0, 1); PG8_STAGE(PG8_SA(0, 0), a2, voffA);
            PG8_BAR; PG8_WAIT_L(0); PG8_MMA(1, 0, At, B0); PG8_BAR; PG8_SCHED;
            PG8_STAGE(PG8_SB(0, 1), b2 + hstep, voffB);
            PG8_WAIT_V(6); PG8_BAR; PG8_MMA(1, 1, At, B1); PG8_BAR;
            PG8_LDB(B0, 1, 0); PG8_SCHED; PG8_LDA(At, 1, 0); PG8_STAGE(PG8_SA(0, 1), a2 + hstep, voffA);
            PG8_WAIT_L(8); PG8_BAR; PG8_WAIT_L(0); PG8_MMA(0, 0, At, B0); PG8_BAR; PG8_SCHED;
            PG8_LDB(B1, 1, 1); PG8_STAGE(PG8_SB(1, 0), b3, voffB);
            PG8_BAR; PG8_WAIT_L(0); PG8_MMA(0, 1, At, B1); PG8_BAR;
            PG8_LDA(At, 1, 1); PG8_STAGE(PG8_SA(1, 0), a3, voffA);
            PG8_BAR; PG8_WAIT_L(0); PG8_MMA(1, 0, At, B0); PG8_BAR; PG8_SCHED;
            PG8_STAGE(PG8_SB(1, 1), b3 + hstep, voffB);
            PG8_WAIT_V(6); PG8_BAR; PG8_MMA(1, 1, At, B1); PG8_BAR;
            }
        }
        if constexpr (ALIGN_EPI) { if (wr == 0) PG8_BAR; }
        if constexpr (!Epi::AFTER_DRAIN) { E(acc, cur, wr, wc, fr, fq); S.done(cur); }
        if (!has_next) break;
#pragma unroll
        for (int a = 0; a < 2; ++a)
#pragma unroll
            for (int b = 0; b < 2; ++b)
#pragma unroll
                for (int m = 0; m < 4; ++m)
#pragma unroll
                    for (int n = 0; n < 2; ++n) acc[a][b][m][n] = (f32x4){0.f, 0.f, 0.f, 0.f};
        cur = nxt; cA = nA; cB = nB; ++ui;
        if constexpr (ALIGN_EPI) { if (wr == 1) PG8_BAR; }
    }
    PG8_WAIT_V(0);
    if constexpr (!ALIGN_EPI) { if (wr == 0) PG8_BAR; }
    PG8_BAR;
    if constexpr (Epi::AFTER_DRAIN) { E.fused(acc, cur, wr, wc, fr, fq, lds, wid, lane); S.done(cur); }
#undef PG8_SA
#undef PG8_SB
#undef PG8_STAGE
#undef PG8_LDA
#undef PG8_LDB
#undef PG8_MMA
#undef PG8_WAIT_V
#undef PG8_WAIT_L
#undef PG8_BAR
#undef PG8_SCHED
}
}
#ifndef REP_FOX
#define REP_FOX 1
#endif
#ifndef REP_PRO
#define REP_PRO 1
#endif
#ifndef REP_RET
#define REP_RET 1
#endif
#ifndef REP_XA
#define REP_XA 1
#endif
#ifndef REP_S5
#define REP_S5 1
#endif

#define LAS __attribute__((address_space(3)))
typedef unsigned short bf16_t;
typedef short bf16x8 __attribute__((ext_vector_type(8)));
typedef short s16x4 __attribute__((ext_vector_type(4)));
typedef float f32x4 __attribute__((ext_vector_type(4)));
typedef float f32x2 __attribute__((ext_vector_type(2)));
typedef float f32x16 __attribute__((ext_vector_type(16)));
typedef unsigned u32x4 __attribute__((ext_vector_type(4)));
typedef unsigned u32x2 __attribute__((ext_vector_type(2)));
typedef __bf16 bf16x2_t __attribute__((ext_vector_type(2)));
using pg8::Unit;

__device__ __forceinline__ unsigned pk2(float lo, float hi) { f32x2 v = {lo, hi}; bf16x2_t b = __builtin_convertvector(v, bf16x2_t); return __builtin_bit_cast(unsigned, b); }
__device__ __forceinline__ float bflo(unsigned w) { return __uint_as_float(w << 16); }
__device__ __forceinline__ float bfhi(unsigned w) { return __uint_as_float(w & 0xffff0000u); }
__device__ __forceinline__ bf16_t f2bf(float f) { return (bf16_t)(pk2(f, 0.f) & 0xffffu); }
__device__ __forceinline__ float ex2(float x) { return __builtin_amdgcn_exp2f(x); }
__device__ __forceinline__ float wave_sum(float v) {
#pragma unroll
    for (int o = 1; o < 64; o <<= 1) v += __shfl_xor(v, o);
    return v;
}
#define LDSBAR() asm volatile("s_waitcnt lgkmcnt(0)" ::: "memory")
#define MFMA32(a, b, c) __builtin_amdgcn_mfma_f32_32x32x16_bf16((a), (b), (c), 0, 0, 0)
#define MFMA16(a, b, c) __builtin_amdgcn_mfma_f32_16x16x32_bf16((a), (b), (c), 0, 0, 0)

constexpr int DM = 1024, RP = 65536, RS = 256, R = RP + RS, T = 8192, TS = 32, PAST = 4096, TKS = PAST + TS;
constexpr float LOG2E = 1.4426950408889634f;
constexpr float EPS = 1e-6f;
constexpr size_t O_Y = 0, O_RSP = (size_t)R * 1024, O_RSS = O_RSP + 524288, O_FKP = O_RSS + 524288, O_FVP = O_FKP + (size_t)RP * 512,
                 O_LFP = O_FVP + (size_t)RP * 512, O_FKS = O_LFP + (size_t)RP * 8, O_FVS = O_FKS + 131072, O_LFS = O_FVS + 131072,
                 O_S5RP = O_LFS + 2048, O_S5IP = O_S5RP + 32768, O_S5RS = O_S5IP + 32768, O_S5IS = O_S5RS + 32768, O_MK = O_S5IS + 32768,
                 O_MV = O_MK + 4194304, O_END = O_MV + 4194304;
constexpr size_t MiB = 1u << 20;
constexpr size_t WS_W = 1 * MiB, WS_ROPE = 65 * MiB, WS_C2P = 69 * MiB, WS_C2S = 71 * MiB, WS_MEMN = 73 * MiB, WS_MEMK = 81 * MiB, WS_MEMVT = 97 * MiB,
                 WS_S5T = 113 * MiB, WS_LE = 114 * MiB, WS_KVS = 118 * MiB, WS_A = 120 * MiB, WS_B = 249 * MiB, WS_C = 763 * MiB, WS_FKS = 892 * MiB,
                 WS_FVTS = 925 * MiB, WS_END = 960 * MiB;
constexpr size_t W_AB = 0, W_OUT = W_AB + 3840 * 1024, W_INC = W_OUT + 1048576, W_GLU = W_INC + 1048576, W_XQ = W_GLU + 2097152, W_XKV = W_XQ + 2097152,
                 W_XO = W_XKV + 4194304, W_UP = W_XO + 2097152, W_DN = W_UP + 8388608, W_ENDE = W_DN + 8388608;
static_assert(W_ENDE * 2 <= 64 * MiB, "weights region");
constexpr size_t B_RQ = 0, B_RK = (size_t)R * 512, B_RG = 2 * (size_t)R * 512, B_FQ = 3 * (size_t)R * 512, B_FK = 4 * (size_t)R * 512, B_KT = 5 * (size_t)R * 512,
                 B_VT = B_KT + (size_t)RP * 512, B_FVT = B_VT + (size_t)RP * 512, B_KTS = B_FVT + (size_t)RP * 512, B_VTS = B_KTS + 131072, B_ENDE = B_VTS + 131072;
static_assert(B_ENDE * 2 <= 514 * MiB, "region B");
constexpr size_t B_X2 = 129 * MiB / 2;
constexpr int LDS_BYTES = 139264;

struct Params {
    const float* in[33];
    float* out;
    unsigned char* ws;
};

template <int ACT  > struct EpiPlain {
    static constexpr bool PERM = true, AFTER_DRAIN = false;
    bf16_t* O; int ldc; float scale;
    __device__ __forceinline__ void operator()(const f32x4 (&acc)[2][2][4][2], const Unit& u, int wr, int wc, int fr, int fq) const {
        asm volatile("" : "+v"(fr), "+v"(fq));
        bf16_t* base = O + (size_t)(u.pm * 256 + wr * 64 + fr) * ldc + u.pn * 256 + wc * 32 + fq * 8;
#pragma unroll
        for (int ai = 0; ai < 2; ++ai)
#pragma unroll
            for (int m = 0; m < 4; ++m) {
                bf16_t* rp = base + (size_t)(ai * 128 + m * 16) * ldc;
#pragma unroll
                for (int bj = 0; bj < 2; ++bj) {
                    f32x4 v0 = acc[ai][bj][m][0], v1 = acc[ai][bj][m][1];
                    if (ACT == 1) { v0.x = fmaxf(v0.x, 0.f); v0.y = fmaxf(v0.y, 0.f); v0.z = fmaxf(v0.z, 0.f); v0.w = fmaxf(v0.w, 0.f); v0 = v0 * v0;
                                    v1.x = fmaxf(v1.x, 0.f); v1.y = fmaxf(v1.y, 0.f); v1.z = fmaxf(v1.z, 0.f); v1.w = fmaxf(v1.w, 0.f); v1 = v1 * v1; }
                    else { v0 = v0 * scale; v1 = v1 * scale; }
                    u32x4 w; w.x = pk2(v0.x, v0.y); w.y = pk2(v0.z, v0.w); w.z = pk2(v1.x, v1.y); w.w = pk2(v1.z, v1.w);
                    *(u32x4*)(rp + bj * 128) = w;
                }
            }
    }
};
struct EpiGlu {
    static constexpr bool PERM = false, AFTER_DRAIN = false;
    bf16_t* O;
    __device__ __forceinline__ void operator()(const f32x4 (&acc)[2][2][4][2], const Unit& u, int wr, int wc, int fr, int fq) const {
        asm volatile("" : "+v"(fr), "+v"(fq));
#pragma unroll
        for (int ai = 0; ai < 2; ++ai)
#pragma unroll
            for (int m = 0; m < 4; ++m) {
                const int row = u.pm * 256 + ai * 128 + wr * 64 + m * 16 + fr;
                bf16_t* rp = O + (size_t)row * 1024 + u.pn * 128 + wc * 32 + fq * 4;
#pragma unroll
                for (int n = 0; n < 2; ++n) {
                    const f32x4 a = acc[ai][0][m][n], g = acc[ai][1][m][n];
                    f32x4 v;
                    v.x = a.x / (1.f + __expf(-g.x)); v.y = a.y / (1.f + __expf(-g.y)); v.z = a.z / (1.f + __expf(-g.z)); v.w = a.w / (1.f + __expf(-g.w));
                    u32x2 w; w.x = pk2(v.x, v.y); w.y = pk2(v.z, v.w);
                    *(u32x2*)(rp + n * 16) = w;
                }
            }
    }
};
struct EpiMemKV {
    static constexpr bool PERM = false, AFTER_DRAIN = false;
    float* oK; float* oV; bf16_t* mk; bf16_t* mvt; int layer;
    __device__ __forceinline__ void operator()(const f32x4 (&acc)[2][2][4][2], const Unit& u, int wr, int wc, int fr, int fq) const {
        asm volatile("" : "+v"(fr), "+v"(fq));
        const bool isv = u.pn >= 4;
#pragma unroll
        for (int ai = 0; ai < 2; ++ai)
#pragma unroll
            for (int m = 0; m < 4; ++m) {
                const int row = u.pm * 256 + ai * 128 + wr * 64 + m * 16 + fr;
                const int b = row >> 8, mm = row & 255;
#pragma unroll
                for (int bj = 0; bj < 2; ++bj)
#pragma unroll
                    for (int n = 0; n < 2; ++n) {
                        const int col = (u.pn & 3) * 256 + bj * 128 + wc * 32 + n * 16 + fq * 4;
                        const f32x4 v = acc[ai][bj][m][n];
                        if (!isv) {
                            *(f32x4*)(oK + ((size_t)layer * 2048 + row) * 1024 + col) = v;
                            u32x2 w; w.x = pk2(v.x, v.y); w.y = pk2(v.z, v.w);
                            *(u32x2*)(mk + ((size_t)(layer * 16 + b) * 256 + mm) * 1024 + col) = w;
                        } else {
                            *(f32x4*)(oV + ((size_t)layer * 2048 + row) * 1024 + col) = v;
                            bf16_t* p = mvt + ((size_t)(layer * 16 + b) * 1024 + col) * 256 + mm;
                            p[0] = f2bf(v.x); p[256] = f2bf(v.y); p[512] = f2bf(v.z); p[768] = f2bf(v.w);
                        }
                    }
            }
    }
};
__device__ __forceinline__ float logsig(float x) { return x >= 0.f ? -log1pf(__expf(-x)) : x - log1pf(__expf(x)); }
struct EpiAB {
    static constexpr bool PERM = false, AFTER_DRAIN = false;
    bf16_t* B;
    bf16_t* fks; bf16_t* fvts;
    float* out; const float* rope; const float* bfox;
    __device__ __forceinline__ void operator()(const f32x4 (&acc)[2][2][4][2], const Unit& u, int wr, int wc, int fr, int fq) const {
        asm volatile("" : "+v"(fr), "+v"(fq));
        switch (u.pn >> 1) {
            case 0: body<0>(acc, u, wr, wc, fr, fq); break; case 1: body<1>(acc, u, wr, wc, fr, fq); break; case 2: body<2>(acc, u, wr, wc, fr, fq); break;
            case 3: body<3>(acc, u, wr, wc, fr, fq); break; case 4: body<4>(acc, u, wr, wc, fr, fq); break; case 5: body<5>(acc, u, wr, wc, fr, fq); break;
            case 6: body<6>(acc, u, wr, wc, fr, fq); break; default: body<7>(acc, u, wr, wc, fr, fq); break;
        }
    }
    template <int sect> __device__ __forceinline__ void body(const f32x4 (&acc)[2][2][4][2], const Unit& u, int wr, int wc, int fr, int fq) const {
        rowgrp<sect, 0, 0>(acc, u, wr, wc, fr, fq); rowgrp<sect, 0, 1>(acc, u, wr, wc, fr, fq); rowgrp<sect, 0, 2>(acc, u, wr, wc, fr, fq); rowgrp<sect, 0, 3>(acc, u, wr, wc, fr, fq);
        rowgrp<sect, 1, 0>(acc, u, wr, wc, fr, fq); rowgrp<sect, 1, 1>(acc, u, wr, wc, fr, fq); rowgrp<sect, 1, 2>(acc, u, wr, wc, fr, fq); rowgrp<sect, 1, 3>(acc, u, wr, wc, fr, fq);
    }
    template <int sect, int ai, int m> __device__ __forceinline__ void rowgrp(const f32x4 (&acc)[2][2][4][2], const Unit& u, int wr, int wc, int fr, int fq) const {
        const int pn = u.pn;
            {
                const int row = u.pm * 256 + ai * 128 + wr * 64 + m * 16 + fr;
                const bool samp = row >= RP;
                const int rr = row - RP;
                const int b = samp ? (rr >> 5) : (row >> 13);
                const int t = samp ? (rr & 31) : (row & 8191);
                const int pos = samp ? PAST + t : t;
#pragma unroll
                for (int bj = 0; bj < 2; ++bj)
#pragma unroll
                    for (int n = 0; n < 2; ++n) {
                        const int sec = (pn & 1) * 256 + bj * 128 + wc * 32 + n * 16 + fq * 4;
                        f32x4 v = acc[ai][bj][m][n];
                        if constexpr (sect <= 1) {
                            const int hd = sec >> 7, w = sec & 127, i0 = w >> 1;
                            const f32x4 cs = *(const f32x4*)(rope + ((size_t)pos * 64 + i0) * 2);
                            f32x4 o;
                            o.x = v.x * cs.x - v.y * cs.y; o.y = v.y * cs.x + v.x * cs.y;
                            o.z = v.z * cs.z - v.w * cs.w; o.w = v.w * cs.z + v.z * cs.w;
                            if constexpr (sect == 0) {
                                u32x2 wv; wv.x = pk2(o.x, o.y); wv.y = pk2(o.z, o.w);
                                *(u32x2*)(B + B_RQ + (size_t)row * 512 + sec) = wv;
                            } else {
                                o = o * 0.08838834764831845f;
                                u32x2 wv; wv.x = pk2(o.x, o.y); wv.y = pk2(o.z, o.w);
                                *(u32x2*)(B + B_RK + (size_t)row * 512 + sec) = wv;
                                const float lg2 = __log2f(1.f - ex2((float)(-5 - hd)));
                                if (!samp) {
                                    const int j = t & 63; const float wk = ex2(lg2 * (float)(63 - j));
                                    bf16_t* p = B + B_KT + ((size_t)((b * 4 + hd) * 128 + (t >> 6)) * 128 + w) * 64 + j;
                                    p[0] = f2bf(o.x * wk); p[64] = f2bf(o.y * wk); p[128] = f2bf(o.z * wk); p[192] = f2bf(o.w * wk);
                                } else {
                                    const float wk = ex2(lg2 * (float)(31 - t));
                                    bf16_t* p = B + B_KTS + ((size_t)(b * 4 + hd) * 128 + w) * 32 + t;
                                    p[0] = f2bf(o.x * wk); p[32] = f2bf(o.y * wk); p[64] = f2bf(o.z * wk); p[96] = f2bf(o.w * wk);
                                }
                            }
                        } else if constexpr (sect == 2) {
                            const int hd = sec >> 7, w = sec & 127;
                            if (!samp) {
                                bf16_t* p = B + B_VT + ((size_t)((b * 4 + hd) * 128 + (t >> 6)) * 128 + w) * 64 + (t & 63);
                                p[0] = f2bf(v.x); p[64] = f2bf(v.y); p[128] = f2bf(v.z); p[192] = f2bf(v.w);
                            } else {
                                bf16_t* p = B + B_VTS + ((size_t)(b * 4 + hd) * 128 + w) * 32 + t;
                                p[0] = f2bf(v.x); p[32] = f2bf(v.y); p[64] = f2bf(v.z); p[96] = f2bf(v.w);
                            }
                        } else if constexpr (sect == 3) {
                            f32x4 o; o.x = v.x / (1.f + __expf(-v.x)); o.y = v.y / (1.f + __expf(-v.y)); o.z = v.z / (1.f + __expf(-v.z)); o.w = v.w / (1.f + __expf(-v.w));
                            u32x2 wv; wv.x = pk2(o.x, o.y); wv.y = pk2(o.z, o.w);
                            *(u32x2*)(B + B_RG + (size_t)row * 512 + sec) = wv;
                        } else if constexpr (sect == 4) {
                            const f32x4 o = v * (0.125f * LOG2E);
                            u32x2 wv; wv.x = pk2(o.x, o.y); wv.y = pk2(o.z, o.w);
                            *(u32x2*)(B + B_FQ + (size_t)row * 512 + sec) = wv;
                        } else if constexpr (sect == 5) {
                            u32x2 wv; wv.x = pk2(v.x, v.y); wv.y = pk2(v.z, v.w);
                            if (!samp) { *(f32x4*)(out + O_FKP + (size_t)row * 512 + sec) = v; *(u32x2*)(B + B_FK + (size_t)row * 512 + sec) = wv; }
                            else { *(f32x4*)(out + O_FKS + (size_t)rr * 512 + sec) = v; *(u32x2*)(fks + ((size_t)b * TKS + PAST + t) * 512 + sec) = wv; }
                        } else if constexpr (sect == 6) {
                            if (!samp) {
                                *(f32x4*)(out + O_FVP + (size_t)row * 512 + sec) = v;
                                bf16_t* p = B + B_FVT + ((size_t)b * 512 + sec) * T + t;
                                p[0] = f2bf(v.x); p[T] = f2bf(v.y); p[2 * T] = f2bf(v.z); p[3 * T] = f2bf(v.w);
                            } else {
                                *(f32x4*)(out + O_FVS + (size_t)rr * 512 + sec) = v;
                                bf16_t* p = fvts + ((size_t)b * 512 + sec) * TKS + PAST + t;
                                p[0] = f2bf(v.x); p[TKS] = f2bf(v.y); p[2 * TKS] = f2bf(v.z); p[3 * TKS] = f2bf(v.w);
                            }
                        } else {
                            if (sec < 8) {
                                const f32x4 bb = *(const f32x4*)(bfox + sec);
                                f32x4 o; o.x = logsig(v.x + bb.x); o.y = logsig(v.y + bb.y); o.z = logsig(v.z + bb.z); o.w = logsig(v.w + bb.w);
                                if (!samp) *(f32x4*)(out + O_LFP + (size_t)row * 8 + sec) = o;
                                else *(f32x4*)(out + O_LFS + (size_t)rr * 8 + sec) = o;
                            }
                        }
                    }
                asm volatile("" ::: "memory");
            }
    }
};

__device__ __forceinline__ void wtrans(const float* __restrict__ src, int K, int Ns, bf16_t* dst, int Nd, int mode, int gtid, int gsz) {
    const int items = Nd * (K >> 3);
    for (int it = gtid; it < items; it += gsz) {
        const int n = it % Nd, k0 = (it / Nd) << 3;
        int col = n; bool z = false;
        if (mode == 1) { if (n < 1024) { const int w = n & 127; col = (n & ~127) + (w >> 1) + 64 * (w & 1); } else if (n >= 3592) z = true; }
        else if (mode == 2) { col = ((n >> 7) & 1) * 1024 + (n >> 8) * 128 + (n & 127); }
        const float* s = src + (size_t)k0 * Ns + (z ? 0 : col);
        float v0 = s[0], v1 = s[(size_t)Ns], v2 = s[2 * (size_t)Ns], v3 = s[3 * (size_t)Ns], v4 = s[4 * (size_t)Ns], v5 = s[5 * (size_t)Ns], v6 = s[6 * (size_t)Ns], v7 = s[7 * (size_t)Ns];
        u32x4 o; o.x = pk2(v0, v1); o.y = pk2(v2, v3); o.z = pk2(v4, v5); o.w = pk2(v6, v7);
        if (z) o = (u32x4){0u, 0u, 0u, 0u};
        *(u32x4*)(dst + (size_t)n * K + k0) = o;
    }
}
__device__ __forceinline__ void ttrans(const float* __restrict__ src, int rows, int C, bf16_t* dst, size_t dpitch, int gtid, int gsz) {
    const int items = C * (rows >> 3);
    for (int it = gtid; it < items; it += gsz) {
        const int c = it % C, r0 = (it / C) << 3;
        const float* s = src + (size_t)r0 * C + c;
        float v0 = s[0], v1 = s[(size_t)C], v2 = s[2 * (size_t)C], v3 = s[3 * (size_t)C], v4 = s[4 * (size_t)C], v5 = s[5 * (size_t)C], v6 = s[6 * (size_t)C], v7 = s[7 * (size_t)C];
        u32x4 o; o.x = pk2(v0, v1); o.y = pk2(v2, v3); o.z = pk2(v4, v5); o.w = pk2(v6, v7);
        *(u32x4*)(dst + (size_t)c * dpitch + r0) = o;
    }
}
__device__ __forceinline__ void cvt8(const float* __restrict__ s, bf16_t* d) {
    const f32x4 a = *(const f32x4*)s, b = *(const f32x4*)(s + 4);
    u32x4 o; o.x = pk2(a.x, a.y); o.y = pk2(a.z, a.w); o.z = pk2(b.x, b.y); o.w = pk2(b.z, b.w);
    *(u32x4*)d = o;
}
__device__ __forceinline__ void norm_row(const float* xr, const float* g, bf16_t* orow, int lane) {
    f32x4 v[4]; float s = 0.f;
#pragma unroll
    for (int j = 0; j < 4; ++j) { v[j] = ((const f32x4*)xr)[lane + 64 * j]; s += (v[j].x * v[j].x + v[j].y * v[j].y) + (v[j].z * v[j].z + v[j].w * v[j].w); }
    const float rstd = rsqrtf(wave_sum(s) * (1.f / 1024.f) + EPS);
#pragma unroll
    for (int j = 0; j < 4; ++j) { const f32x4 gg = ((const f32x4*)g)[lane + 64 * j]; const f32x4 o = v[j] * rstd * gg; u32x2 w; w.x = pk2(o.x, o.y); w.y = pk2(o.z, o.w); ((u32x2*)orow)[lane + 64 * j] = w; }
}
struct RnRow { f32x4 x[4]; u32x2 m[4]; };
__device__ __forceinline__ void rn_load(RnRow& r, const bf16_t* mix, const float* xp, const float* xs, int row, int lane) {
    const float* xr = row < RP ? xp + (size_t)row * 1024 : xs + (size_t)(row - RP) * 1024;
#pragma unroll
    for (int j = 0; j < 4; ++j) { r.x[j] = __builtin_nontemporal_load((const f32x4*)xr + lane + 64 * j); r.m[j] = __builtin_nontemporal_load((const u32x2*)(mix + (size_t)row * 1024) + lane + 64 * j); }
}
__device__ __forceinline__ void rn_proc(const RnRow& r, const float* ga, const float* gb, float* xout, bf16_t* h, int row, int lane) {
    f32x4 xv[4], mv[4]; float s = 0.f;
#pragma unroll
    for (int j = 0; j < 4; ++j) {
        const u32x2 w = r.m[j];
        mv[j] = (f32x4){bflo(w.x), bfhi(w.x), bflo(w.y), bfhi(w.y)};
        s += (mv[j].x * mv[j].x + mv[j].y * mv[j].y) + (mv[j].z * mv[j].z + mv[j].w * mv[j].w);
    }
    const float rm = rsqrtf(wave_sum(s) * (1.f / 1024.f) + EPS);
    float s2 = 0.f;
#pragma unroll
    for (int j = 0; j < 4; ++j) {
        const f32x4 gg = ((const f32x4*)ga)[lane + 64 * j];
        xv[j] = r.x[j] + mv[j] * rm * gg;
        ((f32x4*)(xout + (size_t)row * 1024))[lane + 64 * j] = xv[j];
        s2 += (xv[j].x * xv[j].x + xv[j].y * xv[j].y) + (xv[j].z * xv[j].z + xv[j].w * xv[j].w);
    }
    if (gb) {
        const float rx = rsqrtf(wave_sum(s2) * (1.f / 1024.f) + EPS);
#pragma unroll
        for (int j = 0; j < 4; ++j) { const f32x4 gg = ((const f32x4*)gb)[lane + 64 * j]; const f32x4 o = xv[j] * rx * gg; u32x2 w; w.x = pk2(o.x, o.y); w.y = pk2(o.z, o.w); ((u32x2*)(h + (size_t)row * 1024))[lane + 64 * j] = w; }
    }
}
__device__ __forceinline__ void resnorm_phase(const bf16_t* mix, const float* xp, const float* xs, const float* ga, const float* gb, float* xout, bf16_t* h, int gw, int ngw, int lane) {
    int row = gw * 2;
    if (row >= R) return;
    RnRow a0, a1, b0, b1;
    rn_load(a0, mix, xp, xs, row, lane); rn_load(a1, mix, xp, xs, row + 1, lane);
    for (;;) {
        const int nrow = row + ngw * 2;
        const bool more = nrow < R;
        if (more) { rn_load(b0, mix, xp, xs, nrow, lane); rn_load(b1, mix, xp, xs, nrow + 1, lane); }
        rn_proc(a0, ga, gb, xout, h, row, lane); rn_proc(a1, ga, gb, xout, h, row + 1, lane);
        if (!more) break;
        a0 = b0; a1 = b1; row = nrow;
    }
}

__device__ __forceinline__ float ret_lg2(int h) { return __log2f(1.f - ex2((float)(-5 - h))); }
__device__ __forceinline__ void ret_passA(const Params& P, int wid, int lane) {
    bf16_t* B = (bf16_t*)(P.ws + WS_B);
    bf16_t* KV = (bf16_t*)(P.ws + WS_C);
    bf16_t* KVS = (bf16_t*)(P.ws + WS_KVS);
    const int l32 = lane & 31, hh = lane >> 5;
    const int mt = wid >> 1, nt0 = (wid & 1) * 2;
    for (int u = blockIdx.x; u < 4096 + 32; u += gridDim.x) {
        const bool samp = u >= 4096;
        f32x16 d0 = {}, d1 = {};
        if (!samp) {
            const bf16_t* vt = B + B_VT + (size_t)u * 8192; const bf16_t* kt = B + B_KT + (size_t)u * 8192;
#pragma unroll
            for (int ks = 0; ks < 4; ++ks) {
                const bf16x8 a = *(const bf16x8*)(vt + (32 * mt + l32) * 64 + 16 * ks + 8 * hh);
                const bf16x8 b0 = *(const bf16x8*)(kt + (32 * nt0 + l32) * 64 + 16 * ks + 8 * hh);
                const bf16x8 b1 = *(const bf16x8*)(kt + (32 * nt0 + 32 + l32) * 64 + 16 * ks + 8 * hh);
                d0 = MFMA32(a, b0, d0); d1 = MFMA32(a, b1, d1);
            }
            bf16_t* o = KV + (size_t)u * 16384;
#pragma unroll
            for (int r = 0; r < 16; ++r) { const int e = 32 * mt + (r & 3) + 8 * (r >> 2) + 4 * hh; o[e * 128 + 32 * nt0 + l32] = f2bf(d0[r]); o[e * 128 + 32 * nt0 + 32 + l32] = f2bf(d1[r]); }
        } else {
            const int bh = u - 4096, hd = bh & 3;
            const bf16_t* vt = B + B_VTS + (size_t)bh * 4096; const bf16_t* kt = B + B_KTS + (size_t)bh * 4096;
#pragma unroll
            for (int ks = 0; ks < 2; ++ks) {
                const bf16x8 a = *(const bf16x8*)(vt + (32 * mt + l32) * 32 + 16 * ks + 8 * hh);
                const bf16x8 b0 = *(const bf16x8*)(kt + (32 * nt0 + l32) * 32 + 16 * ks + 8 * hh);
                const bf16x8 b1 = *(const bf16x8*)(kt + (32 * nt0 + 32 + l32) * 32 + 16 * ks + 8 * hh);
                d0 = MFMA32(a, b0, d0); d1 = MFMA32(a, b1, d1);
            }
            const float g32 = ex2(ret_lg2(hd) * 32.f);
            const float* s0 = P.in[2] + (size_t)bh * 16384; float* so = P.out + O_RSS + (size_t)bh * 16384; bf16_t* sb = KVS + (size_t)bh * 16384;
#pragma unroll
            for (int r = 0; r < 16; ++r) {
                const int e = 32 * mt + (r & 3) + 8 * (r >> 2) + 4 * hh;
#pragma unroll
                for (int q = 0; q < 2; ++q) {
                    const int dp = 32 * nt0 + 32 * q + l32, d = (dp >> 1) + 64 * (dp & 1);
                    const float s = s0[d * 128 + e];
                    so[d * 128 + e] = s * g32 + (q ? d1[r] : d0[r]);
                    sb[e * 128 + dp] = f2bf(s);
                }
            }
        }
    }
}
__device__ __forceinline__ void ret_passB(const Params& P, int tid) {
    unsigned* KV = (unsigned*)(P.ws + WS_C);
    for (int i = blockIdx.x * 512 + tid; i < 32 * 8192; i += gridDim.x * 512) {
        const int bh = i >> 13, idx = i & 8191;
        const float dec = ex2(ret_lg2(bh & 3) * 64.f);
        unsigned* p = KV + (size_t)bh * 128 * 8192 + idx;
        float s0 = 0.f, s1 = 0.f;
        for (int n0 = 0; n0 < 128; n0 += 16) {
            unsigned v[16];
#pragma unroll
            for (int k = 0; k < 16; ++k) v[k] = p[(size_t)(n0 + k) * 8192];
#pragma unroll
            for (int k = 0; k < 16; ++k) { p[(size_t)(n0 + k) * 8192] = pk2(s0, s1); s0 = s0 * dec + bflo(v[k]); s1 = s1 * dec + bfhi(v[k]); }
        }
        const int e = idx >> 6, dp = (idx & 63) * 2;
        float* so = P.out + O_RSP + (size_t)bh * 16384;
        so[(dp >> 1) * 128 + e] = s0;
        so[((dp >> 1) + 64) * 128 + e] = s1;
    }
}
template <int L> __device__ __forceinline__ void ret_unitC(const Params& P, LAS float* red, int bh, int n, int wid, int lane) {
    const bf16_t* B = (const bf16_t*)(P.ws + WS_B);
    const int l32 = lane & 31, hh = lane >> 5, hd = bh & 3, b = bh >> 2;
    const int et = wid >> 1, it = wid & 1;
    const bool act = (L == 64) || (it == 0);
    const int row0 = (L == 64) ? (b * T + n * 64) : (RP + b * 32);
    const bf16_t* sbef = (L == 64) ? (const bf16_t*)(P.ws + WS_C) + (size_t)(bh * 128 + n) * 16384 : (const bf16_t*)(P.ws + WS_KVS) + (size_t)bh * 16384;
    const bf16_t* vt = (L == 64) ? B + B_VT + (size_t)(bh * 128 + n) * 8192 : B + B_VTS + (size_t)bh * 4096;
    const float lg2 = ret_lg2(hd);
    const int i = 32 * it + l32;
    f32x16 acc = {};
    float s1 = 0.f, s2 = 0.f;
    if (act) {
        bf16x8 qf[8];
#pragma unroll
        for (int ks = 0; ks < 8; ++ks) qf[ks] = *(const bf16x8*)(B + B_RQ + (size_t)(row0 + i) * 512 + hd * 128 + 16 * ks + 8 * hh);
#pragma unroll
        for (int ks = 0; ks < 8; ++ks) { const bf16x8 a = *(const bf16x8*)(sbef + (32 * et + l32) * 128 + 16 * ks + 8 * hh); acc = MFMA32(a, qf[ks], acc); }
        acc = acc * ex2(lg2 * (float)(i + 1));
#pragma unroll
        for (int jt = 0; jt < L / 32; ++jt) {
            f32x16 sc = {};
#pragma unroll
            for (int ks = 0; ks < 8; ++ks) { const bf16x8 a = *(const bf16x8*)(B + B_RK + (size_t)(row0 + 32 * jt + l32) * 512 + hd * 128 + 16 * ks + 8 * hh); sc = MFMA32(a, qf[ks], sc); }
#pragma unroll
            for (int r = 0; r < 16; ++r) { const int j = 32 * jt + (r & 3) + 8 * (r >> 2) + 4 * hh; const int dd = i > j ? i - j : j - i; sc[r] = sc[r] * ex2(lg2 * (float)dd); }
#pragma unroll
            for (int s = 0; s < 2; ++s) {
                u32x4 pw; pw.x = pk2(sc[8 * s], sc[8 * s + 1]); pw.y = pk2(sc[8 * s + 2], sc[8 * s + 3]); pw.z = pk2(sc[8 * s + 4], sc[8 * s + 5]); pw.w = pk2(sc[8 * s + 6], sc[8 * s + 7]);
                const bf16x8 pf = __builtin_bit_cast(bf16x8, pw);
                const bf16_t* vb = vt + (32 * et + l32) * L + 32 * jt + 16 * s + 4 * hh;
                const u32x2 lo = *(const u32x2*)vb, hi = *(const u32x2*)(vb + 8);
                const u32x4 vw = {lo.x, lo.y, hi.x, hi.y};
                acc = MFMA32(__builtin_bit_cast(bf16x8, vw), pf, acc);
            }
        }
#pragma unroll
        for (int r = 0; r < 16; ++r) { s1 += acc[r]; s2 += acc[r] * acc[r]; }
        s1 += __shfl_xor(s1, 32); s2 += __shfl_xor(s2, 32);
        if (hh == 0) { red[et * 64 + i] = s1; red[256 + et * 64 + i] = s2; }
    }
    __syncthreads();
    if (act) {
        const float t1 = red[i] + red[64 + i] + red[128 + i] + red[192 + i];
        const float t2 = red[256 + i] + red[320 + i] + red[384 + i] + red[448 + i];
        const float mu = t1 * (1.f / 128.f), var = fmaxf(t2 * (1.f / 128.f) - mu * mu, 0.f), rstd = rsqrtf(var + EPS);
        const float* gw = P.in[14] + hd * 128;
        bf16_t* mixed = (bf16_t*)(P.ws + WS_A);
#pragma unroll
        for (int g = 0; g < 4; ++g) {
            const int e = 32 * et + 8 * g + 4 * hh;
            const f32x4 w4 = *(const f32x4*)(gw + e);
            const u32x2 gt = *(const u32x2*)(B + B_RG + (size_t)(row0 + i) * 512 + hd * 128 + e);
            f32x4 o;
            o.x = (acc[4 * g] - mu) * rstd * w4.x * bflo(gt.x); o.y = (acc[4 * g + 1] - mu) * rstd * w4.y * bfhi(gt.x);
            o.z = (acc[4 * g + 2] - mu) * rstd * w4.z * bflo(gt.y); o.w = (acc[4 * g + 3] - mu) * rstd * w4.w * bfhi(gt.y);
            u32x2 w; w.x = pk2(o.x, o.y); w.y = pk2(o.z, o.w);
            *(u32x2*)(mixed + (size_t)(row0 + i) * 1024 + hd * 128 + e) = w;
        }
    }
    __syncthreads();
}

struct FoxUnit { const bf16_t* Q; const bf16_t* K; const bf16_t* VT; const float* c2; bf16_t* O; int vtp, qpos0, nq, ntiles, Tk; };
constexpr int FOX_BUF = 18432, FOX_VOFF = 9216, FOX_COFF = 17920;
__device__ __forceinline__ void fox_unit(LAS unsigned char* lds, const FoxUnit U, int tid, int wid, int lane) {
    const int l32 = lane & 31, hh = lane >> 5;
    const bool active = wid * 32 < U.nq;
    bf16x8 qf[4];
#pragma unroll
    for (int s = 0; s < 4; ++s) qf[s] = active ? *(const bf16x8*)(U.Q + (size_t)(wid * 32 + l32) * 512 + 16 * s + 8 * hh) : (bf16x8){0, 0, 0, 0, 0, 0, 0, 0};
    const int wq_lo = U.qpos0 + wid * 32, wq_hi = wq_lo + 31, qpos = wq_lo + l32;
    float m = -INFINITY, l = 0.f; f32x16 o0 = {}, o1 = {};
    const int srow = tid >> 3, sch = tid & 7;
    u32x4 kr, vr; float cr = 0.f;
#define FOX_LOAD(t) do { int key_ = (t) * 64 + srow; key_ = key_ < U.Tk ? key_ : U.Tk - 1; kr = *(const u32x4*)(U.K + (size_t)key_ * 512 + sch * 8); \
        vr = *(const u32x4*)(U.VT + (size_t)srow * U.vtp + (t) * 64 + sch * 8); \
        if (tid < 64) { int kc_ = (t) * 64 + tid; kc_ = kc_ < U.Tk ? kc_ : U.Tk - 1; cr = U.c2[kc_]; } } while (0)
#define FOX_STORE(bi) do { LAS unsigned char* kb_ = lds + (bi) * FOX_BUF; *(LAS u32x4*)(kb_ + srow * 144 + sch * 16) = kr; \
        *(LAS u32x2*)(kb_ + FOX_VOFF + srow * 136 + sch * 16) = (u32x2){vr.x, vr.y}; *(LAS u32x2*)(kb_ + FOX_VOFF + srow * 136 + sch * 16 + 8) = (u32x2){vr.z, vr.w}; \
        if (tid < 64) *(LAS float*)(kb_ + FOX_COFF + tid * 4) = -cr; } while (0)
    FOX_LOAD(0); FOX_STORE(0);
    __syncthreads();
    for (int t = 0; t < U.ntiles; ++t) {
        const bool more = t + 1 < U.ntiles;
        if (more) FOX_LOAD(t + 1);
        if (active && t * 64 <= wq_hi) {
            LAS unsigned char* kb = lds + (t & 1) * FOX_BUF;
            f32x16 p0, p1;
#pragma unroll
            for (int g = 0; g < 4; ++g) {
                const f32x4 c0 = *(LAS f32x4*)(kb + FOX_COFF + (8 * g + 4 * hh) * 4), c1 = *(LAS f32x4*)(kb + FOX_COFF + (32 + 8 * g + 4 * hh) * 4);
                p0[4 * g] = c0.x; p0[4 * g + 1] = c0.y; p0[4 * g + 2] = c0.z; p0[4 * g + 3] = c0.w;
                p1[4 * g] = c1.x; p1[4 * g + 1] = c1.y; p1[4 * g + 2] = c1.z; p1[4 * g + 3] = c1.w;
            }
#pragma unroll
            for (int s = 0; s < 4; ++s) {
                const bf16x8 a0 = *(LAS bf16x8*)(kb + l32 * 144 + (2 * s + hh) * 16), a1 = *(LAS bf16x8*)(kb + (32 + l32) * 144 + (2 * s + hh) * 16);
                p0 = MFMA32(a0, qf[s], p0); p1 = MFMA32(a1, qf[s], p1);
            }
            if (t * 64 + 63 > wq_lo) {
#pragma unroll
                for (int r = 0; r < 16; ++r) { const int key = t * 64 + (r & 3) + 8 * (r >> 2) + 4 * hh; if (key > qpos) p0[r] = -INFINITY; if (key + 32 > qpos) p1[r] = -INFINITY; }
            }
            float mx = fmaxf(p0[0], p1[0]);
#pragma unroll
            for (int r = 1; r < 16; ++r) mx = fmaxf(mx, fmaxf(p0[r], p1[r]));
            mx = fmaxf(mx, __shfl_xor(mx, 32));
            const float mn = fmaxf(m, mx), alpha = ex2(m - mn); m = mn;
            float rs = 0.f;
#pragma unroll
            for (int r = 0; r < 16; ++r) { p0[r] = ex2(p0[r] - mn); p1[r] = ex2(p1[r] - mn); rs += p0[r] + p1[r]; }
            l = l * alpha + rs; o0 = o0 * alpha; o1 = o1 * alpha;
#pragma unroll
            for (int s = 0; s < 4; ++s) {
                u32x4 pw;
                if (s < 2) { pw.x = pk2(p0[8 * s], p0[8 * s + 1]); pw.y = pk2(p0[8 * s + 2], p0[8 * s + 3]); pw.z = pk2(p0[8 * s + 4], p0[8 * s + 5]); pw.w = pk2(p0[8 * s + 6], p0[8 * s + 7]); }
                else { const int q = 8 * (s - 2); pw.x = pk2(p1[q], p1[q + 1]); pw.y = pk2(p1[q + 2], p1[q + 3]); pw.z = pk2(p1[q + 4], p1[q + 5]); pw.w = pk2(p1[q + 6], p1[q + 7]); }
                const bf16x8 pf = __builtin_bit_cast(bf16x8, pw);
                LAS unsigned char* vb = kb + FOX_VOFF + l32 * 136 + (16 * s + 4 * hh) * 2;
                const u32x2 a = *(LAS u32x2*)vb, b = *(LAS u32x2*)(vb + 16), c = *(LAS u32x2*)(vb + 32 * 136), d = *(LAS u32x2*)(vb + 32 * 136 + 16);
                const u32x4 v0 = {a.x, a.y, b.x, b.y}, v1 = {c.x, c.y, d.x, d.y};
                o0 = MFMA32(__builtin_bit_cast(bf16x8, v0), pf, o0); o1 = MFMA32(__builtin_bit_cast(bf16x8, v1), pf, o1);
            }
        }
        if (more) FOX_STORE((t + 1) & 1);
        __syncthreads();
    }
#undef FOX_LOAD
#undef FOX_STORE
    if (active) {
        const float inv = 1.f / (l + __shfl_xor(l, 32));
        bf16_t* op = U.O + (size_t)(wid * 32 + l32) * 1024 + 4 * hh;
#pragma unroll
        for (int g = 0; g < 4; ++g) {
            u32x2 w; w.x = pk2(o0[4 * g] * inv, o0[4 * g + 1] * inv); w.y = pk2(o0[4 * g + 2] * inv, o0[4 * g + 3] * inv); *(u32x2*)(op + 8 * g) = w;
            w.x = pk2(o1[4 * g] * inv, o1[4 * g + 1] * inv); w.y = pk2(o1[4 * g + 2] * inv, o1[4 * g + 3] * inv); *(u32x2*)(op + 32 + 8 * g) = w;
        }
    }
}
__device__ __forceinline__ void fox_phase(const Params& P, LAS unsigned char* lds, int tid, int wid, int lane) {
    const bf16_t* B = (const bf16_t*)(P.ws + WS_B);
    bf16_t* mixed = (bf16_t*)(P.ws + WS_A);
    for (int it = blockIdx.x; it < 1024 + 64; it += gridDim.x) {
        if (it < 1024) {
            const int bh = it >> 4, pi = it & 15, b = bh >> 3, hd = bh & 7;
#pragma unroll 1
            for (int k = 0; k < 2; ++k) {
                const int qb = k ? 31 - pi : pi;
                FoxUnit U;
                U.Q = B + B_FQ + (size_t)(b * T + qb * 256) * 512 + hd * 64; U.K = B + B_FK + (size_t)b * T * 512 + hd * 64;
                U.VT = B + B_FVT + (size_t)(b * 512 + hd * 64) * T; U.c2 = (const float*)(P.ws + WS_C2P) + (size_t)bh * T;
                U.O = mixed + (size_t)(b * T + qb * 256) * 1024 + 512 + hd * 64; U.vtp = T; U.qpos0 = qb * 256; U.nq = 256; U.ntiles = 4 * (qb + 1); U.Tk = T;
                fox_unit(lds, U, tid, wid, lane);
            }
        } else {
            const int bh = it - 1024, b = bh >> 3, hd = bh & 7;
            FoxUnit U;
            U.Q = B + B_FQ + (size_t)(RP + b * 32) * 512 + hd * 64; U.K = (const bf16_t*)(P.ws + WS_FKS) + (size_t)b * TKS * 512 + hd * 64;
            U.VT = (const bf16_t*)(P.ws + WS_FVTS) + (size_t)(b * 512 + hd * 64) * TKS; U.c2 = (const float*)(P.ws + WS_C2S) + (size_t)bh * TKS;
            U.O = mixed + (size_t)(RP + b * 32) * 1024 + 512 + hd * 64; U.vtp = TKS; U.qpos0 = PAST; U.nq = 32; U.ntiles = 65; U.Tk = TKS;
            fox_unit(lds, U, tid, wid, lane);
        }
    }
}

constexpr int XA_BUF = 16896;
__device__ __forceinline__ void xattn_unit(LAS unsigned char* lds, const bf16_t* Q, const bf16_t* Kb, const bf16_t* VTb, bf16_t* O, int nwaves, int tid, int wid, int lane) {
    const int l32 = lane & 31, hh = lane >> 5;
    const bool active = wid < nwaves;
    bf16x8 qf[16];
#pragma unroll
    for (int s = 0; s < 16; ++s) qf[s] = active ? *(const bf16x8*)(Q + (size_t)(wid * 32 + l32) * 1024 + 16 * s + 8 * hh) : (bf16x8){0, 0, 0, 0, 0, 0, 0, 0};
    f32x16 S[4];
    bf16x8 pf[16];
    float m1 = 0.f, l1 = 0.f, a1 = 0.f, a2 = 0.f;
    u32x4 r0, r1;
    const int i0 = tid, i1 = tid + 512;
    const bf16_t* g0 = Kb + (size_t)(i0 >> 5) * 1024 + (i0 & 31) * 8; const bf16_t* g1 = Kb + (size_t)(i1 >> 5) * 1024 + (i1 & 31) * 8;
    const bf16_t* h0 = VTb + (size_t)(i0 >> 5) * 256 + (i0 & 31) * 8; const bf16_t* h1 = VTb + (size_t)(i1 >> 5) * 256 + (i1 & 31) * 8;
#define XA_LOAD(tt) do { if ((tt) < 8) { r0 = *(const u32x4*)g0; r1 = *(const u32x4*)g1; g0 += 32 * 1024; g1 += 32 * 1024; asm volatile("" : "+v"(g0), "+v"(g1)); } \
        else { r0 = *(const u32x4*)h0; r1 = *(const u32x4*)h1; h0 += 32 * 256; h1 += 32 * 256; asm volatile("" : "+v"(h0), "+v"(h1)); } } while (0)
#define XA_STORE(bi) do { LAS unsigned char* b_ = lds + (bi) * XA_BUF; *(LAS u32x4*)(b_ + (i0 >> 5) * 528 + (i0 & 31) * 16) = r0; *(LAS u32x4*)(b_ + (i1 >> 5) * 528 + (i1 & 31) * 16) = r1; } while (0)
#define XA_HALF(hf, mm, ll) do { float mx_ = S[0][0]; \
        _Pragma("unroll") for (int k = 0; k < 4; ++k) _Pragma("unroll") for (int r = 0; r < 16; ++r) mx_ = fmaxf(mx_, S[k][r]); \
        mx_ = fmaxf(mx_, __shfl_xor(mx_, 32)); float l_ = 0.f; \
        _Pragma("unroll") for (int k = 0; k < 4; ++k) { \
            _Pragma("unroll") for (int r = 0; r < 16; ++r) { S[k][r] = ex2(S[k][r] - mx_); l_ += S[k][r]; } \
            _Pragma("unroll") for (int s = 0; s < 2; ++s) { u32x4 pw; pw.x = pk2(S[k][8 * s], S[k][8 * s + 1]); pw.y = pk2(S[k][8 * s + 2], S[k][8 * s + 3]); pw.z = pk2(S[k][8 * s + 4], S[k][8 * s + 5]); pw.w = pk2(S[k][8 * s + 6], S[k][8 * s + 7]); \
                pf[8 * (hf) + 2 * k + s] = __builtin_bit_cast(bf16x8, pw); } } \
        mm = mx_; ll = l_ + __shfl_xor(l_, 32); } while (0)
    XA_LOAD(0); XA_STORE(0);
    __syncthreads();
#pragma unroll
    for (int tt = 0; tt < 16; ++tt) {
        if (tt + 1 < 16) XA_LOAD(tt + 1);
        LAS unsigned char* buf = lds + (tt & 1) * XA_BUF;
        if (active) {
            if (tt < 8) {
                f32x16 s = {};
#pragma unroll
                for (int k = 0; k < 16; ++k) { const bf16x8 a = *(LAS bf16x8*)(buf + l32 * 528 + (2 * k + hh) * 16); s = MFMA32(a, qf[k], s); }
                S[tt & 3] = s;
                if (tt == 3) XA_HALF(0, m1, l1);
                if (tt == 7) {
                    float m2, l2; XA_HALF(1, m2, l2);
                    const float mm = fmaxf(m1, m2); a1 = ex2(m1 - mm); a2 = ex2(m2 - mm);
                    const float inv = 1.f / (a1 * l1 + a2 * l2); a1 *= inv; a2 *= inv;
                }
            } else {
                f32x16 o1 = {}, o2 = {};
#pragma unroll
                for (int k = 0; k < 16; ++k) {
                    LAS unsigned char* vb = buf + l32 * 528 + (16 * k + 4 * hh) * 2;
                    const u32x2 a = *(LAS u32x2*)vb, b = *(LAS u32x2*)(vb + 16);
                    const u32x4 vw = {a.x, a.y, b.x, b.y};
                    if (k < 8) o1 = MFMA32(__builtin_bit_cast(bf16x8, vw), pf[k], o1); else o2 = MFMA32(__builtin_bit_cast(bf16x8, vw), pf[k], o2);
                }
                bf16_t* op = O + (size_t)(wid * 32 + l32) * 1024 + 32 * (tt - 8) + 4 * hh;
#pragma unroll
                for (int g = 0; g < 4; ++g) { u32x2 w; w.x = pk2(o1[4 * g] * a1 + o2[4 * g] * a2, o1[4 * g + 1] * a1 + o2[4 * g + 1] * a2); w.y = pk2(o1[4 * g + 2] * a1 + o2[4 * g + 2] * a2, o1[4 * g + 3] * a1 + o2[4 * g + 3] * a2); *(u32x2*)(op + 8 * g) = w; }
            }
        }
        if (tt + 1 < 16) XA_STORE((tt + 1) & 1);
        __syncthreads();
    }
#undef XA_HALF
#undef XA_LOAD
#undef XA_STORE
}
__device__ __forceinline__ void xattn_phase(const Params& P, LAS unsigned char* lds, int layer, int tid, int wid, int lane) {
    const bf16_t* XQ = (const bf16_t*)(P.ws + WS_B);
    bf16_t* XO = (bf16_t*)(P.ws + WS_B) + B_X2;
    const bf16_t* MK = (const bf16_t*)(P.ws + WS_MEMK); const bf16_t* MVT = (const bf16_t*)(P.ws + WS_MEMVT);
    for (int it = blockIdx.x; it < 1024 + 32; it += gridDim.x) {
        int row0, set, hd, nw;
        if (it < 1024) { const int pm = it >> 2; hd = it & 3; row0 = pm * 256; set = layer * 16 + (pm >> 5); nw = 8; }
        else { const int q = it - 1024, b = q >> 2; hd = q & 3; row0 = RP + b * 32; set = layer * 16 + 8 + b; nw = 1; }
        xattn_unit(lds, XQ + (size_t)row0 * 1024 + hd * 256, MK + (size_t)set * 262144 + hd * 256, MVT + ((size_t)set * 1024 + hd * 256) * 256, XO + (size_t)row0 * 1024 + hd * 256, nw, tid, wid, lane);
    }
}

__device__ __forceinline__ void s5_run(LAS unsigned char* wl, const bf16_t* U, bf16_t* Y, int row0, int L, int g, f32x2 a, float& xr, float& xi, bool outp,
                                       const bf16_t* SB5, const bf16_t* SC5, const float* s5d, int lane) {
    const int l32 = lane & 31, hh = lane >> 5, l16 = lane & 15, q4 = lane >> 4;
    bf16x8 bfr[4], cfr[4];
#pragma unroll
    for (int k = 0; k < 4; ++k) { bfr[k] = *(const bf16x8*)(SB5 + ((size_t)(g * 4 + k) * 64 + lane) * 8); cfr[k] = *(const bf16x8*)(SC5 + ((size_t)(g * 4 + k) * 64 + lane) * 8); }
    const f32x4 dv = *(const f32x4*)(s5d + g * 16 + 4 * q4);
    for (int sc = 0; sc < L / 32; ++sc) {
        const int r0 = row0 + sc * 32;
        const bf16x8 uf = *(const bf16x8*)(U + (size_t)(r0 + l32) * 1024 + g * 16 + 8 * hh);
        const f32x16 z = {};
        const f32x16 d0 = MFMA32(uf, bfr[0], z), d1 = MFMA32(uf, bfr[1], z), d2 = MFMA32(uf, bfr[2], z), d3 = MFMA32(uf, bfr[3], z);
#pragma unroll
        for (int r = 0; r < 16; ++r) {
            const int tok = (r & 3) + 8 * (r >> 2) + 4 * hh;
            *(LAS f32x2*)(wl + tok * 528 + l32 * 8) = (f32x2){d0[r], d2[r]};
            *(LAS f32x2*)(wl + tok * 528 + (32 + l32) * 8) = (f32x2){d1[r], d3[r]};
        }
        LDSBAR();
#pragma unroll 8
        for (int t = 0; t < 32; ++t) {
            const f32x2 bu = *(LAS f32x2*)(wl + t * 528 + lane * 8);
            const float nr = a.x * xr - a.y * xi + bu.x, ni = a.x * xi + a.y * xr + bu.y;
            xr = nr; xi = ni;
            if (outp) { asm volatile("" ::: "memory"); *(LAS float*)(wl + t * 528 + lane * 4) = __uint_as_float(pk2(xr, xi)); }
        }
        LDSBAR();
        if (outp) {
#pragma unroll
            for (int tb = 0; tb < 2; ++tb) {
                f32x4 acc = {0.f, 0.f, 0.f, 0.f};
#pragma unroll
                for (int ks = 0; ks < 4; ++ks) { const bf16x8 xf = *(LAS bf16x8*)(wl + (16 * tb + l16) * 528 + (32 * ks + 8 * q4) * 2); acc = MFMA16(cfr[ks], xf, acc); }
                const size_t off = (size_t)(r0 + 16 * tb + l16) * 1024 + g * 16 + 4 * q4;
                const u32x2 uu = *(const u32x2*)(U + off);
                f32x4 y; y.x = acc.x + dv.x * bflo(uu.x); y.y = acc.y + dv.y * bfhi(uu.x); y.z = acc.z + dv.z * bflo(uu.y); y.w = acc.w + dv.w * bfhi(uu.y);
                u32x2 w; w.x = pk2(y.x, y.y); w.y = pk2(y.z, y.w);
                *(u32x2*)(Y + off) = w;
            }
        }
        LDSBAR();
    }
}
constexpr int S5_NSEG = 16, S5_LSEG = 512;
__device__ __forceinline__ void s5_phase(const Params& P, LAS unsigned char* lds, int pass, int wid, int lane) {
    const bf16_t* U = (const bf16_t*)(P.ws + WS_B);
    bf16_t* Y = (bf16_t*)(P.ws + WS_B) + B_X2;
    const f32x2* S5A = (const f32x2*)(P.ws + WS_S5T); const f32x2* S5AL = S5A + 4096;
    const bf16_t* SB5 = (const bf16_t*)(P.ws + WS_S5T + 65536); const bf16_t* SC5 = SB5 + 131072;
    f32x2* LE = (f32x2*)(P.ws + WS_LE);
    LAS unsigned char* wl = lds + wid * 16896;
    const int nunits = (pass == 1) ? 8 * (S5_NSEG - 1) * 8 : 8 * S5_NSEG * 8 + 64;
    for (int it = blockIdx.x; it < nunits; it += gridDim.x) {
        if (pass == 1) {
            const int g8 = it & 7, seg = (it >> 3) % (S5_NSEG - 1), b = (it >> 3) / (S5_NSEG - 1), g = g8 * 8 + wid;
            float xr = 0.f, xi = 0.f;
            s5_run(wl, U, Y, b * T + seg * S5_LSEG, S5_LSEG, g, S5A[g * 64 + lane], xr, xi, false, SB5, SC5, P.in[24], lane);
            LE[((size_t)(b * S5_NSEG + seg) * 64 + g) * 64 + lane] = (f32x2){xr, xi};
        } else if (it < 8 * S5_NSEG * 8) {
            const int g8 = it & 7, seg = (it >> 3) & (S5_NSEG - 1), b = it >> 7, g = g8 * 8 + wid;
            const f32x2 aL = S5AL[g * 64 + lane];
            float xr = 0.f, xi = 0.f;
            for (int s = 0; s < seg; ++s) { const f32x2 le = LE[((size_t)(b * S5_NSEG + s) * 64 + g) * 64 + lane]; const float nr = aL.x * xr - aL.y * xi + le.x, ni = aL.x * xi + aL.y * xr + le.y; xr = nr; xi = ni; }
            s5_run(wl, U, Y, b * T + seg * S5_LSEG, S5_LSEG, g, S5A[g * 64 + lane], xr, xi, true, SB5, SC5, P.in[24], lane);
            if (seg == S5_NSEG - 1) { P.out[O_S5RP + (size_t)(b * 64 + g) * 64 + lane] = xr; P.out[O_S5IP + (size_t)(b * 64 + g) * 64 + lane] = xi; }
        } else {
            const int q = it - 8 * S5_NSEG * 8, g8 = q & 7, b = q >> 3, g = g8 * 8 + wid;
            float xr = P.in[6][(size_t)(b * 64 + g) * 64 + lane], xi = P.in[7][(size_t)(b * 64 + g) * 64 + lane];
            s5_run(wl, U, Y, RP + b * 32, 32, g, S5A[g * 64 + lane], xr, xi, true, SB5, SC5, P.in[24], lane);
            P.out[O_S5RS + (size_t)(b * 64 + g) * 64 + lane] = xr; P.out[O_S5IS + (size_t)(b * 64 + g) * 64 + lane] = xi;
        }
    }
}

__device__ __forceinline__ void prologue(const Params& P, int tid, int wid, int lane) {
    const int gtid = blockIdx.x * 512 + tid, gsz = gridDim.x * 512;
    const int gw = blockIdx.x * 8 + wid, ngw = gridDim.x * 8;
    bf16_t* W = (bf16_t*)(P.ws + WS_W);
    wtrans(P.in[12], 1024, 3592, W + W_AB, 3840, 1, gtid, gsz);
    wtrans(P.in[15], 1024, 1024, W + W_OUT, 1024, 0, gtid, gsz);
    wtrans(P.in[16], 1024, 1024, W + W_INC, 1024, 0, gtid, gsz);
    wtrans(P.in[25], 1024, 2048, W + W_GLU, 2048, 2, gtid, gsz);
    for (int l = 0; l < 2; ++l) {
        wtrans(P.in[27] + (size_t)l * 1048576, 1024, 1024, W + W_XQ + (size_t)l * 1048576, 1024, 0, gtid, gsz);
        wtrans(P.in[28] + (size_t)l * 1048576, 1024, 1024, W + W_XKV + (size_t)l * 2097152, 1024, 0, gtid, gsz);
        wtrans(P.in[29] + (size_t)l * 1048576, 1024, 1024, W + W_XKV + (size_t)l * 2097152 + 1048576, 1024, 0, gtid, gsz);
        wtrans(P.in[30] + (size_t)l * 1048576, 1024, 1024, W + W_XO + (size_t)l * 1048576, 1024, 0, gtid, gsz);
        wtrans(P.in[31] + (size_t)l * 4194304, 1024, 4096, W + W_UP + (size_t)l * 4194304, 4096, 0, gtid, gsz);
        wtrans(P.in[32] + (size_t)l * 4194304, 4096, 1024, W + W_DN + (size_t)l * 4194304, 1024, 0, gtid, gsz);
    }
    {
        float* rope = (float*)(P.ws + WS_ROPE);
        for (int i = gtid; i < 8192 * 64; i += gsz) {
            const int pos = i >> 6, k = i & 63;
            const double inv = exp2(-(double)k * (13.287712379549449 / 64.0));
            const double ang = (double)pos * inv;
            rope[2 * i] = (float)cos(ang); rope[2 * i + 1] = (float)sin(ang);
        }
    }
    {
        f32x2* S5A = (f32x2*)(P.ws + WS_S5T); f32x2* S5AL = S5A + 4096;
        bf16_t* SB5 = (bf16_t*)(P.ws + WS_S5T + 65536); bf16_t* SC5 = SB5 + 131072;
        for (int i = gtid; i < 4096; i += gsz) {
            const int g = i >> 6, p = i & 63;
            const double lr = P.in[17][i], li = P.in[18][i], dt = exp((double)P.in[19][g]);
            const double mag = exp(lr * dt), ar = mag * cos(li * dt), ai = mag * sin(li * dt);
            S5A[i] = (f32x2){(float)ar, (float)ai};
            const double magL = exp(lr * dt * S5_LSEG);
            S5AL[i] = (f32x2){(float)(magL * cos(li * dt * S5_LSEG)), (float)(magL * sin(li * dt * S5_LSEG))};
            const double den = lr * lr + li * li, nre = ar - 1.0;
            const double fr = (nre * lr + ai * li) / den, fi = (ai * lr - nre * li) / den;
            const float* br = P.in[20] + (size_t)i * 16; const float* bi = P.in[21] + (size_t)i * 16;
#pragma unroll
            for (int part = 0; part < 2; ++part)
#pragma unroll
                for (int h2 = 0; h2 < 2; ++h2) {
                    float v[8];
#pragma unroll
                    for (int k = 0; k < 8; ++k) { const int c = 8 * h2 + k; v[k] = part == 0 ? (float)(fr * br[c] - fi * bi[c]) : (float)(fr * bi[c] + fi * br[c]); }
                    u32x4 o; o.x = pk2(v[0], v[1]); o.y = pk2(v[2], v[3]); o.z = pk2(v[4], v[5]); o.w = pk2(v[6], v[7]);
                    const int kb = 2 * part + (p >> 5), ln = (p & 31) + 32 * h2;
                    *(u32x4*)(SB5 + ((size_t)(g * 4 + kb) * 64 + ln) * 8) = o;
                }
        }
        for (int i = gtid; i < 64 * 4 * 64; i += gsz) {
            const int ln = i & 63, ks = (i >> 6) & 3, g = i >> 8;
            const int c = ln & 15;
            float v[8];
#pragma unroll
            for (int k = 0; k < 8; ++k) { const int kidx = 32 * ks + 8 * (ln >> 4) + k, p = kidx >> 1; v[k] = (kidx & 1) ? -P.in[23][((size_t)g * 16 + c) * 64 + p] : P.in[22][((size_t)g * 16 + c) * 64 + p]; }
            u32x4 o; o.x = pk2(v[0], v[1]); o.y = pk2(v[2], v[3]); o.z = pk2(v[4], v[5]); o.w = pk2(v[6], v[7]);
            *(u32x4*)(SC5 + (size_t)i * 8) = o;
        }
    }
    {
        bf16_t* FKS = (bf16_t*)(P.ws + WS_FKS); bf16_t* FVTS = (bf16_t*)(P.ws + WS_FVTS);
        for (int i = gtid; i < 8 * PAST * 64; i += gsz) { const int b = i / (PAST * 64), r = i % (PAST * 64); cvt8(P.in[3] + (size_t)i * 8, FKS + (size_t)b * TKS * 512 + (size_t)r * 8); }
        for (int b = 0; b < 8; ++b) ttrans(P.in[4] + (size_t)b * PAST * 512, PAST, 512, FVTS + (size_t)b * 512 * TKS, TKS, gtid, gsz);
        bf16_t* MK = (bf16_t*)(P.ws + WS_MEMK); bf16_t* MVT = (bf16_t*)(P.ws + WS_MEMVT);
        for (int i = gtid; i < 2 * 8 * 32768; i += gsz) { const int lb = i >> 15, r = i & 32767, l = lb >> 3, b = lb & 7; cvt8(P.in[8] + (size_t)i * 8, MK + (size_t)(l * 16 + 8 + b) * 262144 + (size_t)r * 8); }
        for (int lb = 0; lb < 16; ++lb) { const int l = lb >> 3, b = lb & 7; ttrans(P.in[9] + (size_t)lb * 262144, 256, 1024, MVT + (size_t)(l * 16 + 8 + b) * 262144, 256, gtid, gsz); }
    }
    {
        bf16_t* H = (bf16_t*)(P.ws + WS_A); bf16_t* MEMN = (bf16_t*)(P.ws + WS_MEMN);
        for (int row = gw; row < R + 4096; row += ngw) {
            if (row < R) { const float* xr = row < RP ? P.in[0] + (size_t)row * 1024 : P.in[1] + (size_t)(row - RP) * 1024; norm_row(xr, P.in[11], H + (size_t)row * 1024, lane); }
            else { const int q = row - R, l = q >> 11, r = q & 2047; norm_row(P.in[10] + (size_t)r * 1024, P.in[26] + l * 1024, MEMN + (size_t)q * 1024, lane); }
        }
    }
}
__device__ __forceinline__ void cumsum_task(const Params& P, int q, int lane) {
    const bool samp = q >= 64; const int bh = q & 63, b = bh >> 3, hd = bh & 7;
    const int n = samp ? TKS : T;
    float* dst = samp ? (float*)(P.ws + WS_C2S) + (size_t)bh * TKS : (float*)(P.ws + WS_C2P) + (size_t)bh * T;
    float carry = 0.f;
    for (int base0 = 0; base0 < n; base0 += 512) {
        float vv[8];
#pragma unroll
        for (int k = 0; k < 8; ++k) {
            const int idx = base0 + 64 * k + lane; float v = 0.f;
            if (idx < n) {
                if (!samp) v = P.out[O_LFP + ((size_t)b * T + idx) * 8 + hd];
                else v = idx < PAST ? P.in[5][((size_t)b * PAST + idx) * 8 + hd] : P.out[O_LFS + ((size_t)b * 32 + idx - PAST) * 8 + hd];
            }
            vv[k] = v;
        }
#pragma unroll
        for (int k = 0; k < 8; ++k) {
            const int idx = base0 + 64 * k + lane; float v = vv[k];
#pragma unroll
            for (int o = 1; o < 64; o <<= 1) { const float t = __shfl_up(v, o); if (lane >= o) v += t; }
            if (idx < n) dst[idx] = (carry + v) * LOG2E;
            carry += __shfl(v, 63);
        }
    }
}

template <class Epi> __device__ __forceinline__ void run_gemm(LAS unsigned char* lds, const bf16_t* A, const bf16_t* Bt, int M, int N, int K, const Epi& E) {
    pg8::Gemm g{A, Bt, M, N, K}; pg8::StaticOrder S; S.init(M, N, (int)gridDim.x, (int)blockIdx.x);
#ifndef GEMM_REP
#define GEMM_REP 1
#endif
#pragma unroll 1
    for (int rep_ = 0; rep_ < GEMM_REP; ++rep_)
    pg8::gemm_phase<Epi, pg8::StaticOrder, true, true>(lds, g, S, E);
}

#define XB_TMO      128
#define XB_XCNT(j)  (256  + 64 * (j))
#define XB_XSUB(j)  (1280 + 64 * (j))
#define XB_XGEN(j)  (2304 + 64 * (j))
#define XB_TOP      3328
#define XB_TOPGEN   3392
#define XCD_BAR_WORDS 3456
#define XB_SPIN_CAP (1u << 18)

__device__ __forceinline__ unsigned xb_ld(unsigned* p)              { return __hip_atomic_load(p, __ATOMIC_RELAXED, __HIP_MEMORY_SCOPE_AGENT); }
__device__ __forceinline__ unsigned xb_add(unsigned* p, unsigned v) { return __hip_atomic_fetch_add(p, v, __ATOMIC_RELAXED, __HIP_MEMORY_SCOPE_AGENT); }
__device__ __forceinline__ unsigned xb_xcc_id() { return (unsigned)__builtin_amdgcn_s_getreg((3 << 11) | 20) & 0xFu; }
#define XB_SPIN(cond, bar) do { unsigned _sp = 0; while (cond) { __builtin_amdgcn_s_sleep(1); \
    if ((++_sp & 255u) == 0u) { if (xb_ld(&(bar)[XB_TMO])) break; if (_sp > XB_SPIN_CAP) { atomicAdd(&(bar)[XB_TMO], 1u); break; } } } } while (0)

struct XcdBarrier {
    unsigned* bar; unsigned x;
    volatile LAS unsigned* st;
};

__device__ __forceinline__ XcdBarrier xcd_barrier_post(unsigned* bar, volatile LAS unsigned* st) {
    XcdBarrier b; b.bar = bar; b.x = xb_xcc_id(); b.st = st;
    if (threadIdx.x == 0) (void)xb_add(&bar[XB_XCNT(b.x)], 1u);
    return b;
}
__device__ __forceinline__ void xcd_barrier_complete(unsigned* bar, unsigned x, unsigned& nloc, unsigned& nx) {
    const unsigned G = gridDim.x * gridDim.y * gridDim.z;
    unsigned sum, cnt, mine, sp = 0u;
    for (;;) {
        sum = 0u; cnt = 0u; mine = 0u;
#pragma unroll
        for (unsigned j = 0; j < 16; ++j) { const unsigned c = xb_ld(&bar[XB_XCNT(j)]); sum += c; cnt += (c > 0u) ? 1u : 0u; mine = (j == x) ? c : mine; }
        if (sum == G) break;
        __builtin_amdgcn_s_sleep(1);
        if ((++sp & 255u) == 0u) { if (xb_ld(&bar[XB_TMO])) break; if (sp > XB_SPIN_CAP) { atomicAdd(&bar[XB_TMO], 1u); break; } }
    }
    nloc = mine > 0u ? mine : 1u; nx = cnt > 0u ? cnt : 1u;
}

__device__ __forceinline__ void xcd_barrier(const XcdBarrier& b) {
    asm volatile("s_waitcnt vmcnt(0)" ::: "memory");
    __syncthreads();
    if (threadIdx.x == 0) {
        unsigned* bar = b.bar;
        __builtin_amdgcn_s_waitcnt(0);
        unsigned nloc = b.st[0], nx = b.st[1];
        if (nloc == 0u) { xcd_barrier_complete(bar, b.x, nloc, nx); b.st[0] = nloc; b.st[1] = nx; }
        const unsigned old = xb_add(&bar[XB_XSUB(b.x)], 1u);
        const unsigned gen = old / nloc;
        if (old + 1u == (gen + 1u) * nloc) {
            __builtin_amdgcn_fence(__ATOMIC_RELEASE, "agent");
            asm volatile("s_waitcnt vmcnt(0)" ::: "memory");
            const unsigned og = xb_add(&bar[XB_TOP], 1u);
            const unsigned tg = og / nx;
            if (og + 1u == (tg + 1u) * nx) xb_add(&bar[XB_TOPGEN], 1u);
            else XB_SPIN(xb_ld(&bar[XB_TOPGEN]) == tg, bar);
            __builtin_amdgcn_fence(__ATOMIC_ACQUIRE, "agent");
            xb_add(&bar[XB_XGEN(b.x)], 1u);
            asm volatile("s_waitcnt vmcnt(0)" ::: "memory");
        } else {
            XB_SPIN(xb_ld(&bar[XB_XGEN(b.x)]) == gen, bar);
            __builtin_amdgcn_fence(__ATOMIC_ACQUIRE, "agent");
            asm volatile("s_waitcnt vmcnt(0)" ::: "memory");
        }
    }
    __syncthreads();
}

__device__ __forceinline__ void gbar(unsigned* ctr, int& gen) {
    asm volatile("s_waitcnt vmcnt(0) lgkmcnt(0)" ::: "memory");
    __syncthreads();
    if (threadIdx.x == 0) {
        __builtin_amdgcn_fence(__ATOMIC_RELEASE, "agent");
        asm volatile("s_waitcnt vmcnt(0)" ::: "memory");
        const unsigned target = (unsigned)(gen + 1) * gridDim.x;
        __hip_atomic_fetch_add(ctr, 1u, __ATOMIC_RELAXED, __HIP_MEMORY_SCOPE_AGENT);
        while (__hip_atomic_load(ctr, __ATOMIC_RELAXED, __HIP_MEMORY_SCOPE_AGENT) < target) __builtin_amdgcn_s_sleep(2);
        __builtin_amdgcn_fence(__ATOMIC_ACQUIRE, "agent");
        asm volatile("s_waitcnt vmcnt(0)" ::: "memory");
    }
    __syncthreads();
    ++gen;
}
#define PHASE_BEGIN if (ph >= ph_lo && ph < ph_hi) { int tid = threadIdx.x; asm volatile("" : "+v"(tid)); const int lane = tid & 63, wid = __builtin_amdgcn_readfirstlane(tid >> 6); const int gw = blockIdx.x * 8 + wid, ngw = gridDim.x * 8; (void)lane; (void)gw; (void)ngw;
#define PHASE_END   if (ph + 1 < ph_hi) { if (ph == 0) { grid.sync(); if (threadIdx.x == 0) (void)xb_add(&xbar.bar[XB_XCNT(xbar.x)], 1u); } else xcd_barrier(xbar); } } ++ph;
template <int layer> __device__ __forceinline__ void layer_phases(const Params& P, LAS unsigned char* lds, cg::grid_group& grid, int& ph, const XcdBarrier& xbar, int ph_lo, int ph_hi, bf16_t* W, bf16_t* A, bf16_t* B, bf16_t* C, float* xo, float* xo_s) {
        const float* nw = P.in[11] + layer * 6144;
        if constexpr (layer == 1) {
            PHASE_BEGIN { EpiPlain<0> E{B, 1024, 1.f}; run_gemm(lds, A, W + W_INC, R, 1024, 1024, E); } PHASE_END
            PHASE_BEGIN for (int rp_ = 0; rp_ < REP_S5; ++rp_) s5_phase(P, lds, 1, wid, lane); PHASE_END
            PHASE_BEGIN for (int rp_ = 0; rp_ < REP_S5; ++rp_) s5_phase(P, lds, 2, wid, lane); PHASE_END
            PHASE_BEGIN { EpiGlu E{C}; run_gemm(lds, B + B_X2, W + W_GLU, R, 2048, 1024, E); } PHASE_END
            PHASE_BEGIN resnorm_phase(C, xo, xo_s, nw + 1024, nw + 2048, xo, A, gw, ngw, lane); PHASE_END
        }
        PHASE_BEGIN { EpiPlain<0> E{B, 1024, 0.0625f * LOG2E}; run_gemm(lds, A, W + W_XQ + (size_t)layer * 1048576, R, 1024, 1024, E); } PHASE_END
        PHASE_BEGIN for (int rp_ = 0; rp_ < REP_XA; ++rp_) xattn_phase(P, lds, layer, tid, wid, lane); PHASE_END
        PHASE_BEGIN { EpiPlain<0> E{C, 1024, 1.f}; run_gemm(lds, B + B_X2, W + W_XO + (size_t)layer * 1048576, R, 1024, 1024, E); } PHASE_END
        PHASE_BEGIN resnorm_phase(C, xo, xo_s, nw + 3072, nw + 4096, xo, A, gw, ngw, lane); PHASE_END
        PHASE_BEGIN { EpiPlain<1> E{B, 4096, 1.f}; run_gemm(lds, A, W + W_UP + (size_t)layer * 4194304, R, 4096, 1024, E); } PHASE_END
        PHASE_BEGIN { EpiPlain<0> E{C, 1024, 1.f}; run_gemm(lds, B, W + W_DN + (size_t)layer * 4194304, R, 1024, 4096, E); } PHASE_END
        PHASE_BEGIN resnorm_phase(C, xo, xo_s, nw + 5120, layer == 0 ? nw + 6144 : nullptr, xo, A, gw, ngw, lane); PHASE_END
    }
__global__ void __launch_bounds__(512) mega_fwd(Params P, int ph_lo, int ph_hi) {
    extern __shared__ __attribute__((aligned(16))) unsigned char lds_raw[];
    LAS unsigned char* lds = (LAS unsigned char*)lds_raw;
    cg::grid_group grid = cg::this_grid();
    bf16_t* W = (bf16_t*)(P.ws + WS_W);
    bf16_t* A = (bf16_t*)(P.ws + WS_A);
    bf16_t* B = (bf16_t*)(P.ws + WS_B);
    bf16_t* C = (bf16_t*)(P.ws + WS_C);
    float* xo = P.out; float* xo_s = P.out + (size_t)RP * 1024;
    int ph = 0;
    unsigned* barw = (unsigned*)(P.ws + 4096);
    if (blockIdx.x == 0) for (int i = threadIdx.x; i < XCD_BAR_WORDS; i += 512) __hip_atomic_store(barw + i, 0u, __ATOMIC_RELAXED, __HIP_MEMORY_SCOPE_AGENT);
    volatile LAS unsigned* bst = (volatile LAS unsigned*)(lds + LDS_BYTES - 64);
    if (threadIdx.x == 0) { bst[0] = 0u; bst[1] = 0u; }
    __syncthreads();
    XcdBarrier xbar; xbar.bar = barw; xbar.x = xb_xcc_id(); xbar.st = bst;

    PHASE_BEGIN for (int rp_ = 0; rp_ < REP_PRO; ++rp_) prologue(P, tid, wid, lane); PHASE_END
    PHASE_BEGIN {
        EpiAB E{B, (bf16_t*)(P.ws + WS_FKS), (bf16_t*)(P.ws + WS_FVTS), P.out, (const float*)(P.ws + WS_ROPE), P.in[13]};
        run_gemm(lds, A, W + W_AB, R, 3840, 1024, E);
        for (int l = 0; l < 2; ++l) {
            EpiMemKV E2{P.out + O_MK, P.out + O_MV, (bf16_t*)(P.ws + WS_MEMK), (bf16_t*)(P.ws + WS_MEMVT), l};
            run_gemm(lds, (const bf16_t*)(P.ws + WS_MEMN) + (size_t)l * 2048 * 1024, W + W_XKV + (size_t)l * 2097152, 2048, 2048, 1024, E2);
        }
    } PHASE_END
    PHASE_BEGIN { for (int rp_ = 0; rp_ < REP_RET; ++rp_) { ret_passA(P, wid, lane); if (blockIdx.x < 16) cumsum_task(P, blockIdx.x * 8 + wid, lane); } } PHASE_END
    PHASE_BEGIN ret_passB(P, tid); PHASE_END
    PHASE_BEGIN {
        LAS float* red = (LAS float*)lds;
        for (int rp_ = 0; rp_ < REP_RET; ++rp_)
        for (int u = blockIdx.x; u < 4096 + 32; u += gridDim.x) { if (u < 4096) ret_unitC<64>(P, red, u >> 7, u & 127, wid, lane); else ret_unitC<32>(P, red, u - 4096, 0, wid, lane); }
        __syncthreads();
        for (int rp_ = 0; rp_ < REP_FOX; ++rp_) { fox_phase(P, lds, tid, wid, lane); __syncthreads(); }
    } PHASE_END
    PHASE_BEGIN { EpiPlain<0> E{C, 1024, 1.f}; run_gemm(lds, A, W + W_OUT, R, 1024, 1024, E); } PHASE_END
    PHASE_BEGIN resnorm_phase(C, P.in[0], P.in[1], P.in[11] + 1024, P.in[11] + 2048, xo, A, gw, ngw, lane); PHASE_END
    layer_phases<0>(P, lds, grid, ph, xbar, ph_lo, ph_hi, W, A, B, C, xo, xo_s);
    layer_phases<1>(P, lds, grid, ph, xbar, ph_lo, ph_hi, W, A, B, C, xo, xo_s);
}

extern "C" void kernel_launch(void* const* d_in, const int* in_sizes, int n_in, void* d_out, int out_size, void* d_ws, size_t ws_size, hipStream_t stream) {
    static int grid = 0;
    if (grid == 0) {
        if (n_in != 33 || (size_t)out_size != O_END || ws_size < WS_END) { fprintf(stderr, "kernel_launch: unexpected shapes n_in %d out %d ws %zu\n", n_in, out_size, ws_size); grid = -1; return; }
        int dev = 0, cus = 0, per_cu = 0;
        hipGetDevice(&dev);
        hipDeviceGetAttribute(&cus, hipDeviceAttributeMultiprocessorCount, dev);
        if (hipFuncSetAttribute((const void*)mega_fwd, hipFuncAttributeMaxDynamicSharedMemorySize, LDS_BYTES) != hipSuccess) { fprintf(stderr, "kernel_launch: hipFuncSetAttribute failed\n"); grid = -1; return; }
        if (hipOccupancyMaxActiveBlocksPerMultiprocessor(&per_cu, (const void*)mega_fwd, 512, LDS_BYTES) != hipSuccess || per_cu < 1) { fprintf(stderr, "kernel_launch: occupancy query %d\n", per_cu); per_cu = 1; (void)hipGetLastError(); }
        grid = cus * per_cu;
    }
    if (grid < 0) return;
    Params p{};
    for (int i = 0; i < 33; ++i) p.in[i] = (const float*)d_in[i];
    p.out = (float*)d_out; p.ws = (unsigned char*)d_ws;
    int lo = 0, hi = 1000;
    void* args[] = {&p, &lo, &hi};
    hipError_t e = hipLaunchCooperativeKernel((const void*)mega_fwd, dim3(grid), dim3(512), args, LDS_BYTES, stream);
    if (e != hipSuccess) fprintf(stderr, "cooperative launch failed: %s (grid %d)\n", hipGetErrorString(e), grid);
}
```

```cpp
#include <hip/hip_runtime.h>
#include <hip/hip_cooperative_groups.h>
#include <cstdio>
#include <cstdint>
namespace cg = cooperative_groups;
namespace pg8 {
#define PG8_LAS __attribute__((address_space(3)))
typedef unsigned short bf16_t;
typedef short bf16x8 __attribute__((ext_vector_type(8)));
typedef float f32x4 __attribute__((ext_vector_type(4)));
typedef unsigned u32x4 __attribute__((ext_vector_type(4)));
constexpr int BM = 256, BK = 64, HALF = 128, HTB = HALF * BK * 2  , STAGE_BYTES = 8 * HTB, NXCD = 8, WGM = 8;

__host__ __device__ __forceinline__ int lds_byte(int r, int c) { const int st = (r >> 4) * 2 + (c >> 5), rr = r & 15, cc = c & 31, ob = rr * 64 + cc * 2; return st * 1024 + (ob ^ (((ob >> 9) & 1) << 5)); }
__host__ __device__ __forceinline__ void stage_rc(int b, int& R, int& C) { const int st = b / 1024, sb = b % 1024, swz = sb ^ (((sb >> 9) & 1) << 5); R = (st >> 1) * 16 + swz / 64; C = (st & 1) * 32 + (swz % 64) / 2; }
__host__ __device__ __forceinline__ int perm32(int rho) { const int n = rho >> 4, i = rho & 15; return 8 * (i >> 2) + 4 * n + (i & 3); }

struct Unit { int pm, pn; };
struct Gemm { const bf16_t* A; const bf16_t* Bt; int M, N, K; };

struct StaticOrder {
    int nM, nN, nwg, G, c;
    __host__ __device__ void init(int M, int N, int G_, int c_) { nM = M / BM; nN = N / BM; nwg = nM * nN; G = G_; c = c_; }
    __host__ __device__ bool next(int i, Unit& u) const {
        const long L = (long)i * G + c; if (L >= nwg) return false;
        int wgid = (int)L; { const int q = nwg / NXCD, r = nwg % NXCD, xcd = wgid % NXCD, off = wgid / NXCD; wgid = (xcd < r ? xcd * (q + 1) : r * (q + 1) + (xcd - r) * q) + off; }
        const int nig = WGM * nN, gid = wgid / nig, fm = gid * WGM, gsz = (nM - fm) < WGM ? (nM - fm) : WGM;
        u.pm = fm + ((wgid % nig) % gsz); u.pn = (wgid % nig) / gsz; return true;
    }
    __device__ __forceinline__ void a_ready(const Unit&) const {}
    __device__ __forceinline__ void done(const Unit&) const {}
};

template <class Epi, class Sched, bool ALIGN_EPI = false, bool SP2 = false>
__device__ __forceinline__ void gemm_phase(PG8_LAS unsigned char* lds, const Gemm g, const Sched& S, const Epi& E) {
    int tid_l = threadIdx.x; asm volatile("" : "+v"(tid_l)); const int tid = tid_l, wid = __builtin_amdgcn_readfirstlane(tid >> 6), lane = tid & 63, wr = wid >> 2, wc = wid & 3, fr = lane & 15, fq = lane >> 4;
    const int K = g.K, nt = K / BK;
    unsigned voffA[2], voffB[2];
#pragma unroll
    for (int i = 0; i < 2; ++i) { int R, C; stage_rc(tid * 16 + i * 8192, R, C); const int Rb = Epi::PERM ? ((R & ~31) + perm32(R & 31)) : R;
        voffA[i] = (unsigned)(R * K + C) * 2u; voffB[i] = (unsigned)(Rb * K + C) * 2u; }
    const size_t kstep = (size_t)(BK * 2);
    const size_t hstep = (size_t)HALF * K * 2;
    const size_t tstep = 2 * hstep;
    const unsigned ldsw = (unsigned)wid * 1024u;
    const int aoff = lds_byte(wr * 64 + fr, fq * 8), boff = lds_byte(wc * 32 + fr, fq * 8);
#define PG8_SA(b, h) (((b) * 2 + (h)) * HTB)
#define PG8_SB(b, h) ((4 + (b) * 2 + (h)) * HTB)
#define PG8_STAGE(bufoff, gbase, voff) do { _Pragma("unroll") for (int _i = 0; _i < 2; ++_i) \
        __builtin_amdgcn_global_load_lds((const unsigned*)((const char*)(gbase) + (voff)[_i]), (PG8_LAS unsigned*)(lds + (bufoff) + ldsw + _i * 8192), 16, 0, 0); } while (0)
#define PG8_LDA(dst, b, h) do { _Pragma("unroll") for (int m = 0; m < 4; ++m) _Pragma("unroll") for (int k = 0; k < 2; ++k) dst[m][k] = *(const PG8_LAS bf16x8*)(lds + PG8_SA(b, h) + aoff + m * 2048 + k * 1024); } while (0)
#define PG8_LDB(dst, b, h) do { _Pragma("unroll") for (int n = 0; n < 2; ++n) _Pragma("unroll") for (int k = 0; k < 2; ++k) dst[n][k] = *(const PG8_LAS bf16x8*)(lds + PG8_SB(b, h) + boff + n * 2048 + k * 1024); } while (0)
#define PG8_MMA(ai, bj, At, Bt) do { __builtin_amdgcn_s_setprio(1); _Pragma("unroll") for (int m = 0; m < 4; ++m) _Pragma("unroll") for (int n = 0; n < 2; ++n) _Pragma("unroll") for (int k = 0; k < 2; ++k) \
        acc[ai][bj][m][n] = __builtin_amdgcn_mfma_f32_16x16x32_bf16(Bt[n][k], At[m][k], acc[ai][bj][m][n], 0, 0, 0); __builtin_amdgcn_s_setprio(0); } while (0)
#define PG8_WAIT_V(n) asm volatile("s_waitcnt vmcnt(" #n ")" ::: "memory")
#define PG8_WAIT_L(n) asm volatile("s_waitcnt lgkmcnt(" #n ")" ::: "memory")
#define PG8_BAR __builtin_amdgcn_s_barrier()
#define PG8_SCHED __builtin_amdgcn_sched_barrier(0)
    Unit cur, nxt; int ui = 0;
    if (!S.next(0, cur)) return;
    f32x4 acc[2][2][4][2];
#pragma unroll
    for (int a = 0; a < 2; ++a)
#pragma unroll
        for (int b = 0; b < 2; ++b)
#pragma unroll
            for (int m = 0; m < 4; ++m)
#pragma unroll
                for (int n = 0; n < 2; ++n) acc[a][b][m][n] = (f32x4){0.f, 0.f, 0.f, 0.f};
    bf16x8 At[4][2], B0[2][2], B1[2][2];
    const char* cA = (const char*)g.A + (size_t)cur.pm * tstep; const char* cB = (const char*)g.Bt + (size_t)cur.pn * tstep;
    S.a_ready(cur);
    if constexpr (SP2) {
        PG8_STAGE(PG8_SB(0, 0), cB, voffB); PG8_STAGE(PG8_SB(0, 1), cB + hstep, voffB); PG8_STAGE(PG8_SA(0, 0), cA, voffA); PG8_STAGE(PG8_SA(0, 1), cA + hstep, voffA);
        if (wr == 1) PG8_BAR;
        PG8_WAIT_V(2); PG8_BAR;
        PG8_STAGE(PG8_SB(1, 0), cB + kstep, voffB); PG8_STAGE(PG8_SA(1, 0), cA + kstep, voffA); PG8_STAGE(PG8_SB(1, 1), cB + hstep + kstep, voffB);
        PG8_WAIT_V(6); PG8_BAR;
    } else {
        PG8_STAGE(PG8_SB(0, 0), cB, voffB); PG8_STAGE(PG8_SA(0, 0), cA, voffA); PG8_STAGE(PG8_SB(0, 1), cB + hstep, voffB); PG8_STAGE(PG8_SA(0, 1), cA + hstep, voffA);
        if (wr == 1) PG8_BAR;
        PG8_WAIT_V(4); PG8_BAR;
        PG8_STAGE(PG8_SB(1, 0), cB + kstep, voffB); PG8_STAGE(PG8_SA(1, 0), cA + kstep, voffA); PG8_STAGE(PG8_SB(1, 1), cB + hstep + kstep, voffB);
        PG8_WAIT_V(6); PG8_BAR;
    }
    for (;;) {
        const bool has_next = S.next(ui + 1, nxt);
        const char* nA = has_next ? (const char*)g.A + (size_t)nxt.pm * tstep : cA; const char* nB = has_next ? (const char*)g.Bt + (size_t)nxt.pn * tstep : cB;
        for (int t = 0; t < nt; t += 2) {
            const bool last = (t == nt - 2);
            const char* a1 = cA + (size_t)(t + 1) * kstep;
            const char* a2 = last ? nA : cA + (size_t)(t + 2) * kstep; const char* b2 = last ? nB : cB + (size_t)(t + 2) * kstep;
            const char* a3 = a2 + kstep; const char* b3 = b2 + kstep;
            if (last && has_next) S.a_ready(nxt);
            if constexpr (SP2) {
            PG8_LDB(B0, 0, 0); PG8_LDB(B1, 0, 1); PG8_SCHED; PG8_LDA(At, 0, 0); PG8_STAGE(PG8_SA(1, 1), a1 + hstep, voffA);
            PG8_WAIT_V(8); PG8_WAIT_L(0); PG8_BAR; PG8_MMA(0, 0, At, B0); PG8_MMA(0, 1, At, B1); PG8_BAR; PG8_SCHED;
            PG8_LDA(At, 0, 1); PG8_STAGE(PG8_SB(0, 0), b2, voffB); PG8_STAGE(PG8_SB(0, 1), b2 + hstep, voffB); PG8_STAGE(PG8_SA(0, 0), a2, voffA);
            PG8_WAIT_V(8); PG8_WAIT_L(0); PG8_BAR; PG8_MMA(1, 0, At, B0); PG8_MMA(1, 1, At, B1); PG8_BAR; PG8_SCHED;
            PG8_LDB(B0, 1, 0); PG8_LDB(B1, 1, 1); PG8_SCHED; PG8_LDA(At, 1, 0); PG8_STAGE(PG8_SA(0, 1), a2 + hstep, voffA);
            PG8_WAIT_V(8); PG8_WAIT_L(0); PG8_BAR; PG8_MMA(0, 0, At, B0); PG8_MMA(0, 1, At, B1); PG8_BAR; PG8_SCHED;
            PG8_LDA(At, 1, 1); PG8_STAGE(PG8_SB(1, 0), b3, voffB); PG8_STAGE(PG8_SB(1, 1), b3 + hstep, voffB); PG8_STAGE(PG8_SA(1, 0), a3, voffA);
            PG8_WAIT_V(8); PG8_WAIT_L(0); PG8_BAR; PG8_MMA(1, 0, At, B0); PG8_MMA(1, 1, At, B1); PG8_BAR; PG8_SCHED;
            } else {
            PG8_LDB(B0, 0, 0); PG8_SCHED; PG8_LDA(At, 0, 0); PG8_STAGE(PG8_SA(1, 1), a1 + hstep, voffA);
            PG8_WAIT_L(8); PG8_BAR; PG8_WAIT_L(0); PG8_MMA(0, 0, At, B0); PG8_BAR; PG8_SCHED;
            PG8_LDB(B1, 0, 1); PG8_STAGE(PG8_SB(0, 0), b2, voffB);
            PG8_BAR; PG8_WAIT_L(0); PG8_MMA(0, 1, At, B1); PG8_BAR;
            PG8_LDA(At, 0, 1); PG8_STAGE(PG8_SA(0, 0), a2, voffA);
            PG8_BAR; PG8_WAIT_L(0); PG8_MMA(1, 0, At, B0); PG8_BAR; PG8_SCHED;
            PG8_STAGE(PG8_SB(0, 1), b2 + hstep, voffB);
            PG8_WAIT_V(6); PG8_BAR; PG8_MMA(1, 1, At, B1); PG8_BAR;
            PG8_LDB(B0, 1, 0); PG8_SCHED; PG8_LDA(At, 1, 0); PG8_STAGE(PG8_SA(0, 1), a2 + hstep, voffA);
            PG8_WAIT_L(8); PG8_BAR; PG8_WAIT_L(0); PG8_MMA(0, 0, At, B0); PG8_BAR; PG8_SCHED;
            PG8_LDB(B1, 1, 1); PG8_STAGE(PG8_SB(1, 0), b3, voffB);
            PG8_BAR; PG8_WAIT_L(0); PG8_MMA(0, 1, At, B1); PG8_BAR;
            PG8_LDA(At, 1, 1); PG8_STAGE(PG8_SA(1, 0), a3, voffA);
            PG8_BAR; PG8_WAIT_L(0); PG8_MMA(1, 0, At, B0); PG8_BAR; PG8_SCHED;
            PG8_STAGE(PG8_SB(1, 1), b3 + hstep, voffB);
            PG8_WAIT_V(6); PG8_BAR; PG8_MMA(1, 1, At, B1); PG8_BAR;
            }
        }
        if constexpr (ALIGN_EPI) { if (wr == 0) PG8_BAR; }
        if constexpr (!Epi::AFTER_DRAIN) { E(acc, cur, wr, wc, fr, fq); S.done(cur); }
        if (!has_next) break;
#pragma unroll
        for (int a = 0; a < 2; ++a)
#pragma unroll
            for (int b = 0; b < 2; ++b)
#pragma unroll
                for (int m = 0; m < 4; ++m)
#pragma unroll
                    for (int n = 0; n < 2; ++n) acc[a][b][m][n] = (f32x4){0.f, 0.f, 0.f, 0.f};
        cur = nxt; cA = nA; cB = nB; ++ui;
        if constexpr (ALIGN_EPI) { if (wr == 1) PG8_BAR; }
    }
    PG8_WAIT_V(0);
    if constexpr (!ALIGN_EPI) { if (wr == 0) PG8_BAR; }
    PG8_BAR;
    if constexpr (Epi::AFTER_DRAIN) { E.fused(acc, cur, wr, wc, fr, fq, lds, wid, lane); S.done(cur); }
#undef PG8_SA
#undef PG8_SB
#undef PG8_STAGE
#undef PG8_LDA
#undef PG8_LDB
#undef PG8_MMA
#undef PG8_WAIT_V
#undef PG8_WAIT_L
#undef PG8_BAR
#undef PG8_SCHED
}
}
#ifndef REP_FOX
#define REP_FOX 1
#endif
#ifndef REP_PRO
#define REP_PRO 1
#endif
#ifndef REP_RET
#define REP_RET 1
#endif
#ifndef REP_XA
#define REP_XA 1
#endif
#ifndef REP_S5
#define REP_S5 1
#endif

#define LAS __attribute__((address_space(3)))
typedef unsigned short bf16_t;
typedef short bf16x8 __attribute__((ext_vector_type(8)));
typedef short s16x4 __attribute__((ext_vector_type(4)));
typedef float f32x4 __attribute__((ext_vector_type(4)));
typedef float f32x2 __attribute__((ext_vector_type(2)));
typedef float f32x16 __attribute__((ext_vector_type(16)));
typedef unsigned u32x4 __attribute__((ext_vector_type(4)));
typedef unsigned u32x2 __attribute__((ext_vector_type(2)));
typedef __bf16 bf16x2_t __attribute__((ext_vector_type(2)));
using pg8::Unit;

__device__ __forceinline__ unsigned pk2(float lo, float hi) { f32x2 v = {lo, hi}; bf16x2_t b = __builtin_convertvector(v, bf16x2_t); return __builtin_bit_cast(unsigned, b); }
__device__ __forceinline__ float bflo(unsigned w) { return __uint_as_float(w << 16); }
__device__ __forceinline__ float bfhi(unsigned w) { return __uint_as_float(w & 0xffff0000u); }
__device__ __forceinline__ bf16_t f2bf(float f) { return (bf16_t)(pk2(f, 0.f) & 0xffffu); }
__device__ __forceinline__ float ex2(float x) { return __builtin_amdgcn_exp2f(x); }
__device__ __forceinline__ float wave_sum(float v) {
#pragma unroll
    for (int o = 1; o < 64; o <<= 1) v += __shfl_xor(v, o);
    return v;
}
#define LDSBAR() asm volatile("s_waitcnt lgkmcnt(0)" ::: "memory")
#define MFMA32(a, b, c) __builtin_amdgcn_mfma_f32_32x32x16_bf16((a), (b), (c), 0, 0, 0)
#define MFMA16(a, b, c) __builtin_amdgcn_mfma_f32_16x16x32_bf16((a), (b), (c), 0, 0, 0)

constexpr int DM = 1024, RP = 65536, RS = 256, R = RP + RS, T = 8192, TS = 32, PAST = 4096, TKS = PAST + TS;
constexpr float LOG2E = 1.4426950408889634f;
constexpr float EPS = 1e-6f;
constexpr size_t O_Y = 0, O_RSP = (size_t)R * 1024, O_RSS = O_RSP + 524288, O_FKP = O_RSS + 524288, O_FVP = O_FKP + (size_t)RP * 512,
                 O_LFP = O_FVP + (size_t)RP * 512, O_FKS = O_LFP + (size_t)RP * 8, O_FVS = O_FKS + 131072, O_LFS = O_FVS + 131072,
                 O_S5RP = O_LFS + 2048, O_S5IP = O_S5RP + 32768, O_S5RS = O_S5IP + 32768, O_S5IS = O_S5RS + 32768, O_MK = O_S5IS + 32768,
                 O_MV = O_MK + 4194304, O_END = O_MV + 4194304;
constexpr size_t MiB = 1u << 20;
constexpr size_t WS_W = 1 * MiB, WS_ROPE = 65 * MiB, WS_C2P = 69 * MiB, WS_C2S = 71 * MiB, WS_MEMN = 73 * MiB, WS_MEMK = 81 * MiB, WS_MEMVT = 97 * MiB,
                 WS_S5T = 113 * MiB, WS_LE = 114 * MiB, WS_KVS = 118 * MiB, WS_A = 120 * MiB, WS_B = 249 * MiB, WS_C = 763 * MiB, WS_FKS = 892 * MiB,
                 WS_FVTS = 925 * MiB, WS_END = 960 * MiB;
constexpr size_t W_AB = 0, W_OUT = W_AB + 3840 * 1024, W_INC = W_OUT + 1048576, W_GLU = W_INC + 1048576, W_XQ = W_GLU + 2097152, W_XKV = W_XQ + 2097152,
                 W_XO = W_XKV + 4194304, W_UP = W_XO + 2097152, W_DN = W_UP + 8388608, W_ENDE = W_DN + 8388608;
static_assert(W_ENDE * 2 <= 64 * MiB, "weights region");
constexpr size_t B_RQ = 0, B_RK = (size_t)R * 512, B_RG = 2 * (size_t)R * 512, B_FQ = 3 * (size_t)R * 512, B_FK = 4 * (size_t)R * 512, B_KT = 5 * (size_t)R * 512,
                 B_VT = B_KT + (size_t)RP * 512, B_FVT = B_VT + (size_t)RP * 512, B_KTS = B_FVT + (size_t)RP * 512, B_VTS = B_KTS + 131072, B_ENDE = B_VTS + 131072;
static_assert(B_ENDE * 2 <= 514 * MiB, "region B");
constexpr size_t B_X2 = 129 * MiB / 2;
constexpr size_t WS_RS = 119 * MiB;
#define RSV ((float*)(P.ws + WS_RS))
#define MIXED ((bf16_t*)P.out)
constexpr int LDS_BYTES = 139264;

struct Params {
    const float* in[33];
    float* out;
    unsigned char* ws;
};

template <int ACT  > struct EpiPlain {
    static constexpr bool PERM = true, AFTER_DRAIN = false;
    bf16_t* O; int ldc; float scale; const float* rs;
    __device__ __forceinline__ void operator()(const f32x4 (&acc)[2][2][4][2], const Unit& u, int wr, int wc, int fr, int fq) const {
        asm volatile("" : "+v"(fr), "+v"(fq));
        bf16_t* base = O + (size_t)(u.pm * 256 + wr * 64 + fr) * ldc + u.pn * 256 + wc * 32 + fq * 8;
#pragma unroll
        for (int ai = 0; ai < 2; ++ai)
#pragma unroll
            for (int m = 0; m < 4; ++m) {
                bf16_t* rp = base + (size_t)(ai * 128 + m * 16) * ldc;
                const float rsc = rs ? rs[u.pm * 256 + wr * 64 + fr + ai * 128 + m * 16] * scale : scale;
#pragma unroll
                for (int bj = 0; bj < 2; ++bj) {
                    f32x4 v0 = acc[ai][bj][m][0] * rsc, v1 = acc[ai][bj][m][1] * rsc;
                    if (ACT == 1) { v0.x = fmaxf(v0.x, 0.f); v0.y = fmaxf(v0.y, 0.f); v0.z = fmaxf(v0.z, 0.f); v0.w = fmaxf(v0.w, 0.f); v0 = v0 * v0;
                                    v1.x = fmaxf(v1.x, 0.f); v1.y = fmaxf(v1.y, 0.f); v1.z = fmaxf(v1.z, 0.f); v1.w = fmaxf(v1.w, 0.f); v1 = v1 * v1; }
                    u32x4 w; w.x = pk2(v0.x, v0.y); w.y = pk2(v0.z, v0.w); w.z = pk2(v1.x, v1.y); w.w = pk2(v1.z, v1.w);
                    *(u32x4*)(rp + bj * 128) = w;
                }
            }
    }
};
struct EpiGlu {
    static constexpr bool PERM = false, AFTER_DRAIN = false;
    bf16_t* O;
    __device__ __forceinline__ void operator()(const f32x4 (&acc)[2][2][4][2], const Unit& u, int wr, int wc, int fr, int fq) const {
        asm volatile("" : "+v"(fr), "+v"(fq));
#pragma unroll
        for (int ai = 0; ai < 2; ++ai)
#pragma unroll
            for (int m = 0; m < 4; ++m) {
                const int row = u.pm * 256 + ai * 128 + wr * 64 + m * 16 + fr;
                bf16_t* rp = O + (size_t)row * 1024 + u.pn * 128 + wc * 32 + fq * 4;
#pragma unroll
                for (int n = 0; n < 2; ++n) {
                    const f32x4 a = acc[ai][0][m][n], g = acc[ai][1][m][n];
                    f32x4 v;
                    v.x = a.x / (1.f + __expf(-g.x)); v.y = a.y / (1.f + __expf(-g.y)); v.z = a.z / (1.f + __expf(-g.z)); v.w = a.w / (1.f + __expf(-g.w));
                    u32x2 w; w.x = pk2(v.x, v.y); w.y = pk2(v.z, v.w);
                    *(u32x2*)(rp + n * 16) = w;
                }
            }
    }
};
struct EpiMemKV {
    static constexpr bool PERM = false, AFTER_DRAIN = false;
    float* oK; float* oV; bf16_t* mk; bf16_t* mvt; int layer;
    __device__ __forceinline__ void operator()(const f32x4 (&acc)[2][2][4][2], const Unit& u, int wr, int wc, int fr, int fq) const {
        asm volatile("" : "+v"(fr), "+v"(fq));
        const bool isv = u.pn >= 4;
#pragma unroll
        for (int ai = 0; ai < 2; ++ai)
#pragma unroll
            for (int m = 0; m < 4; ++m) {
                const int row = u.pm * 256 + ai * 128 + wr * 64 + m * 16 + fr;
                const int b = row >> 8, mm = row & 255;
#pragma unroll
                for (int bj = 0; bj < 2; ++bj)
#pragma unroll
                    for (int n = 0; n < 2; ++n) {
                        const int col = (u.pn & 3) * 256 + bj * 128 + wc * 32 + n * 16 + fq * 4;
                        const f32x4 v = acc[ai][bj][m][n];
                        if (!isv) {
                            *(f32x4*)(oK + ((size_t)layer * 2048 + row) * 1024 + col) = v;
                            u32x2 w; w.x = pk2(v.x, v.y); w.y = pk2(v.z, v.w);
                            *(u32x2*)(mk + ((size_t)(layer * 16 + b) * 256 + mm) * 1024 + col) = w;
                        } else {
                            *(f32x4*)(oV + ((size_t)layer * 2048 + row) * 1024 + col) = v;
                            bf16_t* p = mvt + ((size_t)(layer * 16 + b) * 1024 + col) * 256 + mm;
                            p[0] = f2bf(v.x); p[256] = f2bf(v.y); p[512] = f2bf(v.z); p[768] = f2bf(v.w);
                        }
                    }
            }
    }
};
__device__ __forceinline__ float logsig(float x) { return x >= 0.f ? -log1pf(__expf(-x)) : x - log1pf(__expf(x)); }
struct EpiAB {
    static constexpr bool PERM = false, AFTER_DRAIN = false;
    bf16_t* B;
    bf16_t* fks; bf16_t* fvts;
    float* out; const float* rope; const float* bfox; const float* rs;
    __device__ __forceinline__ void operator()(const f32x4 (&acc)[2][2][4][2], const Unit& u, int wr, int wc, int fr, int fq) const {
        asm volatile("" : "+v"(fr), "+v"(fq));
        switch (u.pn >> 1) {
            case 0: body<0>(acc, u, wr, wc, fr, fq); break; case 1: body<1>(acc, u, wr, wc, fr, fq); break; case 2: body<2>(acc, u, wr, wc, fr, fq); break;
            case 3: body<3>(acc, u, wr, wc, fr, fq); break; case 4: body<4>(acc, u, wr, wc, fr, fq); break; case 5: body<5>(acc, u, wr, wc, fr, fq); break;
            case 6: body<6>(acc, u, wr, wc, fr, fq); break; default: body<7>(acc, u, wr, wc, fr, fq); break;
        }
    }
    template <int sect> __device__ __forceinline__ void body(const f32x4 (&acc)[2][2][4][2], const Unit& u, int wr, int wc, int fr, int fq) const {
        rowgrp<sect, 0, 0>(acc, u, wr, wc, fr, fq); rowgrp<sect, 0, 1>(acc, u, wr, wc, fr, fq); rowgrp<sect, 0, 2>(acc, u, wr, wc, fr, fq); rowgrp<sect, 0, 3>(acc, u, wr, wc, fr, fq);
        rowgrp<sect, 1, 0>(acc, u, wr, wc, fr, fq); rowgrp<sect, 1, 1>(acc, u, wr, wc, fr, fq); rowgrp<sect, 1, 2>(acc, u, wr, wc, fr, fq); rowgrp<sect, 1, 3>(acc, u, wr, wc, fr, fq);
    }
    template <int sect, int ai, int m> __device__ __forceinline__ void rowgrp(const f32x4 (&acc)[2][2][4][2], const Unit& u, int wr, int wc, int fr, int fq) const {
        const int pn = u.pn;
            {
                const int row = u.pm * 256 + ai * 128 + wr * 64 + m * 16 + fr;
                const bool samp = row >= RP;
                const int rr = row - RP;
                const int b = samp ? (rr >> 5) : (row >> 13);
                const int t = samp ? (rr & 31) : (row & 8191);
                const int pos = samp ? PAST + t : t;
                const float rsc = rs[row];
#pragma unroll
                for (int bj = 0; bj < 2; ++bj)
#pragma unroll
                    for (int n = 0; n < 2; ++n) {
                        const int sec = (pn & 1) * 256 + bj * 128 + wc * 32 + n * 16 + fq * 4;
                        f32x4 v = acc[ai][bj][m][n] * rsc;
                        if constexpr (sect <= 1) {
                            const int hd = sec >> 7, w = sec & 127, i0 = w >> 1;
                            const f32x4 cs = *(const f32x4*)(rope + ((size_t)pos * 64 + i0) * 2);
                            f32x4 o;
                            o.x = v.x * cs.x - v.y * cs.y; o.y = v.y * cs.x + v.x * cs.y;
                            o.z = v.z * cs.z - v.w * cs.w; o.w = v.w * cs.z + v.z * cs.w;
                            if constexpr (sect == 0) {
                                u32x2 wv; wv.x = pk2(o.x, o.y); wv.y = pk2(o.z, o.w);
                                *(u32x2*)(B + B_RQ + (size_t)row * 512 + sec) = wv;
                            } else {
                                o = o * 0.08838834764831845f;
                                u32x2 wv; wv.x = pk2(o.x, o.y); wv.y = pk2(o.z, o.w);
                                *(u32x2*)(B + B_RK + (size_t)row * 512 + sec) = wv;
                                const float lg2 = __log2f(1.f - ex2((float)(-5 - hd)));
                                if (!samp) {
                                    const int j = t & 63; const float wk = ex2(lg2 * (float)(63 - j));
                                    bf16_t* p = B + B_KT + ((size_t)((b * 4 + hd) * 128 + (t >> 6)) * 128 + w) * 64 + j;
                                    p[0] = f2bf(o.x * wk); p[64] = f2bf(o.y * wk); p[128] = f2bf(o.z * wk); p[192] = f2bf(o.w * wk);
                                } else {
                                    const float wk = ex2(lg2 * (float)(31 - t));
                                    bf16_t* p = B + B_KTS + ((size_t)(b * 4 + hd) * 128 + w) * 32 + t;
                                    p[0] = f2bf(o.x * wk); p[32] = f2bf(o.y * wk); p[64] = f2bf(o.z * wk); p[96] = f2bf(o.w * wk);
                                }
                            }
                        } else if constexpr (sect == 2) {
                            const int hd = sec >> 7, w = sec & 127;
                            if (!samp) {
                                bf16_t* p = B + B_VT + ((size_t)((b * 4 + hd) * 128 + (t >> 6)) * 128 + w) * 64 + (t & 63);
                                p[0] = f2bf(v.x); p[64] = f2bf(v.y); p[128] = f2bf(v.z); p[192] = f2bf(v.w);
                            } else {
                                bf16_t* p = B + B_VTS + ((size_t)(b * 4 + hd) * 128 + w) * 32 + t;
                                p[0] = f2bf(v.x); p[32] = f2bf(v.y); p[64] = f2bf(v.z); p[96] = f2bf(v.w);
                            }
                        } else if constexpr (sect == 3) {
                            f32x4 o; o.x = v.x / (1.f + __expf(-v.x)); o.y = v.y / (1.f + __expf(-v.y)); o.z = v.z / (1.f + __expf(-v.z)); o.w = v.w / (1.f + __expf(-v.w));
                            u32x2 wv; wv.x = pk2(o.x, o.y); wv.y = pk2(o.z, o.w);
                            *(u32x2*)(B + B_RG + (size_t)row * 512 + sec) = wv;
                        } else if constexpr (sect == 4) {
                            const f32x4 o = v * (0.125f * LOG2E);
                            u32x2 wv; wv.x = pk2(o.x, o.y); wv.y = pk2(o.z, o.w);
                            *(u32x2*)(B + B_FQ + (size_t)row * 512 + sec) = wv;
                        } else if constexpr (sect == 5) {
                            u32x2 wv; wv.x = pk2(v.x, v.y); wv.y = pk2(v.z, v.w);
                            if (!samp) { *(f32x4*)(out + O_FKP + (size_t)row * 512 + sec) = v; *(u32x2*)(B + B_FK + (size_t)row * 512 + sec) = wv; }
                            else { *(f32x4*)(out + O_FKS + (size_t)rr * 512 + sec) = v; *(u32x2*)(fks + ((size_t)b * TKS + PAST + t) * 512 + sec) = wv; }
                        } else if constexpr (sect == 6) {
                            if (!samp) {
                                *(f32x4*)(out + O_FVP + (size_t)row * 512 + sec) = v;
                                bf16_t* p = B + B_FVT + ((size_t)b * 512 + sec) * T + t;
                                p[0] = f2bf(v.x); p[T] = f2bf(v.y); p[2 * T] = f2bf(v.z); p[3 * T] = f2bf(v.w);
                            } else {
                                *(f32x4*)(out + O_FVS + (size_t)rr * 512 + sec) = v;
                                bf16_t* p = fvts + ((size_t)b * 512 + sec) * TKS + PAST + t;
                                p[0] = f2bf(v.x); p[TKS] = f2bf(v.y); p[2 * TKS] = f2bf(v.z); p[3 * TKS] = f2bf(v.w);
                            }
                        } else {
                            if (sec < 8) {
                                const f32x4 bb = *(const f32x4*)(bfox + sec);
                                f32x4 o; o.x = logsig(v.x + bb.x); o.y = logsig(v.y + bb.y); o.z = logsig(v.z + bb.z); o.w = logsig(v.w + bb.w);
                                if (!samp) *(f32x4*)(out + O_LFP + (size_t)row * 8 + sec) = o;
                                else *(f32x4*)(out + O_LFS + (size_t)rr * 8 + sec) = o;
                            }
                        }
                    }
                asm volatile("" ::: "memory");
            }
    }
};

__device__ __forceinline__ void wtrans(const float* __restrict__ src, int K, int Ns, bf16_t* dst, int Nd, int mode, int gtid, int gsz, const float* gk = nullptr) {
    const int items = Nd * (K >> 3);
    for (int it = gtid; it < items; it += gsz) {
        const int n = it % Nd, k0 = (it / Nd) << 3;
        int col = n; bool z = false;
        if (mode == 1) { if (n < 1024) { const int w = n & 127; col = (n & ~127) + (w >> 1) + 64 * (w & 1); } else if (n >= 3592) z = true; }
        else if (mode == 2) { col = ((n >> 7) & 1) * 1024 + (n >> 8) * 128 + (n & 127); }
        const float* s = src + (size_t)k0 * Ns + (z ? 0 : col);
        float v0 = s[0], v1 = s[(size_t)Ns], v2 = s[2 * (size_t)Ns], v3 = s[3 * (size_t)Ns], v4 = s[4 * (size_t)Ns], v5 = s[5 * (size_t)Ns], v6 = s[6 * (size_t)Ns], v7 = s[7 * (size_t)Ns];
        if (gk) { const f32x4 ga_ = *(const f32x4*)(gk + k0), gb_ = *(const f32x4*)(gk + k0 + 4); v0 *= ga_.x; v1 *= ga_.y; v2 *= ga_.z; v3 *= ga_.w; v4 *= gb_.x; v5 *= gb_.y; v6 *= gb_.z; v7 *= gb_.w; }
        u32x4 o; o.x = pk2(v0, v1); o.y = pk2(v2, v3); o.z = pk2(v4, v5); o.w = pk2(v6, v7);
        if (z) o = (u32x4){0u, 0u, 0u, 0u};
        *(u32x4*)(dst + (size_t)n * K + k0) = o;
    }
}
__device__ __forceinline__ void ttrans(const float* __restrict__ src, int rows, int C, bf16_t* dst, size_t dpitch, int gtid, int gsz) {
    const int items = C * (rows >> 3);
    for (int it = gtid; it < items; it += gsz) {
        const int c = it % C, r0 = (it / C) << 3;
        const float* s = src + (size_t)r0 * C + c;
        float v0 = s[0], v1 = s[(size_t)C], v2 = s[2 * (size_t)C], v3 = s[3 * (size_t)C], v4 = s[4 * (size_t)C], v5 = s[5 * (size_t)C], v6 = s[6 * (size_t)C], v7 = s[7 * (size_t)C];
        u32x4 o; o.x = pk2(v0, v1); o.y = pk2(v2, v3); o.z = pk2(v4, v5); o.w = pk2(v6, v7);
        *(u32x4*)(dst + (size_t)c * dpitch + r0) = o;
    }
}
__device__ __forceinline__ void cvt8(const float* __restrict__ s, bf16_t* d) {
    const f32x4 a = *(const f32x4*)s, b = *(const f32x4*)(s + 4);
    u32x4 o; o.x = pk2(a.x, a.y); o.y = pk2(a.z, a.w); o.z = pk2(b.x, b.y); o.w = pk2(b.z, b.w);
    *(u32x4*)d = o;
}
__device__ __forceinline__ void norm_row(const float* xr, const float* g, bf16_t* orow, int lane) {
    f32x4 v[4]; float s = 0.f;
#pragma unroll
    for (int j = 0; j < 4; ++j) { v[j] = ((const f32x4*)xr)[lane + 64 * j]; s += (v[j].x * v[j].x + v[j].y * v[j].y) + (v[j].z * v[j].z + v[j].w * v[j].w); }
    const float rstd = rsqrtf(wave_sum(s) * (1.f / 1024.f) + EPS);
#pragma unroll
    for (int j = 0; j < 4; ++j) { const f32x4 gg = ((const f32x4*)g)[lane + 64 * j]; const f32x4 o = v[j] * rstd * gg; u32x2 w; w.x = pk2(o.x, o.y); w.y = pk2(o.z, o.w); ((u32x2*)orow)[lane + 64 * j] = w; }
}
__device__ __forceinline__ void cvt_row(const float* xr, bf16_t* orow, float* rs, int lane) {
    f32x4 v[4]; float s = 0.f;
#pragma unroll
    for (int j = 0; j < 4; ++j) { v[j] = ((const f32x4*)xr)[lane + 64 * j]; s += (v[j].x * v[j].x + v[j].y * v[j].y) + (v[j].z * v[j].z + v[j].w * v[j].w); }
    const float rstd = rsqrtf(wave_sum(s) * (1.f / 1024.f) + EPS);
#pragma unroll
    for (int j = 0; j < 4; ++j) { u32x2 w; w.x = pk2(v[j].x, v[j].y); w.y = pk2(v[j].z, v[j].w); ((u32x2*)orow)[lane + 64 * j] = w; }
    if (lane == 0) *rs = rstd;
}
struct RnRow { f32x4 x[4]; u32x2 m[4]; };
template <int IN> __device__ __forceinline__ void rn_load(RnRow& r, const bf16_t* mix, const float* xp, const float* xs, const bf16_t* xb, int row, int lane) {
#pragma unroll
    for (int j = 0; j < 4; ++j) {
        if (IN == 0) { const float* xr = row < RP ? xp + (size_t)row * 1024 : xs + (size_t)(row - RP) * 1024; r.x[j] = __builtin_nontemporal_load((const f32x4*)xr + lane + 64 * j); }
        else { const u32x2 w = *((const u32x2*)(xb + (size_t)row * 1024) + lane + 64 * j); r.x[j] = (f32x4){bflo(w.x), bfhi(w.x), bflo(w.y), bfhi(w.y)}; }
        r.m[j] = __builtin_nontemporal_load((const u32x2*)(mix + (size_t)row * 1024) + lane + 64 * j);
    }
}
template <int OUT> __device__ __forceinline__ void rn_proc(const RnRow& r, const float* ga, bf16_t* xb, float* rs, float* yout, int row, int lane) {
    f32x4 xv[4], mv[4]; float s = 0.f;
#pragma unroll
    for (int j = 0; j < 4; ++j) {
        const u32x2 w = r.m[j];
        mv[j] = (f32x4){bflo(w.x), bfhi(w.x), bflo(w.y), bfhi(w.y)};
        s += (mv[j].x * mv[j].x + mv[j].y * mv[j].y) + (mv[j].z * mv[j].z + mv[j].w * mv[j].w);
    }
    const float rm = rsqrtf(wave_sum(s) * (1.f / 1024.f) + EPS);
    float s2 = 0.f;
#pragma unroll
    for (int j = 0; j < 4; ++j) {
        const f32x4 gg = ((const f32x4*)ga)[lane + 64 * j];
        xv[j] = r.x[j] + mv[j] * rm * gg;
        if (OUT == 1) ((f32x4*)(yout + (size_t)row * 1024))[lane + 64 * j] = xv[j];
        else { u32x2 w; w.x = pk2(xv[j].x, xv[j].y); w.y = pk2(xv[j].z, xv[j].w); ((u32x2*)(xb + (size_t)row * 1024))[lane + 64 * j] = w; }
        s2 += (xv[j].x * xv[j].x + xv[j].y * xv[j].y) + (xv[j].z * xv[j].z + xv[j].w * xv[j].w);
    }
    if (OUT == 0) { const float rx = rsqrtf(wave_sum(s2) * (1.f / 1024.f) + EPS); if (lane == 0) rs[row] = rx; }
}
template <int IN, int OUT> __device__ __forceinline__ void resnorm_phase(const bf16_t* mix, const float* xp, const float* xs, bf16_t* xb, const float* ga, float* rs, float* yout, int gw, int ngw, int lane) {
    int row = gw * 2;
    if (row >= R) return;
    RnRow a0, a1, b0, b1;
    rn_load<IN>(a0, mix, xp, xs, xb, row, lane); rn_load<IN>(a1, mix, xp, xs, xb, row + 1, lane);
    for (;;) {
        const int nrow = row + ngw * 2;
        const bool more = nrow < R;
        if (more) { rn_load<IN>(b0, mix, xp, xs, xb, nrow, lane); rn_load<IN>(b1, mix, xp, xs, xb, nrow + 1, lane); }
        rn_proc<OUT>(a0, ga, xb, rs, yout, row, lane); rn_proc<OUT>(a1, ga, xb, rs, yout, row + 1, lane);
        if (!more) break;
        a0 = b0; a1 = b1; row = nrow;
    }
}

__device__ __forceinline__ float ret_lg2(int h) { return __log2f(1.f - ex2((float)(-5 - h))); }
__device__ __forceinline__ void ret_passA(const Params& P, int wid, int lane) {
    bf16_t* B = (bf16_t*)(P.ws + WS_B);
    bf16_t* KV = (bf16_t*)(P.ws + WS_C);
    bf16_t* KVS = (bf16_t*)(P.ws + WS_KVS);
    const int l32 = lane & 31, hh = lane >> 5;
    const int mt = wid >> 1, nt0 = (wid & 1) * 2;
    for (int u = blockIdx.x; u < 4096 + 32; u += gridDim.x) {
        const bool samp = u >= 4096;
        f32x16 d0 = {}, d1 = {};
        if (!samp) {
            const bf16_t* vt = B + B_VT + (size_t)u * 8192; const bf16_t* kt = B + B_KT + (size_t)u * 8192;
#pragma unroll
            for (int ks = 0; ks < 4; ++ks) {
                const bf16x8 a = *(const bf16x8*)(vt + (32 * mt + l32) * 64 + 16 * ks + 8 * hh);
                const bf16x8 b0 = *(const bf16x8*)(kt + (32 * nt0 + l32) * 64 + 16 * ks + 8 * hh);
                const bf16x8 b1 = *(const bf16x8*)(kt + (32 * nt0 + 32 + l32) * 64 + 16 * ks + 8 * hh);
                d0 = MFMA32(a, b0, d0); d1 = MFMA32(a, b1, d1);
            }
            bf16_t* o = KV + (size_t)u * 16384;
#pragma unroll
            for (int r = 0; r < 16; ++r) { const int e = 32 * mt + (r & 3) + 8 * (r >> 2) + 4 * hh; o[e * 128 + 32 * nt0 + l32] = f2bf(d0[r]); o[e * 128 + 32 * nt0 + 32 + l32] = f2bf(d1[r]); }
        } else {
            const int bh = u - 4096, hd = bh & 3;
            const bf16_t* vt = B + B_VTS + (size_t)bh * 4096; const bf16_t* kt = B + B_KTS + (size_t)bh * 4096;
#pragma unroll
            for (int ks = 0; ks < 2; ++ks) {
                const bf16x8 a = *(const bf16x8*)(vt + (32 * mt + l32) * 32 + 16 * ks + 8 * hh);
                const bf16x8 b0 = *(const bf16x8*)(kt + (32 * nt0 + l32) * 32 + 16 * ks + 8 * hh);
                const bf16x8 b1 = *(const bf16x8*)(kt + (32 * nt0 + 32 + l32) * 32 + 16 * ks + 8 * hh);
                d0 = MFMA32(a, b0, d0); d1 = MFMA32(a, b1, d1);
            }
            const float g32 = ex2(ret_lg2(hd) * 32.f);
            const float* s0 = P.in[2] + (size_t)bh * 16384; float* so = P.out + O_RSS + (size_t)bh * 16384; bf16_t* sb = KVS + (size_t)bh * 16384;
#pragma unroll
            for (int r = 0; r < 16; ++r) {
                const int e = 32 * mt + (r & 3) + 8 * (r >> 2) + 4 * hh;
#pragma unroll
                for (int q = 0; q < 2; ++q) {
                    const int dp = 32 * nt0 + 32 * q + l32, d = (dp >> 1) + 64 * (dp & 1);
                    const float s = s0[d * 128 + e];
                    so[d * 128 + e] = s * g32 + (q ? d1[r] : d0[r]);
                    sb[e * 128 + dp] = f2bf(s);
                }
            }
        }
    }
}
__device__ __forceinline__ void ret_passB(const Params& P, int tid) {
    unsigned* KV = (unsigned*)(P.ws + WS_C);
    for (int i = blockIdx.x * 512 + tid; i < 32 * 8192; i += gridDim.x * 512) {
        const int bh = i >> 13, idx = i & 8191;
        const float dec = ex2(ret_lg2(bh & 3) * 64.f);
        unsigned* p = KV + (size_t)bh * 128 * 8192 + idx;
        float s0 = 0.f, s1 = 0.f;
        for (int n0 = 0; n0 < 128; n0 += 16) {
            unsigned v[16];
#pragma unroll
            for (int k = 0; k < 16; ++k) v[k] = p[(size_t)(n0 + k) * 8192];
#pragma unroll
            for (int k = 0; k < 16; ++k) { p[(size_t)(n0 + k) * 8192] = pk2(s0, s1); s0 = s0 * dec + bflo(v[k]); s1 = s1 * dec + bfhi(v[k]); }
        }
        const int e = idx >> 6, dp = (idx & 63) * 2;
        float* so = P.out + O_RSP + (size_t)bh * 16384;
        so[(dp >> 1) * 128 + e] = s0;
        so[((dp >> 1) + 64) * 128 + e] = s1;
    }
}
template <int L> __device__ __forceinline__ void ret_unitC(const Params& P, LAS float* red, int bh, int n, int wid, int lane) {
    const bf16_t* B = (const bf16_t*)(P.ws + WS_B);
    const int l32 = lane & 31, hh = lane >> 5, hd = bh & 3, b = bh >> 2;
    const int et = wid >> 1, it = wid & 1;
    const bool act = (L == 64) || (it == 0);
    const int row0 = (L == 64) ? (b * T + n * 64) : (RP + b * 32);
    const bf16_t* sbef = (L == 64) ? (const bf16_t*)(P.ws + WS_C) + (size_t)(bh * 128 + n) * 16384 : (const bf16_t*)(P.ws + WS_KVS) + (size_t)bh * 16384;
    const bf16_t* vt = (L == 64) ? B + B_VT + (size_t)(bh * 128 + n) * 8192 : B + B_VTS + (size_t)bh * 4096;
    const float lg2 = ret_lg2(hd);
    const int i = 32 * it + l32;
    f32x16 acc = {};
    float s1 = 0.f, s2 = 0.f;
    if (act) {
        bf16x8 qf[8];
#pragma unroll
        for (int ks = 0; ks < 8; ++ks) qf[ks] = *(const bf16x8*)(B + B_RQ + (size_t)(row0 + i) * 512 + hd * 128 + 16 * ks + 8 * hh);
#pragma unroll
        for (int ks = 0; ks < 8; ++ks) { const bf16x8 a = *(const bf16x8*)(sbef + (32 * et + l32) * 128 + 16 * ks + 8 * hh); acc = MFMA32(a, qf[ks], acc); }
        acc = acc * ex2(lg2 * (float)(i + 1));
#pragma unroll
        for (int jt = 0; jt < L / 32; ++jt) {
            f32x16 sc = {};
#pragma unroll
            for (int ks = 0; ks < 8; ++ks) { const bf16x8 a = *(const bf16x8*)(B + B_RK + (size_t)(row0 + 32 * jt + l32) * 512 + hd * 128 + 16 * ks + 8 * hh); sc = MFMA32(a, qf[ks], sc); }
#pragma unroll
            for (int r = 0; r < 16; ++r) { const int j = 32 * jt + (r & 3) + 8 * (r >> 2) + 4 * hh; const int dd = i > j ? i - j : j - i; sc[r] = sc[r] * ex2(lg2 * (float)dd); }
#pragma unroll
            for (int s = 0; s < 2; ++s) {
                u32x4 pw; pw.x = pk2(sc[8 * s], sc[8 * s + 1]); pw.y = pk2(sc[8 * s + 2], sc[8 * s + 3]); pw.z = pk2(sc[8 * s + 4], sc[8 * s + 5]); pw.w = pk2(sc[8 * s + 6], sc[8 * s + 7]);
                const bf16x8 pf = __builtin_bit_cast(bf16x8, pw);
                const bf16_t* vb = vt + (32 * et + l32) * L + 32 * jt + 16 * s + 4 * hh;
                const u32x2 lo = *(const u32x2*)vb, hi = *(const u32x2*)(vb + 8);
                const u32x4 vw = {lo.x, lo.y, hi.x, hi.y};
                acc = MFMA32(__builtin_bit_cast(bf16x8, vw), pf, acc);
            }
        }
#pragma unroll
        for (int r = 0; r < 16; ++r) { s1 += acc[r]; s2 += acc[r] * acc[r]; }
        s1 += __shfl_xor(s1, 32); s2 += __shfl_xor(s2, 32);
        if (hh == 0) { red[et * 64 + i] = s1; red[256 + et * 64 + i] = s2; }
    }
    __syncthreads();
    if (act) {
        const float t1 = red[i] + red[64 + i] + red[128 + i] + red[192 + i];
        const float t2 = red[256 + i] + red[320 + i] + red[384 + i] + red[448 + i];
        const float mu = t1 * (1.f / 128.f), var = fmaxf(t2 * (1.f / 128.f) - mu * mu, 0.f), rstd = rsqrtf(var + EPS);
        const float* gw = P.in[14] + hd * 128;
        bf16_t* mixed = MIXED;
#pragma unroll
        for (int g = 0; g < 4; ++g) {
            const int e = 32 * et + 8 * g + 4 * hh;
            const f32x4 w4 = *(const f32x4*)(gw + e);
            const u32x2 gt = *(const u32x2*)(B + B_RG + (size_t)(row0 + i) * 512 + hd * 128 + e);
            f32x4 o;
            o.x = (acc[4 * g] - mu) * rstd * w4.x * bflo(gt.x); o.y = (acc[4 * g + 1] - mu) * rstd * w4.y * bfhi(gt.x);
            o.z = (acc[4 * g + 2] - mu) * rstd * w4.z * bflo(gt.y); o.w = (acc[4 * g + 3] - mu) * rstd * w4.w * bfhi(gt.y);
            u32x2 w; w.x = pk2(o.x, o.y); w.y = pk2(o.z, o.w);
            *(u32x2*)(mixed + (size_t)(row0 + i) * 1024 + hd * 128 + e) = w;
        }
    }
    __syncthreads();
}

struct FoxUnit { const bf16_t* Q; const bf16_t* K; const bf16_t* VT; const float* c2; bf16_t* O; int vtp, qpos0, nq, ntiles, Tk; };
constexpr int FOX_BUF = 18432, FOX_VOFF = 9216, FOX_COFF = 17920;
__device__ __forceinline__ void fox_unit(LAS unsigned char* lds, const FoxUnit U, int tid, int wid, int lane) {
    const int l32 = lane & 31, hh = lane >> 5;
    const bool active = wid * 32 < U.nq;
    bf16x8 qf[4];
#pragma unroll
    for (int s = 0; s < 4; ++s) qf[s] = active ? *(const bf16x8*)(U.Q + (size_t)(wid * 32 + l32) * 512 + 16 * s + 8 * hh) : (bf16x8){0, 0, 0, 0, 0, 0, 0, 0};
    const int wq_lo = U.qpos0 + wid * 32, wq_hi = wq_lo + 31, qpos = wq_lo + l32;
    float m = -INFINITY, l = 0.f; f32x16 o0 = {}, o1 = {};
    const int srow = tid >> 3, sch = tid & 7;
    u32x4 kr, vr; float cr = 0.f;
#define FOX_LOAD(t) do { int key_ = (t) * 64 + srow; key_ = key_ < U.Tk ? key_ : U.Tk - 1; kr = *(const u32x4*)(U.K + (size_t)key_ * 512 + sch * 8); \
        vr = *(const u32x4*)(U.VT + (size_t)srow * U.vtp + (t) * 64 + sch * 8); \
        if (tid < 64) { int kc_ = (t) * 64 + tid; kc_ = kc_ < U.Tk ? kc_ : U.Tk - 1; cr = U.c2[kc_]; } } while (0)
#define FOX_STORE(bi) do { LAS unsigned char* kb_ = lds + (bi) * FOX_BUF; *(LAS u32x4*)(kb_ + srow * 144 + sch * 16) = kr; \
        *(LAS u32x2*)(kb_ + FOX_VOFF + srow * 136 + sch * 16) = (u32x2){vr.x, vr.y}; *(LAS u32x2*)(kb_ + FOX_VOFF + srow * 136 + sch * 16 + 8) = (u32x2){vr.z, vr.w}; \
        if (tid < 64) *(LAS float*)(kb_ + FOX_COFF + tid * 4) = -cr; } while (0)
    FOX_LOAD(0); FOX_STORE(0);
    __syncthreads();
    for (int t = 0; t < U.ntiles; ++t) {
        const bool more = t + 1 < U.ntiles;
        if (more) FOX_LOAD(t + 1);
        if (active && t * 64 <= wq_hi) {
            LAS unsigned char* kb = lds + (t & 1) * FOX_BUF;
            f32x16 p0, p1;
#pragma unroll
            for (int g = 0; g < 4; ++g) {
                const f32x4 c0 = *(LAS f32x4*)(kb + FOX_COFF + (8 * g + 4 * hh) * 4), c1 = *(LAS f32x4*)(kb + FOX_COFF + (32 + 8 * g + 4 * hh) * 4);
                p0[4 * g] = c0.x; p0[4 * g + 1] = c0.y; p0[4 * g + 2] = c0.z; p0[4 * g + 3] = c0.w;
                p1[4 * g] = c1.x; p1[4 * g + 1] = c1.y; p1[4 * g + 2] = c1.z; p1[4 * g + 3] = c1.w;
            }
#pragma unroll
            for (int s = 0; s < 4; ++s) {
                const bf16x8 a0 = *(LAS bf16x8*)(kb + l32 * 144 + (2 * s + hh) * 16), a1 = *(LAS bf16x8*)(kb + (32 + l32) * 144 + (2 * s + hh) * 16);
                p0 = MFMA32(a0, qf[s], p0); p1 = MFMA32(a1, qf[s], p1);
            }
            if (t * 64 + 63 > wq_lo) {
#pragma unroll
                for (int r = 0; r < 16; ++r) { const int key = t * 64 + (r & 3) + 8 * (r >> 2) + 4 * hh; if (key > qpos) p0[r] = -INFINITY; if (key + 32 > qpos) p1[r] = -INFINITY; }
            }
            float mx = fmaxf(p0[0], p1[0]);
#pragma unroll
            for (int r = 1; r < 16; ++r) mx = fmaxf(mx, fmaxf(p0[r], p1[r]));
            mx = fmaxf(mx, __shfl_xor(mx, 32));
            const float mn = fmaxf(m, mx), alpha = ex2(m - mn); m = mn;
            float rs = 0.f;
#pragma unroll
            for (int r = 0; r < 16; ++r) { p0[r] = ex2(p0[r] - mn); p1[r] = ex2(p1[r] - mn); rs += p0[r] + p1[r]; }
            l = l * alpha + rs; o0 = o0 * alpha; o1 = o1 * alpha;
#pragma unroll
            for (int s = 0; s < 4; ++s) {
                u32x4 pw;
                if (s < 2) { pw.x = pk2(p0[8 * s], p0[8 * s + 1]); pw.y = pk2(p0[8 * s + 2], p0[8 * s + 3]); pw.z = pk2(p0[8 * s + 4], p0[8 * s + 5]); pw.w = pk2(p0[8 * s + 6], p0[8 * s + 7]); }
                else { const int q = 8 * (s - 2); pw.x = pk2(p1[q], p1[q + 1]); pw.y = pk2(p1[q + 2], p1[q + 3]); pw.z = pk2(p1[q + 4], p1[q + 5]); pw.w = pk2(p1[q + 6], p1[q + 7]); }
                const bf16x8 pf = __builtin_bit_cast(bf16x8, pw);
                LAS unsigned char* vb = kb + FOX_VOFF + l32 * 136 + (16 * s + 4 * hh) * 2;
                const u32x2 a = *(LAS u32x2*)vb, b = *(LAS u32x2*)(vb + 16), c = *(LAS u32x2*)(vb + 32 * 136), d = *(LAS u32x2*)(vb + 32 * 136 + 16);
                const u32x4 v0 = {a.x, a.y, b.x, b.y}, v1 = {c.x, c.y, d.x, d.y};
                o0 = MFMA32(__builtin_bit_cast(bf16x8, v0), pf, o0); o1 = MFMA32(__builtin_bit_cast(bf16x8, v1), pf, o1);
            }
        }
        if (more) FOX_STORE((t + 1) & 1);
        __syncthreads();
    }
#undef FOX_LOAD
#undef FOX_STORE
    if (active) {
        const float inv = 1.f / (l + __shfl_xor(l, 32));
        bf16_t* op = U.O + (size_t)(wid * 32 + l32) * 1024 + 4 * hh;
#pragma unroll
        for (int g = 0; g < 4; ++g) {
            u32x2 w; w.x = pk2(o0[4 * g] * inv, o0[4 * g + 1] * inv); w.y = pk2(o0[4 * g + 2] * inv, o0[4 * g + 3] * inv); *(u32x2*)(op + 8 * g) = w;
            w.x = pk2(o1[4 * g] * inv, o1[4 * g + 1] * inv); w.y = pk2(o1[4 * g + 2] * inv, o1[4 * g + 3] * inv); *(u32x2*)(op + 32 + 8 * g) = w;
        }
    }
}
__device__ __forceinline__ void fox_phase(const Params& P, LAS unsigned char* lds, int tid, int wid, int lane) {
    const bf16_t* B = (const bf16_t*)(P.ws + WS_B);
    bf16_t* mixed = MIXED;
    for (int it = blockIdx.x; it < 1024 + 64; it += gridDim.x) {
        if (it < 1024) {
            const int bh = it >> 4, pi = it & 15, b = bh >> 3, hd = bh & 7;
#pragma unroll 1
            for (int k = 0; k < 2; ++k) {
                const int qb = k ? 31 - pi : pi;
                FoxUnit U;
                U.Q = B + B_FQ + (size_t)(b * T + qb * 256) * 512 + hd * 64; U.K = B + B_FK + (size_t)b * T * 512 + hd * 64;
                U.VT = B + B_FVT + (size_t)(b * 512 + hd * 64) * T; U.c2 = (const float*)(P.ws + WS_C2P) + (size_t)bh * T;
                U.O = mixed + (size_t)(b * T + qb * 256) * 1024 + 512 + hd * 64; U.vtp = T; U.qpos0 = qb * 256; U.nq = 256; U.ntiles = 4 * (qb + 1); U.Tk = T;
                fox_unit(lds, U, tid, wid, lane);
            }
        } else {
            const int bh = it - 1024, b = bh >> 3, hd = bh & 7;
            FoxUnit U;
            U.Q = B + B_FQ + (size_t)(RP + b * 32) * 512 + hd * 64; U.K = (const bf16_t*)(P.ws + WS_FKS) + (size_t)b * TKS * 512 + hd * 64;
            U.VT = (const bf16_t*)(P.ws + WS_FVTS) + (size_t)(b * 512 + hd * 64) * TKS; U.c2 = (const float*)(P.ws + WS_C2S) + (size_t)bh * TKS;
            U.O = mixed + (size_t)(RP + b * 32) * 1024 + 512 + hd * 64; U.vtp = TKS; U.qpos0 = PAST; U.nq = 32; U.ntiles = 65; U.Tk = TKS;
            fox_unit(lds, U, tid, wid, lane);
        }
    }
}

constexpr int XA_BUF = 16896;
__device__ __forceinline__ void xattn_unit(LAS unsigned char* lds, const bf16_t* Q, const bf16_t* Kb, const bf16_t* VTb, bf16_t* O, int nwaves, int tid, int wid, int lane) {
    const int l32 = lane & 31, hh = lane >> 5;
    const bool active = wid < nwaves;
    bf16x8 qf[16];
#pragma unroll
    for (int s = 0; s < 16; ++s) qf[s] = active ? *(const bf16x8*)(Q + (size_t)(wid * 32 + l32) * 1024 + 16 * s + 8 * hh) : (bf16x8){0, 0, 0, 0, 0, 0, 0, 0};
    f32x16 S[4];
    bf16x8 pf[16];
    float m1 = 0.f, l1 = 0.f, a1 = 0.f, a2 = 0.f;
    u32x4 r0, r1;
    const int i0 = tid, i1 = tid + 512;
    const bf16_t* g0 = Kb + (size_t)(i0 >> 5) * 1024 + (i0 & 31) * 8; const bf16_t* g1 = Kb + (size_t)(i1 >> 5) * 1024 + (i1 & 31) * 8;
    const bf16_t* h0 = VTb + (size_t)(i0 >> 5) * 256 + (i0 & 31) * 8; const bf16_t* h1 = VTb + (size_t)(i1 >> 5) * 256 + (i1 & 31) * 8;
#define XA_LOAD(tt) do { if ((tt) < 8) { r0 = *(const u32x4*)g0; r1 = *(const u32x4*)g1; g0 += 32 * 1024; g1 += 32 * 1024; asm volatile("" : "+v"(g0), "+v"(g1)); } \
        else { r0 = *(const u32x4*)h0; r1 = *(const u32x4*)h1; h0 += 32 * 256; h1 += 32 * 256; asm volatile("" : "+v"(h0), "+v"(h1)); } } while (0)
#define XA_STORE(bi) do { LAS unsigned char* b_ = lds + (bi) * XA_BUF; *(LAS u32x4*)(b_ + (i0 >> 5) * 528 + (i0 & 31) * 16) = r0; *(LAS u32x4*)(b_ + (i1 >> 5) * 528 + (i1 & 31) * 16) = r1; } while (0)
#define XA_HALF(hf, mm, ll) do { float mx_ = S[0][0]; \
        _Pragma("unroll") for (int k = 0; k < 4; ++k) _Pragma("unroll") for (int r = 0; r < 16; ++r) mx_ = fmaxf(mx_, S[k][r]); \
        mx_ = fmaxf(mx_, __shfl_xor(mx_, 32)); float l_ = 0.f; \
        _Pragma("unroll") for (int k = 0; k < 4; ++k) { \
            _Pragma("unroll") for (int r = 0; r < 16; ++r) { S[k][r] = ex2(S[k][r] - mx_); l_ += S[k][r]; } \
            _Pragma("unroll") for (int s = 0; s < 2; ++s) { u32x4 pw; pw.x = pk2(S[k][8 * s], S[k][8 * s + 1]); pw.y = pk2(S[k][8 * s + 2], S[k][8 * s + 3]); pw.z = pk2(S[k][8 * s + 4], S[k][8 * s + 5]); pw.w = pk2(S[k][8 * s + 6], S[k][8 * s + 7]); \
                pf[8 * (hf) + 2 * k + s] = __builtin_bit_cast(bf16x8, pw); } } \
        mm = mx_; ll = l_ + __shfl_xor(l_, 32); } while (0)
    XA_LOAD(0); XA_STORE(0);
    __syncthreads();
#pragma unroll
    for (int tt = 0; tt < 16; ++tt) {
        if (tt + 1 < 16) XA_LOAD(tt + 1);
        LAS unsigned char* buf = lds + (tt & 1) * XA_BUF;
        if (active) {
            if (tt < 8) {
                f32x16 s = {};
#pragma unroll
                for (int k = 0; k < 16; ++k) { const bf16x8 a = *(LAS bf16x8*)(buf + l32 * 528 + (2 * k + hh) * 16); s = MFMA32(a, qf[k], s); }
                S[tt & 3] = s;
                if (tt == 3) XA_HALF(0, m1, l1);
                if (tt == 7) {
                    float m2, l2; XA_HALF(1, m2, l2);
                    const float mm = fmaxf(m1, m2); a1 = ex2(m1 - mm); a2 = ex2(m2 - mm);
                    const float inv = 1.f / (a1 * l1 + a2 * l2); a1 *= inv; a2 *= inv;
                }
            } else {
                f32x16 o1 = {}, o2 = {};
#pragma unroll
                for (int k = 0; k < 16; ++k) {
                    LAS unsigned char* vb = buf + l32 * 528 + (16 * k + 4 * hh) * 2;
                    const u32x2 a = *(LAS u32x2*)vb, b = *(LAS u32x2*)(vb + 16);
                    const u32x4 vw = {a.x, a.y, b.x, b.y};
                    if (k < 8) o1 = MFMA32(__builtin_bit_cast(bf16x8, vw), pf[k], o1); else o2 = MFMA32(__builtin_bit_cast(bf16x8, vw), pf[k], o2);
                }
                bf16_t* op = O + (size_t)(wid * 32 + l32) * 1024 + 32 * (tt - 8) + 4 * hh;
#pragma unroll
                for (int g = 0; g < 4; ++g) { u32x2 w; w.x = pk2(o1[4 * g] * a1 + o2[4 * g] * a2, o1[4 * g + 1] * a1 + o2[4 * g + 1] * a2); w.y = pk2(o1[4 * g + 2] * a1 + o2[4 * g + 2] * a2, o1[4 * g + 3] * a1 + o2[4 * g + 3] * a2); *(u32x2*)(op + 8 * g) = w; }
            }
        }
        if (tt + 1 < 16) XA_STORE((tt + 1) & 1);
        __syncthreads();
    }
#undef XA_HALF
#undef XA_LOAD
#undef XA_STORE
}
__device__ __forceinline__ void xattn_phase(const Params& P, LAS unsigned char* lds, int layer, int tid, int wid, int lane) {
    const bf16_t* XQ = (const bf16_t*)(P.ws + WS_B);
    bf16_t* XO = (bf16_t*)(P.ws + WS_B) + B_X2;
    const bf16_t* MK = (const bf16_t*)(P.ws + WS_MEMK); const bf16_t* MVT = (const bf16_t*)(P.ws + WS_MEMVT);
    for (int it = blockIdx.x; it < 1024 + 32; it += gridDim.x) {
        int row0, set, hd, nw;
        if (it < 1024) { const int pm = it >> 2; hd = it & 3; row0 = pm * 256; set = layer * 16 + (pm >> 5); nw = 8; }
        else { const int q = it - 1024, b = q >> 2; hd = q & 3; row0 = RP + b * 32; set = layer * 16 + 8 + b; nw = 1; }
        xattn_unit(lds, XQ + (size_t)row0 * 1024 + hd * 256, MK + (size_t)set * 262144 + hd * 256, MVT + ((size_t)set * 1024 + hd * 256) * 256, XO + (size_t)row0 * 1024 + hd * 256, nw, tid, wid, lane);
    }
}

__device__ __forceinline__ void s5_run(LAS unsigned char* wl, const bf16_t* U, bf16_t* Y, int row0, int L, int g, f32x2 a, float& xr, float& xi, bool outp,
                                       const bf16_t* SB5, const bf16_t* SC5, const float* s5d, int lane) {
    const int l32 = lane & 31, hh = lane >> 5, l16 = lane & 15, q4 = lane >> 4;
    bf16x8 bfr[4], cfr[4];
#pragma unroll
    for (int k = 0; k < 4; ++k) { bfr[k] = *(const bf16x8*)(SB5 + ((size_t)(g * 4 + k) * 64 + lane) * 8); cfr[k] = *(const bf16x8*)(SC5 + ((size_t)(g * 4 + k) * 64 + lane) * 8); }
    const f32x4 dv = *(const f32x4*)(s5d + g * 16 + 4 * q4);
    for (int sc = 0; sc < L / 32; ++sc) {
        const int r0 = row0 + sc * 32;
        const bf16x8 uf = *(const bf16x8*)(U + (size_t)(r0 + l32) * 1024 + g * 16 + 8 * hh);
        const f32x16 z = {};
        const f32x16 d0 = MFMA32(uf, bfr[0], z), d1 = MFMA32(uf, bfr[1], z), d2 = MFMA32(uf, bfr[2], z), d3 = MFMA32(uf, bfr[3], z);
#pragma unroll
        for (int r = 0; r < 16; ++r) {
            const int tok = (r & 3) + 8 * (r >> 2) + 4 * hh;
            *(LAS f32x2*)(wl + tok * 528 + l32 * 8) = (f32x2){d0[r], d2[r]};
            *(LAS f32x2*)(wl + tok * 528 + (32 + l32) * 8) = (f32x2){d1[r], d3[r]};
        }
        LDSBAR();
#pragma unroll
        for (int t0 = 0; t0 < 32; t0 += 8) {
            f32x2 bu[8]; float xo_[8];
#pragma unroll
            for (int k = 0; k < 8; ++k) bu[k] = *(LAS f32x2*)(wl + (t0 + k) * 528 + lane * 8);
            LDSBAR();
#pragma unroll
            for (int k = 0; k < 8; ++k) {
                const float nr = a.x * xr - a.y * xi + bu[k].x, ni = a.x * xi + a.y * xr + bu[k].y;
                xr = nr; xi = ni; xo_[k] = __uint_as_float(pk2(xr, xi));
            }
            if (outp) {
#pragma unroll
                for (int k = 0; k < 8; ++k) *(LAS float*)(wl + (t0 + k) * 528 + lane * 4) = xo_[k];
            }
        }
        LDSBAR();
        if (outp) {
#pragma unroll
            for (int tb = 0; tb < 2; ++tb) {
                f32x4 acc = {0.f, 0.f, 0.f, 0.f};
#pragma unroll
                for (int ks = 0; ks < 4; ++ks) { const bf16x8 xf = *(LAS bf16x8*)(wl + (16 * tb + l16) * 528 + (32 * ks + 8 * q4) * 2); acc = MFMA16(cfr[ks], xf, acc); }
                const size_t off = (size_t)(r0 + 16 * tb + l16) * 1024 + g * 16 + 4 * q4;
                const u32x2 uu = *(const u32x2*)(U + off);
                f32x4 y; y.x = acc.x + dv.x * bflo(uu.x); y.y = acc.y + dv.y * bfhi(uu.x); y.z = acc.z + dv.z * bflo(uu.y); y.w = acc.w + dv.w * bfhi(uu.y);
                u32x2 w; w.x = pk2(y.x, y.y); w.y = pk2(y.z, y.w);
                *(u32x2*)(Y + off) = w;
            }
        }
        LDSBAR();
    }
}
constexpr int S5_NSEG = 16, S5_LSEG = 512;
__device__ __forceinline__ void s5_phase(const Params& P, LAS unsigned char* lds, int pass, int wid, int lane) {
    const bf16_t* U = (const bf16_t*)(P.ws + WS_B);
    bf16_t* Y = (bf16_t*)(P.ws + WS_B) + B_X2;
    const f32x2* S5A = (const f32x2*)(P.ws + WS_S5T); const f32x2* S5AL = S5A + 4096;
    const bf16_t* SB5 = (const bf16_t*)(P.ws + WS_S5T + 65536); const bf16_t* SC5 = SB5 + 131072;
    f32x2* LE = (f32x2*)(P.ws + WS_LE);
    LAS unsigned char* wl = lds + wid * 16896;
    const int nunits = (pass == 1) ? 8 * (S5_NSEG - 1) * 8 : 8 * S5_NSEG * 8 + 64;
    for (int it = blockIdx.x; it < nunits; it += gridDim.x) {
        if (pass == 1) {
            const int g8 = it & 7, seg = (it >> 3) % (S5_NSEG - 1), b = (it >> 3) / (S5_NSEG - 1), g = g8 * 8 + wid;
            float xr = 0.f, xi = 0.f;
            s5_run(wl, U, Y, b * T + seg * S5_LSEG, S5_LSEG, g, S5A[g * 64 + lane], xr, xi, false, SB5, SC5, P.in[24], lane);
            LE[((size_t)(b * S5_NSEG + seg) * 64 + g) * 64 + lane] = (f32x2){xr, xi};
        } else if (it < 8 * S5_NSEG * 8) {
            const int g8 = it & 7, seg = (it >> 3) & (S5_NSEG - 1), b = it >> 7, g = g8 * 8 + wid;
            const f32x2 aL = S5AL[g * 64 + lane];
            float xr = 0.f, xi = 0.f;
            for (int s = 0; s < seg; ++s) { const f32x2 le = LE[((size_t)(b * S5_NSEG + s) * 64 + g) * 64 + lane]; const float nr = aL.x * xr - aL.y * xi + le.x, ni = aL.x * xi + aL.y * xr + le.y; xr = nr; xi = ni; }
            s5_run(wl, U, Y, b * T + seg * S5_LSEG, S5_LSEG, g, S5A[g * 64 + lane], xr, xi, true, SB5, SC5, P.in[24], lane);
            if (seg == S5_NSEG - 1) { P.out[O_S5RP + (size_t)(b * 64 + g) * 64 + lane] = xr; P.out[O_S5IP + (size_t)(b * 64 + g) * 64 + lane] = xi; }
        } else {
            const int q = it - 8 * S5_NSEG * 8, g8 = q & 7, b = q >> 3, g = g8 * 8 + wid;
            float xr = P.in[6][(size_t)(b * 64 + g) * 64 + lane], xi = P.in[7][(size_t)(b * 64 + g) * 64 + lane];
            s5_run(wl, U, Y, RP + b * 32, 32, g, S5A[g * 64 + lane], xr, xi, true, SB5, SC5, P.in[24], lane);
            P.out[O_S5RS + (size_t)(b * 64 + g) * 64 + lane] = xr; P.out[O_S5IS + (size_t)(b * 64 + g) * 64 + lane] = xi;
        }
    }
}

__device__ __forceinline__ void prologue(const Params& P, int tid, int wid, int lane) {
    const int gtid = blockIdx.x * 512 + tid, gsz = gridDim.x * 512;
    const int gw = blockIdx.x * 8 + wid, ngw = gridDim.x * 8;
    bf16_t* W = (bf16_t*)(P.ws + WS_W);
    wtrans(P.in[12], 1024, 3592, W + W_AB, 3840, 1, gtid, gsz, P.in[11]);
    wtrans(P.in[15], 1024, 1024, W + W_OUT, 1024, 0, gtid, gsz);
    wtrans(P.in[16], 1024, 1024, W + W_INC, 1024, 0, gtid, gsz, P.in[11] + 6144);
    wtrans(P.in[25], 1024, 2048, W + W_GLU, 2048, 2, gtid, gsz);
    for (int l = 0; l < 2; ++l) {
        wtrans(P.in[27] + (size_t)l * 1048576, 1024, 1024, W + W_XQ + (size_t)l * 1048576, 1024, 0, gtid, gsz, P.in[11] + l * 6144 + 2048);
        wtrans(P.in[28] + (size_t)l * 1048576, 1024, 1024, W + W_XKV + (size_t)l * 2097152, 1024, 0, gtid, gsz);
        wtrans(P.in[29] + (size_t)l * 1048576, 1024, 1024, W + W_XKV + (size_t)l * 2097152 + 1048576, 1024, 0, gtid, gsz);
        wtrans(P.in[30] + (size_t)l * 1048576, 1024, 1024, W + W_XO + (size_t)l * 1048576, 1024, 0, gtid, gsz);
        wtrans(P.in[31] + (size_t)l * 4194304, 1024, 4096, W + W_UP + (size_t)l * 4194304, 4096, 0, gtid, gsz, P.in[11] + l * 6144 + 4096);
        wtrans(P.in[32] + (size_t)l * 4194304, 4096, 1024, W + W_DN + (size_t)l * 4194304, 1024, 0, gtid, gsz);
    }
    {
        float* rope = (float*)(P.ws + WS_ROPE);
        for (int i = gtid; i < 8192 * 64; i += gsz) {
            const int pos = i >> 6, k = i & 63;
            const double inv = exp2(-(double)k * (13.287712379549449 / 64.0));
            const double ang = (double)pos * inv;
            rope[2 * i] = (float)cos(ang); rope[2 * i + 1] = (float)sin(ang);
        }
    }
    {
        f32x2* S5A = (f32x2*)(P.ws + WS_S5T); f32x2* S5AL = S5A + 4096;
        bf16_t* SB5 = (bf16_t*)(P.ws + WS_S5T + 65536); bf16_t* SC5 = SB5 + 131072;
        for (int i = gtid; i < 4096; i += gsz) {
            const int g = i >> 6, p = i & 63;
            const double lr = P.in[17][i], li = P.in[18][i], dt = exp((double)P.in[19][g]);
            const double mag = exp(lr * dt), ar = mag * cos(li * dt), ai = mag * sin(li * dt);
            S5A[i] = (f32x2){(float)ar, (float)ai};
            const double magL = exp(lr * dt * S5_LSEG);
            S5AL[i] = (f32x2){(float)(magL * cos(li * dt * S5_LSEG)), (float)(magL * sin(li * dt * S5_LSEG))};
            const double den = lr * lr + li * li, nre = ar - 1.0;
            const double fr = (nre * lr + ai * li) / den, fi = (ai * lr - nre * li) / den;
            const float* br = P.in[20] + (size_t)i * 16; const float* bi = P.in[21] + (size_t)i * 16;
#pragma unroll
            for (int part = 0; part < 2; ++part)
#pragma unroll
                for (int h2 = 0; h2 < 2; ++h2) {
                    float v[8];
#pragma unroll
                    for (int k = 0; k < 8; ++k) { const int c = 8 * h2 + k; v[k] = part == 0 ? (float)(fr * br[c] - fi * bi[c]) : (float)(fr * bi[c] + fi * br[c]); }
                    u32x4 o; o.x = pk2(v[0], v[1]); o.y = pk2(v[2], v[3]); o.z = pk2(v[4], v[5]); o.w = pk2(v[6], v[7]);
                    const int kb = 2 * part + (p >> 5), ln = (p & 31) + 32 * h2;
                    *(u32x4*)(SB5 + ((size_t)(g * 4 + kb) * 64 + ln) * 8) = o;
                }
        }
        for (int i = gtid; i < 64 * 4 * 64; i += gsz) {
            const int ln = i & 63, ks = (i >> 6) & 3, g = i >> 8;
            const int c = ln & 15;
            float v[8];
#pragma unroll
            for (int k = 0; k < 8; ++k) { const int kidx = 32 * ks + 8 * (ln >> 4) + k, p = kidx >> 1; v[k] = (kidx & 1) ? -P.in[23][((size_t)g * 16 + c) * 64 + p] : P.in[22][((size_t)g * 16 + c) * 64 + p]; }
            u32x4 o; o.x = pk2(v[0], v[1]); o.y = pk2(v[2], v[3]); o.z = pk2(v[4], v[5]); o.w = pk2(v[6], v[7]);
            *(u32x4*)(SC5 + (size_t)i * 8) = o;
        }
    }
    {
        bf16_t* FKS = (bf16_t*)(P.ws + WS_FKS); bf16_t* FVTS = (bf16_t*)(P.ws + WS_FVTS);
        for (int i = gtid; i < 8 * PAST * 64; i += gsz) { const int b = i / (PAST * 64), r = i % (PAST * 64); cvt8(P.in[3] + (size_t)i * 8, FKS + (size_t)b * TKS * 512 + (size_t)r * 8); }
        for (int b = 0; b < 8; ++b) ttrans(P.in[4] + (size_t)b * PAST * 512, PAST, 512, FVTS + (size_t)b * 512 * TKS, TKS, gtid, gsz);
        bf16_t* MK = (bf16_t*)(P.ws + WS_MEMK); bf16_t* MVT = (bf16_t*)(P.ws + WS_MEMVT);
        for (int i = gtid; i < 2 * 8 * 32768; i += gsz) { const int lb = i >> 15, r = i & 32767, l = lb >> 3, b = lb & 7; cvt8(P.in[8] + (size_t)i * 8, MK + (size_t)(l * 16 + 8 + b) * 262144 + (size_t)r * 8); }
        for (int lb = 0; lb < 16; ++lb) { const int l = lb >> 3, b = lb & 7; ttrans(P.in[9] + (size_t)lb * 262144, 256, 1024, MVT + (size_t)(l * 16 + 8 + b) * 262144, 256, gtid, gsz); }
    }
    {
        bf16_t* H = (bf16_t*)(P.ws + WS_A); bf16_t* MEMN = (bf16_t*)(P.ws + WS_MEMN);
        for (int row = gw; row < R + 4096; row += ngw) {
            if (row < R) { const float* xr = row < RP ? P.in[0] + (size_t)row * 1024 : P.in[1] + (size_t)(row - RP) * 1024; cvt_row(xr, H + (size_t)row * 1024, (float*)(P.ws + WS_RS) + row, lane); }
            else { const int q = row - R, l = q >> 11, r = q & 2047; norm_row(P.in[10] + (size_t)r * 1024, P.in[26] + l * 1024, MEMN + (size_t)q * 1024, lane); }
        }
    }
}
__device__ __forceinline__ void cumsum_task(const Params& P, int q, int lane) {
    const bool samp = q >= 64; const int bh = q & 63, b = bh >> 3, hd = bh & 7;
    const int n = samp ? TKS : T;
    float* dst = samp ? (float*)(P.ws + WS_C2S) + (size_t)bh * TKS : (float*)(P.ws + WS_C2P) + (size_t)bh * T;
    float carry = 0.f;
    for (int base0 = 0; base0 < n; base0 += 512) {
        float vv[8];
#pragma unroll
        for (int k = 0; k < 8; ++k) {
            const int idx = base0 + 64 * k + lane; float v = 0.f;
            if (idx < n) {
                if (!samp) v = P.out[O_LFP + ((size_t)b * T + idx) * 8 + hd];
                else v = idx < PAST ? P.in[5][((size_t)b * PAST + idx) * 8 + hd] : P.out[O_LFS + ((size_t)b * 32 + idx - PAST) * 8 + hd];
            }
            vv[k] = v;
        }
#pragma unroll
        for (int k = 0; k < 8; ++k) {
            const int idx = base0 + 64 * k + lane; float v = vv[k];
#pragma unroll
            for (int o = 1; o < 64; o <<= 1) { const float t = __shfl_up(v, o); if (lane >= o) v += t; }
            if (idx < n) dst[idx] = (carry + v) * LOG2E;
            carry += __shfl(v, 63);
        }
    }
}

template <class Epi> __device__ __forceinline__ void run_gemm(LAS unsigned char* lds, const bf16_t* A, const bf16_t* Bt, int M, int N, int K, const Epi& E) {
    pg8::Gemm g{A, Bt, M, N, K}; pg8::StaticOrder S; S.init(M, N, (int)gridDim.x, (int)blockIdx.x);
#ifndef GEMM_REP
#define GEMM_REP 1
#endif
#pragma unroll 1
    for (int rep_ = 0; rep_ < GEMM_REP; ++rep_)
    pg8::gemm_phase<Epi, pg8::StaticOrder, true, true>(lds, g, S, E);
}

#define XB_TMO      128
#define XB_XCNT(j)  (256  + 64 * (j))
#define XB_XSUB(j)  (1280 + 64 * (j))
#define XB_XGEN(j)  (2304 + 64 * (j))
#define XB_TOP      3328
#define XB_TOPGEN   3392
#define XCD_BAR_WORDS 3456
#define XB_SPIN_CAP (1u << 18)

__device__ __forceinline__ unsigned xb_ld(unsigned* p)              { return __hip_atomic_load(p, __ATOMIC_RELAXED, __HIP_MEMORY_SCOPE_AGENT); }
__device__ __forceinline__ unsigned xb_add(unsigned* p, unsigned v) { return __hip_atomic_fetch_add(p, v, __ATOMIC_RELAXED, __HIP_MEMORY_SCOPE_AGENT); }
__device__ __forceinline__ unsigned xb_xcc_id() { return (unsigned)__builtin_amdgcn_s_getreg((3 << 11) | 20) & 0xFu; }
#define XB_SPIN(cond, bar) do { unsigned _sp = 0; while (cond) { __builtin_amdgcn_s_sleep(1); \
    if ((++_sp & 255u) == 0u) { if (xb_ld(&(bar)[XB_TMO])) break; if (_sp > XB_SPIN_CAP) { atomicAdd(&(bar)[XB_TMO], 1u); break; } } } } while (0)

struct XcdBarrier {
    unsigned* bar; unsigned x;
    volatile LAS unsigned* st;
};

__device__ __forceinline__ XcdBarrier xcd_barrier_post(unsigned* bar, volatile LAS unsigned* st) {
    XcdBarrier b; b.bar = bar; b.x = xb_xcc_id(); b.st = st;
    if (threadIdx.x == 0) (void)xb_add(&bar[XB_XCNT(b.x)], 1u);
    return b;
}
__device__ __forceinline__ void xcd_barrier_complete(unsigned* bar, unsigned x, unsigned& nloc, unsigned& nx) {
    const unsigned G = gridDim.x * gridDim.y * gridDim.z;
    unsigned sum, cnt, mine, sp = 0u;
    for (;;) {
        sum = 0u; cnt = 0u; mine = 0u;
#pragma unroll
        for (unsigned j = 0; j < 16; ++j) { const unsigned c = xb_ld(&bar[XB_XCNT(j)]); sum += c; cnt += (c > 0u) ? 1u : 0u; mine = (j == x) ? c : mine; }
        if (sum == G) break;
        __builtin_amdgcn_s_sleep(1);
        if ((++sp & 255u) == 0u) { if (xb_ld(&bar[XB_TMO])) break; if (sp > XB_SPIN_CAP) { atomicAdd(&bar[XB_TMO], 1u); break; } }
    }
    nloc = mine > 0u ? mine : 1u; nx = cnt > 0u ? cnt : 1u;
}

__device__ __forceinline__ void xcd_barrier(const XcdBarrier& b) {
    asm volatile("s_waitcnt vmcnt(0)" ::: "memory");
    __syncthreads();
    if (threadIdx.x == 0) {
        unsigned* bar = b.bar;
        __builtin_amdgcn_s_waitcnt(0);
        unsigned nloc = b.st[0], nx = b.st[1];
        if (nloc == 0u) { xcd_barrier_complete(bar, b.x, nloc, nx); b.st[0] = nloc; b.st[1] = nx; }
        const unsigned old = xb_add(&bar[XB_XSUB(b.x)], 1u);
        const unsigned gen = old / nloc;
        if (old + 1u == (gen + 1u) * nloc) {
            __builtin_amdgcn_fence(__ATOMIC_RELEASE, "agent");
            asm volatile("s_waitcnt vmcnt(0)" ::: "memory");
            const unsigned og = xb_add(&bar[XB_TOP], 1u);
            const unsigned tg = og / nx;
            if (og + 1u == (tg + 1u) * nx) xb_add(&bar[XB_TOPGEN], 1u);
            else XB_SPIN(xb_ld(&bar[XB_TOPGEN]) == tg, bar);
            __builtin_amdgcn_fence(__ATOMIC_ACQUIRE, "agent");
            xb_add(&bar[XB_XGEN(b.x)], 1u);
            asm volatile("s_waitcnt vmcnt(0)" ::: "memory");
        } else {
            XB_SPIN(xb_ld(&bar[XB_XGEN(b.x)]) == gen, bar);
            __builtin_amdgcn_fence(__ATOMIC_ACQUIRE, "agent");
            asm volatile("s_waitcnt vmcnt(0)" ::: "memory");
        }
    }
    __syncthreads();
}

__device__ __forceinline__ void gbar(unsigned* ctr, int& gen) {
    asm volatile("s_waitcnt vmcnt(0) lgkmcnt(0)" ::: "memory");
    __syncthreads();
    if (threadIdx.x == 0) {
        __builtin_amdgcn_fence(__ATOMIC_RELEASE, "agent");
        asm volatile("s_waitcnt vmcnt(0)" ::: "memory");
        const unsigned target = (unsigned)(gen + 1) * gridDim.x;
        __hip_atomic_fetch_add(ctr, 1u, __ATOMIC_RELAXED, __HIP_MEMORY_SCOPE_AGENT);
        while (__hip_atomic_load(ctr, __ATOMIC_RELAXED, __HIP_MEMORY_SCOPE_AGENT) < target) __builtin_amdgcn_s_sleep(2);
        __builtin_amdgcn_fence(__ATOMIC_ACQUIRE, "agent");
        asm volatile("s_waitcnt vmcnt(0)" ::: "memory");
    }
    __syncthreads();
    ++gen;
}
#define PHASE_BEGIN if (ph >= ph_lo && ph < ph_hi) { int tid = threadIdx.x; asm volatile("" : "+v"(tid)); const int lane = tid & 63, wid = __builtin_amdgcn_readfirstlane(tid >> 6); const int gw = blockIdx.x * 8 + wid, ngw = gridDim.x * 8; (void)lane; (void)gw; (void)ngw;
#define PHASE_END   if (ph + 1 < ph_hi) { if (ph == 0) { grid.sync(); if (threadIdx.x == 0) (void)xb_add(&xbar.bar[XB_XCNT(xbar.x)], 1u); } else xcd_barrier(xbar); } } ++ph;
template <int layer> __device__ __forceinline__ void layer_phases(const Params& P, LAS unsigned char* lds, cg::grid_group& grid, int& ph, const XcdBarrier& xbar, int ph_lo, int ph_hi, bf16_t* W, bf16_t* A, bf16_t* B, bf16_t* C, float* xo, float* xo_s) {
        const float* nw = P.in[11] + layer * 6144;
        if constexpr (layer == 1) {
            PHASE_BEGIN { EpiPlain<0> E{B, 1024, 1.f, RSV}; run_gemm(lds, A, W + W_INC, R, 1024, 1024, E); } PHASE_END
            PHASE_BEGIN for (int rp_ = 0; rp_ < REP_S5; ++rp_) s5_phase(P, lds, 1, wid, lane); PHASE_END
            PHASE_BEGIN for (int rp_ = 0; rp_ < REP_S5; ++rp_) s5_phase(P, lds, 2, wid, lane); PHASE_END
            PHASE_BEGIN { EpiGlu E{C}; run_gemm(lds, B + B_X2, W + W_GLU, R, 2048, 1024, E); } PHASE_END
            PHASE_BEGIN resnorm_phase<1, 0>(C, nullptr, nullptr, A, nw + 1024, RSV, nullptr, gw, ngw, lane); PHASE_END
        }
        PHASE_BEGIN { EpiPlain<0> E{B, 1024, 0.0625f * LOG2E, RSV}; run_gemm(lds, A, W + W_XQ + (size_t)layer * 1048576, R, 1024, 1024, E); } PHASE_END
        PHASE_BEGIN for (int rp_ = 0; rp_ < REP_XA; ++rp_) xattn_phase(P, lds, layer, tid, wid, lane); PHASE_END
        PHASE_BEGIN { EpiPlain<0> E{C, 1024, 1.f, nullptr}; run_gemm(lds, B + B_X2, W + W_XO + (size_t)layer * 1048576, R, 1024, 1024, E); } PHASE_END
        PHASE_BEGIN resnorm_phase<1, 0>(C, nullptr, nullptr, A, nw + 3072, RSV, nullptr, gw, ngw, lane); PHASE_END
        PHASE_BEGIN { EpiPlain<1> E{B, 4096, 1.f, RSV}; run_gemm(lds, A, W + W_UP + (size_t)layer * 4194304, R, 4096, 1024, E); } PHASE_END
        PHASE_BEGIN { EpiPlain<0> E{C, 1024, 1.f, nullptr}; run_gemm(lds, B, W + W_DN + (size_t)layer * 4194304, R, 1024, 4096, E); } PHASE_END
        PHASE_BEGIN { if constexpr (layer == 0) resnorm_phase<1, 0>(C, nullptr, nullptr, A, nw + 5120, RSV, nullptr, gw, ngw, lane); else resnorm_phase<1, 1>(C, nullptr, nullptr, A, nw + 5120, nullptr, xo, gw, ngw, lane); } PHASE_END
    }
__global__ void __launch_bounds__(512) mega_fwd(Params P, int ph_lo, int ph_hi) {
    extern __shared__ __attribute__((aligned(16))) unsigned char lds_raw[];
    LAS unsigned char* lds = (LAS unsigned char*)lds_raw;
    cg::grid_group grid = cg::this_grid();
    bf16_t* W = (bf16_t*)(P.ws + WS_W);
    bf16_t* A = (bf16_t*)(P.ws + WS_A);
    bf16_t* B = (bf16_t*)(P.ws + WS_B);
    bf16_t* C = (bf16_t*)(P.ws + WS_C);
    float* xo = P.out; float* xo_s = P.out + (size_t)RP * 1024;
    int ph = 0;
    unsigned* barw = (unsigned*)(P.ws + 4096);
    if (blockIdx.x == 0) for (int i = threadIdx.x; i < XCD_BAR_WORDS; i += 512) __hip_atomic_store(barw + i, 0u, __ATOMIC_RELAXED, __HIP_MEMORY_SCOPE_AGENT);
    volatile LAS unsigned* bst = (volatile LAS unsigned*)(lds + LDS_BYTES - 64);
    if (threadIdx.x == 0) { bst[0] = 0u; bst[1] = 0u; }
    __syncthreads();
    XcdBarrier xbar; xbar.bar = barw; xbar.x = xb_xcc_id(); xbar.st = bst;

    PHASE_BEGIN for (int rp_ = 0; rp_ < REP_PRO; ++rp_) prologue(P, tid, wid, lane); PHASE_END
    PHASE_BEGIN {
        EpiAB E{B, (bf16_t*)(P.ws + WS_FKS), (bf16_t*)(P.ws + WS_FVTS), P.out, (const float*)(P.ws + WS_ROPE), P.in[13], RSV};
        run_gemm(lds, A, W + W_AB, R, 3840, 1024, E);
        for (int l = 0; l < 2; ++l) {
            EpiMemKV E2{P.out + O_MK, P.out + O_MV, (bf16_t*)(P.ws + WS_MEMK), (bf16_t*)(P.ws + WS_MEMVT), l};
            run_gemm(lds, (const bf16_t*)(P.ws + WS_MEMN) + (size_t)l * 2048 * 1024, W + W_XKV + (size_t)l * 2097152, 2048, 2048, 1024, E2);
        }
    } PHASE_END
    PHASE_BEGIN { for (int rp_ = 0; rp_ < REP_RET; ++rp_) { ret_passA(P, wid, lane); if (blockIdx.x < 16) cumsum_task(P, blockIdx.x * 8 + wid, lane); } } PHASE_END
    PHASE_BEGIN ret_passB(P, tid); PHASE_END
    PHASE_BEGIN {
        LAS float* red = (LAS float*)lds;
        for (int rp_ = 0; rp_ < REP_RET; ++rp_)
        for (int u = blockIdx.x; u < 4096 + 32; u += gridDim.x) { if (u < 4096) ret_unitC<64>(P, red, u >> 7, u & 127, wid, lane); else ret_unitC<32>(P, red, u - 4096, 0, wid, lane); }
        __syncthreads();
        for (int rp_ = 0; rp_ < REP_FOX; ++rp_) { fox_phase(P, lds, tid, wid, lane); __syncthreads(); }
    } PHASE_END
    PHASE_BEGIN { EpiPlain<0> E{C, 1024, 1.f, nullptr}; run_gemm(lds, MIXED, W + W_OUT, R, 1024, 1024, E); } PHASE_END
    PHASE_BEGIN resnorm_phase<0, 0>(C, P.in[0], P.in[1], A, P.in[11] + 1024, RSV, nullptr, gw, ngw, lane); PHASE_END
    layer_phases<0>(P, lds, grid, ph, xbar, ph_lo, ph_hi, W, A, B, C, xo, xo_s);
    layer_phases<1>(P, lds, grid, ph, xbar, ph_lo, ph_hi, W, A, B, C, xo, xo_s);
}

extern "C" void kernel_launch(void* const* d_in, const int* in_sizes, int n_in, void* d_out, int out_size, void* d_ws, size_t ws_size, hipStream_t stream) {
    static int grid = 0;
    if (grid == 0) {
        if (n_in != 33 || (size_t)out_size != O_END || ws_size < WS_END) { fprintf(stderr, "kernel_launch: unexpected shapes n_in %d out %d ws %zu\n", n_in, out_size, ws_size); grid = -1; return; }
        int dev = 0, cus = 0, per_cu = 0;
        hipGetDevice(&dev);
        hipDeviceGetAttribute(&cus, hipDeviceAttributeMultiprocessorCount, dev);
        if (hipFuncSetAttribute((const void*)mega_fwd, hipFuncAttributeMaxDynamicSharedMemorySize, LDS_BYTES) != hipSuccess) { fprintf(stderr, "kernel_launch: hipFuncSetAttribute failed\n"); grid = -1; return; }
        if (hipOccupancyMaxActiveBlocksPerMultiprocessor(&per_cu, (const void*)mega_fwd, 512, LDS_BYTES) != hipSuccess || per_cu < 1) { fprintf(stderr, "kernel_launch: occupancy query %d\n", per_cu); per_cu = 1; (void)hipGetLastError(); }
        grid = cus * per_cu;
    }
    if (grid < 0) return;
    Params p{};
    for (int i = 0; i < 33; ++i) p.in[i] = (const float*)d_in[i];
    p.out = (float*)d_out; p.ws = (unsigned char*)d_ws;
    int lo = 0, hi = 1000;
    void* args[] = {&p, &lo, &hi};
    hipError_t e = hipLaunchCooperativeKernel((const void*)mega_fwd, dim3(grid), dim3(512), args, LDS_BYTES, stream);
    if (e != hipSuccess) fprintf(stderr, "cooperative launch failed: %s (grid %d)\n", hipGetErrorString(e), grid);
}
```

```cpp
#include <hip/hip_runtime.h>
#include <hip/hip_cooperative_groups.h>
#include <cstdio>
#include <cstdint>
namespace cg = cooperative_groups;
namespace pg8 {
#define PG8_LAS __attribute__((address_space(3)))
typedef unsigned short bf16_t;
typedef short bf16x8 __attribute__((ext_vector_type(8)));
typedef float f32x4 __attribute__((ext_vector_type(4)));
typedef unsigned u32x4 __attribute__((ext_vector_type(4)));
constexpr int BM = 256, BK = 64, HALF = 128, HTB = HALF * BK * 2  , STAGE_BYTES = 8 * HTB, NXCD = 8, WGM = 8;

__host__ __device__ __forceinline__ int lds_byte(int r, int c) { const int st = (r >> 4) * 2 + (c >> 5), rr = r & 15, cc = c & 31, ob = rr * 64 + cc * 2; return st * 1024 + (ob ^ (((ob >> 9) & 1) << 5)); }
__host__ __device__ __forceinline__ void stage_rc(int b, int& R, int& C) { const int st = b / 1024, sb = b % 1024, swz = sb ^ (((sb >> 9) & 1) << 5); R = (st >> 1) * 16 + swz / 64; C = (st & 1) * 32 + (swz % 64) / 2; }
__host__ __device__ __forceinline__ int perm32(int rho) { const int n = rho >> 4, i = rho & 15; return 8 * (i >> 2) + 4 * n + (i & 3); }

struct Unit { int pm, pn; };
struct Gemm { const bf16_t* A; const bf16_t* Bt; int M, N, K; };

struct StaticOrder {
    int nM, nN, nwg, G, c;
    __host__ __device__ void init(int M, int N, int G_, int c_) { nM = M / BM; nN = N / BM; nwg = nM * nN; G = G_; c = c_; }
    __host__ __device__ bool next(int i, Unit& u) const {
        const long L = (long)i * G + c; if (L >= nwg) return false;
        int wgid = (int)L; { const int q = nwg / NXCD, r = nwg % NXCD, xcd = wgid % NXCD, off = wgid / NXCD; wgid = (xcd < r ? xcd * (q + 1) : r * (q + 1) + (xcd - r) * q) + off; }
        const int nig = WGM * nN, gid = wgid / nig, fm = gid * WGM, gsz = (nM - fm) < WGM ? (nM - fm) : WGM;
        u.pm = fm + ((wgid % nig) % gsz); u.pn = (wgid % nig) / gsz; return true;
    }
    __device__ __forceinline__ void a_ready(const Unit&) const {}
    __device__ __forceinline__ void done(const Unit&) const {}
};

template <class Epi, class Sched, bool ALIGN_EPI = false, bool SP2 = false>
__device__ __forceinline__ void gemm_phase(PG8_LAS unsigned char* lds, const Gemm g, const Sched& S, const Epi& E) {
    int tid_l = threadIdx.x; asm volatile("" : "+v"(tid_l)); const int tid = tid_l, wid = __builtin_amdgcn_readfirstlane(tid >> 6), lane = tid & 63, wr = wid >> 2, wc = wid & 3, fr = lane & 15, fq = lane >> 4;
    const int K = g.K, nt = K / BK;
    unsigned voffA[2], voffB[2];
#pragma unroll
    for (int i = 0; i < 2; ++i) { int R, C; stage_rc(tid * 16 + i * 8192, R, C); const int Rb = Epi::PERM ? ((R & ~31) + perm32(R & 31)) : R;
        voffA[i] = (unsigned)(R * K + C) * 2u; voffB[i] = (unsigned)(Rb * K + C) * 2u; }
    const size_t kstep = (size_t)(BK * 2);
    const size_t hstep = (size_t)HALF * K * 2;
    const size_t tstep = 2 * hstep;
    const unsigned ldsw = (unsigned)wid * 1024u;
    const int aoff = lds_byte(wr * 64 + fr, fq * 8), boff = lds_byte(wc * 32 + fr, fq * 8);
#define PG8_SA(b, h) (((b) * 2 + (h)) * HTB)
#define PG8_SB(b, h) ((4 + (b) * 2 + (h)) * HTB)
#define PG8_STAGE(bufoff, gbase, voff) do { _Pragma("unroll") for (int _i = 0; _i < 2; ++_i) \
        __builtin_amdgcn_global_load_lds((const unsigned*)((const char*)(gbase) + (voff)[_i]), (PG8_LAS unsigned*)(lds + (bufoff) + ldsw + _i * 8192), 16, 0, 0); } while (0)
#define PG8_LDA(dst, b, h) do { _Pragma("unroll") for (int m = 0; m < 4; ++m) _Pragma("unroll") for (int k = 0; k < 2; ++k) dst[m][k] = *(const PG8_LAS bf16x8*)(lds + PG8_SA(b, h) + aoff + m * 2048 + k * 1024); } while (0)
#define PG8_LDB(dst, b, h) do { _Pragma("unroll") for (int n = 0; n < 2; ++n) _Pragma("unroll") for (int k = 0; k < 2; ++k) dst[n][k] = *(const PG8_LAS bf16x8*)(lds + PG8_SB(b, h) + boff + n * 2048 + k * 1024); } while (0)
#define PG8_MMA(ai, bj, At, Bt) do { __builtin_amdgcn_s_setprio(1); _Pragma("unroll") for (int m = 0; m < 4; ++m) _Pragma("unroll") for (int n = 0; n < 2; ++n) _Pragma("unroll") for (int k = 0; k < 2; ++k) \
        acc[ai][bj][m][n] = __builtin_amdgcn_mfma_f32_16x16x32_bf16(Bt[n][k], At[m][k], acc[ai][bj][m][n], 0, 0, 0); __builtin_amdgcn_s_setprio(0); } while (0)
#define PG8_WAIT_V(n) asm volatile("s_waitcnt vmcnt(" #n ")" ::: "memory")
#define PG8_WAIT_L(n) asm volatile("s_waitcnt lgkmcnt(" #n ")" ::: "memory")
#define PG8_BAR __builtin_amdgcn_s_barrier()
#define PG8_SCHED __builtin_amdgcn_sched_barrier(0)
    Unit cur, nxt; int ui = 0;
    if (!S.next(0, cur)) return;
    f32x4 acc[2][2][4][2];
#pragma unroll
    for (int a = 0; a < 2; ++a)
#pragma unroll
        for (int b = 0; b < 2; ++b)
#pragma unroll
            for (int m = 0; m < 4; ++m)
#pragma unroll
                for (int n = 0; n < 2; ++n) acc[a][b][m][n] = (f32x4){0.f, 0.f, 0.f, 0.f};
    bf16x8 At[4][2], B0[2][2], B1[2][2];
    const char* cA = (const char*)g.A + (size_t)cur.pm * tstep; const char* cB = (const char*)g.Bt + (size_t)cur.pn * tstep;
    S.a_ready(cur);
    if constexpr (SP2) {
        PG8_STAGE(PG8_SB(0, 0), cB, voffB); PG8_STAGE(PG8_SB(0, 1), cB + hstep, voffB); PG8_STAGE(PG8_SA(0, 0), cA, voffA); PG8_STAGE(PG8_SA(0, 1), cA + hstep, voffA);
        if (wr == 1) PG8_BAR;
        PG8_WAIT_V(2); PG8_BAR;
        PG8_STAGE(PG8_SB(1, 0), cB + kstep, voffB); PG8_STAGE(PG8_SA(1, 0), cA + kstep, voffA); PG8_STAGE(PG8_SB(1, 1), cB + hstep + kstep, voffB);
        PG8_WAIT_V(6); PG8_BAR;
    } else {
        PG8_STAGE(PG8_SB(0, 0), cB, voffB); PG8_STAGE(PG8_SA(0, 0), cA, voffA); PG8_STAGE(PG8_SB(0, 1), cB + hstep, voffB); PG8_STAGE(PG8_SA(0, 1), cA + hstep, voffA);
        if (wr == 1) PG8_BAR;
        PG8_WAIT_V(4); PG8_BAR;
        PG8_STAGE(PG8_SB(1, 0), cB + kstep, voffB); PG8_STAGE(PG8_SA(1, 0), cA + kstep, voffA); PG8_STAGE(PG8_SB(1, 1), cB + hstep + kstep, voffB);
        PG8_WAIT_V(6); PG8_BAR;
    }
    for (;;) {
        const bool has_next = S.next(ui + 1, nxt);
        const char* nA = has_next ? (const char*)g.A + (size_t)nxt.pm * tstep : cA; const char* nB = has_next ? (const char*)g.Bt + (size_t)nxt.pn * tstep : cB;
        for (int t = 0; t < nt; t += 2) {
            const bool last = (t == nt - 2);
            const char* a1 = cA + (size_t)(t + 1) * kstep;
            const char* a2 = last ? nA : cA + (size_t)(t + 2) * kstep; const char* b2 = last ? nB : cB + (size_t)(t + 2) * kstep;
            const char* a3 = a2 + kstep; const char* b3 = b2 + kstep;
            if (last && has_next) S.a_ready(nxt);
            if constexpr (SP2) {
            PG8_LDB(B0, 0, 0); PG8_LDB(B1, 0, 1); PG8_SCHED; PG8_LDA(At, 0, 0); PG8_STAGE(PG8_SA(1, 1), a1 + hstep, voffA);
            PG8_WAIT_V(8); PG8_WAIT_L(0); PG8_BAR; PG8_MMA(0, 0, At, B0); PG8_MMA(0, 1, At, B1); PG8_BAR; PG8_SCHED;
            PG8_LDA(At, 0, 1); PG8_STAGE(PG8_SB(0, 0), b2, voffB); PG8_STAGE(PG8_SB(0, 1), b2 + hstep, voffB); PG8_STAGE(PG8_SA(0, 0), a2, voffA);
            PG8_WAIT_V(8); PG8_WAIT_L(0); PG8_BAR; PG8_MMA(1, 0, At, B0); PG8_MMA(1, 1, At, B1); PG8_BAR; PG8_SCHED;
            PG8_LDB(B0, 1, 0); PG8_LDB(B1, 1, 1); PG8_SCHED; PG8_LDA(At, 1, 0); PG8_STAGE(PG8_SA(0, 1), a2 + hstep, voffA);
            PG8_WAIT_V(8); PG8_WAIT_L(0); PG8_BAR; PG8_MMA(0, 0, At, B0); PG8_MMA(0, 1, At, B1); PG8_BAR; PG8_SCHED;
            PG8_LDA(At, 1, 1); PG8_STAGE(PG8_SB(1, 0), b3, voffB); PG8_STAGE(PG8_SB(1, 1), b3 + hstep, voffB); PG8_STAGE(PG8_SA(1, 0), a3, voffA);
            PG8_WAIT_V(8); PG8_WAIT_L(0); PG8_BAR; PG8_MMA(1, 0, At, B0); PG8_MMA(1, 1, At, B1); PG8_BAR; PG8_SCHED;
            } else {
            PG8_LDB(B0, 0, 0); PG8_SCHED; PG8_LDA(At, 0, 0); PG8_STAGE(PG8_SA(1, 1), a1 + hstep, voffA);
            PG8_WAIT_L(8); PG8_BAR; PG8_WAIT_L(0); PG8_MMA(0, 0, At, B0); PG8_BAR; PG8_SCHED;
            PG8_LDB(B1, 0, 1); PG8_STAGE(PG8_SB(0, 0), b2, voffB);
            PG8_BAR; PG8_WAIT_L(0); PG8_MMA(0, 1, At, B1); PG8_BAR;
            PG8_LDA(At, 0, 1); PG8_STAGE(PG8_SA(0, 0), a2, voffA);
            PG8_BAR; PG8_WAIT_L(0); PG8_MMA(1, 0, At, B0); PG8_BAR; PG8_SCHED;
            PG8_STAGE(PG8_SB(0, 1), b2 + hstep, voffB);
            PG8_WAIT_V(6); PG8_BAR; PG8_MMA(1, 1, At, B1); PG8_BAR;
            PG8_LDB(B0, 1, 0); PG8_SCHED; PG8_LDA(At, 1, 0); PG8_STAGE(PG8_SA(0, 1), a2 + hstep, voffA);
            PG8_WAIT_L(8); PG8_BAR; PG8_WAIT_L(0); PG8_MMA(0, 0, At, B0); PG8_BAR; PG8_SCHED;
            PG8_LDB(B1, 1, 1); PG8_STAGE(PG8_SB(1, 0), b3, voffB);
            PG8_BAR; PG8_WAIT_L(0); PG8_MMA(0, 1, At, B1); PG8_BAR;
            PG8_LDA(At, 1, 1); PG8_STAGE(PG8_SA(1, 0), a3, voffA);
            PG8_BAR; PG8_WAIT_L(0); PG8_MMA(1, 0, At, B0); PG8_BAR; PG8_SCHED;
            PG8_STAGE(PG8_SB(1, 1), b3 + hstep, voffB);
            PG8_WAIT_V(6); PG8_BAR; PG8_MMA(1, 1, At, B1); PG8_BAR;
            }
        }
        if constexpr (ALIGN_EPI) { if (wr == 0) PG8_BAR; }
        if constexpr (!Epi::AFTER_DRAIN) { E(acc, cur, wr, wc, fr, fq); S.done(cur); }
        if (!has_next) break;
#pragma unroll
        for (int a = 0; a < 2; ++a)
#pragma unroll
            for (int b = 0; b < 2; ++b)
#pragma unroll
                for (int m = 0; m < 4; ++m)
#pragma unroll
                    for (int n = 0; n < 2; ++n) acc[a][b][m][n] = (f32x4){0.f, 0.f, 0.f, 0.f};
        cur = nxt; cA = nA; cB = nB; ++ui;
        if constexpr (ALIGN_EPI) { if (wr == 1) PG8_BAR; }
    }
    PG8_WAIT_V(0);
    if constexpr (!ALIGN_EPI) { if (wr == 0) PG8_BAR; }
    PG8_BAR;
    if constexpr (Epi::AFTER_DRAIN) { E.fused(acc, cur, wr, wc, fr, fq, lds, wid, lane); S.done(cur); }
#undef PG8_SA
#undef PG8_SB
#undef PG8_STAGE
#undef PG8_LDA
#undef PG8_LDB
#undef PG8_MMA
#undef PG8_WAIT_V
#undef PG8_WAIT_L
#undef PG8_BAR
#undef PG8_SCHED
}
}
#ifndef REP_FOX
#define REP_FOX 1
#endif
#ifndef REP_PRO
#define REP_PRO 1
#endif
#ifndef REP_RET
#define REP_RET 1
#endif
#ifndef REP_XA
#define REP_XA 1
#endif
#ifndef REP_S5
#define REP_S5 1
#endif

#define LAS __attribute__((address_space(3)))
typedef unsigned short bf16_t;
typedef short bf16x8 __attribute__((ext_vector_type(8)));
typedef short s16x4 __attribute__((ext_vector_type(4)));
typedef float f32x4 __attribute__((ext_vector_type(4)));
typedef float f32x2 __attribute__((ext_vector_type(2)));
typedef float f32x16 __attribute__((ext_vector_type(16)));
typedef unsigned u32x4 __attribute__((ext_vector_type(4)));
typedef unsigned u32x2 __attribute__((ext_vector_type(2)));
typedef __bf16 bf16x2_t __attribute__((ext_vector_type(2)));
using pg8::Unit;

__device__ __forceinline__ unsigned pk2(float lo, float hi) { f32x2 v = {lo, hi}; bf16x2_t b = __builtin_convertvector(v, bf16x2_t); return __builtin_bit_cast(unsigned, b); }
__device__ __forceinline__ float bflo(unsigned w) { return __uint_as_float(w << 16); }
__device__ __forceinline__ float bfhi(unsigned w) { return __uint_as_float(w & 0xffff0000u); }
__device__ __forceinline__ bf16_t f2bf(float f) { return (bf16_t)(pk2(f, 0.f) & 0xffffu); }
__device__ __forceinline__ float ex2(float x) { return __builtin_amdgcn_exp2f(x); }
__device__ __forceinline__ float wave_sum(float v) {
#pragma unroll
    for (int o = 1; o < 64; o <<= 1) v += __shfl_xor(v, o);
    return v;
}
#define LDSBAR() asm volatile("s_waitcnt lgkmcnt(0)" ::: "memory")
#define MFMA32(a, b, c) __builtin_amdgcn_mfma_f32_32x32x16_bf16((a), (b), (c), 0, 0, 0)
#define MFMA16(a, b, c) __builtin_amdgcn_mfma_f32_16x16x32_bf16((a), (b), (c), 0, 0, 0)

constexpr int DM = 1024, RP = 65536, RS = 256, R = RP + RS, T = 8192, TS = 32, PAST = 4096, TKS = PAST + TS;
constexpr float LOG2E = 1.4426950408889634f;
constexpr float EPS = 1e-6f;
constexpr size_t O_Y = 0, O_RSP = (size_t)R * 1024, O_RSS = O_RSP + 524288, O_FKP = O_RSS + 524288, O_FVP = O_FKP + (size_t)RP * 512,
                 O_LFP = O_FVP + (size_t)RP * 512, O_FKS = O_LFP + (size_t)RP * 8, O_FVS = O_FKS + 131072, O_LFS = O_FVS + 131072,
                 O_S5RP = O_LFS + 2048, O_S5IP = O_S5RP + 32768, O_S5RS = O_S5IP + 32768, O_S5IS = O_S5RS + 32768, O_MK = O_S5IS + 32768,
                 O_MV = O_MK + 4194304, O_END = O_MV + 4194304;
constexpr size_t MiB = 1u << 20;
constexpr size_t WS_W = 1 * MiB, WS_ROPE = 65 * MiB, WS_C2P = 69 * MiB, WS_C2S = 71 * MiB, WS_MEMN = 73 * MiB, WS_MEMK = 81 * MiB, WS_MEMVT = 97 * MiB,
                 WS_S5T = 113 * MiB, WS_LE = 114 * MiB, WS_KVS = 118 * MiB, WS_A = 120 * MiB, WS_B = 249 * MiB, WS_C = 763 * MiB, WS_FKS = 892 * MiB,
                 WS_FVTS = 925 * MiB, WS_END = 960 * MiB;
constexpr size_t W_AB = 0, W_OUT = W_AB + 3840 * 1024, W_INC = W_OUT + 1048576, W_GLU = W_INC + 1048576, W_XQ = W_GLU + 2097152, W_XKV = W_XQ + 2097152,
                 W_XO = W_XKV + 4194304, W_UP = W_XO + 2097152, W_DN = W_UP + 8388608, W_ENDE = W_DN + 8388608;
static_assert(W_ENDE * 2 <= 64 * MiB, "weights region");
constexpr size_t B_RQ = 0, B_RK = (size_t)R * 512, B_RG = 2 * (size_t)R * 512, B_FQ = 3 * (size_t)R * 512, B_FK = 4 * (size_t)R * 512, B_KT = 5 * (size_t)R * 512,
                 B_VT = B_KT + (size_t)RP * 512, B_FVT = B_VT + (size_t)RP * 512, B_KTS = B_FVT + (size_t)RP * 512, B_VTS = B_KTS + 131072, B_ENDE = B_VTS + 131072;
static_assert(B_ENDE * 2 <= 514 * MiB, "region B");
constexpr size_t B_X2 = 129 * MiB / 2;
constexpr size_t WS_RS = 119 * MiB;
#define RSV ((float*)(P.ws + WS_RS))
#define MIXED ((bf16_t*)P.out)
constexpr int LDS_BYTES = 139264;

struct Params {
    const float* in[33];
    float* out;
    unsigned char* ws;
};

template <int ACT  > struct EpiPlain {
    static constexpr bool PERM = true, AFTER_DRAIN = false;
    bf16_t* O; int ldc; float scale; const float* rs;
    __device__ __forceinline__ void operator()(const f32x4 (&acc)[2][2][4][2], const Unit& u, int wr, int wc, int fr, int fq) const {
        asm volatile("" : "+v"(fr), "+v"(fq));
        bf16_t* base = O + (size_t)(u.pm * 256 + wr * 64 + fr) * ldc + u.pn * 256 + wc * 32 + fq * 8;
#pragma unroll
        for (int ai = 0; ai < 2; ++ai)
#pragma unroll
            for (int m = 0; m < 4; ++m) {
                bf16_t* rp = base + (size_t)(ai * 128 + m * 16) * ldc;
                const float rsc = rs ? rs[u.pm * 256 + wr * 64 + fr + ai * 128 + m * 16] * scale : scale;
#pragma unroll
                for (int bj = 0; bj < 2; ++bj) {
                    f32x4 v0 = acc[ai][bj][m][0] * rsc, v1 = acc[ai][bj][m][1] * rsc;
                    if (ACT == 1) { v0.x = fmaxf(v0.x, 0.f); v0.y = fmaxf(v0.y, 0.f); v0.z = fmaxf(v0.z, 0.f); v0.w = fmaxf(v0.w, 0.f); v0 = v0 * v0;
                                    v1.x = fmaxf(v1.x, 0.f); v1.y = fmaxf(v1.y, 0.f); v1.z = fmaxf(v1.z, 0.f); v1.w = fmaxf(v1.w, 0.f); v1 = v1 * v1; }
                    u32x4 w; w.x = pk2(v0.x, v0.y); w.y = pk2(v0.z, v0.w); w.z = pk2(v1.x, v1.y); w.w = pk2(v1.z, v1.w);
                    *(u32x4*)(rp + bj * 128) = w;
                }
            }
    }
};
struct EpiGlu {
    static constexpr bool PERM = false, AFTER_DRAIN = false;
    bf16_t* O;
    __device__ __forceinline__ void operator()(const f32x4 (&acc)[2][2][4][2], const Unit& u, int wr, int wc, int fr, int fq) const {
        asm volatile("" : "+v"(fr), "+v"(fq));
#pragma unroll
        for (int ai = 0; ai < 2; ++ai)
#pragma unroll
            for (int m = 0; m < 4; ++m) {
                const int row = u.pm * 256 + ai * 128 + wr * 64 + m * 16 + fr;
                bf16_t* rp = O + (size_t)row * 1024 + u.pn * 128 + wc * 32 + fq * 4;
#pragma unroll
                for (int n = 0; n < 2; ++n) {
                    const f32x4 a = acc[ai][0][m][n], g = acc[ai][1][m][n];
                    f32x4 v;
                    v.x = a.x / (1.f + __expf(-g.x)); v.y = a.y / (1.f + __expf(-g.y)); v.z = a.z / (1.f + __expf(-g.z)); v.w = a.w / (1.f + __expf(-g.w));
                    u32x2 w; w.x = pk2(v.x, v.y); w.y = pk2(v.z, v.w);
                    *(u32x2*)(rp + n * 16) = w;
                }
            }
    }
};
struct EpiMemKV {
    static constexpr bool PERM = false, AFTER_DRAIN = false;
    float* oK; float* oV; bf16_t* mk; bf16_t* mvt; int layer;
    __device__ __forceinline__ void operator()(const f32x4 (&acc)[2][2][4][2], const Unit& u, int wr, int wc, int fr, int fq) const {
        asm volatile("" : "+v"(fr), "+v"(fq));
        const bool isv = u.pn >= 4;
#pragma unroll
        for (int ai = 0; ai < 2; ++ai)
#pragma unroll
            for (int m = 0; m < 4; ++m) {
                const int row = u.pm * 256 + ai * 128 + wr * 64 + m * 16 + fr;
                const int b = row >> 8, mm = row & 255;
#pragma unroll
                for (int bj = 0; bj < 2; ++bj)
#pragma unroll
                    for (int n = 0; n < 2; ++n) {
                        const int col = (u.pn & 3) * 256 + bj * 128 + wc * 32 + n * 16 + fq * 4;
                        const f32x4 v = acc[ai][bj][m][n];
                        if (!isv) {
                            *(f32x4*)(oK + ((size_t)layer * 2048 + row) * 1024 + col) = v;
                            u32x2 w; w.x = pk2(v.x, v.y); w.y = pk2(v.z, v.w);
                            *(u32x2*)(mk + ((size_t)(layer * 16 + b) * 256 + mm) * 1024 + col) = w;
                        } else {
                            *(f32x4*)(oV + ((size_t)layer * 2048 + row) * 1024 + col) = v;
                            bf16_t* p = mvt + ((size_t)(layer * 16 + b) * 1024 + col) * 256 + mm;
                            p[0] = f2bf(v.x); p[256] = f2bf(v.y); p[512] = f2bf(v.z); p[768] = f2bf(v.w);
                        }
                    }
            }
    }
};
__device__ __forceinline__ float logsig(float x) { return x >= 0.f ? -log1pf(__expf(-x)) : x - log1pf(__expf(x)); }
struct EpiAB {
    static constexpr bool PERM = false, AFTER_DRAIN = false;
    bf16_t* B;
    bf16_t* fks; bf16_t* fvts;
    float* out; const float* rope; const float* bfox; const float* rs;
    __device__ __forceinline__ void operator()(const f32x4 (&acc)[2][2][4][2], const Unit& u, int wr, int wc, int fr, int fq) const {
        asm volatile("" : "+v"(fr), "+v"(fq));
        switch (u.pn >> 1) {
            case 0: body<0>(acc, u, wr, wc, fr, fq); break; case 1: body<1>(acc, u, wr, wc, fr, fq); break; case 2: body<2>(acc, u, wr, wc, fr, fq); break;
            case 3: body<3>(acc, u, wr, wc, fr, fq); break; case 4: body<4>(acc, u, wr, wc, fr, fq); break; case 5: body<5>(acc, u, wr, wc, fr, fq); break;
            case 6: body<6>(acc, u, wr, wc, fr, fq); break; default: body<7>(acc, u, wr, wc, fr, fq); break;
        }
    }
    template <int sect> __device__ __forceinline__ void body(const f32x4 (&acc)[2][2][4][2], const Unit& u, int wr, int wc, int fr, int fq) const {
        rowgrp<sect, 0, 0>(acc, u, wr, wc, fr, fq); rowgrp<sect, 0, 1>(acc, u, wr, wc, fr, fq); rowgrp<sect, 0, 2>(acc, u, wr, wc, fr, fq); rowgrp<sect, 0, 3>(acc, u, wr, wc, fr, fq);
        rowgrp<sect, 1, 0>(acc, u, wr, wc, fr, fq); rowgrp<sect, 1, 1>(acc, u, wr, wc, fr, fq); rowgrp<sect, 1, 2>(acc, u, wr, wc, fr, fq); rowgrp<sect, 1, 3>(acc, u, wr, wc, fr, fq);
    }
    template <int sect, int ai, int m> __device__ __forceinline__ void rowgrp(const f32x4 (&acc)[2][2][4][2], const Unit& u, int wr, int wc, int fr, int fq) const {
        const int pn = u.pn;
            {
                const int row = u.pm * 256 + ai * 128 + wr * 64 + m * 16 + fr;
                const bool samp = row >= RP;
                const int rr = row - RP;
                const int b = samp ? (rr >> 5) : (row >> 13);
                const int t = samp ? (rr & 31) : (row & 8191);
                const int pos = samp ? PAST + t : t;
                const float rsc = rs[row];
#pragma unroll
                for (int bj = 0; bj < 2; ++bj)
#pragma unroll
                    for (int n = 0; n < 2; ++n) {
                        const int sec = (pn & 1) * 256 + bj * 128 + wc * 32 + n * 16 + fq * 4;
                        f32x4 v = acc[ai][bj][m][n] * rsc;
                        if constexpr (sect <= 1) {
                            const int hd = sec >> 7, w = sec & 127, i0 = w >> 1;
                            const f32x4 cs = *(const f32x4*)(rope + ((size_t)pos * 64 + i0) * 2);
                            f32x4 o;
                            o.x = v.x * cs.x - v.y * cs.y; o.y = v.y * cs.x + v.x * cs.y;
                            o.z = v.z * cs.z - v.w * cs.w; o.w = v.w * cs.z + v.z * cs.w;
                            if constexpr (sect == 0) {
                                u32x2 wv; wv.x = pk2(o.x, o.y); wv.y = pk2(o.z, o.w);
                                *(u32x2*)(B + B_RQ + (size_t)row * 512 + sec) = wv;
                            } else {
                                o = o * 0.08838834764831845f;
                                u32x2 wv; wv.x = pk2(o.x, o.y); wv.y = pk2(o.z, o.w);
                                *(u32x2*)(B + B_RK + (size_t)row * 512 + sec) = wv;
                                const float lg2 = __log2f(1.f - ex2((float)(-5 - hd)));
                                if (!samp) {
                                    const int j = t & 63; const float wk = ex2(lg2 * (float)(63 - j));
                                    bf16_t* p = B + B_KT + ((size_t)((b * 4 + hd) * 128 + (t >> 6)) * 128 + w) * 64 + j;
                                    p[0] = f2bf(o.x * wk); p[64] = f2bf(o.y * wk); p[128] = f2bf(o.z * wk); p[192] = f2bf(o.w * wk);
                                } else {
                                    const float wk = ex2(lg2 * (float)(31 - t));
                                    bf16_t* p = B + B_KTS + ((size_t)(b * 4 + hd) * 128 + w) * 32 + t;
                                    p[0] = f2bf(o.x * wk); p[32] = f2bf(o.y * wk); p[64] = f2bf(o.z * wk); p[96] = f2bf(o.w * wk);
                                }
                            }
                        } else if constexpr (sect == 2) {
                            const int hd = sec >> 7, w = sec & 127;
                            if (!samp) {
                                bf16_t* p = B + B_VT + ((size_t)((b * 4 + hd) * 128 + (t >> 6)) * 128 + w) * 64 + (t & 63);
                                p[0] = f2bf(v.x); p[64] = f2bf(v.y); p[128] = f2bf(v.z); p[192] = f2bf(v.w);
                            } else {
                                bf16_t* p = B + B_VTS + ((size_t)(b * 4 + hd) * 128 + w) * 32 + t;
                                p[0] = f2bf(v.x); p[32] = f2bf(v.y); p[64] = f2bf(v.z); p[96] = f2bf(v.w);
                            }
                        } else if constexpr (sect == 3) {
                            f32x4 o; o.x = v.x / (1.f + __expf(-v.x)); o.y = v.y / (1.f + __expf(-v.y)); o.z = v.z / (1.f + __expf(-v.z)); o.w = v.w / (1.f + __expf(-v.w));
                            u32x2 wv; wv.x = pk2(o.x, o.y); wv.y = pk2(o.z, o.w);
                            *(u32x2*)(B + B_RG + (size_t)row * 512 + sec) = wv;
                        } else if constexpr (sect == 4) {
                            const f32x4 o = v * (0.125f * LOG2E);
                            u32x2 wv; wv.x = pk2(o.x, o.y); wv.y = pk2(o.z, o.w);
                            *(u32x2*)(B + B_FQ + (size_t)row * 512 + sec) = wv;
                        } else if constexpr (sect == 5) {
                            u32x2 wv; wv.x = pk2(v.x, v.y); wv.y = pk2(v.z, v.w);
                            if (!samp) { *(f32x4*)(out + O_FKP + (size_t)row * 512 + sec) = v; *(u32x2*)(B + B_FK + (size_t)row * 512 + sec) = wv; }
                            else { *(f32x4*)(out + O_FKS + (size_t)rr * 512 + sec) = v; *(u32x2*)(fks + ((size_t)b * TKS + PAST + t) * 512 + sec) = wv; }
                        } else if constexpr (sect == 6) {
                            if (!samp) {
                                *(f32x4*)(out + O_FVP + (size_t)row * 512 + sec) = v;
                                bf16_t* p = B + B_FVT + ((size_t)b * 512 + sec) * T + t;
                                p[0] = f2bf(v.x); p[T] = f2bf(v.y); p[2 * T] = f2bf(v.z); p[3 * T] = f2bf(v.w);
                            } else {
                                *(f32x4*)(out + O_FVS + (size_t)rr * 512 + sec) = v;
                                bf16_t* p = fvts + ((size_t)b * 512 + sec) * TKS + PAST + t;
                                p[0] = f2bf(v.x); p[TKS] = f2bf(v.y); p[2 * TKS] = f2bf(v.z); p[3 * TKS] = f2bf(v.w);
                            }
                        } else {
                            if (sec < 8) {
                                const f32x4 bb = *(const f32x4*)(bfox + sec);
                                f32x4 o; o.x = logsig(v.x + bb.x); o.y = logsig(v.y + bb.y); o.z = logsig(v.z + bb.z); o.w = logsig(v.w + bb.w);
                                if (!samp) *(f32x4*)(out + O_LFP + (size_t)row * 8 + sec) = o;
                                else *(f32x4*)(out + O_LFS + (size_t)rr * 8 + sec) = o;
                            }
                        }
                    }
                asm volatile("" ::: "memory");
            }
    }
};

__device__ __forceinline__ void wtrans(const float* __restrict__ src, int K, int Ns, bf16_t* dst, int Nd, int mode, int gtid, int gsz, const float* gk = nullptr) {
    const int items = Nd * (K >> 3);
    for (int it = gtid; it < items; it += gsz) {
        const int n = it % Nd, k0 = (it / Nd) << 3;
        int col = n; bool z = false;
        if (mode == 1) { if (n < 1024) { const int w = n & 127; col = (n & ~127) + (w >> 1) + 64 * (w & 1); } else if (n >= 3592) z = true; }
        else if (mode == 2) { col = ((n >> 7) & 1) * 1024 + (n >> 8) * 128 + (n & 127); }
        const float* s = src + (size_t)k0 * Ns + (z ? 0 : col);
        float v0 = s[0], v1 = s[(size_t)Ns], v2 = s[2 * (size_t)Ns], v3 = s[3 * (size_t)Ns], v4 = s[4 * (size_t)Ns], v5 = s[5 * (size_t)Ns], v6 = s[6 * (size_t)Ns], v7 = s[7 * (size_t)Ns];
        if (gk) { const f32x4 ga_ = *(const f32x4*)(gk + k0), gb_ = *(const f32x4*)(gk + k0 + 4); v0 *= ga_.x; v1 *= ga_.y; v2 *= ga_.z; v3 *= ga_.w; v4 *= gb_.x; v5 *= gb_.y; v6 *= gb_.z; v7 *= gb_.w; }
        u32x4 o; o.x = pk2(v0, v1); o.y = pk2(v2, v3); o.z = pk2(v4, v5); o.w = pk2(v6, v7);
        if (z) o = (u32x4){0u, 0u, 0u, 0u};
        *(u32x4*)(dst + (size_t)n * K + k0) = o;
    }
}
__device__ __forceinline__ void ttrans(const float* __restrict__ src, int rows, int C, bf16_t* dst, size_t dpitch, int gtid, int gsz) {
    const int items = C * (rows >> 3);
    for (int it = gtid; it < items; it += gsz) {
        const int c = it % C, r0 = (it / C) << 3;
        const float* s = src + (size_t)r0 * C + c;
        float v0 = s[0], v1 = s[(size_t)C], v2 = s[2 * (size_t)C], v3 = s[3 * (size_t)C], v4 = s[4 * (size_t)C], v5 = s[5 * (size_t)C], v6 = s[6 * (size_t)C], v7 = s[7 * (size_t)C];
        u32x4 o; o.x = pk2(v0, v1); o.y = pk2(v2, v3); o.z = pk2(v4, v5); o.w = pk2(v6, v7);
        *(u32x4*)(dst + (size_t)c * dpitch + r0) = o;
    }
}
__device__ __forceinline__ void cvt8(const float* __restrict__ s, bf16_t* d) {
    const f32x4 a = *(const f32x4*)s, b = *(const f32x4*)(s + 4);
    u32x4 o; o.x = pk2(a.x, a.y); o.y = pk2(a.z, a.w); o.z = pk2(b.x, b.y); o.w = pk2(b.z, b.w);
    *(u32x4*)d = o;
}
__device__ __forceinline__ void norm_row(const float* xr, const float* g, bf16_t* orow, int lane) {
    f32x4 v[4]; float s = 0.f;
#pragma unroll
    for (int j = 0; j < 4; ++j) { v[j] = ((const f32x4*)xr)[lane + 64 * j]; s += (v[j].x * v[j].x + v[j].y * v[j].y) + (v[j].z * v[j].z + v[j].w * v[j].w); }
    const float rstd = rsqrtf(wave_sum(s) * (1.f / 1024.f) + EPS);
#pragma unroll
    for (int j = 0; j < 4; ++j) { const f32x4 gg = ((const f32x4*)g)[lane + 64 * j]; const f32x4 o = v[j] * rstd * gg; u32x2 w; w.x = pk2(o.x, o.y); w.y = pk2(o.z, o.w); ((u32x2*)orow)[lane + 64 * j] = w; }
}
__device__ __forceinline__ void cvt_row(const float* xr, bf16_t* orow, float* rs, int lane) {
    f32x4 v[4]; float s = 0.f;
#pragma unroll
    for (int j = 0; j < 4; ++j) { v[j] = ((const f32x4*)xr)[lane + 64 * j]; s += (v[j].x * v[j].x + v[j].y * v[j].y) + (v[j].z * v[j].z + v[j].w * v[j].w); }
    const float rstd = rsqrtf(wave_sum(s) * (1.f / 1024.f) + EPS);
#pragma unroll
    for (int j = 0; j < 4; ++j) { u32x2 w; w.x = pk2(v[j].x, v[j].y); w.y = pk2(v[j].z, v[j].w); ((u32x2*)orow)[lane + 64 * j] = w; }
    if (lane == 0) *rs = rstd;
}
struct RnRow { f32x4 x[4]; u32x2 m[4]; };
template <int IN> __device__ __forceinline__ void rn_load(RnRow& r, const bf16_t* mix, const float* xp, const float* xs, const bf16_t* xb, int row, int lane) {
#pragma unroll
    for (int j = 0; j < 4; ++j) {
        if (IN == 0) { const float* xr = row < RP ? xp + (size_t)row * 1024 : xs + (size_t)(row - RP) * 1024; r.x[j] = __builtin_nontemporal_load((const f32x4*)xr + lane + 64 * j); }
        else { const u32x2 w = *((const u32x2*)(xb + (size_t)row * 1024) + lane + 64 * j); r.x[j] = (f32x4){bflo(w.x), bfhi(w.x), bflo(w.y), bfhi(w.y)}; }
        r.m[j] = __builtin_nontemporal_load((const u32x2*)(mix + (size_t)row * 1024) + lane + 64 * j);
    }
}
template <int OUT> __device__ __forceinline__ void rn_proc(const RnRow& r, const float* ga, bf16_t* xb, float* rs, float* yout, int row, int lane) {
    f32x4 xv[4], mv[4]; float s = 0.f;
#pragma unroll
    for (int j = 0; j < 4; ++j) {
        const u32x2 w = r.m[j];
        mv[j] = (f32x4){bflo(w.x), bfhi(w.x), bflo(w.y), bfhi(w.y)};
        s += (mv[j].x * mv[j].x + mv[j].y * mv[j].y) + (mv[j].z * mv[j].z + mv[j].w * mv[j].w);
    }
    const float rm = rsqrtf(wave_sum(s) * (1.f / 1024.f) + EPS);
    float s2 = 0.f;
#pragma unroll
    for (int j = 0; j < 4; ++j) {
        const f32x4 gg = ((const f32x4*)ga)[lane + 64 * j];
        xv[j] = r.x[j] + mv[j] * rm * gg;
        if (OUT == 1) ((f32x4*)(yout + (size_t)row * 1024))[lane + 64 * j] = xv[j];
        else { u32x2 w; w.x = pk2(xv[j].x, xv[j].y); w.y = pk2(xv[j].z, xv[j].w); ((u32x2*)(xb + (size_t)row * 1024))[lane + 64 * j] = w; }
        s2 += (xv[j].x * xv[j].x + xv[j].y * xv[j].y) + (xv[j].z * xv[j].z + xv[j].w * xv[j].w);
    }
    if (OUT == 0) { const float rx = rsqrtf(wave_sum(s2) * (1.f / 1024.f) + EPS); if (lane == 0) rs[row] = rx; }
}
template <int IN, int OUT> __device__ __forceinline__ void resnorm_phase(const bf16_t* mix, const float* xp, const float* xs, bf16_t* xb, const float* ga, float* rs, float* yout, int gw, int ngw, int lane) {
    int row = gw * 2;
    if (row >= R) return;
    RnRow a0, a1, b0, b1;
    rn_load<IN>(a0, mix, xp, xs, xb, row, lane); rn_load<IN>(a1, mix, xp, xs, xb, row + 1, lane);
    for (;;) {
        const int nrow = row + ngw * 2;
        const bool more = nrow < R;
        if (more) { rn_load<IN>(b0, mix, xp, xs, xb, nrow, lane); rn_load<IN>(b1, mix, xp, xs, xb, nrow + 1, lane); }
        rn_proc<OUT>(a0, ga, xb, rs, yout, row, lane); rn_proc<OUT>(a1, ga, xb, rs, yout, row + 1, lane);
        if (!more) break;
        a0 = b0; a1 = b1; row = nrow;
    }
}

__device__ __forceinline__ float ret_lg2(int h) { return __log2f(1.f - ex2((float)(-5 - h))); }
__device__ __forceinline__ void ret_passA(const Params& P, int wid, int lane) {
    bf16_t* B = (bf16_t*)(P.ws + WS_B);
    bf16_t* KV = (bf16_t*)(P.ws + WS_C);
    bf16_t* KVS = (bf16_t*)(P.ws + WS_KVS);
    const int l32 = lane & 31, hh = lane >> 5;
    const int mt = wid >> 1, nt0 = (wid & 1) * 2;
    for (int u = blockIdx.x; u < 4096 + 32; u += gridDim.x) {
        const bool samp = u >= 4096;
        f32x16 d0 = {}, d1 = {};
        if (!samp) {
            const bf16_t* vt = B + B_VT + (size_t)u * 8192; const bf16_t* kt = B + B_KT + (size_t)u * 8192;
#pragma unroll
            for (int ks = 0; ks < 4; ++ks) {
                const bf16x8 a = *(const bf16x8*)(vt + (32 * mt + l32) * 64 + 16 * ks + 8 * hh);
                const bf16x8 b0 = *(const bf16x8*)(kt + (32 * nt0 + l32) * 64 + 16 * ks + 8 * hh);
                const bf16x8 b1 = *(const bf16x8*)(kt + (32 * nt0 + 32 + l32) * 64 + 16 * ks + 8 * hh);
                d0 = MFMA32(a, b0, d0); d1 = MFMA32(a, b1, d1);
            }
            bf16_t* o = KV + (size_t)u * 16384;
#pragma unroll
            for (int r = 0; r < 16; ++r) { const int e = 32 * mt + (r & 3) + 8 * (r >> 2) + 4 * hh; o[e * 128 + 32 * nt0 + l32] = f2bf(d0[r]); o[e * 128 + 32 * nt0 + 32 + l32] = f2bf(d1[r]); }
        } else {
            const int bh = u - 4096, hd = bh & 3;
            const bf16_t* vt = B + B_VTS + (size_t)bh * 4096; const bf16_t* kt = B + B_KTS + (size_t)bh * 4096;
#pragma unroll
            for (int ks = 0; ks < 2; ++ks) {
                const bf16x8 a = *(const bf16x8*)(vt + (32 * mt + l32) * 32 + 16 * ks + 8 * hh);
                const bf16x8 b0 = *(const bf16x8*)(kt + (32 * nt0 + l32) * 32 + 16 * ks + 8 * hh);
                const bf16x8 b1 = *(const bf16x8*)(kt + (32 * nt0 + 32 + l32) * 32 + 16 * ks + 8 * hh);
                d0 = MFMA32(a, b0, d0); d1 = MFMA32(a, b1, d1);
            }
            const float g32 = ex2(ret_lg2(hd) * 32.f);
            const float* s0 = P.in[2] + (size_t)bh * 16384; float* so = P.out + O_RSS + (size_t)bh * 16384; bf16_t* sb = KVS + (size_t)bh * 16384;
#pragma unroll
            for (int r = 0; r < 16; ++r) {
                const int e = 32 * mt + (r & 3) + 8 * (r >> 2) + 4 * hh;
#pragma unroll
                for (int q = 0; q < 2; ++q) {
                    const int dp = 32 * nt0 + 32 * q + l32, d = (dp >> 1) + 64 * (dp & 1);
                    const float s = s0[d * 128 + e];
                    so[d * 128 + e] = s * g32 + (q ? d1[r] : d0[r]);
                    sb[e * 128 + dp] = f2bf(s);
                }
            }
        }
    }
}
__device__ __forceinline__ void ret_passB(const Params& P, int tid) {
    unsigned* KV = (unsigned*)(P.ws + WS_C);
    for (int i = blockIdx.x * 512 + tid; i < 32 * 8192; i += gridDim.x * 512) {
        const int bh = i >> 13, idx = i & 8191;
        const float dec = ex2(ret_lg2(bh & 3) * 64.f);
        unsigned* p = KV + (size_t)bh * 128 * 8192 + idx;
        float s0 = 0.f, s1 = 0.f;
        for (int n0 = 0; n0 < 128; n0 += 16) {
            unsigned v[16];
#pragma unroll
            for (int k = 0; k < 16; ++k) v[k] = p[(size_t)(n0 + k) * 8192];
#pragma unroll
            for (int k = 0; k < 16; ++k) { p[(size_t)(n0 + k) * 8192] = pk2(s0, s1); s0 = s0 * dec + bflo(v[k]); s1 = s1 * dec + bfhi(v[k]); }
        }
        const int e = idx >> 6, dp = (idx & 63) * 2;
        float* so = P.out + O_RSP + (size_t)bh * 16384;
        so[(dp >> 1) * 128 + e] = s0;
        so[((dp >> 1) + 64) * 128 + e] = s1;
    }
}
template <int L> __device__ __forceinline__ void ret_unitC(const Params& P, LAS float* red, int bh, int n, int wid, int lane) {
    const bf16_t* B = (const bf16_t*)(P.ws + WS_B);
    const int l32 = lane & 31, hh = lane >> 5, hd = bh & 3, b = bh >> 2;
    const int et = wid >> 1, it = wid & 1;
    const bool act = (L == 64) || (it == 0);
    const int row0 = (L == 64) ? (b * T + n * 64) : (RP + b * 32);
    const bf16_t* sbef = (L == 64) ? (const bf16_t*)(P.ws + WS_C) + (size_t)(bh * 128 + n) * 16384 : (const bf16_t*)(P.ws + WS_KVS) + (size_t)bh * 16384;
    const bf16_t* vt = (L == 64) ? B + B_VT + (size_t)(bh * 128 + n) * 8192 : B + B_VTS + (size_t)bh * 4096;
    const float lg2 = ret_lg2(hd);
    const int i = 32 * it + l32;
    f32x16 acc = {};
    float s1 = 0.f, s2 = 0.f;
    if (act) {
        bf16x8 qf[8];
#pragma unroll
        for (int ks = 0; ks < 8; ++ks) qf[ks] = *(const bf16x8*)(B + B_RQ + (size_t)(row0 + i) * 512 + hd * 128 + 16 * ks + 8 * hh);
#pragma unroll
        for (int ks = 0; ks < 8; ++ks) { const bf16x8 a = *(const bf16x8*)(sbef + (32 * et + l32) * 128 + 16 * ks + 8 * hh); acc = MFMA32(a, qf[ks], acc); }
        acc = acc * ex2(lg2 * (float)(i + 1));
#pragma unroll
        for (int jt = 0; jt < L / 32; ++jt) {
            f32x16 sc = {};
#pragma unroll
            for (int ks = 0; ks < 8; ++ks) { const bf16x8 a = *(const bf16x8*)(B + B_RK + (size_t)(row0 + 32 * jt + l32) * 512 + hd * 128 + 16 * ks + 8 * hh); sc = MFMA32(a, qf[ks], sc); }
#pragma unroll
            for (int r = 0; r < 16; ++r) { const int j = 32 * jt + (r & 3) + 8 * (r >> 2) + 4 * hh; const int dd = i > j ? i - j : j - i; sc[r] = sc[r] * ex2(lg2 * (float)dd); }
#pragma unroll
            for (int s = 0; s < 2; ++s) {
                u32x4 pw; pw.x = pk2(sc[8 * s], sc[8 * s + 1]); pw.y = pk2(sc[8 * s + 2], sc[8 * s + 3]); pw.z = pk2(sc[8 * s + 4], sc[8 * s + 5]); pw.w = pk2(sc[8 * s + 6], sc[8 * s + 7]);
                const bf16x8 pf = __builtin_bit_cast(bf16x8, pw);
                const bf16_t* vb = vt + (32 * et + l32) * L + 32 * jt + 16 * s + 4 * hh;
                const u32x2 lo = *(const u32x2*)vb, hi = *(const u32x2*)(vb + 8);
                const u32x4 vw = {lo.x, lo.y, hi.x, hi.y};
                acc = MFMA32(__builtin_bit_cast(bf16x8, vw), pf, acc);
            }
        }
#pragma unroll
        for (int r = 0; r < 16; ++r) { s1 += acc[r]; s2 += acc[r] * acc[r]; }
        s1 += __shfl_xor(s1, 32); s2 += __shfl_xor(s2, 32);
        if (hh == 0) { red[et * 64 + i] = s1; red[256 + et * 64 + i] = s2; }
    }
    __syncthreads();
    if (act) {
        const float t1 = red[i] + red[64 + i] + red[128 + i] + red[192 + i];
        const float t2 = red[256 + i] + red[320 + i] + red[384 + i] + red[448 + i];
        const float mu = t1 * (1.f / 128.f), var = fmaxf(t2 * (1.f / 128.f) - mu * mu, 0.f), rstd = rsqrtf(var + EPS);
        const float* gw = P.in[14] + hd * 128;
        bf16_t* mixed = MIXED;
#pragma unroll
        for (int g = 0; g < 4; ++g) {
            const int e = 32 * et + 8 * g + 4 * hh;
            const f32x4 w4 = *(const f32x4*)(gw + e);
            const u32x2 gt = *(const u32x2*)(B + B_RG + (size_t)(row0 + i) * 512 + hd * 128 + e);
            f32x4 o;
            o.x = (acc[4 * g] - mu) * rstd * w4.x * bflo(gt.x); o.y = (acc[4 * g + 1] - mu) * rstd * w4.y * bfhi(gt.x);
            o.z = (acc[4 * g + 2] - mu) * rstd * w4.z * bflo(gt.y); o.w = (acc[4 * g + 3] - mu) * rstd * w4.w * bfhi(gt.y);
            u32x2 w; w.x = pk2(o.x, o.y); w.y = pk2(o.z, o.w);
            *(u32x2*)(mixed + (size_t)(row0 + i) * 1024 + hd * 128 + e) = w;
        }
    }
    __syncthreads();
}

struct FoxUnit { const bf16_t* Q; const bf16_t* K; const bf16_t* VT; const float* c2; bf16_t* O; int vtp, qpos0, nq, ntiles, Tk; };
constexpr int FOX_BUF = 18432, FOX_VOFF = 9216, FOX_COFF = 17920;
__device__ __forceinline__ void fox_unit(LAS unsigned char* lds, const FoxUnit U, int tid, int wid, int lane) {
    const int l32 = lane & 31, hh = lane >> 5;
    const int wrow = wid * 64;
    const bool active = wrow < U.nq;
    const bool act1 = wrow + 32 < U.nq;
    bf16x8 qf[2][4];
#pragma unroll
    for (int qt = 0; qt < 2; ++qt)
#pragma unroll
        for (int s = 0; s < 4; ++s) qf[qt][s] = (qt == 0 ? active : act1) ? *(const bf16x8*)(U.Q + (size_t)(wrow + 32 * qt + l32) * 512 + 16 * s + 8 * hh) : (bf16x8){0, 0, 0, 0, 0, 0, 0, 0};
    const int wq_lo = U.qpos0 + wrow, wq_hi = wq_lo + (act1 ? 63 : 31);
    float mrun[2] = {-INFINITY, -INFINITY}, lrun[2] = {0.f, 0.f};
    f32x16 o0[2] = {{}, {}}, o1[2] = {{}, {}};
    const int srow = tid >> 3, sch = tid & 7;
    u32x4 kr, vr; float cr = 0.f;
#define FOX_LOAD(t) do { int key_ = (t) * 64 + srow; key_ = key_ < U.Tk ? key_ : U.Tk - 1; kr = *(const u32x4*)(U.K + (size_t)key_ * 512 + sch * 8); \
        vr = *(const u32x4*)(U.VT + (size_t)srow * U.vtp + (t) * 64 + sch * 8); \
        if (tid < 64) { int kc_ = (t) * 64 + tid; kc_ = kc_ < U.Tk ? kc_ : U.Tk - 1; cr = U.c2[kc_]; } } while (0)
#define FOX_STORE(bi) do { LAS unsigned char* kb_ = lds + (bi) * FOX_BUF; *(LAS u32x4*)(kb_ + srow * 144 + sch * 16) = kr; \
        *(LAS u32x2*)(kb_ + FOX_VOFF + srow * 136 + sch * 16) = (u32x2){vr.x, vr.y}; *(LAS u32x2*)(kb_ + FOX_VOFF + srow * 136 + sch * 16 + 8) = (u32x2){vr.z, vr.w}; \
        if (tid < 64) *(LAS float*)(kb_ + FOX_COFF + tid * 4) = -cr; } while (0)
    FOX_LOAD(0); FOX_STORE(0);
    __syncthreads();
    for (int t = 0; t < U.ntiles; ++t) {
        const bool more = t + 1 < U.ntiles;
        if (more) FOX_LOAD(t + 1);
        if (active && t * 64 <= wq_hi) {
            LAS unsigned char* kb = lds + (t & 1) * FOX_BUF;
            bf16x8 pf[2][4];
#pragma unroll
            for (int qt = 0; qt < 2; ++qt) {
                __builtin_amdgcn_sched_barrier(0);
                f32x16 p0, p1;
#pragma unroll
                for (int g = 0; g < 4; ++g) {
                    const f32x4 c0 = *(LAS f32x4*)(kb + FOX_COFF + (8 * g + 4 * hh) * 4), c1 = *(LAS f32x4*)(kb + FOX_COFF + (32 + 8 * g + 4 * hh) * 4);
                    p0[4 * g] = c0.x; p0[4 * g + 1] = c0.y; p0[4 * g + 2] = c0.z; p0[4 * g + 3] = c0.w;
                    p1[4 * g] = c1.x; p1[4 * g + 1] = c1.y; p1[4 * g + 2] = c1.z; p1[4 * g + 3] = c1.w;
                }
#pragma unroll
                for (int s = 0; s < 4; ++s) {
                    const bf16x8 a0 = *(LAS bf16x8*)(kb + l32 * 144 + (2 * s + hh) * 16), a1 = *(LAS bf16x8*)(kb + (32 + l32) * 144 + (2 * s + hh) * 16);
                    p0 = MFMA32(a0, qf[qt][s], p0); p1 = MFMA32(a1, qf[qt][s], p1);
                }
                const int qpos = wq_lo + 32 * qt + l32;
                if (t * 64 + 63 > wq_lo + 32 * qt) {
#pragma unroll
                    for (int r = 0; r < 16; ++r) { const int key = t * 64 + (r & 3) + 8 * (r >> 2) + 4 * hh; if (key > qpos) p0[r] = -INFINITY; if (key + 32 > qpos) p1[r] = -INFINITY; }
                }
                float mx = fmaxf(p0[0], p1[0]);
#pragma unroll
                for (int r = 1; r < 16; ++r) mx = fmaxf(mx, fmaxf(p0[r], p1[r]));
                mx = fmaxf(mx, __shfl_xor(mx, 32));
                const float mn = fmaxf(mrun[qt], mx), alpha = ex2(mrun[qt] - mn); mrun[qt] = mn;
                float rs = 0.f;
#pragma unroll
                for (int r = 0; r < 16; ++r) { p0[r] = ex2(p0[r] - mn); p1[r] = ex2(p1[r] - mn); rs += p0[r] + p1[r]; }
                lrun[qt] = lrun[qt] * alpha + rs; o0[qt] = o0[qt] * alpha; o1[qt] = o1[qt] * alpha;
#pragma unroll
                for (int s = 0; s < 4; ++s) {
                    u32x4 pw;
                    if (s < 2) { pw.x = pk2(p0[8 * s], p0[8 * s + 1]); pw.y = pk2(p0[8 * s + 2], p0[8 * s + 3]); pw.z = pk2(p0[8 * s + 4], p0[8 * s + 5]); pw.w = pk2(p0[8 * s + 6], p0[8 * s + 7]); }
                    else { const int q = 8 * (s - 2); pw.x = pk2(p1[q], p1[q + 1]); pw.y = pk2(p1[q + 2], p1[q + 3]); pw.z = pk2(p1[q + 4], p1[q + 5]); pw.w = pk2(p1[q + 6], p1[q + 7]); }
                    pf[qt][s] = __builtin_bit_cast(bf16x8, pw);
                }
            }
#pragma unroll
            for (int s = 0; s < 4; ++s) {
                LAS unsigned char* vb = kb + FOX_VOFF + l32 * 136 + (16 * s + 4 * hh) * 2;
                const u32x2 a = *(LAS u32x2*)vb, b = *(LAS u32x2*)(vb + 16), c = *(LAS u32x2*)(vb + 32 * 136), d = *(LAS u32x2*)(vb + 32 * 136 + 16);
                const u32x4 v0 = {a.x, a.y, b.x, b.y}, v1 = {c.x, c.y, d.x, d.y};
#pragma unroll
                for (int qt = 0; qt < 2; ++qt) { o0[qt] = MFMA32(__builtin_bit_cast(bf16x8, v0), pf[qt][s], o0[qt]); o1[qt] = MFMA32(__builtin_bit_cast(bf16x8, v1), pf[qt][s], o1[qt]); }
            }
        }
        if (more) FOX_STORE((t + 1) & 1);
        __syncthreads();
    }
#undef FOX_LOAD
#undef FOX_STORE
#pragma unroll
    for (int qt = 0; qt < 2; ++qt) {
        if (qt == 0 ? active : act1) {
            const float inv = 1.f / (lrun[qt] + __shfl_xor(lrun[qt], 32));
            bf16_t* op = U.O + (size_t)(wrow + 32 * qt + l32) * 1024 + 4 * hh;
#pragma unroll
            for (int g = 0; g < 4; ++g) {
                u32x2 w; w.x = pk2(o0[qt][4 * g] * inv, o0[qt][4 * g + 1] * inv); w.y = pk2(o0[qt][4 * g + 2] * inv, o0[qt][4 * g + 3] * inv); *(u32x2*)(op + 8 * g) = w;
                w.x = pk2(o1[qt][4 * g] * inv, o1[qt][4 * g + 1] * inv); w.y = pk2(o1[qt][4 * g + 2] * inv, o1[qt][4 * g + 3] * inv); *(u32x2*)(op + 32 + 8 * g) = w;
            }
        }
    }
}
__device__ __forceinline__ void fox_phase(const Params& P, LAS unsigned char* lds, int tid, int wid, int lane) {
    const bf16_t* B = (const bf16_t*)(P.ws + WS_B);
    bf16_t* mixed = MIXED;
    for (int it2 = 2 * blockIdx.x; it2 < 1024 + 128; it2 += (it2 < 1024) ? (((it2 & 1) == 0) ? 1 : 2 * (int)gridDim.x - 1) : 2 * (int)gridDim.x) {
        FoxUnit U;
        if (it2 < 1024) {
            const int it = it2 >> 1, k = it2 & 1;
            const int bh = it >> 3, pi = it & 7, b = bh >> 3, hd = bh & 7;
            const int qb = k ? 15 - pi : pi;
            U.Q = B + B_FQ + (size_t)(b * T + qb * 512) * 512 + hd * 64; U.K = B + B_FK + (size_t)b * T * 512 + hd * 64;
            U.VT = B + B_FVT + (size_t)(b * 512 + hd * 64) * T; U.c2 = (const float*)(P.ws + WS_C2P) + (size_t)bh * T;
            U.O = mixed + (size_t)(b * T + qb * 512) * 1024 + 512 + hd * 64; U.vtp = T; U.qpos0 = qb * 512; U.nq = 512; U.ntiles = 8 * (qb + 1); U.Tk = T;
        } else {
            const int bh = (it2 - 1024) >> 1;
            const int b = bh >> 3, hd = bh & 7;
            U.Q = B + B_FQ + (size_t)(RP + b * 32) * 512 + hd * 64; U.K = (const bf16_t*)(P.ws + WS_FKS) + (size_t)b * TKS * 512 + hd * 64;
            U.VT = (const bf16_t*)(P.ws + WS_FVTS) + (size_t)(b * 512 + hd * 64) * TKS; U.c2 = (const float*)(P.ws + WS_C2S) + (size_t)bh * TKS;
            U.O = mixed + (size_t)(RP + b * 32) * 1024 + 512 + hd * 64; U.vtp = TKS; U.qpos0 = PAST; U.nq = 32; U.ntiles = 65; U.Tk = TKS;
        }
        int tid_ = tid; asm volatile("" : "+v"(tid_));
        fox_unit(lds, U, tid_, wid, tid_ & 63);
    }
}

constexpr int XA_BUF = 16896;
__device__ __forceinline__ void xattn_unit(LAS unsigned char* lds, const bf16_t* Q, const bf16_t* Kb, const bf16_t* VTb, bf16_t* O, int nwaves, int tid, int wid, int lane) {
    const int l32 = lane & 31, hh = lane >> 5;
    const bool active = wid < nwaves;
    bf16x8 qf[16];
#pragma unroll
    for (int s = 0; s < 16; ++s) qf[s] = active ? *(const bf16x8*)(Q + (size_t)(wid * 32 + l32) * 1024 + 16 * s + 8 * hh) : (bf16x8){0, 0, 0, 0, 0, 0, 0, 0};
    f32x16 S[4];
    bf16x8 pf[16];
    float m1 = 0.f, l1 = 0.f, a1 = 0.f, a2 = 0.f;
    u32x4 r0, r1;
    const int i0 = tid, i1 = tid + 512;
    const bf16_t* g0 = Kb + (size_t)(i0 >> 5) * 1024 + (i0 & 31) * 8; const bf16_t* g1 = Kb + (size_t)(i1 >> 5) * 1024 + (i1 & 31) * 8;
    const bf16_t* h0 = VTb + (size_t)(i0 >> 5) * 256 + (i0 & 31) * 8; const bf16_t* h1 = VTb + (size_t)(i1 >> 5) * 256 + (i1 & 31) * 8;
#define XA_LOAD(tt) do { if ((tt) < 8) { r0 = *(const u32x4*)g0; r1 = *(const u32x4*)g1; g0 += 32 * 1024; g1 += 32 * 1024; asm volatile("" : "+v"(g0), "+v"(g1)); } \
        else { r0 = *(const u32x4*)h0; r1 = *(const u32x4*)h1; h0 += 32 * 256; h1 += 32 * 256; asm volatile("" : "+v"(h0), "+v"(h1)); } } while (0)
#define XA_STORE(bi) do { LAS unsigned char* b_ = lds + (bi) * XA_BUF; *(LAS u32x4*)(b_ + (i0 >> 5) * 528 + (i0 & 31) * 16) = r0; *(LAS u32x4*)(b_ + (i1 >> 5) * 528 + (i1 & 31) * 16) = r1; } while (0)
#define XA_HALF(hf, mm, ll) do { float mx_ = S[0][0]; \
        _Pragma("unroll") for (int k = 0; k < 4; ++k) _Pragma("unroll") for (int r = 0; r < 16; ++r) mx_ = fmaxf(mx_, S[k][r]); \
        mx_ = fmaxf(mx_, __shfl_xor(mx_, 32)); float l_ = 0.f; \
        _Pragma("unroll") for (int k = 0; k < 4; ++k) { \
            _Pragma("unroll") for (int r = 0; r < 16; ++r) { S[k][r] = ex2(S[k][r] - mx_); l_ += S[k][r]; } \
            _Pragma("unroll") for (int s = 0; s < 2; ++s) { u32x4 pw; pw.x = pk2(S[k][8 * s], S[k][8 * s + 1]); pw.y = pk2(S[k][8 * s + 2], S[k][8 * s + 3]); pw.z = pk2(S[k][8 * s + 4], S[k][8 * s + 5]); pw.w = pk2(S[k][8 * s + 6], S[k][8 * s + 7]); \
                pf[8 * (hf) + 2 * k + s] = __builtin_bit_cast(bf16x8, pw); } } \
        mm = mx_; ll = l_ + __shfl_xor(l_, 32); } while (0)
    XA_LOAD(0); XA_STORE(0);
    __syncthreads();
#pragma unroll
    for (int tt = 0; tt < 16; ++tt) {
        if (tt + 1 < 16) XA_LOAD(tt + 1);
        LAS unsigned char* buf = lds + (tt & 1) * XA_BUF;
        if (active) {
            if (tt < 8) {
                f32x16 s = {};
#pragma unroll
                for (int k = 0; k < 16; ++k) { const bf16x8 a = *(LAS bf16x8*)(buf + l32 * 528 + (2 * k + hh) * 16); s = MFMA32(a, qf[k], s); }
                S[tt & 3] = s;
                if (tt == 3) XA_HALF(0, m1, l1);
                if (tt == 7) {
                    float m2, l2; XA_HALF(1, m2, l2);
                    const float mm = fmaxf(m1, m2); a1 = ex2(m1 - mm); a2 = ex2(m2 - mm);
                    const float inv = 1.f / (a1 * l1 + a2 * l2); a1 *= inv; a2 *= inv;
                }
            } else {
                f32x16 o1 = {}, o2 = {};
#pragma unroll
                for (int k = 0; k < 16; ++k) {
                    LAS unsigned char* vb = buf + l32 * 528 + (16 * k + 4 * hh) * 2;
                    const u32x2 a = *(LAS u32x2*)vb, b = *(LAS u32x2*)(vb + 16);
                    const u32x4 vw = {a.x, a.y, b.x, b.y};
                    if (k < 8) o1 = MFMA32(__builtin_bit_cast(bf16x8, vw), pf[k], o1); else o2 = MFMA32(__builtin_bit_cast(bf16x8, vw), pf[k], o2);
                }
                bf16_t* op = O + (size_t)(wid * 32 + l32) * 1024 + 32 * (tt - 8) + 4 * hh;
#pragma unroll
                for (int g = 0; g < 4; ++g) { u32x2 w; w.x = pk2(o1[4 * g] * a1 + o2[4 * g] * a2, o1[4 * g + 1] * a1 + o2[4 * g + 1] * a2); w.y = pk2(o1[4 * g + 2] * a1 + o2[4 * g + 2] * a2, o1[4 * g + 3] * a1 + o2[4 * g + 3] * a2); *(u32x2*)(op + 8 * g) = w; }
            }
        }
        if (tt + 1 < 16) XA_STORE((tt + 1) & 1);
        __syncthreads();
    }
#undef XA_HALF
#undef XA_LOAD
#undef XA_STORE
}
__device__ __forceinline__ void xattn_phase(const Params& P, LAS unsigned char* lds, int layer, int tid, int wid, int lane) {
    const bf16_t* XQ = (const bf16_t*)(P.ws + WS_B);
    bf16_t* XO = (bf16_t*)(P.ws + WS_B) + B_X2;
    const bf16_t* MK = (const bf16_t*)(P.ws + WS_MEMK); const bf16_t* MVT = (const bf16_t*)(P.ws + WS_MEMVT);
    for (int it = blockIdx.x; it < 1024 + 32; it += gridDim.x) {
        int row0, set, hd, nw;
        if (it < 1024) { const int pm = it >> 2; hd = it & 3; row0 = pm * 256; set = layer * 16 + (pm >> 5); nw = 8; }
        else { const int q = it - 1024, b = q >> 2; hd = q & 3; row0 = RP + b * 32; set = layer * 16 + 8 + b; nw = 1; }
        xattn_unit(lds, XQ + (size_t)row0 * 1024 + hd * 256, MK + (size_t)set * 262144 + hd * 256, MVT + ((size_t)set * 1024 + hd * 256) * 256, XO + (size_t)row0 * 1024 + hd * 256, nw, tid, wid, lane);
    }
}

__device__ __forceinline__ void s5_run(LAS unsigned char* wl, const bf16_t* U, bf16_t* Y, int row0, int L, int g, f32x2 a, float& xr, float& xi, bool outp,
                                       const bf16_t* SB5, const bf16_t* SC5, const float* s5d, int lane) {
    const int l32 = lane & 31, hh = lane >> 5, l16 = lane & 15, q4 = lane >> 4;
    bf16x8 bfr[4], cfr[4];
#pragma unroll
    for (int k = 0; k < 4; ++k) { bfr[k] = *(const bf16x8*)(SB5 + ((size_t)(g * 4 + k) * 64 + lane) * 8); cfr[k] = *(const bf16x8*)(SC5 + ((size_t)(g * 4 + k) * 64 + lane) * 8); }
    const f32x4 dv = *(const f32x4*)(s5d + g * 16 + 4 * q4);
    for (int sc = 0; sc < L / 32; ++sc) {
        const int r0 = row0 + sc * 32;
        const bf16x8 uf = *(const bf16x8*)(U + (size_t)(r0 + l32) * 1024 + g * 16 + 8 * hh);
        const f32x16 z = {};
        const f32x16 d0 = MFMA32(uf, bfr[0], z), d1 = MFMA32(uf, bfr[1], z), d2 = MFMA32(uf, bfr[2], z), d3 = MFMA32(uf, bfr[3], z);
#pragma unroll
        for (int r = 0; r < 16; ++r) {
            const int tok = (r & 3) + 8 * (r >> 2) + 4 * hh;
            *(LAS f32x2*)(wl + tok * 528 + l32 * 8) = (f32x2){d0[r], d2[r]};
            *(LAS f32x2*)(wl + tok * 528 + (32 + l32) * 8) = (f32x2){d1[r], d3[r]};
        }
        LDSBAR();
#pragma unroll
        for (int t0 = 0; t0 < 32; t0 += 8) {
            f32x2 bu[8]; float xo_[8];
#pragma unroll
            for (int k = 0; k < 8; ++k) bu[k] = *(LAS f32x2*)(wl + (t0 + k) * 528 + lane * 8);
            LDSBAR();
#pragma unroll
            for (int k = 0; k < 8; ++k) {
                const float nr = a.x * xr - a.y * xi + bu[k].x, ni = a.x * xi + a.y * xr + bu[k].y;
                xr = nr; xi = ni; xo_[k] = __uint_as_float(pk2(xr, xi));
            }
            if (outp) {
#pragma unroll
                for (int k = 0; k < 8; ++k) *(LAS float*)(wl + (t0 + k) * 528 + lane * 4) = xo_[k];
            }
        }
        LDSBAR();
        if (outp) {
#pragma unroll
            for (int tb = 0; tb < 2; ++tb) {
                f32x4 acc = {0.f, 0.f, 0.f, 0.f};
#pragma unroll
                for (int ks = 0; ks < 4; ++ks) { const bf16x8 xf = *(LAS bf16x8*)(wl + (16 * tb + l16) * 528 + (32 * ks + 8 * q4) * 2); acc = MFMA16(cfr[ks], xf, acc); }
                const size_t off = (size_t)(r0 + 16 * tb + l16) * 1024 + g * 16 + 4 * q4;
                const u32x2 uu = *(const u32x2*)(U + off);
                f32x4 y; y.x = acc.x + dv.x * bflo(uu.x); y.y = acc.y + dv.y * bfhi(uu.x); y.z = acc.z + dv.z * bflo(uu.y); y.w = acc.w + dv.w * bfhi(uu.y);
                u32x2 w; w.x = pk2(y.x, y.y); w.y = pk2(y.z, y.w);
                *(u32x2*)(Y + off) = w;
            }
        }
        LDSBAR();
    }
}
constexpr int S5_NSEG = 16, S5_LSEG = 512;
__device__ __forceinline__ void s5_phase(const Params& P, LAS unsigned char* lds, int pass, int wid, int lane) {
    const bf16_t* U = (const bf16_t*)(P.ws + WS_B);
    bf16_t* Y = (bf16_t*)(P.ws + WS_B) + B_X2;
    const f32x2* S5A = (const f32x2*)(P.ws + WS_S5T); const f32x2* S5AL = S5A + 4096;
    const bf16_t* SB5 = (const bf16_t*)(P.ws + WS_S5T + 65536); const bf16_t* SC5 = SB5 + 131072;
    f32x2* LE = (f32x2*)(P.ws + WS_LE);
    LAS unsigned char* wl = lds + wid * 16896;
    const int nunits = (pass == 1) ? 8 * (S5_NSEG - 1) * 8 : 8 * S5_NSEG * 8 + 64;
    for (int it = blockIdx.x; it < nunits; it += gridDim.x) {
        if (pass == 1) {
            const int g8 = it & 7, seg = (it >> 3) % (S5_NSEG - 1), b = (it >> 3) / (S5_NSEG - 1), g = g8 * 8 + wid;
            float xr = 0.f, xi = 0.f;
            s5_run(wl, U, Y, b * T + seg * S5_LSEG, S5_LSEG, g, S5A[g * 64 + lane], xr, xi, false, SB5, SC5, P.in[24], lane);
            LE[((size_t)(b * S5_NSEG + seg) * 64 + g) * 64 + lane] = (f32x2){xr, xi};
        } else if (it < 8 * S5_NSEG * 8) {
            const int g8 = it & 7, seg = (it >> 3) & (S5_NSEG - 1), b = it >> 7, g = g8 * 8 + wid;
            const f32x2 aL = S5AL[g * 64 + lane];
            float xr = 0.f, xi = 0.f;
            for (int s = 0; s < seg; ++s) { const f32x2 le = LE[((size_t)(b * S5_NSEG + s) * 64 + g) * 64 + lane]; const float nr = aL.x * xr - aL.y * xi + le.x, ni = aL.x * xi + aL.y * xr + le.y; xr = nr; xi = ni; }
            s5_run(wl, U, Y, b * T + seg * S5_LSEG, S5_LSEG, g, S5A[g * 64 + lane], xr, xi, true, SB5, SC5, P.in[24], lane);
            if (seg == S5_NSEG - 1) { P.out[O_S5RP + (size_t)(b * 64 + g) * 64 + lane] = xr; P.out[O_S5IP + (size_t)(b * 64 + g) * 64 + lane] = xi; }
        } else {
            const int q = it - 8 * S5_NSEG * 8, g8 = q & 7, b = q >> 3, g = g8 * 8 + wid;
            float xr = P.in[6][(size_t)(b * 64 + g) * 64 + lane], xi = P.in[7][(size_t)(b * 64 + g) * 64 + lane];
            s5_run(wl, U, Y, RP + b * 32, 32, g, S5A[g * 64 + lane], xr, xi, true, SB5, SC5, P.in[24], lane);
            P.out[O_S5RS + (size_t)(b * 64 + g) * 64 + lane] = xr; P.out[O_S5IS + (size_t)(b * 64 + g) * 64 + lane] = xi;
        }
    }
}

__device__ __forceinline__ void prologue(const Params& P, int tid, int wid, int lane) {
    const int gtid = blockIdx.x * 512 + tid, gsz = gridDim.x * 512;
    const int gw = blockIdx.x * 8 + wid, ngw = gridDim.x * 8;
    bf16_t* W = (bf16_t*)(P.ws + WS_W);
    wtrans(P.in[12], 1024, 3592, W + W_AB, 3840, 1, gtid, gsz, P.in[11]);
    wtrans(P.in[15], 1024, 1024, W + W_OUT, 1024, 0, gtid, gsz);
    wtrans(P.in[16], 1024, 1024, W + W_INC, 1024, 0, gtid, gsz, P.in[11] + 6144);
    wtrans(P.in[25], 1024, 2048, W + W_GLU, 2048, 2, gtid, gsz);
    for (int l = 0; l < 2; ++l) {
        wtrans(P.in[27] + (size_t)l * 1048576, 1024, 1024, W + W_XQ + (size_t)l * 1048576, 1024, 0, gtid, gsz, P.in[11] + l * 6144 + 2048);
        wtrans(P.in[28] + (size_t)l * 1048576, 1024, 1024, W + W_XKV + (size_t)l * 2097152, 1024, 0, gtid, gsz);
        wtrans(P.in[29] + (size_t)l * 1048576, 1024, 1024, W + W_XKV + (size_t)l * 2097152 + 1048576, 1024, 0, gtid, gsz);
        wtrans(P.in[30] + (size_t)l * 1048576, 1024, 1024, W + W_XO + (size_t)l * 1048576, 1024, 0, gtid, gsz);
        wtrans(P.in[31] + (size_t)l * 4194304, 1024, 4096, W + W_UP + (size_t)l * 4194304, 4096, 0, gtid, gsz, P.in[11] + l * 6144 + 4096);
        wtrans(P.in[32] + (size_t)l * 4194304, 4096, 1024, W + W_DN + (size_t)l * 4194304, 1024, 0, gtid, gsz);
    }
    {
        float* rope = (float*)(P.ws + WS_ROPE);
        for (int i = gtid; i < 8192 * 64; i += gsz) {
            const int pos = i >> 6, k = i & 63;
            const double inv = exp2(-(double)k * (13.287712379549449 / 64.0));
            const double ang = (double)pos * inv;
            rope[2 * i] = (float)cos(ang); rope[2 * i + 1] = (float)sin(ang);
        }
    }
    {
        f32x2* S5A = (f32x2*)(P.ws + WS_S5T); f32x2* S5AL = S5A + 4096;
        bf16_t* SB5 = (bf16_t*)(P.ws + WS_S5T + 65536); bf16_t* SC5 = SB5 + 131072;
        for (int i = gtid; i < 4096; i += gsz) {
            const int g = i >> 6, p = i & 63;
            const double lr = P.in[17][i], li = P.in[18][i], dt = exp((double)P.in[19][g]);
            const double mag = exp(lr * dt), ar = mag * cos(li * dt), ai = mag * sin(li * dt);
            S5A[i] = (f32x2){(float)ar, (float)ai};
            const double magL = exp(lr * dt * S5_LSEG);
            S5AL[i] = (f32x2){(float)(magL * cos(li * dt * S5_LSEG)), (float)(magL * sin(li * dt * S5_LSEG))};
            const double den = lr * lr + li * li, nre = ar - 1.0;
            const double fr = (nre * lr + ai * li) / den, fi = (ai * lr - nre * li) / den;
            const float* br = P.in[20] + (size_t)i * 16; const float* bi = P.in[21] + (size_t)i * 16;
#pragma unroll
            for (int part = 0; part < 2; ++part)
#pragma unroll
                for (int h2 = 0; h2 < 2; ++h2) {
                    float v[8];
#pragma unroll
                    for (int k = 0; k < 8; ++k) { const int c = 8 * h2 + k; v[k] = part == 0 ? (float)(fr * br[c] - fi * bi[c]) : (float)(fr * bi[c] + fi * br[c]); }
                    u32x4 o; o.x = pk2(v[0], v[1]); o.y = pk2(v[2], v[3]); o.z = pk2(v[4], v[5]); o.w = pk2(v[6], v[7]);
                    const int kb = 2 * part + (p >> 5), ln = (p & 31) + 32 * h2;
                    *(u32x4*)(SB5 + ((size_t)(g * 4 + kb) * 64 + ln) * 8) = o;
                }
        }
        for (int i = gtid; i < 64 * 4 * 64; i += gsz) {
            const int ln = i & 63, ks = (i >> 6) & 3, g = i >> 8;
            const int c = ln & 15;
            float v[8];
#pragma unroll
            for (int k = 0; k < 8; ++k) { const int kidx = 32 * ks + 8 * (ln >> 4) + k, p = kidx >> 1; v[k] = (kidx & 1) ? -P.in[23][((size_t)g * 16 + c) * 64 + p] : P.in[22][((size_t)g * 16 + c) * 64 + p]; }
            u32x4 o; o.x = pk2(v[0], v[1]); o.y = pk2(v[2], v[3]); o.z = pk2(v[4], v[5]); o.w = pk2(v[6], v[7]);
            *(u32x4*)(SC5 + (size_t)i * 8) = o;
        }
    }
    {
        bf16_t* FKS = (bf16_t*)(P.ws + WS_FKS); bf16_t* FVTS = (bf16_t*)(P.ws + WS_FVTS);
        for (int i = gtid; i < 8 * PAST * 64; i += gsz) { const int b = i / (PAST * 64), r = i % (PAST * 64); cvt8(P.in[3] + (size_t)i * 8, FKS + (size_t)b * TKS * 512 + (size_t)r * 8); }
        for (int b = 0; b < 8; ++b) ttrans(P.in[4] + (size_t)b * PAST * 512, PAST, 512, FVTS + (size_t)b * 512 * TKS, TKS, gtid, gsz);
        bf16_t* MK = (bf16_t*)(P.ws + WS_MEMK); bf16_t* MVT = (bf16_t*)(P.ws + WS_MEMVT);
        for (int i = gtid; i < 2 * 8 * 32768; i += gsz) { const int lb = i >> 15, r = i & 32767, l = lb >> 3, b = lb & 7; cvt8(P.in[8] + (size_t)i * 8, MK + (size_t)(l * 16 + 8 + b) * 262144 + (size_t)r * 8); }
        for (int lb = 0; lb < 16; ++lb) { const int l = lb >> 3, b = lb & 7; ttrans(P.in[9] + (size_t)lb * 262144, 256, 1024, MVT + (size_t)(l * 16 + 8 + b) * 262144, 256, gtid, gsz); }
    }
    {
        bf16_t* H = (bf16_t*)(P.ws + WS_A); bf16_t* MEMN = (bf16_t*)(P.ws + WS_MEMN);
        for (int row = gw; row < R + 4096; row += ngw) {
            if (row < R) { const float* xr = row < RP ? P.in[0] + (size_t)row * 1024 : P.in[1] + (size_t)(row - RP) * 1024; cvt_row(xr, H + (size_t)row * 1024, (float*)(P.ws + WS_RS) + row, lane); }
            else { const int q = row - R, l = q >> 11, r = q & 2047; norm_row(P.in[10] + (size_t)r * 1024, P.in[26] + l * 1024, MEMN + (size_t)q * 1024, lane); }
        }
    }
}
__device__ __forceinline__ void cumsum_task(const Params& P, int q, int lane) {
    const bool samp = q >= 64; const int bh = q & 63, b = bh >> 3, hd = bh & 7;
    const int n = samp ? TKS : T;
    float* dst = samp ? (float*)(P.ws + WS_C2S) + (size_t)bh * TKS : (float*)(P.ws + WS_C2P) + (size_t)bh * T;
    float carry = 0.f;
    for (int base0 = 0; base0 < n; base0 += 512) {
        float vv[8];
#pragma unroll
        for (int k = 0; k < 8; ++k) {
            const int idx = base0 + 64 * k + lane; float v = 0.f;
            if (idx < n) {
                if (!samp) v = P.out[O_LFP + ((size_t)b * T + idx) * 8 + hd];
                else v = idx < PAST ? P.in[5][((size_t)b * PAST + idx) * 8 + hd] : P.out[O_LFS + ((size_t)b * 32 + idx - PAST) * 8 + hd];
            }
            vv[k] = v;
        }
#pragma unroll
        for (int k = 0; k < 8; ++k) {
            const int idx = base0 + 64 * k + lane; float v = vv[k];
#pragma unroll
            for (int o = 1; o < 64; o <<= 1) { const float t = __shfl_up(v, o); if (lane >= o) v += t; }
            if (idx < n) dst[idx] = (carry + v) * LOG2E;
            carry += __shfl(v, 63);
        }
    }
}

template <class Epi> __device__ __forceinline__ void run_gemm(LAS unsigned char* lds, const bf16_t* A, const bf16_t* Bt, int M, int N, int K, const Epi& E) {
    pg8::Gemm g{A, Bt, M, N, K}; pg8::StaticOrder S; S.init(M, N, (int)gridDim.x, (int)blockIdx.x);
#ifndef GEMM_REP
#define GEMM_REP 1
#endif
#pragma unroll 1
    for (int rep_ = 0; rep_ < GEMM_REP; ++rep_)
    pg8::gemm_phase<Epi, pg8::StaticOrder, true, true>(lds, g, S, E);
}

#define XB_TMO      128
#define XB_XCNT(j)  (256  + 64 * (j))
#define XB_XSUB(j)  (1280 + 64 * (j))
#define XB_XGEN(j)  (2304 + 64 * (j))
#define XB_TOP      3328
#define XB_TOPGEN   3392
#define XCD_BAR_WORDS 3456
#define XB_SPIN_CAP (1u << 18)

__device__ __forceinline__ unsigned xb_ld(unsigned* p)              { return __hip_atomic_load(p, __ATOMIC_RELAXED, __HIP_MEMORY_SCOPE_AGENT); }
__device__ __forceinline__ unsigned xb_add(unsigned* p, unsigned v) { return __hip_atomic_fetch_add(p, v, __ATOMIC_RELAXED, __HIP_MEMORY_SCOPE_AGENT); }
__device__ __forceinline__ unsigned xb_xcc_id() { return (unsigned)__builtin_amdgcn_s_getreg((3 << 11) | 20) & 0xFu; }
#define XB_SPIN(cond, bar) do { unsigned _sp = 0; while (cond) { __builtin_amdgcn_s_sleep(1); \
    if ((++_sp & 255u) == 0u) { if (xb_ld(&(bar)[XB_TMO])) break; if (_sp > XB_SPIN_CAP) { atomicAdd(&(bar)[XB_TMO], 1u); break; } } } } while (0)

struct XcdBarrier {
    unsigned* bar; unsigned x;
    volatile LAS unsigned* st;
};

__device__ __forceinline__ XcdBarrier xcd_barrier_post(unsigned* bar, volatile LAS unsigned* st) {
    XcdBarrier b; b.bar = bar; b.x = xb_xcc_id(); b.st = st;
    if (threadIdx.x == 0) (void)xb_add(&bar[XB_XCNT(b.x)], 1u);
    return b;
}
__device__ __forceinline__ void xcd_barrier_complete(unsigned* bar, unsigned x, unsigned& nloc, unsigned& nx) {
    const unsigned G = gridDim.x * gridDim.y * gridDim.z;
    unsigned sum, cnt, mine, sp = 0u;
    for (;;) {
        sum = 0u; cnt = 0u; mine = 0u;
#pragma unroll
        for (unsigned j = 0; j < 16; ++j) { const unsigned c = xb_ld(&bar[XB_XCNT(j)]); sum += c; cnt += (c > 0u) ? 1u : 0u; mine = (j == x) ? c : mine; }
        if (sum == G) break;
        __builtin_amdgcn_s_sleep(1);
        if ((++sp & 255u) == 0u) { if (xb_ld(&bar[XB_TMO])) break; if (sp > XB_SPIN_CAP) { atomicAdd(&bar[XB_TMO], 1u); break; } }
    }
    nloc = mine > 0u ? mine : 1u; nx = cnt > 0u ? cnt : 1u;
}

__device__ __forceinline__ void xcd_barrier(const XcdBarrier& b) {
    asm volatile("s_waitcnt vmcnt(0)" ::: "memory");
    __syncthreads();
    if (threadIdx.x == 0) {
        unsigned* bar = b.bar;
        __builtin_amdgcn_s_waitcnt(0);
        unsigned nloc = b.st[0], nx = b.st[1];
        if (nloc == 0u) { xcd_barrier_complete(bar, b.x, nloc, nx); b.st[0] = nloc; b.st[1] = nx; }
        const unsigned old = xb_add(&bar[XB_XSUB(b.x)], 1u);
        const unsigned gen = old / nloc;
        if (old + 1u == (gen + 1u) * nloc) {
            __builtin_amdgcn_fence(__ATOMIC_RELEASE, "agent");
            asm volatile("s_waitcnt vmcnt(0)" ::: "memory");
            const unsigned og = xb_add(&bar[XB_TOP], 1u);
            const unsigned tg = og / nx;
            if (og + 1u == (tg + 1u) * nx) xb_add(&bar[XB_TOPGEN], 1u);
            else XB_SPIN(xb_ld(&bar[XB_TOPGEN]) == tg, bar);
            __builtin_amdgcn_fence(__ATOMIC_ACQUIRE, "agent");
            xb_add(&bar[XB_XGEN(b.x)], 1u);
            asm volatile("s_waitcnt vmcnt(0)" ::: "memory");
        } else {
            XB_SPIN(xb_ld(&bar[XB_XGEN(b.x)]) == gen, bar);
            __builtin_amdgcn_fence(__ATOMIC_ACQUIRE, "agent");
            asm volatile("s_waitcnt vmcnt(0)" ::: "memory");
        }
    }
    __syncthreads();
}

__device__ __forceinline__ void gbar(unsigned* ctr, int& gen) {
    asm volatile("s_waitcnt vmcnt(0) lgkmcnt(0)" ::: "memory");
    __syncthreads();
    if (threadIdx.x == 0) {
        __builtin_amdgcn_fence(__ATOMIC_RELEASE, "agent");
        asm volatile("s_waitcnt vmcnt(0)" ::: "memory");
        const unsigned target = (unsigned)(gen + 1) * gridDim.x;
        __hip_atomic_fetch_add(ctr, 1u, __ATOMIC_RELAXED, __HIP_MEMORY_SCOPE_AGENT);
        while (__hip_atomic_load(ctr, __ATOMIC_RELAXED, __HIP_MEMORY_SCOPE_AGENT) < target) __builtin_amdgcn_s_sleep(2);
        __builtin_amdgcn_fence(__ATOMIC_ACQUIRE, "agent");
        asm volatile("s_waitcnt vmcnt(0)" ::: "memory");
    }
    __syncthreads();
    ++gen;
}
#define PHASE_BEGIN if (ph >= ph_lo && ph < ph_hi) { int tid = threadIdx.x; asm volatile("" : "+v"(tid)); const int lane = tid & 63, wid = __builtin_amdgcn_readfirstlane(tid >> 6); const int gw = blockIdx.x * 8 + wid, ngw = gridDim.x * 8; (void)lane; (void)gw; (void)ngw;
#define PHASE_END   if (ph + 1 < ph_hi) { if (ph == 0) { grid.sync(); if (threadIdx.x == 0) (void)xb_add(&xbar.bar[XB_XCNT(xbar.x)], 1u); } else xcd_barrier(xbar); } } ++ph;
template <int layer> __device__ __forceinline__ void layer_phases(const Params& P, LAS unsigned char* lds, cg::grid_group& grid, int& ph, const XcdBarrier& xbar, int ph_lo, int ph_hi, bf16_t* W, bf16_t* A, bf16_t* B, bf16_t* C, float* xo, float* xo_s) {
        const float* nw = P.in[11] + layer * 6144;
        if constexpr (layer == 1) {
            PHASE_BEGIN { EpiPlain<0> E{B, 1024, 1.f, RSV}; run_gemm(lds, A, W + W_INC, R, 1024, 1024, E); } PHASE_END
            PHASE_BEGIN for (int rp_ = 0; rp_ < REP_S5; ++rp_) s5_phase(P, lds, 1, wid, lane); PHASE_END
            PHASE_BEGIN for (int rp_ = 0; rp_ < REP_S5; ++rp_) s5_phase(P, lds, 2, wid, lane); PHASE_END
            PHASE_BEGIN { EpiGlu E{C}; run_gemm(lds, B + B_X2, W + W_GLU, R, 2048, 1024, E); } PHASE_END
            PHASE_BEGIN resnorm_phase<1, 0>(C, nullptr, nullptr, A, nw + 1024, RSV, nullptr, gw, ngw, lane); PHASE_END
        }
        PHASE_BEGIN { EpiPlain<0> E{B, 1024, 0.0625f * LOG2E, RSV}; run_gemm(lds, A, W + W_XQ + (size_t)layer * 1048576, R, 1024, 1024, E); } PHASE_END
        PHASE_BEGIN for (int rp_ = 0; rp_ < REP_XA; ++rp_) xattn_phase(P, lds, layer, tid, wid, lane); PHASE_END
        PHASE_BEGIN { EpiPlain<0> E{C, 1024, 1.f, nullptr}; run_gemm(lds, B + B_X2, W + W_XO + (size_t)layer * 1048576, R, 1024, 1024, E); } PHASE_END
        PHASE_BEGIN resnorm_phase<1, 0>(C, nullptr, nullptr, A, nw + 3072, RSV, nullptr, gw, ngw, lane); PHASE_END
        PHASE_BEGIN { EpiPlain<1> E{B, 4096, 1.f, RSV}; run_gemm(lds, A, W + W_UP + (size_t)layer * 4194304, R, 4096, 1024, E); } PHASE_END
        PHASE_BEGIN { EpiPlain<0> E{C, 1024, 1.f, nullptr}; run_gemm(lds, B, W + W_DN + (size_t)layer * 4194304, R, 1024, 4096, E); } PHASE_END
        PHASE_BEGIN { if constexpr (layer == 0) resnorm_phase<1, 0>(C, nullptr, nullptr, A, nw + 5120, RSV, nullptr, gw, ngw, lane); else resnorm_phase<1, 1>(C, nullptr, nullptr, A, nw + 5120, nullptr, xo, gw, ngw, lane); } PHASE_END
    }
__global__ void __launch_bounds__(512) mega_fwd(Params P, int ph_lo, int ph_hi) {
    extern __shared__ __attribute__((aligned(16))) unsigned char lds_raw[];
    LAS unsigned char* lds = (LAS unsigned char*)lds_raw;
    cg::grid_group grid = cg::this_grid();
    bf16_t* W = (bf16_t*)(P.ws + WS_W);
    bf16_t* A = (bf16_t*)(P.ws + WS_A);
    bf16_t* B = (bf16_t*)(P.ws + WS_B);
    bf16_t* C = (bf16_t*)(P.ws + WS_C);
    float* xo = P.out; float* xo_s = P.out + (size_t)RP * 1024;
    int ph = 0;
    unsigned* barw = (unsigned*)(P.ws + 4096);
    if (blockIdx.x == 0) for (int i = threadIdx.x; i < XCD_BAR_WORDS; i += 512) __hip_atomic_store(barw + i, 0u, __ATOMIC_RELAXED, __HIP_MEMORY_SCOPE_AGENT);
    volatile LAS unsigned* bst = (volatile LAS unsigned*)(lds + LDS_BYTES - 64);
    if (threadIdx.x == 0) { bst[0] = 0u; bst[1] = 0u; }
    __syncthreads();
    XcdBarrier xbar; xbar.bar = barw; xbar.x = xb_xcc_id(); xbar.st = bst;

    PHASE_BEGIN for (int rp_ = 0; rp_ < REP_PRO; ++rp_) prologue(P, tid, wid, lane); PHASE_END
    PHASE_BEGIN {
        EpiAB E{B, (bf16_t*)(P.ws + WS_FKS), (bf16_t*)(P.ws + WS_FVTS), P.out, (const float*)(P.ws + WS_ROPE), P.in[13], RSV};
        run_gemm(lds, A, W + W_AB, R, 3840, 1024, E);
        for (int l = 0; l < 2; ++l) {
            EpiMemKV E2{P.out + O_MK, P.out + O_MV, (bf16_t*)(P.ws + WS_MEMK), (bf16_t*)(P.ws + WS_MEMVT), l};
            run_gemm(lds, (const bf16_t*)(P.ws + WS_MEMN) + (size_t)l * 2048 * 1024, W + W_XKV + (size_t)l * 2097152, 2048, 2048, 1024, E2);
        }
    } PHASE_END
    PHASE_BEGIN { for (int rp_ = 0; rp_ < REP_RET; ++rp_) { ret_passA(P, wid, lane); if (blockIdx.x < 16) cumsum_task(P, blockIdx.x * 8 + wid, lane); } } PHASE_END
    PHASE_BEGIN ret_passB(P, tid); PHASE_END
    PHASE_BEGIN {
        LAS float* red = (LAS float*)lds;
        for (int rp_ = 0; rp_ < REP_RET; ++rp_)
        for (int u = blockIdx.x; u < 4096 + 32; u += gridDim.x) { if (u < 4096) ret_unitC<64>(P, red, u >> 7, u & 127, wid, lane); else ret_unitC<32>(P, red, u - 4096, 0, wid, lane); }
        __syncthreads();
        for (int rp_ = 0; rp_ < REP_FOX; ++rp_) { fox_phase(P, lds, tid, wid, lane); __syncthreads(); }
    } PHASE_END
    PHASE_BEGIN { EpiPlain<0> E{C, 1024, 1.f, nullptr}; run_gemm(lds, MIXED, W + W_OUT, R, 1024, 1024, E); } PHASE_END
    PHASE_BEGIN resnorm_phase<0, 0>(C, P.in[0], P.in[1], A, P.in[11] + 1024, RSV, nullptr, gw, ngw, lane); PHASE_END
    layer_phases<0>(P, lds, grid, ph, xbar, ph_lo, ph_hi, W, A, B, C, xo, xo_s);
    layer_phases<1>(P, lds, grid, ph, xbar, ph_lo, ph_hi, W, A, B, C, xo, xo_s);
}

extern "C" void kernel_launch(void* const* d_in, const int* in_sizes, int n_in, void* d_out, int out_size, void* d_ws, size_t ws_size, hipStream_t stream) {
    static int grid = 0;
    if (grid == 0) {
        if (n_in != 33 || (size_t)out_size != O_END || ws_size < WS_END) { fprintf(stderr, "kernel_launch: unexpected shapes n_in %d out %d ws %zu\n", n_in, out_size, ws_size); grid = -1; return; }
        int dev = 0, cus = 0, per_cu = 0;
        hipGetDevice(&dev);
        hipDeviceGetAttribute(&cus, hipDeviceAttributeMultiprocessorCount, dev);
        if (hipFuncSetAttribute((const void*)mega_fwd, hipFuncAttributeMaxDynamicSharedMemorySize, LDS_BYTES) != hipSuccess) { fprintf(stderr, "kernel_launch: hipFuncSetAttribute failed\n"); grid = -1; return; }
        if (hipOccupancyMaxActiveBlocksPerMultiprocessor(&per_cu, (const void*)mega_fwd, 512, LDS_BYTES) != hipSuccess || per_cu < 1) { fprintf(stderr, "kernel_launch: occupancy query %d\n", per_cu); per_cu = 1; (void)hipGetLastError(); }
        grid = cus * per_cu;
    }
    if (grid < 0) return;
    Params p{};
    for (int i = 0; i < 33; ++i) p.in[i] = (const float*)d_in[i];
    p.out = (float*)d_out; p.ws = (unsigned char*)d_ws;
    int lo = 0, hi = 1000;
    void* args[] = {&p, &lo, &hi};
    hipError_t e = hipLaunchCooperativeKernel((const void*)mega_fwd, dim3(grid), dim3(512), args, LDS_BYTES, stream);
    if (e != hipSuccess) fprintf(stderr, "cooperative launch failed: %s (grid %d)\n", hipGetErrorString(e), grid);
}
```

```cpp
#include <hip/hip_runtime.h>
#include <hip/hip_cooperative_groups.h>
#include <cstdio>
#include <cstdint>
namespace cg = cooperative_groups;
namespace pg8 {
#define PG8_LAS __attribute__((address_space(3)))
typedef unsigned short bf16_t;
typedef short bf16x8 __attribute__((ext_vector_type(8)));
typedef float f32x4 __attribute__((ext_vector_type(4)));
typedef unsigned u32x4 __attribute__((ext_vector_type(4)));
constexpr int BM = 256, BK = 64, HALF = 128, HTB = HALF * BK * 2  , STAGE_BYTES = 8 * HTB, NXCD = 8, WGM = 8;

__host__ __device__ __forceinline__ int lds_byte(int r, int c) { const int st = (r >> 4) * 2 + (c >> 5), rr = r & 15, cc = c & 31, ob = rr * 64 + cc * 2; return st * 1024 + (ob ^ (((ob >> 9) & 1) << 5)); }
__host__ __device__ __forceinline__ void stage_rc(int b, int& R, int& C) { const int st = b / 1024, sb = b % 1024, swz = sb ^ (((sb >> 9) & 1) << 5); R = (st >> 1) * 16 + swz / 64; C = (st & 1) * 32 + (swz % 64) / 2; }
__host__ __device__ __forceinline__ int perm32(int rho) { const int n = rho >> 4, i = rho & 15; return 8 * (i >> 2) + 4 * n + (i & 3); }

struct Unit { int pm, pn; };
struct Gemm { const bf16_t* A; const bf16_t* Bt; int M, N, K; };

struct StaticOrder {
    int nM, nN, nwg, G, c;
    __host__ __device__ void init(int M, int N, int G_, int c_) { nM = M / BM; nN = N / BM; nwg = nM * nN; G = G_; c = c_; }
    __host__ __device__ bool next(int i, Unit& u) const {
        const long L = (long)i * G + c; if (L >= nwg) return false;
        int wgid = (int)L; { const int q = nwg / NXCD, r = nwg % NXCD, xcd = wgid % NXCD, off = wgid / NXCD; wgid = (xcd < r ? xcd * (q + 1) : r * (q + 1) + (xcd - r) * q) + off; }
        const int nig = WGM * nN, gid = wgid / nig, fm = gid * WGM, gsz = (nM - fm) < WGM ? (nM - fm) : WGM;
        u.pm = fm + ((wgid % nig) % gsz); u.pn = (wgid % nig) / gsz; return true;
    }
    __device__ __forceinline__ void a_ready(const Unit&) const {}
    __device__ __forceinline__ void done(const Unit&) const {}
};

template <class Epi, class Sched, bool ALIGN_EPI = false, bool SP2 = false>
__device__ __forceinline__ void gemm_phase(PG8_LAS unsigned char* lds, const Gemm g, const Sched& S, const Epi& E) {
    int tid_l = threadIdx.x; asm volatile("" : "+v"(tid_l)); const int tid = tid_l, wid = __builtin_amdgcn_readfirstlane(tid >> 6), lane = tid & 63, wr = wid >> 2, wc = wid & 3, fr = lane & 15, fq = lane >> 4;
    const int K = g.K, nt = K / BK;
    unsigned voffA[2], voffB[2];
#pragma unroll
    for (int i = 0; i < 2; ++i) { int R, C; stage_rc(tid * 16 + i * 8192, R, C); const int Rb = Epi::PERM ? ((R & ~31) + perm32(R & 31)) : R;
        voffA[i] = (unsigned)(R * K + C) * 2u; voffB[i] = (unsigned)(Rb * K + C) * 2u; }
    const size_t kstep = (size_t)(BK * 2);
    const size_t hstep = (size_t)HALF * K * 2;
    const size_t tstep = 2 * hstep;
    const unsigned ldsw = (unsigned)wid * 1024u;
    const int aoff = lds_byte(wr * 64 + fr, fq * 8), boff = lds_byte(wc * 32 + fr, fq * 8);
#define PG8_SA(b, h) (((b) * 2 + (h)) * HTB)
#define PG8_SB(b, h) ((4 + (b) * 2 + (h)) * HTB)
#define PG8_STAGE(bufoff, gbase, voff) do { _Pragma("unroll") for (int _i = 0; _i < 2; ++_i) \
        __builtin_amdgcn_global_load_lds((const unsigned*)((const char*)(gbase) + (voff)[_i]), (PG8_LAS unsigned*)(lds + (bufoff) + ldsw + _i * 8192), 16, 0, 0); } while (0)
#define PG8_LDA(dst, b, h) do { _Pragma("unroll") for (int m = 0; m < 4; ++m) _Pragma("unroll") for (int k = 0; k < 2; ++k) dst[m][k] = *(const PG8_LAS bf16x8*)(lds + PG8_SA(b, h) + aoff + m * 2048 + k * 1024); } while (0)
#define PG8_LDB(dst, b, h) do { _Pragma("unroll") for (int n = 0; n < 2; ++n) _Pragma("unroll") for (int k = 0; k < 2; ++k) dst[n][k] = *(const PG8_LAS bf16x8*)(lds + PG8_SB(b, h) + boff + n * 2048 + k * 1024); } while (0)
#define PG8_MMA(ai, bj, At, Bt) do { __builtin_amdgcn_s_setprio(1); _Pragma("unroll") for (int m = 0; m < 4; ++m) _Pragma("unroll") for (int n = 0; n < 2; ++n) _Pragma("unroll") for (int k = 0; k < 2; ++k) \
        acc[ai][bj][m][n] = __builtin_amdgcn_mfma_f32_16x16x32_bf16(Bt[n][k], At[m][k], acc[ai][bj][m][n], 0, 0, 0); __builtin_amdgcn_s_setprio(0); } while (0)
#define PG8_WAIT_V(n) asm volatile("s_waitcnt vmcnt(" #n ")" ::: "memory")
#define PG8_WAIT_L(n) asm volatile("s_waitcnt lgkmcnt(" #n ")" ::: "memory")
#define PG8_BAR __builtin_amdgcn_s_barrier()
#define PG8_SCHED __builtin_amdgcn_sched_barrier(0)
    Unit cur, nxt; int ui = 0;
    if (!S.next(0, cur)) return;
    f32x4 acc[2][2][4][2];
#pragma unroll
    for (int a = 0; a < 2; ++a)
#pragma unroll
        for (int b = 0; b < 2; ++b)
#pragma unroll
            for (int m = 0; m < 4; ++m)
#pragma unroll
                for (int n = 0; n < 2; ++n) acc[a][b][m][n] = (f32x4){0.f, 0.f, 0.f, 0.f};
    bf16x8 At[4][2], B0[2][2], B1[2][2];
    const char* cA = (const char*)g.A + (size_t)cur.pm * tstep; const char* cB = (const char*)g.Bt + (size_t)cur.pn * tstep;
    S.a_ready(cur);
    if constexpr (SP2) {
        PG8_STAGE(PG8_SB(0, 0), cB, voffB); PG8_STAGE(PG8_SB(0, 1), cB + hstep, voffB); PG8_STAGE(PG8_SA(0, 0), cA, voffA); PG8_STAGE(PG8_SA(0, 1), cA + hstep, voffA);
        if (wr == 1) PG8_BAR;
        PG8_WAIT_V(2); PG8_BAR;
        PG8_STAGE(PG8_SB(1, 0), cB + kstep, voffB); PG8_STAGE(PG8_SA(1, 0), cA + kstep, voffA); PG8_STAGE(PG8_SB(1, 1), cB + hstep + kstep, voffB);
        PG8_WAIT_V(6); PG8_BAR;
    } else {
        PG8_STAGE(PG8_SB(0, 0), cB, voffB); PG8_STAGE(PG8_SA(0, 0), cA, voffA); PG8_STAGE(PG8_SB(0, 1), cB + hstep, voffB); PG8_STAGE(PG8_SA(0, 1), cA + hstep, voffA);
        if (wr == 1) PG8_BAR;
        PG8_WAIT_V(4); PG8_BAR;
        PG8_STAGE(PG8_SB(1, 0), cB + kstep, voffB); PG8_STAGE(PG8_SA(1, 0), cA + kstep, voffA); PG8_STAGE(PG8_SB(1, 1), cB + hstep + kstep, voffB);
        PG8_WAIT_V(6); PG8_BAR;
    }
    for (;;) {
        const bool has_next = S.next(ui + 1, nxt);
        const char* nA = has_next ? (const char*)g.A + (size_t)nxt.pm * tstep : cA; const char* nB = has_next ? (const char*)g.Bt + (size_t)nxt.pn * tstep : cB;
        for (int t = 0; t < nt; t += 2) {
            const bool last = (t == nt - 2);
            const char* a1 = cA + (size_t)(t + 1) * kstep;
            const char* a2 = last ? nA : cA + (size_t)(t + 2) * kstep; const char* b2 = last ? nB : cB + (size_t)(t + 2) * kstep;
            const char* a3 = a2 + kstep; const char* b3 = b2 + kstep;
            if (last && has_next) S.a_ready(nxt);
            if constexpr (SP2) {
            PG8_LDB(B0, 0, 0); PG8_LDB(B1, 0, 1); PG8_SCHED; PG8_LDA(At, 0, 0); PG8_STAGE(PG8_SA(1, 1), a1 + hstep, voffA);
            PG8_WAIT_V(8); PG8_WAIT_L(0); PG8_BAR; PG8_MMA(0, 0, At, B0); PG8_MMA(0, 1, At, B1); PG8_BAR; PG8_SCHED;
            PG8_LDA(At, 0, 1); PG8_STAGE(PG8_SB(0, 0), b2, voffB); PG8_STAGE(PG8_SB(0, 1), b2 + hstep, voffB); PG8_STAGE(PG8_SA(0, 0), a2, voffA);
            PG8_WAIT_V(8); PG8_WAIT_L(0); PG8_BAR; PG8_MMA(1, 0, At, B0); PG8_MMA(1, 1, At, B1); PG8_BAR; PG8_SCHED;
            PG8_LDB(B0, 1, 0); PG8_LDB(B1, 1, 1); PG8_SCHED; PG8_LDA(At, 1, 0); PG8_STAGE(PG8_SA(0, 1), a2 + hstep, voffA);
            PG8_WAIT_V(8); PG8_WAIT_L(0); PG8_BAR; PG8_MMA(0, 0, At, B0); PG8_MMA(0, 1, At, B1); PG8_BAR; PG8_SCHED;
            PG8_LDA(At, 1, 1); PG8_STAGE(PG8_SB(1, 0), b3, voffB); PG8_STAGE(PG8_SB(1, 1), b3 + hstep, voffB); PG8_STAGE(PG8_SA(1, 0), a3, voffA);
            PG8_WAIT_V(8); PG8_WAIT_L(0); PG8_BAR; PG8_MMA(1, 0, At, B0); PG8_MMA(1, 1, At, B1); PG8_BAR; PG8_SCHED;
            } else {
            PG8_LDB(B0, 0, 0); PG8_SCHED; PG8_LDA(At, 0, 0); PG8_STAGE(PG8_SA(1, 1), a1 + hstep, voffA);
            PG8_WAIT_L(8); PG8_BAR; PG8_WAIT_L(0); PG8_MMA(0, 0, At, B0); PG8_BAR; PG8_SCHED;
            PG8_LDB(B1, 0, 1); PG8_STAGE(PG8_SB(0, 0), b2, voffB);
            PG8_BAR; PG8_WAIT_L(0); PG8_MMA(0, 1, At, B1); PG8_BAR;
            PG8_LDA(At, 0, 1); PG8_STAGE(PG8_SA(0, 0), a2, voffA);
            PG8_BAR; PG8_WAIT_L(0); PG8_MMA(1, 0, At, B0); PG8_BAR; PG8_SCHED;
            PG8_STAGE(PG8_SB(0, 1), b2 + hstep, voffB);
            PG8_WAIT_V(6); PG8_BAR; PG8_MMA(1, 1, At, B1); PG8_BAR;
            PG8_LDB(B0, 1, 0); PG8_SCHED; PG8_LDA(At, 1, 0); PG8_STAGE(PG8_SA(0, 1), a2 + hstep, voffA);
            PG8_WAIT_L(8); PG8_BAR; PG8_WAIT_L(0); PG8_MMA(0, 0, At, B0); PG8_BAR; PG8_SCHED;
            PG8_LDB(B1, 1, 1); PG8_STAGE(PG8_SB(1, 0), b3, voffB);
            PG8_BAR; PG8_WAIT_L(0); PG8_MMA(0, 1, At, B1); PG8_BAR;
            PG8_LDA(At, 1, 1); PG8_STAGE(PG8_SA(1, 0), a3, voffA);
            PG8_BAR; PG8_WAIT_L(0); PG8_MMA(1, 0, At, B0); PG8_BAR; PG8_SCHED;
            PG8_STAGE(PG8_SB(1, 1), b3 + hstep, voffB);
            PG8_WAIT_V(6); PG8_BAR; PG8_MMA(1, 1, At, B1); PG8_BAR;
            }
        }
        if constexpr (ALIGN_EPI) { if (wr == 0) PG8_BAR; }
        if constexpr (!Epi::AFTER_DRAIN) { E(acc, cur, wr, wc, fr, fq); S.done(cur); }
        if (!has_next) break;
#pragma unroll
        for (int a = 0; a < 2; ++a)
#pragma unroll
            for (int b = 0; b < 2; ++b)
#pragma unroll
                for (int m = 0; m < 4; ++m)
#pragma unroll
                    for (int n = 0; n < 2; ++n) acc[a][b][m][n] = (f32x4){0.f, 0.f, 0.f, 0.f};
        cur = nxt; cA = nA; cB = nB; ++ui;
        if constexpr (ALIGN_EPI) { if (wr == 1) PG8_BAR; }
    }
    PG8_WAIT_V(0);
    if constexpr (!ALIGN_EPI) { if (wr == 0) PG8_BAR; }
    PG8_BAR;
    if constexpr (Epi::AFTER_DRAIN) { E.fused(acc, cur, wr, wc, fr, fq, lds, wid, lane); S.done(cur); }
#undef PG8_SA
#undef PG8_SB
#undef PG8_STAGE
#undef PG8_LDA
#undef PG8_LDB
#undef PG8_MMA
#undef PG8_WAIT_V
#undef PG8_WAIT_L
#undef PG8_BAR
#undef PG8_SCHED
}
}
#ifndef REP_FOX
#define REP_FOX 1
#endif
#ifndef REP_PRO
#define REP_PRO 1
#endif
#ifndef REP_RET
#define REP_RET 1
#endif
#ifndef REP_XA
#define REP_XA 1
#endif
#ifndef REP_S5
#define REP_S5 1
#endif

#define LAS __attribute__((address_space(3)))
typedef unsigned short bf16_t;
typedef short bf16x8 __attribute__((ext_vector_type(8)));
typedef short s16x4 __attribute__((ext_vector_type(4)));
typedef float f32x4 __attribute__((ext_vector_type(4)));
typedef float f32x2 __attribute__((ext_vector_type(2)));
typedef float f32x16 __attribute__((ext_vector_type(16)));
typedef unsigned u32x4 __attribute__((ext_vector_type(4)));
typedef unsigned u32x2 __attribute__((ext_vector_type(2)));
typedef __bf16 bf16x2_t __attribute__((ext_vector_type(2)));
using pg8::Unit;

__device__ __forceinline__ unsigned pk2(float lo, float hi) { f32x2 v = {lo, hi}; bf16x2_t b = __builtin_convertvector(v, bf16x2_t); return __builtin_bit_cast(unsigned, b); }
__device__ __forceinline__ float bflo(unsigned w) { return __uint_as_float(w << 16); }
__device__ __forceinline__ float bfhi(unsigned w) { return __uint_as_float(w & 0xffff0000u); }
__device__ __forceinline__ bf16_t f2bf(float f) { return (bf16_t)(pk2(f, 0.f) & 0xffffu); }
__device__ __forceinline__ float ex2(float x) { return __builtin_amdgcn_exp2f(x); }
__device__ __forceinline__ float wave_sum(float v) {
#pragma unroll
    for (int o = 1; o < 64; o <<= 1) v += __shfl_xor(v, o);
    return v;
}
#define LDSBAR() asm volatile("s_waitcnt lgkmcnt(0)" ::: "memory")
#define MFMA32(a, b, c) __builtin_amdgcn_mfma_f32_32x32x16_bf16((a), (b), (c), 0, 0, 0)
#define MFMA16(a, b, c) __builtin_amdgcn_mfma_f32_16x16x32_bf16((a), (b), (c), 0, 0, 0)

constexpr int DM = 1024, RP = 65536, RS = 256, R = RP + RS, T = 8192, TS = 32, PAST = 4096, TKS = PAST + TS;
constexpr float LOG2E = 1.4426950408889634f;
constexpr float EPS = 1e-6f;
constexpr size_t O_Y = 0, O_RSP = (size_t)R * 1024, O_RSS = O_RSP + 524288, O_FKP = O_RSS + 524288, O_FVP = O_FKP + (size_t)RP * 512,
                 O_LFP = O_FVP + (size_t)RP * 512, O_FKS = O_LFP + (size_t)RP * 8, O_FVS = O_FKS + 131072, O_LFS = O_FVS + 131072,
                 O_S5RP = O_LFS + 2048, O_S5IP = O_S5RP + 32768, O_S5RS = O_S5IP + 32768, O_S5IS = O_S5RS + 32768, O_MK = O_S5IS + 32768,
                 O_MV = O_MK + 4194304, O_END = O_MV + 4194304;
constexpr size_t MiB = 1u << 20;
constexpr size_t WS_W = 1 * MiB, WS_ROPE = 65 * MiB, WS_C2P = 69 * MiB, WS_C2S = 71 * MiB, WS_MEMN = 73 * MiB, WS_MEMK = 81 * MiB, WS_MEMVT = 97 * MiB,
                 WS_S5T = 113 * MiB, WS_LE = 114 * MiB, WS_KVS = 118 * MiB, WS_A = 120 * MiB, WS_B = 249 * MiB, WS_C = 763 * MiB, WS_FKS = 892 * MiB,
                 WS_FVTS = 925 * MiB, WS_END = 960 * MiB;
constexpr size_t W_AB = 0, W_OUT = W_AB + 3840 * 1024, W_INC = W_OUT + 1048576, W_GLU = W_INC + 1048576, W_XQ = W_GLU + 2097152, W_XKV = W_XQ + 2097152,
                 W_XO = W_XKV + 4194304, W_UP = W_XO + 2097152, W_DN = W_UP + 8388608, W_ENDE = W_DN + 8388608;
static_assert(W_ENDE * 2 <= 64 * MiB, "weights region");
constexpr size_t B_RQ = 0, B_RK = (size_t)R * 512, B_RG = 2 * (size_t)R * 512, B_FQ = 3 * (size_t)R * 512, B_FK = 4 * (size_t)R * 512, B_KT = 5 * (size_t)R * 512,
                 B_VT = B_KT + (size_t)RP * 512, B_FVT = B_VT + (size_t)RP * 512, B_KTS = B_FVT + (size_t)RP * 512, B_VTS = B_KTS + 131072, B_ENDE = B_VTS + 131072;
static_assert(B_ENDE * 2 <= 514 * MiB, "region B");
constexpr size_t B_X2 = 129 * MiB / 2;
constexpr size_t WS_RS = 119 * MiB;
#define RSV ((float*)(P.ws + WS_RS))
#define MIXED ((bf16_t*)P.out)
constexpr int LDS_BYTES = 139264;

struct Params {
    const float* in[33];
    float* out;
    unsigned char* ws;
};

template <int ACT  > struct EpiPlain {
    static constexpr bool PERM = true, AFTER_DRAIN = false;
    bf16_t* O; int ldc; float scale; const float* rs;
    __device__ __forceinline__ void operator()(const f32x4 (&acc)[2][2][4][2], const Unit& u, int wr, int wc, int fr, int fq) const {
        asm volatile("" : "+v"(fr), "+v"(fq));
        bf16_t* base = O + (size_t)(u.pm * 256 + wr * 64 + fr) * ldc + u.pn * 256 + wc * 32 + fq * 8;
#pragma unroll
        for (int ai = 0; ai < 2; ++ai)
#pragma unroll
            for (int m = 0; m < 4; ++m) {
                bf16_t* rp = base + (size_t)(ai * 128 + m * 16) * ldc;
                const float rsc = rs ? rs[u.pm * 256 + wr * 64 + fr + ai * 128 + m * 16] * scale : scale;
#pragma unroll
                for (int bj = 0; bj < 2; ++bj) {
                    f32x4 v0 = acc[ai][bj][m][0] * rsc, v1 = acc[ai][bj][m][1] * rsc;
                    if (ACT == 1) { v0.x = fmaxf(v0.x, 0.f); v0.y = fmaxf(v0.y, 0.f); v0.z = fmaxf(v0.z, 0.f); v0.w = fmaxf(v0.w, 0.f); v0 = v0 * v0;
                                    v1.x = fmaxf(v1.x, 0.f); v1.y = fmaxf(v1.y, 0.f); v1.z = fmaxf(v1.z, 0.f); v1.w = fmaxf(v1.w, 0.f); v1 = v1 * v1; }
                    u32x4 w; w.x = pk2(v0.x, v0.y); w.y = pk2(v0.z, v0.w); w.z = pk2(v1.x, v1.y); w.w = pk2(v1.z, v1.w);
                    *(u32x4*)(rp + bj * 128) = w;
                }
            }
    }
};
struct EpiGlu {
    static constexpr bool PERM = false, AFTER_DRAIN = false;
    bf16_t* O;
    __device__ __forceinline__ void operator()(const f32x4 (&acc)[2][2][4][2], const Unit& u, int wr, int wc, int fr, int fq) const {
        asm volatile("" : "+v"(fr), "+v"(fq));
#pragma unroll
        for (int ai = 0; ai < 2; ++ai)
#pragma unroll
            for (int m = 0; m < 4; ++m) {
                const int row = u.pm * 256 + ai * 128 + wr * 64 + m * 16 + fr;
                bf16_t* rp = O + (size_t)row * 1024 + u.pn * 128 + wc * 32 + fq * 4;
#pragma unroll
                for (int n = 0; n < 2; ++n) {
                    const f32x4 a = acc[ai][0][m][n], g = acc[ai][1][m][n];
                    f32x4 v;
                    v.x = a.x / (1.f + __expf(-g.x)); v.y = a.y / (1.f + __expf(-g.y)); v.z = a.z / (1.f + __expf(-g.z)); v.w = a.w / (1.f + __expf(-g.w));
                    u32x2 w; w.x = pk2(v.x, v.y); w.y = pk2(v.z, v.w);
                    *(u32x2*)(rp + n * 16) = w;
                }
            }
    }
};
struct EpiMemKV {
    static constexpr bool PERM = false, AFTER_DRAIN = false;
    float* oK; float* oV; bf16_t* mk; bf16_t* mvt; int layer;
    __device__ __forceinline__ void operator()(const f32x4 (&acc)[2][2][4][2], const Unit& u, int wr, int wc, int fr, int fq) const {
        asm volatile("" : "+v"(fr), "+v"(fq));
        const bool isv = u.pn >= 4;
#pragma unroll
        for (int ai = 0; ai < 2; ++ai)
#pragma unroll
            for (int m = 0; m < 4; ++m) {
                const int row = u.pm * 256 + ai * 128 + wr * 64 + m * 16 + fr;
                const int b = row >> 8, mm = row & 255;
#pragma unroll
                for (int bj = 0; bj < 2; ++bj)
#pragma unroll
                    for (int n = 0; n < 2; ++n) {
                        const int col = (u.pn & 3) * 256 + bj * 128 + wc * 32 + n * 16 + fq * 4;
                        const f32x4 v = acc[ai][bj][m][n];
                        if (!isv) {
                            *(f32x4*)(oK + ((size_t)layer * 2048 + row) * 1024 + col) = v;
                            u32x2 w; w.x = pk2(v.x, v.y); w.y = pk2(v.z, v.w);
                            *(u32x2*)(mk + ((size_t)(layer * 16 + b) * 256 + mm) * 1024 + col) = w;
                        } else {
                            *(f32x4*)(oV + ((size_t)layer * 2048 + row) * 1024 + col) = v;
                            bf16_t* p = mvt + ((size_t)(layer * 16 + b) * 1024 + col) * 256 + mm;
                            p[0] = f2bf(v.x); p[256] = f2bf(v.y); p[512] = f2bf(v.z); p[768] = f2bf(v.w);
                        }
                    }
            }
    }
};
__device__ __forceinline__ float logsig(float x) { return x >= 0.f ? -log1pf(__expf(-x)) : x - log1pf(__expf(x)); }
struct EpiAB {
    static constexpr bool PERM = false, AFTER_DRAIN = false;
    bf16_t* B;
    bf16_t* fks; bf16_t* fvts;
    float* out; const float* rope; const float* bfox; const float* rs;
    __device__ __forceinline__ void operator()(const f32x4 (&acc)[2][2][4][2], const Unit& u, int wr, int wc, int fr, int fq) const {
        asm volatile("" : "+v"(fr), "+v"(fq));
        switch (u.pn >> 1) {
            case 0: body<0>(acc, u, wr, wc, fr, fq); break; case 1: body<1>(acc, u, wr, wc, fr, fq); break; case 2: body<2>(acc, u, wr, wc, fr, fq); break;
            case 3: body<3>(acc, u, wr, wc, fr, fq); break; case 4: body<4>(acc, u, wr, wc, fr, fq); break; case 5: body<5>(acc, u, wr, wc, fr, fq); break;
            case 6: body<6>(acc, u, wr, wc, fr, fq); break; default: body<7>(acc, u, wr, wc, fr, fq); break;
        }
    }
    template <int sect> __device__ __forceinline__ void body(const f32x4 (&acc)[2][2][4][2], const Unit& u, int wr, int wc, int fr, int fq) const {
        rowgrp<sect, 0, 0>(acc, u, wr, wc, fr, fq); rowgrp<sect, 0, 1>(acc, u, wr, wc, fr, fq); rowgrp<sect, 0, 2>(acc, u, wr, wc, fr, fq); rowgrp<sect, 0, 3>(acc, u, wr, wc, fr, fq);
        rowgrp<sect, 1, 0>(acc, u, wr, wc, fr, fq); rowgrp<sect, 1, 1>(acc, u, wr, wc, fr, fq); rowgrp<sect, 1, 2>(acc, u, wr, wc, fr, fq); rowgrp<sect, 1, 3>(acc, u, wr, wc, fr, fq);
    }
    template <int sect, int ai, int m> __device__ __forceinline__ void rowgrp(const f32x4 (&acc)[2][2][4][2], const Unit& u, int wr, int wc, int fr, int fq) const {
        const int pn = u.pn;
            {
                const int row = u.pm * 256 + ai * 128 + wr * 64 + m * 16 + fr;
                const bool samp = row >= RP;
                const int rr = row - RP;
                const int b = samp ? (rr >> 5) : (row >> 13);
                const int t = samp ? (rr & 31) : (row & 8191);
                const int pos = samp ? PAST + t : t;
                const float rsc = rs[row];
#pragma unroll
                for (int bj = 0; bj < 2; ++bj)
#pragma unroll
                    for (int n = 0; n < 2; ++n) {
                        const int sec = (pn & 1) * 256 + bj * 128 + wc * 32 + n * 16 + fq * 4;
                        f32x4 v = acc[ai][bj][m][n] * rsc;
                        if constexpr (sect <= 1) {
                            const int hd = sec >> 7, w = sec & 127, i0 = w >> 1;
                            const f32x4 cs = *(const f32x4*)(rope + ((size_t)pos * 64 + i0) * 2);
                            f32x4 o;
                            o.x = v.x * cs.x - v.y * cs.y; o.y = v.y * cs.x + v.x * cs.y;
                            o.z = v.z * cs.z - v.w * cs.w; o.w = v.w * cs.z + v.z * cs.w;
                            if constexpr (sect == 0) {
                                u32x2 wv; wv.x = pk2(o.x, o.y); wv.y = pk2(o.z, o.w);
                                *(u32x2*)(B + B_RQ + (size_t)row * 512 + sec) = wv;
                            } else {
                                o = o * 0.08838834764831845f;
                                u32x2 wv; wv.x = pk2(o.x, o.y); wv.y = pk2(o.z, o.w);
                                *(u32x2*)(B + B_RK + (size_t)row * 512 + sec) = wv;
                                const float lg2 = __log2f(1.f - ex2((float)(-5 - hd)));
                                if (!samp) {
                                    const int j = t & 63; const float wk = ex2(lg2 * (float)(63 - j));
                                    bf16_t* p = B + B_KT + ((size_t)((b * 4 + hd) * 128 + (t >> 6)) * 128 + w) * 64 + j;
                                    p[0] = f2bf(o.x * wk); p[64] = f2bf(o.y * wk); p[128] = f2bf(o.z * wk); p[192] = f2bf(o.w * wk);
                                } else {
                                    const float wk = ex2(lg2 * (float)(31 - t));
                                    bf16_t* p = B + B_KTS + ((size_t)(b * 4 + hd) * 128 + w) * 32 + t;
                                    p[0] = f2bf(o.x * wk); p[32] = f2bf(o.y * wk); p[64] = f2bf(o.z * wk); p[96] = f2bf(o.w * wk);
                                }
                            }
                        } else if constexpr (sect == 2) {
                            const int hd = sec >> 7, w = sec & 127;
                            if (!samp) {
                                bf16_t* p = B + B_VT + ((size_t)((b * 4 + hd) * 128 + (t >> 6)) * 128 + w) * 64 + (t & 63);
                                p[0] = f2bf(v.x); p[64] = f2bf(v.y); p[128] = f2bf(v.z); p[192] = f2bf(v.w);
                            } else {
                                bf16_t* p = B + B_VTS + ((size_t)(b * 4 + hd) * 128 + w) * 32 + t;
                                p[0] = f2bf(v.x); p[32] = f2bf(v.y); p[64] = f2bf(v.z); p[96] = f2bf(v.w);
                            }
                        } else if constexpr (sect == 3) {
                            f32x4 o; o.x = v.x / (1.f + __expf(-v.x)); o.y = v.y / (1.f + __expf(-v.y)); o.z = v.z / (1.f + __expf(-v.z)); o.w = v.w / (1.f + __expf(-v.w));
                            u32x2 wv; wv.x = pk2(o.x, o.y); wv.y = pk2(o.z, o.w);
                            *(u32x2*)(B + B_RG + (size_t)row * 512 + sec) = wv;
                        } else if constexpr (sect == 4) {
                            const f32x4 o = v * (0.125f * LOG2E);
                            u32x2 wv; wv.x = pk2(o.x, o.y); wv.y = pk2(o.z, o.w);
                            *(u32x2*)(B + B_FQ + (size_t)row * 512 + sec) = wv;
                        } else if constexpr (sect == 5) {
                            u32x2 wv; wv.x = pk2(v.x, v.y); wv.y = pk2(v.z, v.w);
                            if (!samp) { *(f32x4*)(out + O_FKP + (size_t)row * 512 + sec) = v; *(u32x2*)(B + B_FK + (size_t)row * 512 + sec) = wv; }
                            else { *(f32x4*)(out + O_FKS + (size_t)rr * 512 + sec) = v; *(u32x2*)(fks + ((size_t)b * TKS + PAST + t) * 512 + sec) = wv; }
                        } else if constexpr (sect == 6) {
                            if (!samp) {
                                *(f32x4*)(out + O_FVP + (size_t)row * 512 + sec) = v;
                                bf16_t* p = B + B_FVT + ((size_t)b * 512 + sec) * T + t;
                                p[0] = f2bf(v.x); p[T] = f2bf(v.y); p[2 * T] = f2bf(v.z); p[3 * T] = f2bf(v.w);
                            } else {
                                *(f32x4*)(out + O_FVS + (size_t)rr * 512 + sec) = v;
                                bf16_t* p = fvts + ((size_t)b * 512 + sec) * TKS + PAST + t;
                                p[0] = f2bf(v.x); p[TKS] = f2bf(v.y); p[2 * TKS] = f2bf(v.z); p[3 * TKS] = f2bf(v.w);
                            }
                        } else {
                            if (sec < 8) {
                                const f32x4 bb = *(const f32x4*)(bfox + sec);
                                f32x4 o; o.x = logsig(v.x + bb.x); o.y = logsig(v.y + bb.y); o.z = logsig(v.z + bb.z); o.w = logsig(v.w + bb.w);
                                if (!samp) *(f32x4*)(out + O_LFP + (size_t)row * 8 + sec) = o;
                                else *(f32x4*)(out + O_LFS + (size_t)rr * 8 + sec) = o;
                            }
                        }
                    }
                asm volatile("" ::: "memory");
            }
    }
};

__device__ __forceinline__ void wtrans(const float* __restrict__ src, int K, int Ns, bf16_t* dst, int Nd, int mode, int gtid, int gsz, const float* gk = nullptr) {
    const int nb = Nd >> 3, items = nb * (K >> 6) * 64;
    for (int it = gtid; it < items; it += gsz) {
        const int ln = it & 63, blk = it >> 6;
        const int n = (blk % nb) * 8 + (ln >> 3), k0 = (blk / nb) * 64 + (ln & 7) * 8;
        int col = n; bool z = false;
        if (mode == 1) { if (n < 1024) { const int w = n & 127; col = (n & ~127) + (w >> 1) + 64 * (w & 1); } else if (n >= 3592) z = true; }
        else if (mode == 2) { col = ((n >> 7) & 1) * 1024 + (n >> 8) * 128 + (n & 127); }
        const float* s = src + (size_t)k0 * Ns + (z ? 0 : col);
        float v0 = s[0], v1 = s[(size_t)Ns], v2 = s[2 * (size_t)Ns], v3 = s[3 * (size_t)Ns], v4 = s[4 * (size_t)Ns], v5 = s[5 * (size_t)Ns], v6 = s[6 * (size_t)Ns], v7 = s[7 * (size_t)Ns];
        if (gk) { const f32x4 ga_ = *(const f32x4*)(gk + k0), gb_ = *(const f32x4*)(gk + k0 + 4); v0 *= ga_.x; v1 *= ga_.y; v2 *= ga_.z; v3 *= ga_.w; v4 *= gb_.x; v5 *= gb_.y; v6 *= gb_.z; v7 *= gb_.w; }
        u32x4 o; o.x = pk2(v0, v1); o.y = pk2(v2, v3); o.z = pk2(v4, v5); o.w = pk2(v6, v7);
        if (z) o = (u32x4){0u, 0u, 0u, 0u};
        *(u32x4*)(dst + (size_t)n * K + k0) = o;
    }
}
__device__ __forceinline__ void ttrans(const float* __restrict__ src, int rows, int C, bf16_t* dst, size_t dpitch, int gtid, int gsz) {
    const int cb = C >> 3, items = cb * (rows >> 6) * 64;
    for (int it = gtid; it < items; it += gsz) {
        const int ln = it & 63, blk = it >> 6;
        const int c = (blk % cb) * 8 + (ln >> 3), r0 = (blk / cb) * 64 + (ln & 7) * 8;
        const float* s = src + (size_t)r0 * C + c;
        float v0 = s[0], v1 = s[(size_t)C], v2 = s[2 * (size_t)C], v3 = s[3 * (size_t)C], v4 = s[4 * (size_t)C], v5 = s[5 * (size_t)C], v6 = s[6 * (size_t)C], v7 = s[7 * (size_t)C];
        u32x4 o; o.x = pk2(v0, v1); o.y = pk2(v2, v3); o.z = pk2(v4, v5); o.w = pk2(v6, v7);
        *(u32x4*)(dst + (size_t)c * dpitch + r0) = o;
    }
}
__device__ __forceinline__ void cvt8(const float* __restrict__ s, bf16_t* d) {
    const f32x4 a = *(const f32x4*)s, b = *(const f32x4*)(s + 4);
    u32x4 o; o.x = pk2(a.x, a.y); o.y = pk2(a.z, a.w); o.z = pk2(b.x, b.y); o.w = pk2(b.z, b.w);
    *(u32x4*)d = o;
}
__device__ __forceinline__ void norm_row(const float* xr, const float* g, bf16_t* orow, int lane) {
    f32x4 v[4]; float s = 0.f;
#pragma unroll
    for (int j = 0; j < 4; ++j) { v[j] = ((const f32x4*)xr)[lane + 64 * j]; s += (v[j].x * v[j].x + v[j].y * v[j].y) + (v[j].z * v[j].z + v[j].w * v[j].w); }
    const float rstd = rsqrtf(wave_sum(s) * (1.f / 1024.f) + EPS);
#pragma unroll
    for (int j = 0; j < 4; ++j) { const f32x4 gg = ((const f32x4*)g)[lane + 64 * j]; const f32x4 o = v[j] * rstd * gg; u32x2 w; w.x = pk2(o.x, o.y); w.y = pk2(o.z, o.w); ((u32x2*)orow)[lane + 64 * j] = w; }
}
__device__ __forceinline__ void cvt_row(const float* xr, bf16_t* orow, float* rs, int lane) {
    f32x4 v[4]; float s = 0.f;
#pragma unroll
    for (int j = 0; j < 4; ++j) { v[j] = ((const f32x4*)xr)[lane + 64 * j]; s += (v[j].x * v[j].x + v[j].y * v[j].y) + (v[j].z * v[j].z + v[j].w * v[j].w); }
    const float rstd = rsqrtf(wave_sum(s) * (1.f / 1024.f) + EPS);
#pragma unroll
    for (int j = 0; j < 4; ++j) { u32x2 w; w.x = pk2(v[j].x, v[j].y); w.y = pk2(v[j].z, v[j].w); ((u32x2*)orow)[lane + 64 * j] = w; }
    if (lane == 0) *rs = rstd;
}
struct RnRow { f32x4 x[4]; u32x2 m[4]; };
template <int IN> __device__ __forceinline__ void rn_load(RnRow& r, const bf16_t* mix, const float* xp, const float* xs, const bf16_t* xb, int row, int lane) {
#pragma unroll
    for (int j = 0; j < 4; ++j) {
        if (IN == 0) { const float* xr = row < RP ? xp + (size_t)row * 1024 : xs + (size_t)(row - RP) * 1024; r.x[j] = __builtin_nontemporal_load((const f32x4*)xr + lane + 64 * j); }
        else { const u32x2 w = *((const u32x2*)(xb + (size_t)row * 1024) + lane + 64 * j); r.x[j] = (f32x4){bflo(w.x), bfhi(w.x), bflo(w.y), bfhi(w.y)}; }
        r.m[j] = __builtin_nontemporal_load((const u32x2*)(mix + (size_t)row * 1024) + lane + 64 * j);
    }
}
template <int OUT> __device__ __forceinline__ void rn_proc(const RnRow& r, const float* ga, bf16_t* xb, float* rs, float* yout, int row, int lane) {
    f32x4 xv[4], mv[4]; float s = 0.f;
#pragma unroll
    for (int j = 0; j < 4; ++j) {
        const u32x2 w = r.m[j];
        mv[j] = (f32x4){bflo(w.x), bfhi(w.x), bflo(w.y), bfhi(w.y)};
        s += (mv[j].x * mv[j].x + mv[j].y * mv[j].y) + (mv[j].z * mv[j].z + mv[j].w * mv[j].w);
    }
    const float rm = rsqrtf(wave_sum(s) * (1.f / 1024.f) + EPS);
    float s2 = 0.f;
#pragma unroll
    for (int j = 0; j < 4; ++j) {
        const f32x4 gg = ((const f32x4*)ga)[lane + 64 * j];
        xv[j] = r.x[j] + mv[j] * rm * gg;
        if (OUT == 1) ((f32x4*)(yout + (size_t)row * 1024))[lane + 64 * j] = xv[j];
        else { u32x2 w; w.x = pk2(xv[j].x, xv[j].y); w.y = pk2(xv[j].z, xv[j].w); ((u32x2*)(xb + (size_t)row * 1024))[lane + 64 * j] = w; }
        s2 += (xv[j].x * xv[j].x + xv[j].y * xv[j].y) + (xv[j].z * xv[j].z + xv[j].w * xv[j].w);
    }
    if (OUT == 0) { const float rx = rsqrtf(wave_sum(s2) * (1.f / 1024.f) + EPS); if (lane == 0) rs[row] = rx; }
}
template <int IN, int OUT> __device__ __forceinline__ void resnorm_phase(const bf16_t* mix, const float* xp, const float* xs, bf16_t* xb, const float* ga, float* rs, float* yout, int gw, int ngw, int lane) {
    int row = gw * 2;
    if (row >= R) return;
    RnRow a0, a1, b0, b1;
    rn_load<IN>(a0, mix, xp, xs, xb, row, lane); rn_load<IN>(a1, mix, xp, xs, xb, row + 1, lane);
    for (;;) {
        const int nrow = row + ngw * 2;
        const bool more = nrow < R;
        if (more) { rn_load<IN>(b0, mix, xp, xs, xb, nrow, lane); rn_load<IN>(b1, mix, xp, xs, xb, nrow + 1, lane); }
        rn_proc<OUT>(a0, ga, xb, rs, yout, row, lane); rn_proc<OUT>(a1, ga, xb, rs, yout, row + 1, lane);
        if (!more) break;
        a0 = b0; a1 = b1; row = nrow;
    }
}

__device__ __forceinline__ float ret_lg2(int h) { return __log2f(1.f - ex2((float)(-5 - h))); }
__device__ __forceinline__ void ret_passA(const Params& P, int wid, int lane) {
    bf16_t* B = (bf16_t*)(P.ws + WS_B);
    bf16_t* KV = (bf16_t*)(P.ws + WS_C);
    bf16_t* KVS = (bf16_t*)(P.ws + WS_KVS);
    const int l32 = lane & 31, hh = lane >> 5;
    const int mt = wid >> 1, nt0 = (wid & 1) * 2;
    for (int u = blockIdx.x; u < 4096 + 32; u += gridDim.x) {
        const bool samp = u >= 4096;
        f32x16 d0 = {}, d1 = {};
        if (!samp) {
            const bf16_t* vt = B + B_VT + (size_t)u * 8192; const bf16_t* kt = B + B_KT + (size_t)u * 8192;
#pragma unroll
            for (int ks = 0; ks < 4; ++ks) {
                const bf16x8 a = *(const bf16x8*)(vt + (32 * mt + l32) * 64 + 16 * ks + 8 * hh);
                const bf16x8 b0 = *(const bf16x8*)(kt + (32 * nt0 + l32) * 64 + 16 * ks + 8 * hh);
                const bf16x8 b1 = *(const bf16x8*)(kt + (32 * nt0 + 32 + l32) * 64 + 16 * ks + 8 * hh);
                d0 = MFMA32(a, b0, d0); d1 = MFMA32(a, b1, d1);
            }
            bf16_t* o = KV + (size_t)u * 16384;
#pragma unroll
            for (int r = 0; r < 16; ++r) { const int e = 32 * mt + (r & 3) + 8 * (r >> 2) + 4 * hh; o[e * 128 + 32 * nt0 + l32] = f2bf(d0[r]); o[e * 128 + 32 * nt0 + 32 + l32] = f2bf(d1[r]); }
        } else {
            const int bh = u - 4096, hd = bh & 3;
            const bf16_t* vt = B + B_VTS + (size_t)bh * 4096; const bf16_t* kt = B + B_KTS + (size_t)bh * 4096;
#pragma unroll
            for (int ks = 0; ks < 2; ++ks) {
                const bf16x8 a = *(const bf16x8*)(vt + (32 * mt + l32) * 32 + 16 * ks + 8 * hh);
                const bf16x8 b0 = *(const bf16x8*)(kt + (32 * nt0 + l32) * 32 + 16 * ks + 8 * hh);
                const bf16x8 b1 = *(const bf16x8*)(kt + (32 * nt0 + 32 + l32) * 32 + 16 * ks + 8 * hh);
                d0 = MFMA32(a, b0, d0); d1 = MFMA32(a, b1, d1);
            }
            const float g32 = ex2(ret_lg2(hd) * 32.f);
            const float* s0 = P.in[2] + (size_t)bh * 16384; float* so = P.out + O_RSS + (size_t)bh * 16384; bf16_t* sb = KVS + (size_t)bh * 16384;
#pragma unroll
            for (int r = 0; r < 16; ++r) {
                const int e = 32 * mt + (r & 3) + 8 * (r >> 2) + 4 * hh;
#pragma unroll
                for (int q = 0; q < 2; ++q) {
                    const int dp = 32 * nt0 + 32 * q + l32, d = (dp >> 1) + 64 * (dp & 1);
                    const float s = s0[d * 128 + e];
                    so[d * 128 + e] = s * g32 + (q ? d1[r] : d0[r]);
                    sb[e * 128 + dp] = f2bf(s);
                }
            }
        }
    }
}
__device__ __forceinline__ void ret_passB(const Params& P, int tid) {
    unsigned* KV = (unsigned*)(P.ws + WS_C);
    for (int i = blockIdx.x * 512 + tid; i < 32 * 8192; i += gridDim.x * 512) {
        const int bh = i >> 13, idx = i & 8191;
        const float dec = ex2(ret_lg2(bh & 3) * 64.f);
        unsigned* p = KV + (size_t)bh * 128 * 8192 + idx;
        float s0 = 0.f, s1 = 0.f;
        for (int n0 = 0; n0 < 128; n0 += 16) {
            unsigned v[16];
#pragma unroll
            for (int k = 0; k < 16; ++k) v[k] = p[(size_t)(n0 + k) * 8192];
#pragma unroll
            for (int k = 0; k < 16; ++k) { p[(size_t)(n0 + k) * 8192] = pk2(s0, s1); s0 = s0 * dec + bflo(v[k]); s1 = s1 * dec + bfhi(v[k]); }
        }
        const int e = idx >> 6, dp = (idx & 63) * 2;
        float* so = P.out + O_RSP + (size_t)bh * 16384;
        so[(dp >> 1) * 128 + e] = s0;
        so[((dp >> 1) + 64) * 128 + e] = s1;
    }
}
template <int L> __device__ __forceinline__ void ret_unitC(const Params& P, LAS float* red, int bh, int n, int wid, int lane) {
    const bf16_t* B = (const bf16_t*)(P.ws + WS_B);
    const int l32 = lane & 31, hh = lane >> 5, hd = bh & 3, b = bh >> 2;
    const int et = wid >> 1, it = wid & 1;
    const bool act = (L == 64) || (it == 0);
    const int row0 = (L == 64) ? (b * T + n * 64) : (RP + b * 32);
    const bf16_t* sbef = (L == 64) ? (const bf16_t*)(P.ws + WS_C) + (size_t)(bh * 128 + n) * 16384 : (const bf16_t*)(P.ws + WS_KVS) + (size_t)bh * 16384;
    const bf16_t* vt = (L == 64) ? B + B_VT + (size_t)(bh * 128 + n) * 8192 : B + B_VTS + (size_t)bh * 4096;
    const float lg2 = ret_lg2(hd);
    const int i = 32 * it + l32;
    f32x16 acc = {};
    float s1 = 0.f, s2 = 0.f;
    if (act) {
        bf16x8 qf[8];
#pragma unroll
        for (int ks = 0; ks < 8; ++ks) qf[ks] = *(const bf16x8*)(B + B_RQ + (size_t)(row0 + i) * 512 + hd * 128 + 16 * ks + 8 * hh);
#pragma unroll
        for (int ks = 0; ks < 8; ++ks) { const bf16x8 a = *(const bf16x8*)(sbef + (32 * et + l32) * 128 + 16 * ks + 8 * hh); acc = MFMA32(a, qf[ks], acc); }
        acc = acc * ex2(lg2 * (float)(i + 1));
#pragma unroll
        for (int jt = 0; jt < L / 32; ++jt) {
            f32x16 sc = {};
#pragma unroll
            for (int ks = 0; ks < 8; ++ks) { const bf16x8 a = *(const bf16x8*)(B + B_RK + (size_t)(row0 + 32 * jt + l32) * 512 + hd * 128 + 16 * ks + 8 * hh); sc = MFMA32(a, qf[ks], sc); }
#pragma unroll
            for (int r = 0; r < 16; ++r) { const int j = 32 * jt + (r & 3) + 8 * (r >> 2) + 4 * hh; const int dd = i > j ? i - j : j - i; sc[r] = sc[r] * ex2(lg2 * (float)dd); }
#pragma unroll
            for (int s = 0; s < 2; ++s) {
                u32x4 pw; pw.x = pk2(sc[8 * s], sc[8 * s + 1]); pw.y = pk2(sc[8 * s + 2], sc[8 * s + 3]); pw.z = pk2(sc[8 * s + 4], sc[8 * s + 5]); pw.w = pk2(sc[8 * s + 6], sc[8 * s + 7]);
                const bf16x8 pf = __builtin_bit_cast(bf16x8, pw);
                const bf16_t* vb = vt + (32 * et + l32) * L + 32 * jt + 16 * s + 4 * hh;
                const u32x2 lo = *(const u32x2*)vb, hi = *(const u32x2*)(vb + 8);
                const u32x4 vw = {lo.x, lo.y, hi.x, hi.y};
                acc = MFMA32(__builtin_bit_cast(bf16x8, vw), pf, acc);
            }
        }
#pragma unroll
        for (int r = 0; r < 16; ++r) { s1 += acc[r]; s2 += acc[r] * acc[r]; }
        s1 += __shfl_xor(s1, 32); s2 += __shfl_xor(s2, 32);
        if (hh == 0) { red[et * 64 + i] = s1; red[256 + et * 64 + i] = s2; }
    }
    __syncthreads();
    if (act) {
        const float t1 = red[i] + red[64 + i] + red[128 + i] + red[192 + i];
        const float t2 = red[256 + i] + red[320 + i] + red[384 + i] + red[448 + i];
        const float mu = t1 * (1.f / 128.f), var = fmaxf(t2 * (1.f / 128.f) - mu * mu, 0.f), rstd = rsqrtf(var + EPS);
        const float* gw = P.in[14] + hd * 128;
        bf16_t* mixed = MIXED;
#pragma unroll
        for (int g = 0; g < 4; ++g) {
            const int e = 32 * et + 8 * g + 4 * hh;
            const f32x4 w4 = *(const f32x4*)(gw + e);
            const u32x2 gt = *(const u32x2*)(B + B_RG + (size_t)(row0 + i) * 512 + hd * 128 + e);
            f32x4 o;
            o.x = (acc[4 * g] - mu) * rstd * w4.x * bflo(gt.x); o.y = (acc[4 * g + 1] - mu) * rstd * w4.y * bfhi(gt.x);
            o.z = (acc[4 * g + 2] - mu) * rstd * w4.z * bflo(gt.y); o.w = (acc[4 * g + 3] - mu) * rstd * w4.w * bfhi(gt.y);
            u32x2 w; w.x = pk2(o.x, o.y); w.y = pk2(o.z, o.w);
            *(u32x2*)(mixed + (size_t)(row0 + i) * 1024 + hd * 128 + e) = w;
        }
    }
    __syncthreads();
}

struct FoxUnit { const bf16_t* Q; const bf16_t* K; const bf16_t* VT; const float* c2; bf16_t* O; int vtp, qpos0, nq, ntiles, Tk; };
constexpr int FOX_BUF = 18432, FOX_VOFF = 9216, FOX_COFF = 17920;
__device__ __forceinline__ void fox_unit(LAS unsigned char* lds, const FoxUnit U, int tid, int wid, int lane) {
    const int l32 = lane & 31, hh = lane >> 5;
    const int wrow = wid * 64;
    const bool active = wrow < U.nq;
    const bool act1 = wrow + 32 < U.nq;
    bf16x8 qf[2][4];
#pragma unroll
    for (int qt = 0; qt < 2; ++qt)
#pragma unroll
        for (int s = 0; s < 4; ++s) qf[qt][s] = (qt == 0 ? active : act1) ? *(const bf16x8*)(U.Q + (size_t)(wrow + 32 * qt + l32) * 512 + 16 * s + 8 * hh) : (bf16x8){0, 0, 0, 0, 0, 0, 0, 0};
    const int wq_lo = U.qpos0 + wrow, wq_hi = wq_lo + (act1 ? 63 : 31);
    float mrun[2] = {-INFINITY, -INFINITY}, lrun[2] = {0.f, 0.f};
    f32x16 o0[2] = {{}, {}}, o1[2] = {{}, {}};
    const int srow = tid >> 3, sch = tid & 7;
    u32x4 kr, vr; float cr = 0.f;
#define FOX_LOAD(t) do { int key_ = (t) * 64 + srow; key_ = key_ < U.Tk ? key_ : U.Tk - 1; kr = *(const u32x4*)(U.K + (size_t)key_ * 512 + sch * 8); \
        vr = *(const u32x4*)(U.VT + (size_t)srow * U.vtp + (t) * 64 + sch * 8); \
        if (tid < 64) { int kc_ = (t) * 64 + tid; kc_ = kc_ < U.Tk ? kc_ : U.Tk - 1; cr = U.c2[kc_]; } } while (0)
#define FOX_STORE(bi) do { LAS unsigned char* kb_ = lds + (bi) * FOX_BUF; *(LAS u32x4*)(kb_ + srow * 144 + sch * 16) = kr; \
        *(LAS u32x2*)(kb_ + FOX_VOFF + srow * 136 + sch * 16) = (u32x2){vr.x, vr.y}; *(LAS u32x2*)(kb_ + FOX_VOFF + srow * 136 + sch * 16 + 8) = (u32x2){vr.z, vr.w}; \
        if (tid < 64) *(LAS float*)(kb_ + FOX_COFF + tid * 4) = -cr; } while (0)
    FOX_LOAD(0); FOX_STORE(0);
    __syncthreads();
    for (int t = 0; t < U.ntiles; ++t) {
        const bool more = t + 1 < U.ntiles;
        if (more) FOX_LOAD(t + 1);
        if (active && t * 64 <= wq_hi) {
            LAS unsigned char* kb = lds + (t & 1) * FOX_BUF;
            bf16x8 pf[2][4];
#pragma unroll
            for (int qt = 0; qt < 2; ++qt) {
                __builtin_amdgcn_sched_barrier(0);
                f32x16 p0, p1;
#pragma unroll
                for (int g = 0; g < 4; ++g) {
                    const f32x4 c0 = *(LAS f32x4*)(kb + FOX_COFF + (8 * g + 4 * hh) * 4), c1 = *(LAS f32x4*)(kb + FOX_COFF + (32 + 8 * g + 4 * hh) * 4);
                    p0[4 * g] = c0.x; p0[4 * g + 1] = c0.y; p0[4 * g + 2] = c0.z; p0[4 * g + 3] = c0.w;
                    p1[4 * g] = c1.x; p1[4 * g + 1] = c1.y; p1[4 * g + 2] = c1.z; p1[4 * g + 3] = c1.w;
                }
#pragma unroll
                for (int s = 0; s < 4; ++s) {
                    const bf16x8 a0 = *(LAS bf16x8*)(kb + l32 * 144 + (2 * s + hh) * 16), a1 = *(LAS bf16x8*)(kb + (32 + l32) * 144 + (2 * s + hh) * 16);
                    p0 = MFMA32(a0, qf[qt][s], p0); p1 = MFMA32(a1, qf[qt][s], p1);
                }
                const int qpos = wq_lo + 32 * qt + l32;
                if (t * 64 + 63 > wq_lo + 32 * qt) {
#pragma unroll
                    for (int r = 0; r < 16; ++r) { const int key = t * 64 + (r & 3) + 8 * (r >> 2) + 4 * hh; if (key > qpos) p0[r] = -INFINITY; if (key + 32 > qpos) p1[r] = -INFINITY; }
                }
                float mx = fmaxf(p0[0], p1[0]);
#pragma unroll
                for (int r = 1; r < 16; ++r) mx = fmaxf(mx, fmaxf(p0[r], p1[r]));
                mx = fmaxf(mx, __shfl_xor(mx, 32));
                const float mn = fmaxf(mrun[qt], mx), alpha = ex2(mrun[qt] - mn); mrun[qt] = mn;
                float rs = 0.f;
#pragma unroll
                for (int r = 0; r < 16; ++r) { p0[r] = ex2(p0[r] - mn); p1[r] = ex2(p1[r] - mn); rs += p0[r] + p1[r]; }
                lrun[qt] = lrun[qt] * alpha + rs; o0[qt] = o0[qt] * alpha; o1[qt] = o1[qt] * alpha;
#pragma unroll
                for (int s = 0; s < 4; ++s) {
                    u32x4 pw;
                    if (s < 2) { pw.x = pk2(p0[8 * s], p0[8 * s + 1]); pw.y = pk2(p0[8 * s + 2], p0[8 * s + 3]); pw.z = pk2(p0[8 * s + 4], p0[8 * s + 5]); pw.w = pk2(p0[8 * s + 6], p0[8 * s + 7]); }
                    else { const int q = 8 * (s - 2); pw.x = pk2(p1[q], p1[q + 1]); pw.y = pk2(p1[q + 2], p1[q + 3]); pw.z = pk2(p1[q + 4], p1[q + 5]); pw.w = pk2(p1[q + 6], p1[q + 7]); }
                    pf[qt][s] = __builtin_bit_cast(bf16x8, pw);
                }
            }
#pragma unroll
            for (int s = 0; s < 4; ++s) {
                LAS unsigned char* vb = kb + FOX_VOFF + l32 * 136 + (16 * s + 4 * hh) * 2;
                const u32x2 a = *(LAS u32x2*)vb, b = *(LAS u32x2*)(vb + 16), c = *(LAS u32x2*)(vb + 32 * 136), d = *(LAS u32x2*)(vb + 32 * 136 + 16);
                const u32x4 v0 = {a.x, a.y, b.x, b.y}, v1 = {c.x, c.y, d.x, d.y};
#pragma unroll
                for (int qt = 0; qt < 2; ++qt) { o0[qt] = MFMA32(__builtin_bit_cast(bf16x8, v0), pf[qt][s], o0[qt]); o1[qt] = MFMA32(__builtin_bit_cast(bf16x8, v1), pf[qt][s], o1[qt]); }
            }
        }
        if (more) FOX_STORE((t + 1) & 1);
        __syncthreads();
    }
#undef FOX_LOAD
#undef FOX_STORE
#pragma unroll
    for (int qt = 0; qt < 2; ++qt) {
        if (qt == 0 ? active : act1) {
            const float inv = 1.f / (lrun[qt] + __shfl_xor(lrun[qt], 32));
            bf16_t* op = U.O + (size_t)(wrow + 32 * qt + l32) * 1024 + 4 * hh;
#pragma unroll
            for (int g = 0; g < 4; ++g) {
                u32x2 w; w.x = pk2(o0[qt][4 * g] * inv, o0[qt][4 * g + 1] * inv); w.y = pk2(o0[qt][4 * g + 2] * inv, o0[qt][4 * g + 3] * inv); *(u32x2*)(op + 8 * g) = w;
                w.x = pk2(o1[qt][4 * g] * inv, o1[qt][4 * g + 1] * inv); w.y = pk2(o1[qt][4 * g + 2] * inv, o1[qt][4 * g + 3] * inv); *(u32x2*)(op + 32 + 8 * g) = w;
            }
        }
    }
}
__device__ __forceinline__ void fox_phase(const Params& P, LAS unsigned char* lds, int tid, int wid, int lane) {
    const bf16_t* B = (const bf16_t*)(P.ws + WS_B);
    bf16_t* mixed = MIXED;
    for (int it2 = 2 * blockIdx.x; it2 < 1024 + 128; it2 += (it2 < 1024) ? (((it2 & 1) == 0) ? 1 : 2 * (int)gridDim.x - 1) : 2 * (int)gridDim.x) {
        FoxUnit U;
        if (it2 < 1024) {
            const int it = it2 >> 1, k = it2 & 1;
            const int bh = it >> 3, pi = it & 7, b = bh >> 3, hd = bh & 7;
            const int qb = k ? 15 - pi : pi;
            U.Q = B + B_FQ + (size_t)(b * T + qb * 512) * 512 + hd * 64; U.K = B + B_FK + (size_t)b * T * 512 + hd * 64;
            U.VT = B + B_FVT + (size_t)(b * 512 + hd * 64) * T; U.c2 = (const float*)(P.ws + WS_C2P) + (size_t)bh * T;
            U.O = mixed + (size_t)(b * T + qb * 512) * 1024 + 512 + hd * 64; U.vtp = T; U.qpos0 = qb * 512; U.nq = 512; U.ntiles = 8 * (qb + 1); U.Tk = T;
        } else {
            const int bh = (it2 - 1024) >> 1;
            const int b = bh >> 3, hd = bh & 7;
            U.Q = B + B_FQ + (size_t)(RP + b * 32) * 512 + hd * 64; U.K = (const bf16_t*)(P.ws + WS_FKS) + (size_t)b * TKS * 512 + hd * 64;
            U.VT = (const bf16_t*)(P.ws + WS_FVTS) + (size_t)(b * 512 + hd * 64) * TKS; U.c2 = (const float*)(P.ws + WS_C2S) + (size_t)bh * TKS;
            U.O = mixed + (size_t)(RP + b * 32) * 1024 + 512 + hd * 64; U.vtp = TKS; U.qpos0 = PAST; U.nq = 32; U.ntiles = 65; U.Tk = TKS;
        }
        int tid_ = tid; asm volatile("" : "+v"(tid_));
        fox_unit(lds, U, tid_, wid, tid_ & 63);
    }
}

constexpr int XA_BUF = 16896;
__device__ __forceinline__ void xattn_unit(LAS unsigned char* lds, const bf16_t* Q, const bf16_t* Kb, const bf16_t* VTb, bf16_t* O, int nwaves, int tid, int wid, int lane) {
    const int l32 = lane & 31, hh = lane >> 5;
    const bool active = wid < nwaves;
    bf16x8 qf[16];
#pragma unroll
    for (int s = 0; s < 16; ++s) qf[s] = active ? *(const bf16x8*)(Q + (size_t)(wid * 32 + l32) * 1024 + 16 * s + 8 * hh) : (bf16x8){0, 0, 0, 0, 0, 0, 0, 0};
    f32x16 S[4];
    bf16x8 pf[16];
    float m1 = 0.f, l1 = 0.f, a1 = 0.f, a2 = 0.f;
    u32x4 r0, r1;
    const int i0 = tid, i1 = tid + 512;
    const bf16_t* g0 = Kb + (size_t)(i0 >> 5) * 1024 + (i0 & 31) * 8; const bf16_t* g1 = Kb + (size_t)(i1 >> 5) * 1024 + (i1 & 31) * 8;
    const bf16_t* h0 = VTb + (size_t)(i0 >> 5) * 256 + (i0 & 31) * 8; const bf16_t* h1 = VTb + (size_t)(i1 >> 5) * 256 + (i1 & 31) * 8;
#define XA_LOAD(tt) do { if ((tt) < 8) { r0 = *(const u32x4*)g0; r1 = *(const u32x4*)g1; g0 += 32 * 1024; g1 += 32 * 1024; asm volatile("" : "+v"(g0), "+v"(g1)); } \
        else { r0 = *(const u32x4*)h0; r1 = *(const u32x4*)h1; h0 += 32 * 256; h1 += 32 * 256; asm volatile("" : "+v"(h0), "+v"(h1)); } } while (0)
#define XA_STORE(bi) do { LAS unsigned char* b_ = lds + (bi) * XA_BUF; *(LAS u32x4*)(b_ + (i0 >> 5) * 528 + (i0 & 31) * 16) = r0; *(LAS u32x4*)(b_ + (i1 >> 5) * 528 + (i1 & 31) * 16) = r1; } while (0)
#define XA_HALF(hf, mm, ll) do { float mx_ = S[0][0]; \
        _Pragma("unroll") for (int k = 0; k < 4; ++k) _Pragma("unroll") for (int r = 0; r < 16; ++r) mx_ = fmaxf(mx_, S[k][r]); \
        mx_ = fmaxf(mx_, __shfl_xor(mx_, 32)); float l_ = 0.f; \
        _Pragma("unroll") for (int k = 0; k < 4; ++k) { \
            _Pragma("unroll") for (int r = 0; r < 16; ++r) { S[k][r] = ex2(S[k][r] - mx_); l_ += S[k][r]; } \
            _Pragma("unroll") for (int s = 0; s < 2; ++s) { u32x4 pw; pw.x = pk2(S[k][8 * s], S[k][8 * s + 1]); pw.y = pk2(S[k][8 * s + 2], S[k][8 * s + 3]); pw.z = pk2(S[k][8 * s + 4], S[k][8 * s + 5]); pw.w = pk2(S[k][8 * s + 6], S[k][8 * s + 7]); \
                pf[8 * (hf) + 2 * k + s] = __builtin_bit_cast(bf16x8, pw); } } \
        mm = mx_; ll = l_ + __shfl_xor(l_, 32); } while (0)
    XA_LOAD(0); XA_STORE(0);
    __syncthreads();
#pragma unroll
    for (int tt = 0; tt < 16; ++tt) {
        if (tt + 1 < 16) XA_LOAD(tt + 1);
        LAS unsigned char* buf = lds + (tt & 1) * XA_BUF;
        if (active) {
            if (tt < 8) {
                f32x16 s = {};
#pragma unroll
                for (int k = 0; k < 16; ++k) { const bf16x8 a = *(LAS bf16x8*)(buf + l32 * 528 + (2 * k + hh) * 16); s = MFMA32(a, qf[k], s); }
                S[tt & 3] = s;
                if (tt == 3) XA_HALF(0, m1, l1);
                if (tt == 7) {
                    float m2, l2; XA_HALF(1, m2, l2);
                    const float mm = fmaxf(m1, m2); a1 = ex2(m1 - mm); a2 = ex2(m2 - mm);
                    const float inv = 1.f / (a1 * l1 + a2 * l2); a1 *= inv; a2 *= inv;
                }
            } else {
                f32x16 o1 = {}, o2 = {};
#pragma unroll
                for (int k = 0; k < 16; ++k) {
                    LAS unsigned char* vb = buf + l32 * 528 + (16 * k + 4 * hh) * 2;
                    const u32x2 a = *(LAS u32x2*)vb, b = *(LAS u32x2*)(vb + 16);
                    const u32x4 vw = {a.x, a.y, b.x, b.y};
                    if (k < 8) o1 = MFMA32(__builtin_bit_cast(bf16x8, vw), pf[k], o1); else o2 = MFMA32(__builtin_bit_cast(bf16x8, vw), pf[k], o2);
                }
                bf16_t* op = O + (size_t)(wid * 32 + l32) * 1024 + 32 * (tt - 8) + 4 * hh;
#pragma unroll
                for (int g = 0; g < 4; ++g) { u32x2 w; w.x = pk2(o1[4 * g] * a1 + o2[4 * g] * a2, o1[4 * g + 1] * a1 + o2[4 * g + 1] * a2); w.y = pk2(o1[4 * g + 2] * a1 + o2[4 * g + 2] * a2, o1[4 * g + 3] * a1 + o2[4 * g + 3] * a2); *(u32x2*)(op + 8 * g) = w; }
            }
        }
        if (tt + 1 < 16) XA_STORE((tt + 1) & 1);
        __syncthreads();
    }
#undef XA_HALF
#undef XA_LOAD
#undef XA_STORE
}
__device__ __forceinline__ void xattn_phase(const Params& P, LAS unsigned char* lds, int layer, int tid, int wid, int lane) {
    const bf16_t* XQ = (const bf16_t*)(P.ws + WS_B);
    bf16_t* XO = (bf16_t*)(P.ws + WS_B) + B_X2;
    const bf16_t* MK = (const bf16_t*)(P.ws + WS_MEMK); const bf16_t* MVT = (const bf16_t*)(P.ws + WS_MEMVT);
    for (int it = blockIdx.x; it < 1024 + 32; it += gridDim.x) {
        int row0, set, hd, nw;
        if (it < 1024) { const int pm = it >> 2; hd = it & 3; row0 = pm * 256; set = layer * 16 + (pm >> 5); nw = 8; }
        else { const int q = it - 1024, b = q >> 2; hd = q & 3; row0 = RP + b * 32; set = layer * 16 + 8 + b; nw = 1; }
        xattn_unit(lds, XQ + (size_t)row0 * 1024 + hd * 256, MK + (size_t)set * 262144 + hd * 256, MVT + ((size_t)set * 1024 + hd * 256) * 256, XO + (size_t)row0 * 1024 + hd * 256, nw, tid, wid, lane);
    }
}

__device__ __forceinline__ void s5_run(LAS unsigned char* wl, const bf16_t* U, bf16_t* Y, int row0, int L, int g, f32x2 a, float& xr, float& xi, bool outp,
                                       const bf16_t* SB5, const bf16_t* SC5, const float* s5d, int lane) {
    const int l32 = lane & 31, hh = lane >> 5, l16 = lane & 15, q4 = lane >> 4;
    bf16x8 bfr[4], cfr[4];
#pragma unroll
    for (int k = 0; k < 4; ++k) { bfr[k] = *(const bf16x8*)(SB5 + ((size_t)(g * 4 + k) * 64 + lane) * 8); cfr[k] = *(const bf16x8*)(SC5 + ((size_t)(g * 4 + k) * 64 + lane) * 8); }
    const f32x4 dv = *(const f32x4*)(s5d + g * 16 + 4 * q4);
    for (int sc = 0; sc < L / 32; ++sc) {
        const int r0 = row0 + sc * 32;
        const bf16x8 uf = *(const bf16x8*)(U + (size_t)(r0 + l32) * 1024 + g * 16 + 8 * hh);
        const f32x16 z = {};
        const f32x16 d0 = MFMA32(uf, bfr[0], z), d1 = MFMA32(uf, bfr[1], z), d2 = MFMA32(uf, bfr[2], z), d3 = MFMA32(uf, bfr[3], z);
#pragma unroll
        for (int r = 0; r < 16; ++r) {
            const int tok = (r & 3) + 8 * (r >> 2) + 4 * hh;
            *(LAS f32x2*)(wl + tok * 528 + l32 * 8) = (f32x2){d0[r], d2[r]};
            *(LAS f32x2*)(wl + tok * 528 + (32 + l32) * 8) = (f32x2){d1[r], d3[r]};
        }
        LDSBAR();
#pragma unroll
        for (int t0 = 0; t0 < 32; t0 += 8) {
            f32x2 bu[8]; float xo_[8];
#pragma unroll
            for (int k = 0; k < 8; ++k) bu[k] = *(LAS f32x2*)(wl + (t0 + k) * 528 + lane * 8);
            LDSBAR();
#pragma unroll
            for (int k = 0; k < 8; ++k) {
                const float nr = a.x * xr - a.y * xi + bu[k].x, ni = a.x * xi + a.y * xr + bu[k].y;
                xr = nr; xi = ni; xo_[k] = __uint_as_float(pk2(xr, xi));
            }
            if (outp) {
#pragma unroll
                for (int k = 0; k < 8; ++k) *(LAS float*)(wl + (t0 + k) * 528 + lane * 4) = xo_[k];
            }
        }
        LDSBAR();
        if (outp) {
#pragma unroll
            for (int tb = 0; tb < 2; ++tb) {
                f32x4 acc = {0.f, 0.f, 0.f, 0.f};
#pragma unroll
                for (int ks = 0; ks < 4; ++ks) { const bf16x8 xf = *(LAS bf16x8*)(wl + (16 * tb + l16) * 528 + (32 * ks + 8 * q4) * 2); acc = MFMA16(cfr[ks], xf, acc); }
                const size_t off = (size_t)(r0 + 16 * tb + l16) * 1024 + g * 16 + 4 * q4;
                const u32x2 uu = *(const u32x2*)(U + off);
                f32x4 y; y.x = acc.x + dv.x * bflo(uu.x); y.y = acc.y + dv.y * bfhi(uu.x); y.z = acc.z + dv.z * bflo(uu.y); y.w = acc.w + dv.w * bfhi(uu.y);
                u32x2 w; w.x = pk2(y.x, y.y); w.y = pk2(y.z, y.w);
                *(u32x2*)(Y + off) = w;
            }
        }
        LDSBAR();
    }
}
constexpr int S5_NSEG = 16, S5_LSEG = 512;
__device__ __forceinline__ void s5_phase(const Params& P, LAS unsigned char* lds, int pass, int wid, int lane) {
    const bf16_t* U = (const bf16_t*)(P.ws + WS_B);
    bf16_t* Y = (bf16_t*)(P.ws + WS_B) + B_X2;
    const f32x2* S5A = (const f32x2*)(P.ws + WS_S5T); const f32x2* S5AL = S5A + 4096;
    const bf16_t* SB5 = (const bf16_t*)(P.ws + WS_S5T + 65536); const bf16_t* SC5 = SB5 + 131072;
    f32x2* LE = (f32x2*)(P.ws + WS_LE);
    LAS unsigned char* wl = lds + wid * 16896;
    const int nunits = (pass == 1) ? 8 * (S5_NSEG - 1) * 8 : 8 * S5_NSEG * 8 + 64;
    for (int it = blockIdx.x; it < nunits; it += gridDim.x) {
        if (pass == 1) {
            const int g8 = it & 7, seg = (it >> 3) % (S5_NSEG - 1), b = (it >> 3) / (S5_NSEG - 1), g = g8 * 8 + wid;
            float xr = 0.f, xi = 0.f;
            s5_run(wl, U, Y, b * T + seg * S5_LSEG, S5_LSEG, g, S5A[g * 64 + lane], xr, xi, false, SB5, SC5, P.in[24], lane);
            LE[((size_t)(b * S5_NSEG + seg) * 64 + g) * 64 + lane] = (f32x2){xr, xi};
        } else if (it < 8 * S5_NSEG * 8) {
            const int g8 = it & 7, seg = (it >> 3) & (S5_NSEG - 1), b = it >> 7, g = g8 * 8 + wid;
            const f32x2 aL = S5AL[g * 64 + lane];
            float xr = 0.f, xi = 0.f;
            for (int s = 0; s < seg; ++s) { const f32x2 le = LE[((size_t)(b * S5_NSEG + s) * 64 + g) * 64 + lane]; const float nr = aL.x * xr - aL.y * xi + le.x, ni = aL.x * xi + aL.y * xr + le.y; xr = nr; xi = ni; }
            s5_run(wl, U, Y, b * T + seg * S5_LSEG, S5_LSEG, g, S5A[g * 64 + lane], xr, xi, true, SB5, SC5, P.in[24], lane);
            if (seg == S5_NSEG - 1) { P.out[O_S5RP + (size_t)(b * 64 + g) * 64 + lane] = xr; P.out[O_S5IP + (size_t)(b * 64 + g) * 64 + lane] = xi; }
        } else {
            const int q = it - 8 * S5_NSEG * 8, g8 = q & 7, b = q >> 3, g = g8 * 8 + wid;
            float xr = P.in[6][(size_t)(b * 64 + g) * 64 + lane], xi = P.in[7][(size_t)(b * 64 + g) * 64 + lane];
            s5_run(wl, U, Y, RP + b * 32, 32, g, S5A[g * 64 + lane], xr, xi, true, SB5, SC5, P.in[24], lane);
            P.out[O_S5RS + (size_t)(b * 64 + g) * 64 + lane] = xr; P.out[O_S5IS + (size_t)(b * 64 + g) * 64 + lane] = xi;
        }
    }
}

__device__ __forceinline__ void prologue(const Params& P, int tid, int wid, int lane) {
    const int gtid = blockIdx.x * 512 + tid, gsz = gridDim.x * 512;
    const int gw = blockIdx.x * 8 + wid, ngw = gridDim.x * 8;
    bf16_t* W = (bf16_t*)(P.ws + WS_W);
    wtrans(P.in[12], 1024, 3592, W + W_AB, 3840, 1, gtid, gsz, P.in[11]);
    wtrans(P.in[15], 1024, 1024, W + W_OUT, 1024, 0, gtid, gsz);
    wtrans(P.in[16], 1024, 1024, W + W_INC, 1024, 0, gtid, gsz, P.in[11] + 6144);
    wtrans(P.in[25], 1024, 2048, W + W_GLU, 2048, 2, gtid, gsz);
    for (int l = 0; l < 2; ++l) {
        wtrans(P.in[27] + (size_t)l * 1048576, 1024, 1024, W + W_XQ + (size_t)l * 1048576, 1024, 0, gtid, gsz, P.in[11] + l * 6144 + 2048);
        wtrans(P.in[28] + (size_t)l * 1048576, 1024, 1024, W + W_XKV + (size_t)l * 2097152, 1024, 0, gtid, gsz);
        wtrans(P.in[29] + (size_t)l * 1048576, 1024, 1024, W + W_XKV + (size_t)l * 2097152 + 1048576, 1024, 0, gtid, gsz);
        wtrans(P.in[30] + (size_t)l * 1048576, 1024, 1024, W + W_XO + (size_t)l * 1048576, 1024, 0, gtid, gsz);
        wtrans(P.in[31] + (size_t)l * 4194304, 1024, 4096, W + W_UP + (size_t)l * 4194304, 4096, 0, gtid, gsz, P.in[11] + l * 6144 + 4096);
        wtrans(P.in[32] + (size_t)l * 4194304, 4096, 1024, W + W_DN + (size_t)l * 4194304, 1024, 0, gtid, gsz);
    }
    {
        float* rope = (float*)(P.ws + WS_ROPE);
        for (int i = gtid; i < 8192 * 64; i += gsz) {
            const int pos = i >> 6, k = i & 63;
            const double inv = exp2(-(double)k * (13.287712379549449 / 64.0));
            const double ang = (double)pos * inv;
            rope[2 * i] = (float)cos(ang); rope[2 * i + 1] = (float)sin(ang);
        }
    }
    {
        f32x2* S5A = (f32x2*)(P.ws + WS_S5T); f32x2* S5AL = S5A + 4096;
        bf16_t* SB5 = (bf16_t*)(P.ws + WS_S5T + 65536); bf16_t* SC5 = SB5 + 131072;
        for (int i = gtid; i < 4096; i += gsz) {
            const int g = i >> 6, p = i & 63;
            const double lr = P.in[17][i], li = P.in[18][i], dt = exp((double)P.in[19][g]);
            const double mag = exp(lr * dt), ar = mag * cos(li * dt), ai = mag * sin(li * dt);
            S5A[i] = (f32x2){(float)ar, (float)ai};
            const double magL = exp(lr * dt * S5_LSEG);
            S5AL[i] = (f32x2){(float)(magL * cos(li * dt * S5_LSEG)), (float)(magL * sin(li * dt * S5_LSEG))};
            const double den = lr * lr + li * li, nre = ar - 1.0;
            const double fr = (nre * lr + ai * li) / den, fi = (ai * lr - nre * li) / den;
            const float* br = P.in[20] + (size_t)i * 16; const float* bi = P.in[21] + (size_t)i * 16;
#pragma unroll
            for (int part = 0; part < 2; ++part)
#pragma unroll
                for (int h2 = 0; h2 < 2; ++h2) {
                    float v[8];
#pragma unroll
                    for (int k = 0; k < 8; ++k) { const int c = 8 * h2 + k; v[k] = part == 0 ? (float)(fr * br[c] - fi * bi[c]) : (float)(fr * bi[c] + fi * br[c]); }
                    u32x4 o; o.x = pk2(v[0], v[1]); o.y = pk2(v[2], v[3]); o.z = pk2(v[4], v[5]); o.w = pk2(v[6], v[7]);
                    const int kb = 2 * part + (p >> 5), ln = (p & 31) + 32 * h2;
                    *(u32x4*)(SB5 + ((size_t)(g * 4 + kb) * 64 + ln) * 8) = o;
                }
        }
        for (int i = gtid; i < 64 * 4 * 64; i += gsz) {
            const int ln = i & 63, ks = (i >> 6) & 3, g = i >> 8;
            const int c = ln & 15;
            float v[8];
#pragma unroll
            for (int k = 0; k < 8; ++k) { const int kidx = 32 * ks + 8 * (ln >> 4) + k, p = kidx >> 1; v[k] = (kidx & 1) ? -P.in[23][((size_t)g * 16 + c) * 64 + p] : P.in[22][((size_t)g * 16 + c) * 64 + p]; }
            u32x4 o; o.x = pk2(v[0], v[1]); o.y = pk2(v[2], v[3]); o.z = pk2(v[4], v[5]); o.w = pk2(v[6], v[7]);
            *(u32x4*)(SC5 + (size_t)i * 8) = o;
        }
    }
    {
        bf16_t* FKS = (bf16_t*)(P.ws + WS_FKS); bf16_t* FVTS = (bf16_t*)(P.ws + WS_FVTS);
        for (int i = gtid; i < 8 * PAST * 64; i += gsz) { const int b = i / (PAST * 64), r = i % (PAST * 64); cvt8(P.in[3] + (size_t)i * 8, FKS + (size_t)b * TKS * 512 + (size_t)r * 8); }
        for (int b = 0; b < 8; ++b) ttrans(P.in[4] + (size_t)b * PAST * 512, PAST, 512, FVTS + (size_t)b * 512 * TKS, TKS, gtid, gsz);
        bf16_t* MK = (bf16_t*)(P.ws + WS_MEMK); bf16_t* MVT = (bf16_t*)(P.ws + WS_MEMVT);
        for (int i = gtid; i < 2 * 8 * 32768; i += gsz) { const int lb = i >> 15, r = i & 32767, l = lb >> 3, b = lb & 7; cvt8(P.in[8] + (size_t)i * 8, MK + (size_t)(l * 16 + 8 + b) * 262144 + (size_t)r * 8); }
        for (int lb = 0; lb < 16; ++lb) { const int l = lb >> 3, b = lb & 7; ttrans(P.in[9] + (size_t)lb * 262144, 256, 1024, MVT + (size_t)(l * 16 + 8 + b) * 262144, 256, gtid, gsz); }
    }
    {
        bf16_t* H = (bf16_t*)(P.ws + WS_A); bf16_t* MEMN = (bf16_t*)(P.ws + WS_MEMN);
        for (int row = gw; row < R + 4096; row += ngw) {
            if (row < R) { const float* xr = row < RP ? P.in[0] + (size_t)row * 1024 : P.in[1] + (size_t)(row - RP) * 1024; cvt_row(xr, H + (size_t)row * 1024, (float*)(P.ws + WS_RS) + row, lane); }
            else { const int q = row - R, l = q >> 11, r = q & 2047; norm_row(P.in[10] + (size_t)r * 1024, P.in[26] + l * 1024, MEMN + (size_t)q * 1024, lane); }
        }
    }
}
__device__ __forceinline__ void cumsum_task(const Params& P, int q, int lane) {
    const bool samp = q >= 64; const int bh = q & 63, b = bh >> 3, hd = bh & 7;
    const int n = samp ? TKS : T;
    float* dst = samp ? (float*)(P.ws + WS_C2S) + (size_t)bh * TKS : (float*)(P.ws + WS_C2P) + (size_t)bh * T;
    float carry = 0.f;
    for (int base0 = 0; base0 < n; base0 += 512) {
        float vv[8];
#pragma unroll
        for (int k = 0; k < 8; ++k) {
            const int idx = base0 + 64 * k + lane; float v = 0.f;
            if (idx < n) {
                if (!samp) v = P.out[O_LFP + ((size_t)b * T + idx) * 8 + hd];
                else v = idx < PAST ? P.in[5][((size_t)b * PAST + idx) * 8 + hd] : P.out[O_LFS + ((size_t)b * 32 + idx - PAST) * 8 + hd];
            }
            vv[k] = v;
        }
#pragma unroll
        for (int k = 0; k < 8; ++k) {
            const int idx = base0 + 64 * k + lane; float v = vv[k];
#pragma unroll
            for (int o = 1; o < 64; o <<= 1) { const float t = __shfl_up(v, o); if (lane >= o) v += t; }
            if (idx < n) dst[idx] = (carry + v) * LOG2E;
            carry += __shfl(v, 63);
        }
    }
}

template <class Epi> __device__ __forceinline__ void run_gemm(LAS unsigned char* lds, const bf16_t* A, const bf16_t* Bt, int M, int N, int K, const Epi& E) {
    pg8::Gemm g{A, Bt, M, N, K}; pg8::StaticOrder S; S.init(M, N, (int)gridDim.x, (int)blockIdx.x);
#ifndef GEMM_REP
#define GEMM_REP 1
#endif
#pragma unroll 1
    for (int rep_ = 0; rep_ < GEMM_REP; ++rep_)
    pg8::gemm_phase<Epi, pg8::StaticOrder, true, true>(lds, g, S, E);
}

#define XB_TMO      128
#define XB_XCNT(j)  (256  + 64 * (j))
#define XB_XSUB(j)  (1280 + 64 * (j))
#define XB_XGEN(j)  (2304 + 64 * (j))
#define XB_TOP      3328
#define XB_TOPGEN   3392
#define XCD_BAR_WORDS 3456
#define XB_SPIN_CAP (1u << 18)

__device__ __forceinline__ unsigned xb_ld(unsigned* p)              { return __hip_atomic_load(p, __ATOMIC_RELAXED, __HIP_MEMORY_SCOPE_AGENT); }
__device__ __forceinline__ unsigned xb_add(unsigned* p, unsigned v) { return __hip_atomic_fetch_add(p, v, __ATOMIC_RELAXED, __HIP_MEMORY_SCOPE_AGENT); }
__device__ __forceinline__ unsigned xb_xcc_id() { return (unsigned)__builtin_amdgcn_s_getreg((3 << 11) | 20) & 0xFu; }
#define XB_SPIN(cond, bar) do { unsigned _sp = 0; while (cond) { __builtin_amdgcn_s_sleep(1); \
    if ((++_sp & 255u) == 0u) { if (xb_ld(&(bar)[XB_TMO])) break; if (_sp > XB_SPIN_CAP) { atomicAdd(&(bar)[XB_TMO], 1u); break; } } } } while (0)

struct XcdBarrier {
    unsigned* bar; unsigned x;
    volatile LAS unsigned* st;
};

__device__ __forceinline__ XcdBarrier xcd_barrier_post(unsigned* bar, volatile LAS unsigned* st) {
    XcdBarrier b; b.bar = bar; b.x = xb_xcc_id(); b.st = st;
    if (threadIdx.x == 0) (void)xb_add(&bar[XB_XCNT(b.x)], 1u);
    return b;
}
__device__ __forceinline__ void xcd_barrier_complete(unsigned* bar, unsigned x, unsigned& nloc, unsigned& nx) {
    const unsigned G = gridDim.x * gridDim.y * gridDim.z;
    unsigned sum, cnt, mine, sp = 0u;
    for (;;) {
        sum = 0u; cnt = 0u; mine = 0u;
#pragma unroll
        for (unsigned j = 0; j < 16; ++j) { const unsigned c = xb_ld(&bar[XB_XCNT(j)]); sum += c; cnt += (c > 0u) ? 1u : 0u; mine = (j == x) ? c : mine; }
        if (sum == G) break;
        __builtin_amdgcn_s_sleep(1);
        if ((++sp & 255u) == 0u) { if (xb_ld(&bar[XB_TMO])) break; if (sp > XB_SPIN_CAP) { atomicAdd(&bar[XB_TMO], 1u); break; } }
    }
    nloc = mine > 0u ? mine : 1u; nx = cnt > 0u ? cnt : 1u;
}

__device__ __forceinline__ void xcd_barrier(const XcdBarrier& b) {
    asm volatile("s_waitcnt vmcnt(0)" ::: "memory");
    __syncthreads();
    if (threadIdx.x == 0) {
        unsigned* bar = b.bar;
        __builtin_amdgcn_s_waitcnt(0);
        unsigned nloc = b.st[0], nx = b.st[1];
        if (nloc == 0u) { xcd_barrier_complete(bar, b.x, nloc, nx); b.st[0] = nloc; b.st[1] = nx; }
        const unsigned old = xb_add(&bar[XB_XSUB(b.x)], 1u);
        const unsigned gen = old / nloc;
        if (old + 1u == (gen + 1u) * nloc) {
            __builtin_amdgcn_fence(__ATOMIC_RELEASE, "agent");
            asm volatile("s_waitcnt vmcnt(0)" ::: "memory");
            const unsigned og = xb_add(&bar[XB_TOP], 1u);
            const unsigned tg = og / nx;
            if (og + 1u == (tg + 1u) * nx) xb_add(&bar[XB_TOPGEN], 1u);
            else XB_SPIN(xb_ld(&bar[XB_TOPGEN]) == tg, bar);
            __builtin_amdgcn_fence(__ATOMIC_ACQUIRE, "agent");
            xb_add(&bar[XB_XGEN(b.x)], 1u);
            asm volatile("s_waitcnt vmcnt(0)" ::: "memory");
        } else {
            XB_SPIN(xb_ld(&bar[XB_XGEN(b.x)]) == gen, bar);
            __builtin_amdgcn_fence(__ATOMIC_ACQUIRE, "agent");
            asm volatile("s_waitcnt vmcnt(0)" ::: "memory");
        }
    }
    __syncthreads();
}

__device__ __forceinline__ void gbar(unsigned* ctr, int& gen) {
    asm volatile("s_waitcnt vmcnt(0) lgkmcnt(0)" ::: "memory");
    __syncthreads();
    if (threadIdx.x == 0) {
        __builtin_amdgcn_fence(__ATOMIC_RELEASE, "agent");
        asm volatile("s_waitcnt vmcnt(0)" ::: "memory");
        const unsigned target = (unsigned)(gen + 1) * gridDim.x;
        __hip_atomic_fetch_add(ctr, 1u, __ATOMIC_RELAXED, __HIP_MEMORY_SCOPE_AGENT);
        while (__hip_atomic_load(ctr, __ATOMIC_RELAXED, __HIP_MEMORY_SCOPE_AGENT) < target) __builtin_amdgcn_s_sleep(2);
        __builtin_amdgcn_fence(__ATOMIC_ACQUIRE, "agent");
        asm volatile("s_waitcnt vmcnt(0)" ::: "memory");
    }
    __syncthreads();
    ++gen;
}
#define PHASE_BEGIN if (ph >= ph_lo && ph < ph_hi) { int tid = threadIdx.x; asm volatile("" : "+v"(tid)); const int lane = tid & 63, wid = __builtin_amdgcn_readfirstlane(tid >> 6); const int gw = blockIdx.x * 8 + wid, ngw = gridDim.x * 8; (void)lane; (void)gw; (void)ngw;
#define PHASE_END   if (ph + 1 < ph_hi) { if (ph == 0) { grid.sync(); if (threadIdx.x == 0) (void)xb_add(&xbar.bar[XB_XCNT(xbar.x)], 1u); } else xcd_barrier(xbar); } } ++ph;
template <int layer> __device__ __forceinline__ void layer_phases(const Params& P, LAS unsigned char* lds, cg::grid_group& grid, int& ph, const XcdBarrier& xbar, int ph_lo, int ph_hi, bf16_t* W, bf16_t* A, bf16_t* B, bf16_t* C, float* xo, float* xo_s) {
        const float* nw = P.in[11] + layer * 6144;
        if constexpr (layer == 1) {
            PHASE_BEGIN { EpiPlain<0> E{B, 1024, 1.f, RSV}; run_gemm(lds, A, W + W_INC, R, 1024, 1024, E); } PHASE_END
            PHASE_BEGIN for (int rp_ = 0; rp_ < REP_S5; ++rp_) s5_phase(P, lds, 1, wid, lane); PHASE_END
            PHASE_BEGIN for (int rp_ = 0; rp_ < REP_S5; ++rp_) s5_phase(P, lds, 2, wid, lane); PHASE_END
            PHASE_BEGIN { EpiGlu E{C}; run_gemm(lds, B + B_X2, W + W_GLU, R, 2048, 1024, E); } PHASE_END
            PHASE_BEGIN resnorm_phase<1, 0>(C, nullptr, nullptr, A, nw + 1024, RSV, nullptr, gw, ngw, lane); PHASE_END
        }
        PHASE_BEGIN { EpiPlain<0> E{B, 1024, 0.0625f * LOG2E, RSV}; run_gemm(lds, A, W + W_XQ + (size_t)layer * 1048576, R, 1024, 1024, E); } PHASE_END
        PHASE_BEGIN for (int rp_ = 0; rp_ < REP_XA; ++rp_) xattn_phase(P, lds, layer, tid, wid, lane); PHASE_END
        PHASE_BEGIN { EpiPlain<0> E{C, 1024, 1.f, nullptr}; run_gemm(lds, B + B_X2, W + W_XO + (size_t)layer * 1048576, R, 1024, 1024, E); } PHASE_END
        PHASE_BEGIN resnorm_phase<1, 0>(C, nullptr, nullptr, A, nw + 3072, RSV, nullptr, gw, ngw, lane); PHASE_END
        PHASE_BEGIN { EpiPlain<1> E{B, 4096, 1.f, RSV}; run_gemm(lds, A, W + W_UP + (size_t)layer * 4194304, R, 4096, 1024, E); } PHASE_END
        PHASE_BEGIN { EpiPlain<0> E{C, 1024, 1.f, nullptr}; run_gemm(lds, B, W + W_DN + (size_t)layer * 4194304, R, 1024, 4096, E); } PHASE_END
        PHASE_BEGIN { if constexpr (layer == 0) resnorm_phase<1, 0>(C, nullptr, nullptr, A, nw + 5120, RSV, nullptr, gw, ngw, lane); else resnorm_phase<1, 1>(C, nullptr, nullptr, A, nw + 5120, nullptr, xo, gw, ngw, lane); } PHASE_END
    }
__global__ void __launch_bounds__(512) mega_fwd(Params P, int ph_lo, int ph_hi) {
    extern __shared__ __attribute__((aligned(16))) unsigned char lds_raw[];
    LAS unsigned char* lds = (LAS unsigned char*)lds_raw;
    cg::grid_group grid = cg::this_grid();
    bf16_t* W = (bf16_t*)(P.ws + WS_W);
    bf16_t* A = (bf16_t*)(P.ws + WS_A);
    bf16_t* B = (bf16_t*)(P.ws + WS_B);
    bf16_t* C = (bf16_t*)(P.ws + WS_C);
    float* xo = P.out; float* xo_s = P.out + (size_t)RP * 1024;
    int ph = 0;
    unsigned* barw = (unsigned*)(P.ws + 4096);
    if (blockIdx.x == 0) for (int i = threadIdx.x; i < XCD_BAR_WORDS; i += 512) __hip_atomic_store(barw + i, 0u, __ATOMIC_RELAXED, __HIP_MEMORY_SCOPE_AGENT);
    volatile LAS unsigned* bst = (volatile LAS unsigned*)(lds + LDS_BYTES - 64);
    if (threadIdx.x == 0) { bst[0] = 0u; bst[1] = 0u; }
    __syncthreads();
    XcdBarrier xbar; xbar.bar = barw; xbar.x = xb_xcc_id(); xbar.st = bst;

    PHASE_BEGIN for (int rp_ = 0; rp_ < REP_PRO; ++rp_) prologue(P, tid, wid, lane); PHASE_END
    PHASE_BEGIN {
        EpiAB E{B, (bf16_t*)(P.ws + WS_FKS), (bf16_t*)(P.ws + WS_FVTS), P.out, (const float*)(P.ws + WS_ROPE), P.in[13], RSV};
        run_gemm(lds, A, W + W_AB, R, 3840, 1024, E);
        for (int l = 0; l < 2; ++l) {
            EpiMemKV E2{P.out + O_MK, P.out + O_MV, (bf16_t*)(P.ws + WS_MEMK), (bf16_t*)(P.ws + WS_MEMVT), l};
            run_gemm(lds, (const bf16_t*)(P.ws + WS_MEMN) + (size_t)l * 2048 * 1024, W + W_XKV + (size_t)l * 2097152, 2048, 2048, 1024, E2);
        }
    } PHASE_END
    PHASE_BEGIN { for (int rp_ = 0; rp_ < REP_RET; ++rp_) { ret_passA(P, wid, lane); if (blockIdx.x < 16) cumsum_task(P, blockIdx.x * 8 + wid, lane); } } PHASE_END
    PHASE_BEGIN ret_passB(P, tid); PHASE_END
    PHASE_BEGIN {
        LAS float* red = (LAS float*)lds;
        for (int rp_ = 0; rp_ < REP_RET; ++rp_)
        for (int u = blockIdx.x; u < 4096 + 32; u += gridDim.x) { if (u < 4096) ret_unitC<64>(P, red, u >> 7, u & 127, wid, lane); else ret_unitC<32>(P, red, u - 4096, 0, wid, lane); }
        __syncthreads();
        for (int rp_ = 0; rp_ < REP_FOX; ++rp_) { fox_phase(P, lds, tid, wid, lane); __syncthreads(); }
    } PHASE_END
    PHASE_BEGIN { EpiPlain<0> E{C, 1024, 1.f, nullptr}; run_gemm(lds, MIXED, W + W_OUT, R, 1024, 1024, E); } PHASE_END
    PHASE_BEGIN resnorm_phase<0, 0>(C, P.in[0], P.in[1], A, P.in[11] + 1024, RSV, nullptr, gw, ngw, lane); PHASE_END
    layer_phases<0>(P, lds, grid, ph, xbar, ph_lo, ph_hi, W, A, B, C, xo, xo_s);
    layer_phases<1>(P, lds, grid, ph, xbar, ph_lo, ph_hi, W, A, B, C, xo, xo_s);
}

extern "C" void kernel_launch(void* const* d_in, const int* in_sizes, int n_in, void* d_out, int out_size, void* d_ws, size_t ws_size, hipStream_t stream) {
    static int grid = 0;
    if (grid == 0) {
        if (n_in != 33 || (size_t)out_size != O_END || ws_size < WS_END) { fprintf(stderr, "kernel_launch: unexpected shapes n_in %d out %d ws %zu\n", n_in, out_size, ws_size); grid = -1; return; }
        int dev = 0, cus = 0, per_cu = 0;
        hipGetDevice(&dev);
        hipDeviceGetAttribute(&cus, hipDeviceAttributeMultiprocessorCount, dev);
        if (hipFuncSetAttribute((const void*)mega_fwd, hipFuncAttributeMaxDynamicSharedMemorySize, LDS_BYTES) != hipSuccess) { fprintf(stderr, "kernel_launch: hipFuncSetAttribute failed\n"); grid = -1; return; }
        if (hipOccupancyMaxActiveBlocksPerMultiprocessor(&per_cu, (const void*)mega_fwd, 512, LDS_BYTES) != hipSuccess || per_cu < 1) { fprintf(stderr, "kernel_launch: occupancy query %d\n", per_cu); per_cu = 1; (void)hipGetLastError(); }
        grid = cus * per_cu;
    }
    if (grid < 0) return;
    Params p{};
    for (int i = 0; i < 33; ++i) p.in[i] = (const float*)d_in[i];
    p.out = (float*)d_out; p.ws = (unsigned char*)d_ws;
    int lo = 0, hi = 1000;
    void* args[] = {&p, &lo, &hi};
    hipError_t e = hipLaunchCooperativeKernel((const void*)mega_fwd, dim3(grid), dim3(512), args, LDS_BYTES, stream);
    if (e != hipSuccess) fprintf(stderr, "cooperative launch failed: %s (grid %d)\n", hipGetErrorString(e), grid);
}
```

```cpp
#include <hip/hip_runtime.h>
#include <hip/hip_cooperative_groups.h>
#include <cstdio>
#include <cstdint>
namespace cg = cooperative_groups;
namespace pg8 {
#define PG8_LAS __attribute__((address_space(3)))
typedef unsigned short bf16_t;
typedef short bf16x8 __attribute__((ext_vector_type(8)));
typedef float f32x4 __attribute__((ext_vector_type(4)));
typedef unsigned u32x4 __attribute__((ext_vector_type(4)));
constexpr int BM = 256, BK = 64, HALF = 128, HTB = HALF * BK * 2  , STAGE_BYTES = 8 * HTB, NXCD = 8, WGM = 8;

__host__ __device__ __forceinline__ int lds_byte(int r, int c) { const int st = (r >> 4) * 2 + (c >> 5), rr = r & 15, cc = c & 31, ob = rr * 64 + cc * 2; return st * 1024 + (ob ^ (((ob >> 9) & 1) << 5)); }
__host__ __device__ __forceinline__ void stage_rc(int b, int& R, int& C) { const int st = b / 1024, sb = b % 1024, swz = sb ^ (((sb >> 9) & 1) << 5); R = (st >> 1) * 16 + swz / 64; C = (st & 1) * 32 + (swz % 64) / 2; }
__host__ __device__ __forceinline__ int perm32(int rho) { const int n = rho >> 4, i = rho & 15; return 8 * (i >> 2) + 4 * n + (i & 3); }

struct Unit { int pm, pn; };
struct Gemm { const bf16_t* A; const bf16_t* Bt; int M, N, K; };

struct StaticOrder {
    int nM, nN, nwg, G, c;
    __host__ __device__ void init(int M, int N, int G_, int c_) { nM = M / BM; nN = N / BM; nwg = nM * nN; G = G_; c = c_; }
    __host__ __device__ bool next(int i, Unit& u) const {
        const long L = (long)i * G + c; if (L >= nwg) return false;
        int wgid = (int)L; { const int q = nwg / NXCD, r = nwg % NXCD, xcd = wgid % NXCD, off = wgid / NXCD; wgid = (xcd < r ? xcd * (q + 1) : r * (q + 1) + (xcd - r) * q) + off; }
        const int nig = WGM * nN, gid = wgid / nig, fm = gid * WGM, gsz = (nM - fm) < WGM ? (nM - fm) : WGM;
        u.pm = fm + ((wgid % nig) % gsz); u.pn = (wgid % nig) / gsz; return true;
    }
    __device__ __forceinline__ void a_ready(const Unit&) const {}
    __device__ __forceinline__ void done(const Unit&) const {}
};

template <class Epi, class Sched, bool ALIGN_EPI = false, bool SP2 = false>
__device__ __forceinline__ void gemm_phase(PG8_LAS unsigned char* lds, const Gemm g, const Sched& S, const Epi& E) {
    int tid_l = threadIdx.x; asm volatile("" : "+v"(tid_l)); const int tid = tid_l, wid = __builtin_amdgcn_readfirstlane(tid >> 6), lane = tid & 63, wr = wid >> 2, wc = wid & 3, fr = lane & 15, fq = lane >> 4;
    const int K = g.K, nt = K / BK;
    unsigned voffA[2], voffB[2];
#pragma unroll
    for (int i = 0; i < 2; ++i) { int R, C; stage_rc(tid * 16 + i * 8192, R, C); const int Rb = Epi::PERM ? ((R & ~31) + perm32(R & 31)) : R;
        voffA[i] = (unsigned)(R * K + C) * 2u; voffB[i] = (unsigned)(Rb * K + C) * 2u; }
    const size_t kstep = (size_t)(BK * 2);
    const size_t hstep = (size_t)HALF * K * 2;
    const size_t tstep = 2 * hstep;
    const unsigned ldsw = (unsigned)wid * 1024u;
    const int aoff = lds_byte(wr * 64 + fr, fq * 8), boff = lds_byte(wc * 32 + fr, fq * 8);
#define PG8_SA(b, h) (((b) * 2 + (h)) * HTB)
#define PG8_SB(b, h) ((4 + (b) * 2 + (h)) * HTB)
#define PG8_STAGE(bufoff, gbase, voff) do { _Pragma("unroll") for (int _i = 0; _i < 2; ++_i) \
        __builtin_amdgcn_global_load_lds((const unsigned*)((const char*)(gbase) + (voff)[_i]), (PG8_LAS unsigned*)(lds + (bufoff) + ldsw + _i * 8192), 16, 0, 0); } while (0)
#define PG8_LDA(dst, b, h) do { _Pragma("unroll") for (int m = 0; m < 4; ++m) _Pragma("unroll") for (int k = 0; k < 2; ++k) dst[m][k] = *(const PG8_LAS bf16x8*)(lds + PG8_SA(b, h) + aoff + m * 2048 + k * 1024); } while (0)
#define PG8_LDB(dst, b, h) do { _Pragma("unroll") for (int n = 0; n < 2; ++n) _Pragma("unroll") for (int k = 0; k < 2; ++k) dst[n][k] = *(const PG8_LAS bf16x8*)(lds + PG8_SB(b, h) + boff + n * 2048 + k * 1024); } while (0)
#define PG8_MMA(ai, bj, At, Bt) do { __builtin_amdgcn_s_setprio(1); _Pragma("unroll") for (int m = 0; m < 4; ++m) _Pragma("unroll") for (int n = 0; n < 2; ++n) _Pragma("unroll") for (int k = 0; k < 2; ++k) \
        acc[ai][bj][m][n] = __builtin_amdgcn_mfma_f32_16x16x32_bf16(Bt[n][k], At[m][k], acc[ai][bj][m][n], 0, 0, 0); __builtin_amdgcn_s_setprio(0); } while (0)
#define PG8_WAIT_V(n) asm volatile("s_waitcnt vmcnt(" #n ")" ::: "memory")
#define PG8_WAIT_L(n) asm volatile("s_waitcnt lgkmcnt(" #n ")" ::: "memory")
#define PG8_BAR __builtin_amdgcn_s_barrier()
#define PG8_SCHED __builtin_amdgcn_sched_barrier(0)
    Unit cur, nxt; int ui = 0;
    if (!S.next(0, cur)) return;
    f32x4 acc[2][2][4][2];
#pragma unroll
    for (int a = 0; a < 2; ++a)
#pragma unroll
        for (int b = 0; b < 2; ++b)
#pragma unroll
            for (int m = 0; m < 4; ++m)
#pragma unroll
                for (int n = 0; n < 2; ++n) acc[a][b][m][n] = (f32x4){0.f, 0.f, 0.f, 0.f};
    bf16x8 At[4][2], B0[2][2], B1[2][2];
    const char* cA = (const char*)g.A + (size_t)cur.pm * tstep; const char* cB = (const char*)g.Bt + (size_t)cur.pn * tstep;
    S.a_ready(cur);
    if constexpr (SP2) {
        PG8_STAGE(PG8_SB(0, 0), cB, voffB); PG8_STAGE(PG8_SB(0, 1), cB + hstep, voffB); PG8_STAGE(PG8_SA(0, 0), cA, voffA); PG8_STAGE(PG8_SA(0, 1), cA + hstep, voffA);
        if (wr == 1) PG8_BAR;
        PG8_WAIT_V(2); PG8_BAR;
        PG8_STAGE(PG8_SB(1, 0), cB + kstep, voffB); PG8_STAGE(PG8_SA(1, 0), cA + kstep, voffA); PG8_STAGE(PG8_SB(1, 1), cB + hstep + kstep, voffB);
        PG8_WAIT_V(6); PG8_BAR;
    } else {
        PG8_STAGE(PG8_SB(0, 0), cB, voffB); PG8_STAGE(PG8_SA(0, 0), cA, voffA); PG8_STAGE(PG8_SB(0, 1), cB + hstep, voffB); PG8_STAGE(PG8_SA(0, 1), cA + hstep, voffA);
        if (wr == 1) PG8_BAR;
        PG8_WAIT_V(4); PG8_BAR;
        PG8_STAGE(PG8_SB(1, 0), cB + kstep, voffB); PG8_STAGE(PG8_SA(1, 0), cA + kstep, voffA); PG8_STAGE(PG8_SB(1, 1), cB + hstep + kstep, voffB);
        PG8_WAIT_V(6); PG8_BAR;
    }
    for (;;) {
        const bool has_next = S.next(ui + 1, nxt);
        const char* nA = has_next ? (const char*)g.A + (size_t)nxt.pm * tstep : cA; const char* nB = has_next ? (const char*)g.Bt + (size_t)nxt.pn * tstep : cB;
        for (int t = 0; t < nt; t += 2) {
            const bool last = (t == nt - 2);
            const char* a1 = cA + (size_t)(t + 1) * kstep;
            const char* a2 = last ? nA : cA + (size_t)(t + 2) * kstep; const char* b2 = last ? nB : cB + (size_t)(t + 2) * kstep;
            const char* a3 = a2 + kstep; const char* b3 = b2 + kstep;
            if (last && has_next) S.a_ready(nxt);
            if constexpr (SP2) {
            PG8_LDB(B0, 0, 0); PG8_LDB(B1, 0, 1); PG8_SCHED; PG8_LDA(At, 0, 0); PG8_STAGE(PG8_SA(1, 1), a1 + hstep, voffA);
            PG8_WAIT_V(8); PG8_WAIT_L(0); PG8_BAR; PG8_MMA(0, 0, At, B0); PG8_MMA(0, 1, At, B1); PG8_BAR; PG8_SCHED;
            PG8_LDA(At, 0, 1); PG8_STAGE(PG8_SB(0, 0), b2, voffB); PG8_STAGE(PG8_SB(0, 1), b2 + hstep, voffB); PG8_STAGE(PG8_SA(0, 0), a2, voffA);
            PG8_WAIT_V(8); PG8_WAIT_L(0); PG8_BAR; PG8_MMA(1, 0, At, B0); PG8_MMA(1, 1, At, B1); PG8_BAR; PG8_SCHED;
            PG8_LDB(B0, 1, 0); PG8_LDB(B1, 1, 1); PG8_SCHED; PG8_LDA(At, 1, 0); PG8_STAGE(PG8_SA(0, 1), a2 + hstep, voffA);
            PG8_WAIT_V(8); PG8_WAIT_L(0); PG8_BAR; PG8_MMA(0, 0, At, B0); PG8_MMA(0, 1, At, B1); PG8_BAR; PG8_SCHED;
            PG8_LDA(At, 1, 1); PG8_STAGE(PG8_SB(1, 0), b3, voffB); PG8_STAGE(PG8_SB(1, 1), b3 + hstep, voffB); PG8_STAGE(PG8_SA(1, 0), a3, voffA);
            PG8_WAIT_V(8); PG8_WAIT_L(0); PG8_BAR; PG8_MMA(1, 0, At, B0); PG8_MMA(1, 1, At, B1); PG8_BAR; PG8_SCHED;
            } else {
            PG8_LDB(B0, 0, 0); PG8_SCHED; PG8_LDA(At, 0, 0); PG8_STAGE(PG8_SA(1, 1), a1 + hstep, voffA);
            PG8_WAIT_L(8); PG8_BAR; PG8_WAIT_L(0); PG8_MMA(0, 0, At, B0); PG8_BAR; PG8_SCHED;
            PG8_LDB(B1, 0, 1); PG8_STAGE(PG8_SB(0, 0), b2, voffB);
            PG8_BAR; PG8_WAIT_L(0); PG8_MMA(0, 1, At, B1); PG8_BAR;
            PG8_LDA(At, 0, 1); PG8_STAGE(PG8_SA(0, 0), a2, voffA);
            PG8_BAR; PG8_WAIT_L(0); PG8_MMA(1, 0, At, B0); PG8_BAR; PG8_SCHED;
            PG8_STAGE(PG8_SB(0, 1), b2 + hstep, voffB);
            PG8_WAIT_V(6); PG8_BAR; PG8_MMA(1, 1, At, B1); PG8_BAR;
            PG8_LDB(B0, 1, 0); PG8_SCHED; PG8_LDA(At, 1, 0); PG8_STAGE(PG8_SA(0, 1), a2 + hstep, voffA);
            PG8_WAIT_L(8); PG8_BAR; PG8_WAIT_L(0); PG8_MMA(0, 0, At, B0); PG8_BAR; PG8_SCHED;
            PG8_LDB(B1, 1, 1); PG8_STAGE(PG8_SB(1, 0), b3, voffB);
            PG8_BAR; PG8_WAIT_L(0); PG8_MMA(0, 1, At, B1); PG8_BAR;
            PG8_LDA(At, 1, 1); PG8_STAGE(PG8_SA(1, 0), a3, voffA);
            PG8_BAR; PG8_WAIT_L(0); PG8_MMA(1, 0, At, B0); PG8_BAR; PG8_SCHED;
            PG8_STAGE(PG8_SB(1, 1), b3 + hstep, voffB);
            PG8_WAIT_V(6); PG8_BAR; PG8_MMA(1, 1, At, B1); PG8_BAR;
            }
        }
        if constexpr (ALIGN_EPI) { if (wr == 0) PG8_BAR; }
        if constexpr (!Epi::AFTER_DRAIN) { E(acc, cur, wr, wc, fr, fq); S.done(cur); }
        if (!has_next) break;
#pragma unroll
        for (int a = 0; a < 2; ++a)
#pragma unroll
            for (int b = 0; b < 2; ++b)
#pragma unroll
                for (int m = 0; m < 4; ++m)
#pragma unroll
                    for (int n = 0; n < 2; ++n) acc[a][b][m][n] = (f32x4){0.f, 0.f, 0.f, 0.f};
        cur = nxt; cA = nA; cB = nB; ++ui;
        if constexpr (ALIGN_EPI) { if (wr == 1) PG8_BAR; }
    }
    PG8_WAIT_V(0);
    if constexpr (!ALIGN_EPI) { if (wr == 0) PG8_BAR; }
    PG8_BAR;
    if constexpr (Epi::AFTER_DRAIN) { E.fused(acc, cur, wr, wc, fr, fq, lds, wid, lane); S.done(cur); }
#undef PG8_SA
#undef PG8_SB
#undef PG8_STAGE
#undef PG8_LDA
#undef PG8_LDB
#undef PG8_MMA
#undef PG8_WAIT_V
#undef PG8_WAIT_L
#undef PG8_BAR
#undef PG8_SCHED
}
}
#ifndef REP_FOX
#define REP_FOX 1
#endif
#ifndef REP_PRO
#define REP_PRO 1
#endif
#ifndef REP_RET
#define REP_RET 1
#endif
#ifndef REP_XA
#define REP_XA 1
#endif
#ifndef REP_S5
#define REP_S5 1
#endif

#define LAS __attribute__((address_space(3)))
typedef unsigned short bf16_t;
typedef short bf16x8 __attribute__((ext_vector_type(8)));
typedef short s16x4 __attribute__((ext_vector_type(4)));
typedef float f32x4 __attribute__((ext_vector_type(4)));
typedef float f32x2 __attribute__((ext_vector_type(2)));
typedef float f32x16 __attribute__((ext_vector_type(16)));
typedef unsigned u32x4 __attribute__((ext_vector_type(4)));
typedef unsigned u32x2 __attribute__((ext_vector_type(2)));
typedef __bf16 bf16x2_t __attribute__((ext_vector_type(2)));
using pg8::Unit;

__device__ __forceinline__ unsigned pk2(float lo, float hi) { f32x2 v = {lo, hi}; bf16x2_t b = __builtin_convertvector(v, bf16x2_t); return __builtin_bit_cast(unsigned, b); }
__device__ __forceinline__ float bflo(unsigned w) { return __uint_as_float(w << 16); }
__device__ __forceinline__ float bfhi(unsigned w) { return __uint_as_float(w & 0xffff0000u); }
__device__ __forceinline__ bf16_t f2bf(float f) { return (bf16_t)(pk2(f, 0.f) & 0xffffu); }
__device__ __forceinline__ float ex2(float x) { return __builtin_amdgcn_exp2f(x); }
__device__ __forceinline__ float wave_sum(float v) {
#pragma unroll
    for (int o = 1; o < 64; o <<= 1) v += __shfl_xor(v, o);
    return v;
}
#define LDSBAR() asm volatile("s_waitcnt lgkmcnt(0)" ::: "memory")
#define MFMA32(a, b, c) __builtin_amdgcn_mfma_f32_32x32x16_bf16((a), (b), (c), 0, 0, 0)
#define MFMA16(a, b, c) __builtin_amdgcn_mfma_f32_16x16x32_bf16((a), (b), (c), 0, 0, 0)

constexpr int DM = 1024, RP = 65536, RS = 256, R = RP + RS, T = 8192, TS = 32, PAST = 4096, TKS = PAST + TS;
constexpr float LOG2E = 1.4426950408889634f;
constexpr float EPS = 1e-6f;
constexpr size_t O_Y = 0, O_RSP = (size_t)R * 1024, O_RSS = O_RSP + 524288, O_FKP = O_RSS + 524288, O_FVP = O_FKP + (size_t)RP * 512,
                 O_LFP = O_FVP + (size_t)RP * 512, O_FKS = O_LFP + (size_t)RP * 8, O_FVS = O_FKS + 131072, O_LFS = O_FVS + 131072,
                 O_S5RP = O_LFS + 2048, O_S5IP = O_S5RP + 32768, O_S5RS = O_S5IP + 32768, O_S5IS = O_S5RS + 32768, O_MK = O_S5IS + 32768,
                 O_MV = O_MK + 4194304, O_END = O_MV + 4194304;
constexpr size_t MiB = 1u << 20;
constexpr size_t WS_W = 1 * MiB, WS_ROPE = 65 * MiB, WS_C2P = 69 * MiB, WS_C2S = 71 * MiB, WS_MEMN = 73 * MiB, WS_MEMK = 81 * MiB, WS_MEMVT = 97 * MiB,
                 WS_S5T = 113 * MiB, WS_LE = 114 * MiB, WS_KVS = 118 * MiB, WS_A = 120 * MiB, WS_B = 249 * MiB, WS_C = 763 * MiB, WS_FKS = 892 * MiB,
                 WS_FVTS = 925 * MiB, WS_END = 960 * MiB;
constexpr size_t W_AB = 0, W_OUT = W_AB + 3840 * 1024, W_INC = W_OUT + 1048576, W_GLU = W_INC + 1048576, W_XQ = W_GLU + 2097152, W_XKV = W_XQ + 2097152,
                 W_XO = W_XKV + 4194304, W_UP = W_XO + 2097152, W_DN = W_UP + 8388608, W_ENDE = W_DN + 8388608;
static_assert(W_ENDE * 2 <= 64 * MiB, "weights region");
constexpr size_t B_RQ = 0, B_RK = (size_t)R * 512, B_RG = 2 * (size_t)R * 512, B_FQ = 3 * (size_t)R * 512, B_FK = 4 * (size_t)R * 512, B_KT = 5 * (size_t)R * 512,
                 B_VT = B_KT + (size_t)RP * 512, B_FVT = B_VT + (size_t)RP * 512, B_KTS = B_FVT + (size_t)RP * 512, B_VTS = B_KTS + 131072, B_ENDE = B_VTS + 131072;
static_assert(B_ENDE * 2 <= 514 * MiB, "region B");
constexpr size_t B_X2 = 129 * MiB / 2;
constexpr size_t WS_RS = 119 * MiB;
#define RSV ((float*)(P.ws + WS_RS))
#define MIXED ((bf16_t*)P.out)
constexpr int LDS_BYTES = 139264;

struct Params {
    const float* in[33];
    float* out;
    unsigned char* ws;
};

template <int ACT  > struct EpiPlain {
    static constexpr bool PERM = true, AFTER_DRAIN = false;
    bf16_t* O; int ldc; float scale; const float* rs;
    __device__ __forceinline__ void operator()(const f32x4 (&acc)[2][2][4][2], const Unit& u, int wr, int wc, int fr, int fq) const {
        asm volatile("" : "+v"(fr), "+v"(fq));
        bf16_t* base = O + (size_t)(u.pm * 256 + wr * 64 + fr) * ldc + u.pn * 256 + wc * 32 + fq * 8;
#pragma unroll
        for (int ai = 0; ai < 2; ++ai)
#pragma unroll
            for (int m = 0; m < 4; ++m) {
                bf16_t* rp = base + (size_t)(ai * 128 + m * 16) * ldc;
                const float rsc = rs ? rs[u.pm * 256 + wr * 64 + fr + ai * 128 + m * 16] * scale : scale;
#pragma unroll
                for (int bj = 0; bj < 2; ++bj) {
                    f32x4 v0 = acc[ai][bj][m][0] * rsc, v1 = acc[ai][bj][m][1] * rsc;
                    if (ACT == 1) { v0.x = fmaxf(v0.x, 0.f); v0.y = fmaxf(v0.y, 0.f); v0.z = fmaxf(v0.z, 0.f); v0.w = fmaxf(v0.w, 0.f); v0 = v0 * v0;
                                    v1.x = fmaxf(v1.x, 0.f); v1.y = fmaxf(v1.y, 0.f); v1.z = fmaxf(v1.z, 0.f); v1.w = fmaxf(v1.w, 0.f); v1 = v1 * v1; }
                    u32x4 w; w.x = pk2(v0.x, v0.y); w.y = pk2(v0.z, v0.w); w.z = pk2(v1.x, v1.y); w.w = pk2(v1.z, v1.w);
                    *(u32x4*)(rp + bj * 128) = w;
                }
            }
    }
};
struct EpiGlu {
    static constexpr bool PERM = false, AFTER_DRAIN = false;
    bf16_t* O;
    __device__ __forceinline__ void operator()(const f32x4 (&acc)[2][2][4][2], const Unit& u, int wr, int wc, int fr, int fq) const {
        asm volatile("" : "+v"(fr), "+v"(fq));
#pragma unroll
        for (int ai = 0; ai < 2; ++ai)
#pragma unroll
            for (int m = 0; m < 4; ++m) {
                const int row = u.pm * 256 + ai * 128 + wr * 64 + m * 16 + fr;
                bf16_t* rp = O + (size_t)row * 1024 + u.pn * 128 + wc * 32 + fq * 4;
#pragma unroll
                for (int n = 0; n < 2; ++n) {
                    const f32x4 a = acc[ai][0][m][n], g = acc[ai][1][m][n];
                    f32x4 v;
                    v.x = a.x / (1.f + __expf(-g.x)); v.y = a.y / (1.f + __expf(-g.y)); v.z = a.z / (1.f + __expf(-g.z)); v.w = a.w / (1.f + __expf(-g.w));
                    u32x2 w; w.x = pk2(v.x, v.y); w.y = pk2(v.z, v.w);
                    *(u32x2*)(rp + n * 16) = w;
                }
            }
    }
};
struct EpiMemKV {
    static constexpr bool PERM = false, AFTER_DRAIN = false;
    float* oK; float* oV; bf16_t* mk; bf16_t* mvt; int layer;
    __device__ __forceinline__ void operator()(const f32x4 (&acc)[2][2][4][2], const Unit& u, int wr, int wc, int fr, int fq) const {
        asm volatile("" : "+v"(fr), "+v"(fq));
        const bool isv = u.pn >= 4;
#pragma unroll
        for (int ai = 0; ai < 2; ++ai)
#pragma unroll
            for (int m = 0; m < 4; ++m) {
                const int row = u.pm * 256 + ai * 128 + wr * 64 + m * 16 + fr;
                const int b = row >> 8, mm = row & 255;
#pragma unroll
                for (int bj = 0; bj < 2; ++bj)
#pragma unroll
                    for (int n = 0; n < 2; ++n) {
                        const int col = (u.pn & 3) * 256 + bj * 128 + wc * 32 + n * 16 + fq * 4;
                        const f32x4 v = acc[ai][bj][m][n];
                        if (!isv) {
                            *(f32x4*)(oK + ((size_t)layer * 2048 + row) * 1024 + col) = v;
                            u32x2 w; w.x = pk2(v.x, v.y); w.y = pk2(v.z, v.w);
                            *(u32x2*)(mk + ((size_t)(layer * 16 + b) * 256 + mm) * 1024 + col) = w;
                        } else {
                            *(f32x4*)(oV + ((size_t)layer * 2048 + row) * 1024 + col) = v;
                            bf16_t* p = mvt + ((size_t)(layer * 16 + b) * 1024 + col) * 256 + mm;
                            p[0] = f2bf(v.x); p[256] = f2bf(v.y); p[512] = f2bf(v.z); p[768] = f2bf(v.w);
                        }
                    }
            }
    }
};
__device__ __forceinline__ float logsig(float x) { return x >= 0.f ? -log1pf(__expf(-x)) : x - log1pf(__expf(x)); }
struct EpiAB {
    static constexpr bool PERM = false, AFTER_DRAIN = false;
    bf16_t* B;
    bf16_t* fks; bf16_t* fvts;
    float* out; const float* rope; const float* bfox; const float* rs;
    __device__ __forceinline__ void operator()(const f32x4 (&acc)[2][2][4][2], const Unit& u, int wr, int wc, int fr, int fq) const {
        asm volatile("" : "+v"(fr), "+v"(fq));
        switch (u.pn >> 1) {
            case 0: body<0>(acc, u, wr, wc, fr, fq); break; case 1: body<1>(acc, u, wr, wc, fr, fq); break; case 2: body<2>(acc, u, wr, wc, fr, fq); break;
            case 3: body<3>(acc, u, wr, wc, fr, fq); break; case 4: body<4>(acc, u, wr, wc, fr, fq); break; case 5: body<5>(acc, u, wr, wc, fr, fq); break;
            case 6: body<6>(acc, u, wr, wc, fr, fq); break; default: body<7>(acc, u, wr, wc, fr, fq); break;
        }
    }
    template <int sect> __device__ __forceinline__ void body(const f32x4 (&acc)[2][2][4][2], const Unit& u, int wr, int wc, int fr, int fq) const {
        rowgrp<sect, 0, 0>(acc, u, wr, wc, fr, fq); rowgrp<sect, 0, 1>(acc, u, wr, wc, fr, fq); rowgrp<sect, 0, 2>(acc, u, wr, wc, fr, fq); rowgrp<sect, 0, 3>(acc, u, wr, wc, fr, fq);
        rowgrp<sect, 1, 0>(acc, u, wr, wc, fr, fq); rowgrp<sect, 1, 1>(acc, u, wr, wc, fr, fq); rowgrp<sect, 1, 2>(acc, u, wr, wc, fr, fq); rowgrp<sect, 1, 3>(acc, u, wr, wc, fr, fq);
    }
    template <int sect, int ai, int m> __device__ __forceinline__ void rowgrp(const f32x4 (&acc)[2][2][4][2], const Unit& u, int wr, int wc, int fr, int fq) const {
        const int pn = u.pn;
            {
                const int row = u.pm * 256 + ai * 128 + wr * 64 + m * 16 + fr;
                const bool samp = row >= RP;
                const int rr = row - RP;
                const int b = samp ? (rr >> 5) : (row >> 13);
                const int t = samp ? (rr & 31) : (row & 8191);
                const int pos = samp ? PAST + t : t;
                const float rsc = rs[row];
#pragma unroll
                for (int bj = 0; bj < 2; ++bj)
#pragma unroll
                    for (int n = 0; n < 2; ++n) {
                        const int sec = (pn & 1) * 256 + bj * 128 + wc * 32 + n * 16 + fq * 4;
                        f32x4 v = acc[ai][bj][m][n] * rsc;
                        if constexpr (sect <= 1) {
                            const int hd = sec >> 7, w = sec & 127, i0 = w >> 1;
                            const f32x4 cs = *(const f32x4*)(rope + ((size_t)pos * 64 + i0) * 2);
                            f32x4 o;
                            o.x = v.x * cs.x - v.y * cs.y; o.y = v.y * cs.x + v.x * cs.y;
                            o.z = v.z * cs.z - v.w * cs.w; o.w = v.w * cs.z + v.z * cs.w;
                            if constexpr (sect == 0) {
                                u32x2 wv; wv.x = pk2(o.x, o.y); wv.y = pk2(o.z, o.w);
                                *(u32x2*)(B + B_RQ + (size_t)row * 512 + sec) = wv;
                            } else {
                                o = o * 0.08838834764831845f;
                                u32x2 wv; wv.x = pk2(o.x, o.y); wv.y = pk2(o.z, o.w);
                                *(u32x2*)(B + B_RK + (size_t)row * 512 + sec) = wv;
                                const float lg2 = __log2f(1.f - ex2((float)(-5 - hd)));
                                if (!samp) {
                                    const int j = t & 63; const float wk = ex2(lg2 * (float)(63 - j));
                                    bf16_t* p = B + B_KT + ((size_t)((b * 4 + hd) * 128 + (t >> 6)) * 128 + w) * 64 + j;
                                    p[0] = f2bf(o.x * wk); p[64] = f2bf(o.y * wk); p[128] = f2bf(o.z * wk); p[192] = f2bf(o.w * wk);
                                } else {
                                    const float wk = ex2(lg2 * (float)(31 - t));
                                    bf16_t* p = B + B_KTS + ((size_t)(b * 4 + hd) * 128 + w) * 32 + t;
                                    p[0] = f2bf(o.x * wk); p[32] = f2bf(o.y * wk); p[64] = f2bf(o.z * wk); p[96] = f2bf(o.w * wk);
                                }
                            }
                        } else if constexpr (sect == 2) {
                            const int hd = sec >> 7, w = sec & 127;
                            if (!samp) {
                                bf16_t* p = B + B_VT + ((size_t)((b * 4 + hd) * 128 + (t >> 6)) * 128 + w) * 64 + (t & 63);
                                p[0] = f2bf(v.x); p[64] = f2bf(v.y); p[128] = f2bf(v.z); p[192] = f2bf(v.w);
                            } else {
                                bf16_t* p = B + B_VTS + ((size_t)(b * 4 + hd) * 128 + w) * 32 + t;
                                p[0] = f2bf(v.x); p[32] = f2bf(v.y); p[64] = f2bf(v.z); p[96] = f2bf(v.w);
                            }
                        } else if constexpr (sect == 3) {
                            f32x4 o; o.x = v.x / (1.f + __expf(-v.x)); o.y = v.y / (1.f + __expf(-v.y)); o.z = v.z / (1.f + __expf(-v.z)); o.w = v.w / (1.f + __expf(-v.w));
                            u32x2 wv; wv.x = pk2(o.x, o.y); wv.y = pk2(o.z, o.w);
                            *(u32x2*)(B + B_RG + (size_t)row * 512 + sec) = wv;
                        } else if constexpr (sect == 4) {
                            const f32x4 o = v * (0.125f * LOG2E);
                            u32x2 wv; wv.x = pk2(o.x, o.y); wv.y = pk2(o.z, o.w);
                            *(u32x2*)(B + B_FQ + (size_t)row * 512 + sec) = wv;
                        } else if constexpr (sect == 5) {
                            u32x2 wv; wv.x = pk2(v.x, v.y); wv.y = pk2(v.z, v.w);
                            if (!samp) { *(f32x4*)(out + O_FKP + (size_t)row * 512 + sec) = v; *(u32x2*)(B + B_FK + (size_t)row * 512 + sec) = wv; }
                            else { *(f32x4*)(out + O_FKS + (size_t)rr * 512 + sec) = v; *(u32x2*)(fks + ((size_t)b * TKS + PAST + t) * 512 + sec) = wv; }
                        } else if constexpr (sect == 6) {
                            if (!samp) {
                                *(f32x4*)(out + O_FVP + (size_t)row * 512 + sec) = v;
                                bf16_t* p = B + B_FVT + ((size_t)b * 512 + sec) * T + t;
                                p[0] = f2bf(v.x); p[T] = f2bf(v.y); p[2 * T] = f2bf(v.z); p[3 * T] = f2bf(v.w);
                            } else {
                                *(f32x4*)(out + O_FVS + (size_t)rr * 512 + sec) = v;
                                bf16_t* p = fvts + ((size_t)b * 512 + sec) * TKS + PAST + t;
                                p[0] = f2bf(v.x); p[TKS] = f2bf(v.y); p[2 * TKS] = f2bf(v.z); p[3 * TKS] = f2bf(v.w);
                            }
                        } else {
                            if (sec < 8) {
                                const f32x4 bb = *(const f32x4*)(bfox + sec);
                                f32x4 o; o.x = logsig(v.x + bb.x); o.y = logsig(v.y + bb.y); o.z = logsig(v.z + bb.z); o.w = logsig(v.w + bb.w);
                                if (!samp) *(f32x4*)(out + O_LFP + (size_t)row * 8 + sec) = o;
                                else *(f32x4*)(out + O_LFS + (size_t)rr * 8 + sec) = o;
                            }
                        }
                    }
                asm volatile("" ::: "memory");
            }
    }
};

__device__ __forceinline__ void wtrans(const float* __restrict__ src, int K, int Ns, bf16_t* dst, int Nd, int mode, int gtid, int gsz, const float* gk = nullptr) {
    const int nb = Nd >> 3, items = nb * (K >> 6) * 64;
    for (int it = gtid; it < items; it += gsz) {
        const int ln = it & 63, blk = it >> 6;
        const int n = (blk % nb) * 8 + (ln >> 3), k0 = (blk / nb) * 64 + (ln & 7) * 8;
        int col = n; bool z = false;
        if (mode == 1) { if (n < 1024) { const int w = n & 127; col = (n & ~127) + (w >> 1) + 64 * (w & 1); } else if (n >= 3592) z = true; }
        else if (mode == 2) { col = ((n >> 7) & 1) * 1024 + (n >> 8) * 128 + (n & 127); }
        const float* s = src + (size_t)k0 * Ns + (z ? 0 : col);
        float v0 = s[0], v1 = s[(size_t)Ns], v2 = s[2 * (size_t)Ns], v3 = s[3 * (size_t)Ns], v4 = s[4 * (size_t)Ns], v5 = s[5 * (size_t)Ns], v6 = s[6 * (size_t)Ns], v7 = s[7 * (size_t)Ns];
        if (gk) { const f32x4 ga_ = *(const f32x4*)(gk + k0), gb_ = *(const f32x4*)(gk + k0 + 4); v0 *= ga_.x; v1 *= ga_.y; v2 *= ga_.z; v3 *= ga_.w; v4 *= gb_.x; v5 *= gb_.y; v6 *= gb_.z; v7 *= gb_.w; }
        u32x4 o; o.x = pk2(v0, v1); o.y = pk2(v2, v3); o.z = pk2(v4, v5); o.w = pk2(v6, v7);
        if (z) o = (u32x4){0u, 0u, 0u, 0u};
        *(u32x4*)(dst + (size_t)n * K + k0) = o;
    }
}
__device__ __forceinline__ void ttrans(const float* __restrict__ src, int rows, int C, bf16_t* dst, size_t dpitch, int gtid, int gsz) {
    const int cb = C >> 3, items = cb * (rows >> 6) * 64;
    for (int it = gtid; it < items; it += gsz) {
        const int ln = it & 63, blk = it >> 6;
        const int c = (blk % cb) * 8 + (ln >> 3), r0 = (blk / cb) * 64 + (ln & 7) * 8;
        const float* s = src + (size_t)r0 * C + c;
        float v0 = s[0], v1 = s[(size_t)C], v2 = s[2 * (size_t)C], v3 = s[3 * (size_t)C], v4 = s[4 * (size_t)C], v5 = s[5 * (size_t)C], v6 = s[6 * (size_t)C], v7 = s[7 * (size_t)C];
        u32x4 o; o.x = pk2(v0, v1); o.y = pk2(v2, v3); o.z = pk2(v4, v5); o.w = pk2(v6, v7);
        *(u32x4*)(dst + (size_t)c * dpitch + r0) = o;
    }
}
__device__ __forceinline__ void cvt8(const float* __restrict__ s, bf16_t* d) {
    const f32x4 a = *(const f32x4*)s, b = *(const f32x4*)(s + 4);
    u32x4 o; o.x = pk2(a.x, a.y); o.y = pk2(a.z, a.w); o.z = pk2(b.x, b.y); o.w = pk2(b.z, b.w);
    *(u32x4*)d = o;
}
__device__ __forceinline__ void norm_row(const float* xr, const float* g, bf16_t* orow, int lane) {
    f32x4 v[4]; float s = 0.f;
#pragma unroll
    for (int j = 0; j < 4; ++j) { v[j] = ((const f32x4*)xr)[lane + 64 * j]; s += (v[j].x * v[j].x + v[j].y * v[j].y) + (v[j].z * v[j].z + v[j].w * v[j].w); }
    const float rstd = rsqrtf(wave_sum(s) * (1.f / 1024.f) + EPS);
#pragma unroll
    for (int j = 0; j < 4; ++j) { const f32x4 gg = ((const f32x4*)g)[lane + 64 * j]; const f32x4 o = v[j] * rstd * gg; u32x2 w; w.x = pk2(o.x, o.y); w.y = pk2(o.z, o.w); ((u32x2*)orow)[lane + 64 * j] = w; }
}
__device__ __forceinline__ void cvt_row(const float* xr, bf16_t* orow, float* rs, int lane) {
    f32x4 v[4]; float s = 0.f;
#pragma unroll
    for (int j = 0; j < 4; ++j) { v[j] = ((const f32x4*)xr)[lane + 64 * j]; s += (v[j].x * v[j].x + v[j].y * v[j].y) + (v[j].z * v[j].z + v[j].w * v[j].w); }
    const float rstd = rsqrtf(wave_sum(s) * (1.f / 1024.f) + EPS);
#pragma unroll
    for (int j = 0; j < 4; ++j) { u32x2 w; w.x = pk2(v[j].x, v[j].y); w.y = pk2(v[j].z, v[j].w); ((u32x2*)orow)[lane + 64 * j] = w; }
    if (lane == 0) *rs = rstd;
}
struct RnRow { f32x4 x[4]; u32x2 m[4]; };
template <int IN> __device__ __forceinline__ void rn_load(RnRow& r, const bf16_t* mix, const float* xp, const float* xs, const bf16_t* xb, int row, int lane) {
#pragma unroll
    for (int j = 0; j < 4; ++j) {
        if (IN == 0) { const float* xr = row < RP ? xp + (size_t)row * 1024 : xs + (size_t)(row - RP) * 1024; r.x[j] = __builtin_nontemporal_load((const f32x4*)xr + lane + 64 * j); }
        else { const u32x2 w = *((const u32x2*)(xb + (size_t)row * 1024) + lane + 64 * j); r.x[j] = (f32x4){bflo(w.x), bfhi(w.x), bflo(w.y), bfhi(w.y)}; }
        r.m[j] = __builtin_nontemporal_load((const u32x2*)(mix + (size_t)row * 1024) + lane + 64 * j);
    }
}
template <int OUT> __device__ __forceinline__ void rn_proc(const RnRow& r, const float* ga, bf16_t* xb, float* rs, float* yout, int row, int lane) {
    f32x4 xv[4], mv[4]; float s = 0.f;
#pragma unroll
    for (int j = 0; j < 4; ++j) {
        const u32x2 w = r.m[j];
        mv[j] = (f32x4){bflo(w.x), bfhi(w.x), bflo(w.y), bfhi(w.y)};
        s += (mv[j].x * mv[j].x + mv[j].y * mv[j].y) + (mv[j].z * mv[j].z + mv[j].w * mv[j].w);
    }
    const float rm = rsqrtf(wave_sum(s) * (1.f / 1024.f) + EPS);
    float s2 = 0.f;
#pragma unroll
    for (int j = 0; j < 4; ++j) {
        const f32x4 gg = ((const f32x4*)ga)[lane + 64 * j];
        xv[j] = r.x[j] + mv[j] * rm * gg;
        if (OUT == 1) ((f32x4*)(yout + (size_t)row * 1024))[lane + 64 * j] = xv[j];
        else { u32x2 w; w.x = pk2(xv[j].x, xv[j].y); w.y = pk2(xv[j].z, xv[j].w); ((u32x2*)(xb + (size_t)row * 1024))[lane + 64 * j] = w; }
        s2 += (xv[j].x * xv[j].x + xv[j].y * xv[j].y) + (xv[j].z * xv[j].z + xv[j].w * xv[j].w);
    }
    if (OUT == 0) { const float rx = rsqrtf(wave_sum(s2) * (1.f / 1024.f) + EPS); if (lane == 0) rs[row] = rx; }
}
template <int IN, int OUT> __device__ __forceinline__ void resnorm_phase(const bf16_t* mix, const float* xp, const float* xs, bf16_t* xb, const float* ga, float* rs, float* yout, int gw, int ngw, int lane) {
    int row = gw * 2;
    if (row >= R) return;
    RnRow a0, a1, b0, b1;
    rn_load<IN>(a0, mix, xp, xs, xb, row, lane); rn_load<IN>(a1, mix, xp, xs, xb, row + 1, lane);
    for (;;) {
        const int nrow = row + ngw * 2;
        const bool more = nrow < R;
        if (more) { rn_load<IN>(b0, mix, xp, xs, xb, nrow, lane); rn_load<IN>(b1, mix, xp, xs, xb, nrow + 1, lane); }
        rn_proc<OUT>(a0, ga, xb, rs, yout, row, lane); rn_proc<OUT>(a1, ga, xb, rs, yout, row + 1, lane);
        if (!more) break;
        a0 = b0; a1 = b1; row = nrow;
    }
}

__device__ __forceinline__ float ret_lg2(int h) { return __log2f(1.f - ex2((float)(-5 - h))); }
__device__ __forceinline__ void ret_passA(const Params& P, int wid, int lane) {
    bf16_t* B = (bf16_t*)(P.ws + WS_B);
    bf16_t* KV = (bf16_t*)(P.ws + WS_C);
    bf16_t* KVS = (bf16_t*)(P.ws + WS_KVS);
    const int l32 = lane & 31, hh = lane >> 5;
    const int mt = wid >> 1, nt0 = (wid & 1) * 2;
    for (int u = blockIdx.x; u < 4096 + 32; u += gridDim.x) {
        const bool samp = u >= 4096;
        f32x16 d0 = {}, d1 = {};
        if (!samp) {
            const bf16_t* vt = B + B_VT + (size_t)u * 8192; const bf16_t* kt = B + B_KT + (size_t)u * 8192;
#pragma unroll
            for (int ks = 0; ks < 4; ++ks) {
                const bf16x8 a = *(const bf16x8*)(vt + (32 * mt + l32) * 64 + 16 * ks + 8 * hh);
                const bf16x8 b0 = *(const bf16x8*)(kt + (32 * nt0 + l32) * 64 + 16 * ks + 8 * hh);
                const bf16x8 b1 = *(const bf16x8*)(kt + (32 * nt0 + 32 + l32) * 64 + 16 * ks + 8 * hh);
                d0 = MFMA32(a, b0, d0); d1 = MFMA32(a, b1, d1);
            }
            bf16_t* o = KV + (size_t)u * 16384;
#pragma unroll
            for (int r = 0; r < 16; ++r) { const int e = 32 * mt + (r & 3) + 8 * (r >> 2) + 4 * hh; o[e * 128 + 32 * nt0 + l32] = f2bf(d0[r]); o[e * 128 + 32 * nt0 + 32 + l32] = f2bf(d1[r]); }
        } else {
            const int bh = u - 4096, hd = bh & 3;
            const bf16_t* vt = B + B_VTS + (size_t)bh * 4096; const bf16_t* kt = B + B_KTS + (size_t)bh * 4096;
#pragma unroll
            for (int ks = 0; ks < 2; ++ks) {
                const bf16x8 a = *(const bf16x8*)(vt + (32 * mt + l32) * 32 + 16 * ks + 8 * hh);
                const bf16x8 b0 = *(const bf16x8*)(kt + (32 * nt0 + l32) * 32 + 16 * ks + 8 * hh);
                const bf16x8 b1 = *(const bf16x8*)(kt + (32 * nt0 + 32 + l32) * 32 + 16 * ks + 8 * hh);
                d0 = MFMA32(a, b0, d0); d1 = MFMA32(a, b1, d1);
            }
            const float g32 = ex2(ret_lg2(hd) * 32.f);
            const float* s0 = P.in[2] + (size_t)bh * 16384; float* so = P.out + O_RSS + (size_t)bh * 16384; bf16_t* sb = KVS + (size_t)bh * 16384;
#pragma unroll
            for (int r = 0; r < 16; ++r) {
                const int e = 32 * mt + (r & 3) + 8 * (r >> 2) + 4 * hh;
#pragma unroll
                for (int q = 0; q < 2; ++q) {
                    const int dp = 32 * nt0 + 32 * q + l32, d = (dp >> 1) + 64 * (dp & 1);
                    const float s = s0[d * 128 + e];
                    so[d * 128 + e] = s * g32 + (q ? d1[r] : d0[r]);
                    sb[e * 128 + dp] = f2bf(s);
                }
            }
        }
    }
}
__device__ __forceinline__ void ret_passB(const Params& P, int tid) {
    unsigned* KV = (unsigned*)(P.ws + WS_C);
    for (int i = blockIdx.x * 512 + tid; i < 32 * 8192; i += gridDim.x * 512) {
        const int bh = i >> 13, idx = i & 8191;
        const float dec = ex2(ret_lg2(bh & 3) * 64.f);
        unsigned* p = KV + (size_t)bh * 128 * 8192 + idx;
        float s0 = 0.f, s1 = 0.f;
        for (int n0 = 0; n0 < 128; n0 += 16) {
            unsigned v[16];
#pragma unroll
            for (int k = 0; k < 16; ++k) v[k] = p[(size_t)(n0 + k) * 8192];
#pragma unroll
            for (int k = 0; k < 16; ++k) { p[(size_t)(n0 + k) * 8192] = pk2(s0, s1); s0 = s0 * dec + bflo(v[k]); s1 = s1 * dec + bfhi(v[k]); }
        }
        const int e = idx >> 6, dp = (idx & 63) * 2;
        float* so = P.out + O_RSP + (size_t)bh * 16384;
        so[(dp >> 1) * 128 + e] = s0;
        so[((dp >> 1) + 64) * 128 + e] = s1;
    }
}
template <int L> __device__ __forceinline__ void ret_unitC(const Params& P, LAS float* red, int bh, int n, int wid, int lane) {
    const bf16_t* B = (const bf16_t*)(P.ws + WS_B);
    const int l32 = lane & 31, hh = lane >> 5, hd = bh & 3, b = bh >> 2;
    const int et = wid >> 1, it = wid & 1;
    const bool act = (L == 64) || (it == 0);
    const int row0 = (L == 64) ? (b * T + n * 64) : (RP + b * 32);
    const bf16_t* sbef = (L == 64) ? (const bf16_t*)(P.ws + WS_C) + (size_t)(bh * 128 + n) * 16384 : (const bf16_t*)(P.ws + WS_KVS) + (size_t)bh * 16384;
    const bf16_t* vt = (L == 64) ? B + B_VT + (size_t)(bh * 128 + n) * 8192 : B + B_VTS + (size_t)bh * 4096;
    const float lg2 = ret_lg2(hd);
    const int i = 32 * it + l32;
    f32x16 acc = {};
    float s1 = 0.f, s2 = 0.f;
    if (act) {
        bf16x8 qf[8];
#pragma unroll
        for (int ks = 0; ks < 8; ++ks) qf[ks] = *(const bf16x8*)(B + B_RQ + (size_t)(row0 + i) * 512 + hd * 128 + 16 * ks + 8 * hh);
#pragma unroll
        for (int ks = 0; ks < 8; ++ks) { const bf16x8 a = *(const bf16x8*)(sbef + (32 * et + l32) * 128 + 16 * ks + 8 * hh); acc = MFMA32(a, qf[ks], acc); }
        acc = acc * ex2(lg2 * (float)(i + 1));
#pragma unroll
        for (int jt = 0; jt < L / 32; ++jt) {
            f32x16 sc = {};
#pragma unroll
            for (int ks = 0; ks < 8; ++ks) { const bf16x8 a = *(const bf16x8*)(B + B_RK + (size_t)(row0 + 32 * jt + l32) * 512 + hd * 128 + 16 * ks + 8 * hh); sc = MFMA32(a, qf[ks], sc); }
#pragma unroll
            for (int r = 0; r < 16; ++r) { const int j = 32 * jt + (r & 3) + 8 * (r >> 2) + 4 * hh; const int dd = i > j ? i - j : j - i; sc[r] = sc[r] * ex2(lg2 * (float)dd); }
#pragma unroll
            for (int s = 0; s < 2; ++s) {
                u32x4 pw; pw.x = pk2(sc[8 * s], sc[8 * s + 1]); pw.y = pk2(sc[8 * s + 2], sc[8 * s + 3]); pw.z = pk2(sc[8 * s + 4], sc[8 * s + 5]); pw.w = pk2(sc[8 * s + 6], sc[8 * s + 7]);
                const bf16x8 pf = __builtin_bit_cast(bf16x8, pw);
                const bf16_t* vb = vt + (32 * et + l32) * L + 32 * jt + 16 * s + 4 * hh;
                const u32x2 lo = *(const u32x2*)vb, hi = *(const u32x2*)(vb + 8);
                const u32x4 vw = {lo.x, lo.y, hi.x, hi.y};
                acc = MFMA32(__builtin_bit_cast(bf16x8, vw), pf, acc);
            }
        }
#pragma unroll
        for (int r = 0; r < 16; ++r) { s1 += acc[r]; s2 += acc[r] * acc[r]; }
        s1 += __shfl_xor(s1, 32); s2 += __shfl_xor(s2, 32);
        if (hh == 0) { red[et * 64 + i] = s1; red[256 + et * 64 + i] = s2; }
    }
    __syncthreads();
    if (act) {
        const float t1 = red[i] + red[64 + i] + red[128 + i] + red[192 + i];
        const float t2 = red[256 + i] + red[320 + i] + red[384 + i] + red[448 + i];
        const float mu = t1 * (1.f / 128.f), var = fmaxf(t2 * (1.f / 128.f) - mu * mu, 0.f), rstd = rsqrtf(var + EPS);
        const float* gw = P.in[14] + hd * 128;
        bf16_t* mixed = MIXED;
#pragma unroll
        for (int g = 0; g < 4; ++g) {
            const int e = 32 * et + 8 * g + 4 * hh;
            const f32x4 w4 = *(const f32x4*)(gw + e);
            const u32x2 gt = *(const u32x2*)(B + B_RG + (size_t)(row0 + i) * 512 + hd * 128 + e);
            f32x4 o;
            o.x = (acc[4 * g] - mu) * rstd * w4.x * bflo(gt.x); o.y = (acc[4 * g + 1] - mu) * rstd * w4.y * bfhi(gt.x);
            o.z = (acc[4 * g + 2] - mu) * rstd * w4.z * bflo(gt.y); o.w = (acc[4 * g + 3] - mu) * rstd * w4.w * bfhi(gt.y);
            u32x2 w; w.x = pk2(o.x, o.y); w.y = pk2(o.z, o.w);
            *(u32x2*)(mixed + (size_t)(row0 + i) * 1024 + hd * 128 + e) = w;
        }
    }
    __syncthreads();
}

struct FoxUnit { const bf16_t* Q; const bf16_t* K; const bf16_t* VT; const float* c2; bf16_t* O; int vtp, qpos0, nq, ntiles, Tk; };
constexpr int FOX_BUF = 18432, FOX_VOFF = 9216, FOX_COFF = 17920;
__device__ __forceinline__ void fox_unit(LAS unsigned char* lds, const FoxUnit U, int tid, int wid, int lane) {
    const int l32 = lane & 31, hh = lane >> 5;
    const int wrow = wid * 64;
    const bool active = wrow < U.nq;
    const bool act1 = wrow + 32 < U.nq;
    bf16x8 qf[2][4];
#pragma unroll
    for (int qt = 0; qt < 2; ++qt)
#pragma unroll
        for (int s = 0; s < 4; ++s) qf[qt][s] = (qt == 0 ? active : act1) ? *(const bf16x8*)(U.Q + (size_t)(wrow + 32 * qt + l32) * 512 + 16 * s + 8 * hh) : (bf16x8){0, 0, 0, 0, 0, 0, 0, 0};
    const int wq_lo = U.qpos0 + wrow, wq_hi = wq_lo + (act1 ? 63 : 31);
    float mrun[2] = {-INFINITY, -INFINITY}, lrun[2] = {0.f, 0.f};
    f32x16 o0[2] = {{}, {}}, o1[2] = {{}, {}};
    const int srow = tid >> 3, sch = tid & 7;
    u32x4 kr, vr; float cr = 0.f;
#define FOX_LOAD(t) do { int key_ = (t) * 64 + srow; key_ = key_ < U.Tk ? key_ : U.Tk - 1; kr = *(const u32x4*)(U.K + (size_t)key_ * 512 + sch * 8); \
        vr = *(const u32x4*)(U.VT + (size_t)srow * U.vtp + (t) * 64 + sch * 8); \
        if (tid < 64) { int kc_ = (t) * 64 + tid; kc_ = kc_ < U.Tk ? kc_ : U.Tk - 1; cr = U.c2[kc_]; } } while (0)
#define FOX_STORE(bi) do { LAS unsigned char* kb_ = lds + (bi) * FOX_BUF; *(LAS u32x4*)(kb_ + srow * 144 + sch * 16) = kr; \
        *(LAS u32x2*)(kb_ + FOX_VOFF + srow * 136 + sch * 16) = (u32x2){vr.x, vr.y}; *(LAS u32x2*)(kb_ + FOX_VOFF + srow * 136 + sch * 16 + 8) = (u32x2){vr.z, vr.w}; \
        if (tid < 64) *(LAS float*)(kb_ + FOX_COFF + tid * 4) = -cr; } while (0)
    FOX_LOAD(0); FOX_STORE(0);
    __syncthreads();
    for (int t = 0; t < U.ntiles; ++t) {
        const bool more = t + 1 < U.ntiles;
        if (more) FOX_LOAD(t + 1);
        if (active && t * 64 <= wq_hi) {
            LAS unsigned char* kb = lds + (t & 1) * FOX_BUF;
            bf16x8 pf[2][4];
#pragma unroll
            for (int qt = 0; qt < 2; ++qt) {
                __builtin_amdgcn_sched_barrier(0);
                f32x16 p0, p1;
#pragma unroll
                for (int g = 0; g < 4; ++g) {
                    const f32x4 c0 = *(LAS f32x4*)(kb + FOX_COFF + (8 * g + 4 * hh) * 4), c1 = *(LAS f32x4*)(kb + FOX_COFF + (32 + 8 * g + 4 * hh) * 4);
                    p0[4 * g] = c0.x; p0[4 * g + 1] = c0.y; p0[4 * g + 2] = c0.z; p0[4 * g + 3] = c0.w;
                    p1[4 * g] = c1.x; p1[4 * g + 1] = c1.y; p1[4 * g + 2] = c1.z; p1[4 * g + 3] = c1.w;
                }
#pragma unroll
                for (int s = 0; s < 4; ++s) {
                    const bf16x8 a0 = *(LAS bf16x8*)(kb + l32 * 144 + (2 * s + hh) * 16), a1 = *(LAS bf16x8*)(kb + (32 + l32) * 144 + (2 * s + hh) * 16);
                    p0 = MFMA32(a0, qf[qt][s], p0); p1 = MFMA32(a1, qf[qt][s], p1);
                }
                const int qpos = wq_lo + 32 * qt + l32;
                if (t * 64 + 63 > wq_lo + 32 * qt) {
#pragma unroll
                    for (int r = 0; r < 16; ++r) { const int key = t * 64 + (r & 3) + 8 * (r >> 2) + 4 * hh; if (key > qpos) p0[r] = -INFINITY; if (key + 32 > qpos) p1[r] = -INFINITY; }
                }
                float mx = fmaxf(p0[0], p1[0]);
#pragma unroll
                for (int r = 1; r < 16; ++r) mx = fmaxf(mx, fmaxf(p0[r], p1[r]));
                mx = fmaxf(mx, __shfl_xor(mx, 32));
                const float mn = fmaxf(mrun[qt], mx), alpha = ex2(mrun[qt] - mn); mrun[qt] = mn;
                float rs = 0.f;
#pragma unroll
                for (int r = 0; r < 16; ++r) { p0[r] = ex2(p0[r] - mn); p1[r] = ex2(p1[r] - mn); rs += p0[r] + p1[r]; }
                lrun[qt] = lrun[qt] * alpha + rs; o0[qt] = o0[qt] * alpha; o1[qt] = o1[qt] * alpha;
#pragma unroll
                for (int s = 0; s < 4; ++s) {
                    u32x4 pw;
                    if (s < 2) { pw.x = pk2(p0[8 * s], p0[8 * s + 1]); pw.y = pk2(p0[8 * s + 2], p0[8 * s + 3]); pw.z = pk2(p0[8 * s + 4], p0[8 * s + 5]); pw.w = pk2(p0[8 * s + 6], p0[8 * s + 7]); }
                    else { const int q = 8 * (s - 2); pw.x = pk2(p1[q], p1[q + 1]); pw.y = pk2(p1[q + 2], p1[q + 3]); pw.z = pk2(p1[q + 4], p1[q + 5]); pw.w = pk2(p1[q + 6], p1[q + 7]); }
                    pf[qt][s] = __builtin_bit_cast(bf16x8, pw);
                }
            }
#pragma unroll
            for (int s = 0; s < 4; ++s) {
                LAS unsigned char* vb = kb + FOX_VOFF + l32 * 136 + (16 * s + 4 * hh) * 2;
                const u32x2 a = *(LAS u32x2*)vb, b = *(LAS u32x2*)(vb + 16), c = *(LAS u32x2*)(vb + 32 * 136), d = *(LAS u32x2*)(vb + 32 * 136 + 16);
                const u32x4 v0 = {a.x, a.y, b.x, b.y}, v1 = {c.x, c.y, d.x, d.y};
#pragma unroll
                for (int qt = 0; qt < 2; ++qt) { o0[qt] = MFMA32(__builtin_bit_cast(bf16x8, v0), pf[qt][s], o0[qt]); o1[qt] = MFMA32(__builtin_bit_cast(bf16x8, v1), pf[qt][s], o1[qt]); }
            }
        }
        if (more) FOX_STORE((t + 1) & 1);
        __syncthreads();
    }
#undef FOX_LOAD
#undef FOX_STORE
#pragma unroll
    for (int qt = 0; qt < 2; ++qt) {
        if (qt == 0 ? active : act1) {
            const float inv = 1.f / (lrun[qt] + __shfl_xor(lrun[qt], 32));
            bf16_t* op = U.O + (size_t)(wrow + 32 * qt + l32) * 1024 + 4 * hh;
#pragma unroll
            for (int g = 0; g < 4; ++g) {
                u32x2 w; w.x = pk2(o0[qt][4 * g] * inv, o0[qt][4 * g + 1] * inv); w.y = pk2(o0[qt][4 * g + 2] * inv, o0[qt][4 * g + 3] * inv); *(u32x2*)(op + 8 * g) = w;
                w.x = pk2(o1[qt][4 * g] * inv, o1[qt][4 * g + 1] * inv); w.y = pk2(o1[qt][4 * g + 2] * inv, o1[qt][4 * g + 3] * inv); *(u32x2*)(op + 32 + 8 * g) = w;
            }
        }
    }
}
__device__ __forceinline__ void fox_phase(const Params& P, LAS unsigned char* lds, int tid, int wid, int lane) {
    const bf16_t* B = (const bf16_t*)(P.ws + WS_B);
    bf16_t* mixed = MIXED;
    for (int it2 = 2 * blockIdx.x; it2 < 1024 + 128; it2 += (it2 < 1024) ? (((it2 & 1) == 0) ? 1 : 2 * (int)gridDim.x - 1) : 2 * (int)gridDim.x) {
        FoxUnit U;
        if (it2 < 1024) {
            const int it = it2 >> 1, k = it2 & 1;
            const int bh = it >> 3, pi = it & 7, b = bh >> 3, hd = bh & 7;
            const int qb = k ? 15 - pi : pi;
            U.Q = B + B_FQ + (size_t)(b * T + qb * 512) * 512 + hd * 64; U.K = B + B_FK + (size_t)b * T * 512 + hd * 64;
            U.VT = B + B_FVT + (size_t)(b * 512 + hd * 64) * T; U.c2 = (const float*)(P.ws + WS_C2P) + (size_t)bh * T;
            U.O = mixed + (size_t)(b * T + qb * 512) * 1024 + 512 + hd * 64; U.vtp = T; U.qpos0 = qb * 512; U.nq = 512; U.ntiles = 8 * (qb + 1); U.Tk = T;
        } else {
            const int bh = (it2 - 1024) >> 1;
            const int b = bh >> 3, hd = bh & 7;
            U.Q = B + B_FQ + (size_t)(RP + b * 32) * 512 + hd * 64; U.K = (const bf16_t*)(P.ws + WS_FKS) + (size_t)b * TKS * 512 + hd * 64;
            U.VT = (const bf16_t*)(P.ws + WS_FVTS) + (size_t)(b * 512 + hd * 64) * TKS; U.c2 = (const float*)(P.ws + WS_C2S) + (size_t)bh * TKS;
            U.O = mixed + (size_t)(RP + b * 32) * 1024 + 512 + hd * 64; U.vtp = TKS; U.qpos0 = PAST; U.nq = 32; U.ntiles = 65; U.Tk = TKS;
        }
        int tid_ = tid; asm volatile("" : "+v"(tid_));
        fox_unit(lds, U, tid_, wid, tid_ & 63);
    }
}

constexpr int XA_BUF = 16896;
__device__ __forceinline__ void xattn_unit(LAS unsigned char* lds, const bf16_t* Q, const bf16_t* Kb, const bf16_t* VTb, bf16_t* O, int nwaves, int tid, int wid, int lane) {
    const int l32 = lane & 31, hh = lane >> 5;
    const bool active = wid < nwaves;
    bf16x8 qf[16];
#pragma unroll
    for (int s = 0; s < 16; ++s) qf[s] = active ? *(const bf16x8*)(Q + (size_t)(wid * 32 + l32) * 1024 + 16 * s + 8 * hh) : (bf16x8){0, 0, 0, 0, 0, 0, 0, 0};
    f32x16 S[4];
    bf16x8 pf[16];
    float m1 = 0.f, l1 = 0.f, a1 = 0.f, a2 = 0.f;
    u32x4 r0, r1;
    const int i0 = tid, i1 = tid + 512;
    const bf16_t* g0 = Kb + (size_t)(i0 >> 5) * 1024 + (i0 & 31) * 8; const bf16_t* g1 = Kb + (size_t)(i1 >> 5) * 1024 + (i1 & 31) * 8;
    const bf16_t* h0 = VTb + (size_t)(i0 >> 5) * 256 + (i0 & 31) * 8; const bf16_t* h1 = VTb + (size_t)(i1 >> 5) * 256 + (i1 & 31) * 8;
#define XA_LOAD(tt) do { if ((tt) < 8) { r0 = *(const u32x4*)g0; r1 = *(const u32x4*)g1; g0 += 32 * 1024; g1 += 32 * 1024; asm volatile("" : "+v"(g0), "+v"(g1)); } \
        else { r0 = *(const u32x4*)h0; r1 = *(const u32x4*)h1; h0 += 32 * 256; h1 += 32 * 256; asm volatile("" : "+v"(h0), "+v"(h1)); } } while (0)
#define XA_STORE(bi) do { LAS unsigned char* b_ = lds + (bi) * XA_BUF; *(LAS u32x4*)(b_ + (i0 >> 5) * 528 + (i0 & 31) * 16) = r0; *(LAS u32x4*)(b_ + (i1 >> 5) * 528 + (i1 & 31) * 16) = r1; } while (0)
#define XA_HALF(hf, mm, ll) do { float mx_ = S[0][0]; \
        _Pragma("unroll") for (int k = 0; k < 4; ++k) _Pragma("unroll") for (int r = 0; r < 16; ++r) mx_ = fmaxf(mx_, S[k][r]); \
        mx_ = fmaxf(mx_, __shfl_xor(mx_, 32)); float l_ = 0.f; \
        _Pragma("unroll") for (int k = 0; k < 4; ++k) { \
            _Pragma("unroll") for (int r = 0; r < 16; ++r) { S[k][r] = ex2(S[k][r] - mx_); l_ += S[k][r]; } \
            _Pragma("unroll") for (int s = 0; s < 2; ++s) { u32x4 pw; pw.x = pk2(S[k][8 * s], S[k][8 * s + 1]); pw.y = pk2(S[k][8 * s + 2], S[k][8 * s + 3]); pw.z = pk2(S[k][8 * s + 4], S[k][8 * s + 5]); pw.w = pk2(S[k][8 * s + 6], S[k][8 * s + 7]); \
                pf[8 * (hf) + 2 * k + s] = __builtin_bit_cast(bf16x8, pw); } } \
        mm = mx_; ll = l_ + __shfl_xor(l_, 32); } while (0)
    XA_LOAD(0); XA_STORE(0);
    __syncthreads();
#pragma unroll
    for (int tt = 0; tt < 16; ++tt) {
        if (tt + 1 < 16) XA_LOAD(tt + 1);
        LAS unsigned char* buf = lds + (tt & 1) * XA_BUF;
        if (active) {
            if (tt < 8) {
                f32x16 s = {};
#pragma unroll
                for (int k = 0; k < 16; ++k) { const bf16x8 a = *(LAS bf16x8*)(buf + l32 * 528 + (2 * k + hh) * 16); s = MFMA32(a, qf[k], s); }
                S[tt & 3] = s;
                if (tt == 3) XA_HALF(0, m1, l1);
                if (tt == 7) {
                    float m2, l2; XA_HALF(1, m2, l2);
                    const float mm = fmaxf(m1, m2); a1 = ex2(m1 - mm); a2 = ex2(m2 - mm);
                    const float inv = 1.f / (a1 * l1 + a2 * l2); a1 *= inv; a2 *= inv;
                }
            } else {
                f32x16 o1 = {}, o2 = {};
#pragma unroll
                for (int k = 0; k < 16; ++k) {
                    LAS unsigned char* vb = buf + l32 * 528 + (16 * k + 4 * hh) * 2;
                    const u32x2 a = *(LAS u32x2*)vb, b = *(LAS u32x2*)(vb + 16);
                    const u32x4 vw = {a.x, a.y, b.x, b.y};
                    if (k < 8) o1 = MFMA32(__builtin_bit_cast(bf16x8, vw), pf[k], o1); else o2 = MFMA32(__builtin_bit_cast(bf16x8, vw), pf[k], o2);
                }
                bf16_t* op = O + (size_t)(wid * 32 + l32) * 1024 + 32 * (tt - 8) + 4 * hh;
#pragma unroll
                for (int g = 0; g < 4; ++g) { u32x2 w; w.x = pk2(o1[4 * g] * a1 + o2[4 * g] * a2, o1[4 * g + 1] * a1 + o2[4 * g + 1] * a2); w.y = pk2(o1[4 * g + 2] * a1 + o2[4 * g + 2] * a2, o1[4 * g + 3] * a1 + o2[4 * g + 3] * a2); *(u32x2*)(op + 8 * g) = w; }
            }
        }
        if (tt + 1 < 16) XA_STORE((tt + 1) & 1);
        __syncthreads();
    }
#undef XA_HALF
#undef XA_LOAD
#undef XA_STORE
}
__device__ __forceinline__ void xattn_phase(const Params& P, LAS unsigned char* lds, int layer, int tid, int wid, int lane) {
    const bf16_t* XQ = (const bf16_t*)(P.ws + WS_B);
    bf16_t* XO = (bf16_t*)(P.ws + WS_B) + B_X2;
    const bf16_t* MK = (const bf16_t*)(P.ws + WS_MEMK); const bf16_t* MVT = (const bf16_t*)(P.ws + WS_MEMVT);
    for (int it = blockIdx.x; it < 1024 + 32; it += gridDim.x) {
        int row0, set, hd, nw;
        if (it < 1024) { const int pm = it >> 2; hd = it & 3; row0 = pm * 256; set = layer * 16 + (pm >> 5); nw = 8; }
        else { const int q = it - 1024, b = q >> 2; hd = q & 3; row0 = RP + b * 32; set = layer * 16 + 8 + b; nw = 1; }
        xattn_unit(lds, XQ + (size_t)row0 * 1024 + hd * 256, MK + (size_t)set * 262144 + hd * 256, MVT + ((size_t)set * 1024 + hd * 256) * 256, XO + (size_t)row0 * 1024 + hd * 256, nw, tid, wid, lane);
    }
}

__device__ __forceinline__ void s5_run(LAS unsigned char* wl, const bf16_t* U, bf16_t* Y, int row0, int L, int g, f32x2 a, float& xr, float& xi, bool outp,
                                       const bf16_t* SB5, const bf16_t* SC5, const float* s5d, int lane) {
    const int l32 = lane & 31, hh = lane >> 5, l16 = lane & 15, q4 = lane >> 4;
    bf16x8 bfr[4], cfr[4];
#pragma unroll
    for (int k = 0; k < 4; ++k) { bfr[k] = *(const bf16x8*)(SB5 + ((size_t)(g * 4 + k) * 64 + lane) * 8); cfr[k] = *(const bf16x8*)(SC5 + ((size_t)(g * 4 + k) * 64 + lane) * 8); }
    const f32x4 dv = *(const f32x4*)(s5d + g * 16 + 4 * q4);
    for (int sc0 = 0; sc0 < L / 32; sc0 += 4) {
      bf16x8 ufa[4];
#pragma unroll
      for (int q = 0; q < 4; ++q) ufa[q] = (sc0 + q < L / 32) ? *(const bf16x8*)(U + (size_t)(row0 + (sc0 + q) * 32 + l32) * 1024 + g * 16 + 8 * hh) : (bf16x8){0, 0, 0, 0, 0, 0, 0, 0};
#pragma unroll
      for (int q = 0; q < 4; ++q) {
        const int sc = sc0 + q;
        if (sc >= L / 32) break;
        const int r0 = row0 + sc * 32;
        const bf16x8 uf = ufa[q];
        const f32x16 z = {};
        const f32x16 d0 = MFMA32(uf, bfr[0], z), d1 = MFMA32(uf, bfr[1], z), d2 = MFMA32(uf, bfr[2], z), d3 = MFMA32(uf, bfr[3], z);
#pragma unroll
        for (int r = 0; r < 16; ++r) {
            const int tok = (r & 3) + 8 * (r >> 2) + 4 * hh;
            *(LAS f32x2*)(wl + tok * 528 + l32 * 8) = (f32x2){d0[r], d2[r]};
            *(LAS f32x2*)(wl + tok * 528 + (32 + l32) * 8) = (f32x2){d1[r], d3[r]};
        }
        LDSBAR();
#pragma unroll
        for (int t0 = 0; t0 < 32; t0 += 8) {
            f32x2 bu[8]; float xo_[8];
#pragma unroll
            for (int k = 0; k < 8; ++k) bu[k] = *(LAS f32x2*)(wl + (t0 + k) * 528 + lane * 8);
            LDSBAR();
#pragma unroll
            for (int k = 0; k < 8; ++k) {
                const float nr = a.x * xr - a.y * xi + bu[k].x, ni = a.x * xi + a.y * xr + bu[k].y;
                xr = nr; xi = ni; xo_[k] = __uint_as_float(pk2(xr, xi));
            }
            if (outp) {
#pragma unroll
                for (int k = 0; k < 8; ++k) *(LAS float*)(wl + (t0 + k) * 528 + lane * 4) = xo_[k];
            }
        }
        LDSBAR();
        if (outp) {
#pragma unroll
            for (int tb = 0; tb < 2; ++tb) {
                f32x4 acc = {0.f, 0.f, 0.f, 0.f};
#pragma unroll
                for (int ks = 0; ks < 4; ++ks) { const bf16x8 xf = *(LAS bf16x8*)(wl + (16 * tb + l16) * 528 + (32 * ks + 8 * q4) * 2); acc = MFMA16(cfr[ks], xf, acc); }
                const size_t off = (size_t)(r0 + 16 * tb + l16) * 1024 + g * 16 + 4 * q4;
                const u32x2 uu = *(const u32x2*)(U + off);
                f32x4 y; y.x = acc.x + dv.x * bflo(uu.x); y.y = acc.y + dv.y * bfhi(uu.x); y.z = acc.z + dv.z * bflo(uu.y); y.w = acc.w + dv.w * bfhi(uu.y);
                u32x2 w; w.x = pk2(y.x, y.y); w.y = pk2(y.z, y.w);
                *(u32x2*)(Y + off) = w;
            }
        }
        LDSBAR();
      }
    }
}
constexpr int S5_NSEG = 16, S5_LSEG = 512;
__device__ __forceinline__ void s5_phase(const Params& P, LAS unsigned char* lds, int pass, int wid, int lane) {
    const bf16_t* U = (const bf16_t*)(P.ws + WS_B);
    bf16_t* Y = (bf16_t*)(P.ws + WS_B) + B_X2;
    const f32x2* S5A = (const f32x2*)(P.ws + WS_S5T); const f32x2* S5AL = S5A + 4096;
    const bf16_t* SB5 = (const bf16_t*)(P.ws + WS_S5T + 65536); const bf16_t* SC5 = SB5 + 131072;
    f32x2* LE = (f32x2*)(P.ws + WS_LE);
    LAS unsigned char* wl = lds + wid * 16896;
    const int nunits = (pass == 1) ? 8 * (S5_NSEG - 1) * 8 : 8 * S5_NSEG * 8 + 64;
    for (int it = blockIdx.x; it < nunits; it += gridDim.x) {
        if (pass == 1) {
            const int g8 = it & 7, seg = (it >> 3) % (S5_NSEG - 1), b = (it >> 3) / (S5_NSEG - 1), g = g8 * 8 + wid;
            float xr = 0.f, xi = 0.f;
            s5_run(wl, U, Y, b * T + seg * S5_LSEG, S5_LSEG, g, S5A[g * 64 + lane], xr, xi, false, SB5, SC5, P.in[24], lane);
            LE[((size_t)(b * S5_NSEG + seg) * 64 + g) * 64 + lane] = (f32x2){xr, xi};
        } else if (it < 8 * S5_NSEG * 8) {
            const int g8 = it & 7, seg = (it >> 3) & (S5_NSEG - 1), b = it >> 7, g = g8 * 8 + wid;
            const f32x2 aL = S5AL[g * 64 + lane];
            float xr = 0.f, xi = 0.f;
            for (int s = 0; s < seg; ++s) { const f32x2 le = LE[((size_t)(b * S5_NSEG + s) * 64 + g) * 64 + lane]; const float nr = aL.x * xr - aL.y * xi + le.x, ni = aL.x * xi + aL.y * xr + le.y; xr = nr; xi = ni; }
            s5_run(wl, U, Y, b * T + seg * S5_LSEG, S5_LSEG, g, S5A[g * 64 + lane], xr, xi, true, SB5, SC5, P.in[24], lane);
            if (seg == S5_NSEG - 1) { P.out[O_S5RP + (size_t)(b * 64 + g) * 64 + lane] = xr; P.out[O_S5IP + (size_t)(b * 64 + g) * 64 + lane] = xi; }
        } else {
            const int q = it - 8 * S5_NSEG * 8, g8 = q & 7, b = q >> 3, g = g8 * 8 + wid;
            float xr = P.in[6][(size_t)(b * 64 + g) * 64 + lane], xi = P.in[7][(size_t)(b * 64 + g) * 64 + lane];
            s5_run(wl, U, Y, RP + b * 32, 32, g, S5A[g * 64 + lane], xr, xi, true, SB5, SC5, P.in[24], lane);
            P.out[O_S5RS + (size_t)(b * 64 + g) * 64 + lane] = xr; P.out[O_S5IS + (size_t)(b * 64 + g) * 64 + lane] = xi;
        }
    }
}

__device__ __forceinline__ void prologue(const Params& P, int tid, int wid, int lane) {
    const int gtid = blockIdx.x * 512 + tid, gsz = gridDim.x * 512;
    const int gw = blockIdx.x * 8 + wid, ngw = gridDim.x * 8;
    bf16_t* W = (bf16_t*)(P.ws + WS_W);
    wtrans(P.in[12], 1024, 3592, W + W_AB, 3840, 1, gtid, gsz, P.in[11]);
    wtrans(P.in[15], 1024, 1024, W + W_OUT, 1024, 0, gtid, gsz);
    wtrans(P.in[16], 1024, 1024, W + W_INC, 1024, 0, gtid, gsz, P.in[11] + 6144);
    wtrans(P.in[25], 1024, 2048, W + W_GLU, 2048, 2, gtid, gsz);
    for (int l = 0; l < 2; ++l) {
        wtrans(P.in[27] + (size_t)l * 1048576, 1024, 1024, W + W_XQ + (size_t)l * 1048576, 1024, 0, gtid, gsz, P.in[11] + l * 6144 + 2048);
        wtrans(P.in[28] + (size_t)l * 1048576, 1024, 1024, W + W_XKV + (size_t)l * 2097152, 1024, 0, gtid, gsz);
        wtrans(P.in[29] + (size_t)l * 1048576, 1024, 1024, W + W_XKV + (size_t)l * 2097152 + 1048576, 1024, 0, gtid, gsz);
        wtrans(P.in[30] + (size_t)l * 1048576, 1024, 1024, W + W_XO + (size_t)l * 1048576, 1024, 0, gtid, gsz);
        wtrans(P.in[31] + (size_t)l * 4194304, 1024, 4096, W + W_UP + (size_t)l * 4194304, 4096, 0, gtid, gsz, P.in[11] + l * 6144 + 4096);
        wtrans(P.in[32] + (size_t)l * 4194304, 4096, 1024, W + W_DN + (size_t)l * 4194304, 1024, 0, gtid, gsz);
    }
    {
        float* rope = (float*)(P.ws + WS_ROPE);
        for (int i = gtid; i < 8192 * 64; i += gsz) {
            const int pos = i >> 6, k = i & 63;
            const double inv = exp2(-(double)k * (13.287712379549449 / 64.0));
            const double ang = (double)pos * inv;
            rope[2 * i] = (float)cos(ang); rope[2 * i + 1] = (float)sin(ang);
        }
    }
    {
        f32x2* S5A = (f32x2*)(P.ws + WS_S5T); f32x2* S5AL = S5A + 4096;
        bf16_t* SB5 = (bf16_t*)(P.ws + WS_S5T + 65536); bf16_t* SC5 = SB5 + 131072;
        for (int i = gtid; i < 4096; i += gsz) {
            const int g = i >> 6, p = i & 63;
            const double lr = P.in[17][i], li = P.in[18][i], dt = exp((double)P.in[19][g]);
            const double mag = exp(lr * dt), ar = mag * cos(li * dt), ai = mag * sin(li * dt);
            S5A[i] = (f32x2){(float)ar, (float)ai};
            const double magL = exp(lr * dt * S5_LSEG);
            S5AL[i] = (f32x2){(float)(magL * cos(li * dt * S5_LSEG)), (float)(magL * sin(li * dt * S5_LSEG))};
            const double den = lr * lr + li * li, nre = ar - 1.0;
            const double fr = (nre * lr + ai * li) / den, fi = (ai * lr - nre * li) / den;
            const float* br = P.in[20] + (size_t)i * 16; const float* bi = P.in[21] + (size_t)i * 16;
#pragma unroll
            for (int part = 0; part < 2; ++part)
#pragma unroll
                for (int h2 = 0; h2 < 2; ++h2) {
                    float v[8];
#pragma unroll
                    for (int k = 0; k < 8; ++k) { const int c = 8 * h2 + k; v[k] = part == 0 ? (float)(fr * br[c] - fi * bi[c]) : (float)(fr * bi[c] + fi * br[c]); }
                    u32x4 o; o.x = pk2(v[0], v[1]); o.y = pk2(v[2], v[3]); o.z = pk2(v[4], v[5]); o.w = pk2(v[6], v[7]);
                    const int kb = 2 * part + (p >> 5), ln = (p & 31) + 32 * h2;
                    *(u32x4*)(SB5 + ((size_t)(g * 4 + kb) * 64 + ln) * 8) = o;
                }
        }
        for (int i = gtid; i < 64 * 4 * 64; i += gsz) {
            const int ln = i & 63, ks = (i >> 6) & 3, g = i >> 8;
            const int c = ln & 15;
            float v[8];
#pragma unroll
            for (int k = 0; k < 8; ++k) { const int kidx = 32 * ks + 8 * (ln >> 4) + k, p = kidx >> 1; v[k] = (kidx & 1) ? -P.in[23][((size_t)g * 16 + c) * 64 + p] : P.in[22][((size_t)g * 16 + c) * 64 + p]; }
            u32x4 o; o.x = pk2(v[0], v[1]); o.y = pk2(v[2], v[3]); o.z = pk2(v[4], v[5]); o.w = pk2(v[6], v[7]);
            *(u32x4*)(SC5 + (size_t)i * 8) = o;
        }
    }
    {
        bf16_t* FKS = (bf16_t*)(P.ws + WS_FKS); bf16_t* FVTS = (bf16_t*)(P.ws + WS_FVTS);
        for (int i = gtid; i < 8 * PAST * 64; i += gsz) { const int b = i / (PAST * 64), r = i % (PAST * 64); cvt8(P.in[3] + (size_t)i * 8, FKS + (size_t)b * TKS * 512 + (size_t)r * 8); }
        for (int b = 0; b < 8; ++b) ttrans(P.in[4] + (size_t)b * PAST * 512, PAST, 512, FVTS + (size_t)b * 512 * TKS, TKS, gtid, gsz);
        bf16_t* MK = (bf16_t*)(P.ws + WS_MEMK); bf16_t* MVT = (bf16_t*)(P.ws + WS_MEMVT);
        for (int i = gtid; i < 2 * 8 * 32768; i += gsz) { const int lb = i >> 15, r = i & 32767, l = lb >> 3, b = lb & 7; cvt8(P.in[8] + (size_t)i * 8, MK + (size_t)(l * 16 + 8 + b) * 262144 + (size_t)r * 8); }
        for (int lb = 0; lb < 16; ++lb) { const int l = lb >> 3, b = lb & 7; ttrans(P.in[9] + (size_t)lb * 262144, 256, 1024, MVT + (size_t)(l * 16 + 8 + b) * 262144, 256, gtid, gsz); }
    }
    {
        bf16_t* H = (bf16_t*)(P.ws + WS_A); bf16_t* MEMN = (bf16_t*)(P.ws + WS_MEMN);
        for (int row = gw; row < R + 4096; row += ngw) {
            if (row < R) { const float* xr = row < RP ? P.in[0] + (size_t)row * 1024 : P.in[1] + (size_t)(row - RP) * 1024; cvt_row(xr, H + (size_t)row * 1024, (float*)(P.ws + WS_RS) + row, lane); }
            else { const int q = row - R, l = q >> 11, r = q & 2047; norm_row(P.in[10] + (size_t)r * 1024, P.in[26] + l * 1024, MEMN + (size_t)q * 1024, lane); }
        }
    }
}
__device__ __forceinline__ void cumsum_task(const Params& P, int q, int lane) {
    const bool samp = q >= 64; const int bh = q & 63, b = bh >> 3, hd = bh & 7;
    const int n = samp ? TKS : T;
    float* dst = samp ? (float*)(P.ws + WS_C2S) + (size_t)bh * TKS : (float*)(P.ws + WS_C2P) + (size_t)bh * T;
    float carry = 0.f;
    for (int base0 = 0; base0 < n; base0 += 512) {
        float vv[8];
#pragma unroll
        for (int k = 0; k < 8; ++k) {
            const int idx = base0 + 64 * k + lane; float v = 0.f;
            if (idx < n) {
                if (!samp) v = P.out[O_LFP + ((size_t)b * T + idx) * 8 + hd];
                else v = idx < PAST ? P.in[5][((size_t)b * PAST + idx) * 8 + hd] : P.out[O_LFS + ((size_t)b * 32 + idx - PAST) * 8 + hd];
            }
            vv[k] = v;
        }
#pragma unroll
        for (int k = 0; k < 8; ++k) {
            const int idx = base0 + 64 * k + lane; float v = vv[k];
#pragma unroll
            for (int o = 1; o < 64; o <<= 1) { const float t = __shfl_up(v, o); if (lane >= o) v += t; }
            if (idx < n) dst[idx] = (carry + v) * LOG2E;
            carry += __shfl(v, 63);
        }
    }
}

template <class Epi> __device__ __forceinline__ void run_gemm(LAS unsigned char* lds, const bf16_t* A, const bf16_t* Bt, int M, int N, int K, const Epi& E) {
    pg8::Gemm g{A, Bt, M, N, K}; pg8::StaticOrder S; S.init(M, N, (int)gridDim.x, (int)blockIdx.x);
#ifndef GEMM_REP
#define GEMM_REP 1
#endif
#pragma unroll 1
    for (int rep_ = 0; rep_ < GEMM_REP; ++rep_)
    pg8::gemm_phase<Epi, pg8::StaticOrder, true, true>(lds, g, S, E);
}

#define XB_TMO      128
#define XB_XCNT(j)  (256  + 64 * (j))
#define XB_XSUB(j)  (1280 + 64 * (j))
#define XB_XGEN(j)  (2304 + 64 * (j))
#define XB_TOP      3328
#define XB_TOPGEN   3392
#define XCD_BAR_WORDS 3456
#define XB_SPIN_CAP (1u << 18)

__device__ __forceinline__ unsigned xb_ld(unsigned* p)              { return __hip_atomic_load(p, __ATOMIC_RELAXED, __HIP_MEMORY_SCOPE_AGENT); }
__device__ __forceinline__ unsigned xb_add(unsigned* p, unsigned v) { return __hip_atomic_fetch_add(p, v, __ATOMIC_RELAXED, __HIP_MEMORY_SCOPE_AGENT); }
__device__ __forceinline__ unsigned xb_xcc_id() { return (unsigned)__builtin_amdgcn_s_getreg((3 << 11) | 20) & 0xFu; }
#define XB_SPIN(cond, bar) do { unsigned _sp = 0; while (cond) { __builtin_amdgcn_s_sleep(1); \
    if ((++_sp & 255u) == 0u) { if (xb_ld(&(bar)[XB_TMO])) break; if (_sp > XB_SPIN_CAP) { atomicAdd(&(bar)[XB_TMO], 1u); break; } } } } while (0)

struct XcdBarrier {
    unsigned* bar; unsigned x;
    volatile LAS unsigned* st;
};

__device__ __forceinline__ XcdBarrier xcd_barrier_post(unsigned* bar, volatile LAS unsigned* st) {
    XcdBarrier b; b.bar = bar; b.x = xb_xcc_id(); b.st = st;
    if (threadIdx.x == 0) (void)xb_add(&bar[XB_XCNT(b.x)], 1u);
    return b;
}
__device__ __forceinline__ void xcd_barrier_complete(unsigned* bar, unsigned x, unsigned& nloc, unsigned& nx) {
    const unsigned G = gridDim.x * gridDim.y * gridDim.z;
    unsigned sum, cnt, mine, sp = 0u;
    for (;;) {
        sum = 0u; cnt = 0u; mine = 0u;
#pragma unroll
        for (unsigned j = 0; j < 16; ++j) { const unsigned c = xb_ld(&bar[XB_XCNT(j)]); sum += c; cnt += (c > 0u) ? 1u : 0u; mine = (j == x) ? c : mine; }
        if (sum == G) break;
        __builtin_amdgcn_s_sleep(1);
        if ((++sp & 255u) == 0u) { if (xb_ld(&bar[XB_TMO])) break; if (sp > XB_SPIN_CAP) { atomicAdd(&bar[XB_TMO], 1u); break; } }
    }
    nloc = mine > 0u ? mine : 1u; nx = cnt > 0u ? cnt : 1u;
}

__device__ __forceinline__ void xcd_barrier(const XcdBarrier& b) {
    asm volatile("s_waitcnt vmcnt(0)" ::: "memory");
    __syncthreads();
    if (threadIdx.x == 0) {
        unsigned* bar = b.bar;
        __builtin_amdgcn_s_waitcnt(0);
        unsigned nloc = b.st[0], nx = b.st[1];
        if (nloc == 0u) { xcd_barrier_complete(bar, b.x, nloc, nx); b.st[0] = nloc; b.st[1] = nx; }
        const unsigned old = xb_add(&bar[XB_XSUB(b.x)], 1u);
        const unsigned gen = old / nloc;
        if (old + 1u == (gen + 1u) * nloc) {
            __builtin_amdgcn_fence(__ATOMIC_RELEASE, "agent");
            asm volatile("s_waitcnt vmcnt(0)" ::: "memory");
            const unsigned og = xb_add(&bar[XB_TOP], 1u);
            const unsigned tg = og / nx;
            if (og + 1u == (tg + 1u) * nx) xb_add(&bar[XB_TOPGEN], 1u);
            else XB_SPIN(xb_ld(&bar[XB_TOPGEN]) == tg, bar);
            __builtin_amdgcn_fence(__ATOMIC_ACQUIRE, "agent");
            xb_add(&bar[XB_XGEN(b.x)], 1u);
            asm volatile("s_waitcnt vmcnt(0)" ::: "memory");
        } else {
            XB_SPIN(xb_ld(&bar[XB_XGEN(b.x)]) == gen, bar);
            __builtin_amdgcn_fence(__ATOMIC_ACQUIRE, "agent");
            asm volatile("s_waitcnt vmcnt(0)" ::: "memory");
        }
    }
    __syncthreads();
}

__device__ __forceinline__ void gbar(unsigned* ctr, int& gen) {
    asm volatile("s_waitcnt vmcnt(0) lgkmcnt(0)" ::: "memory");
    __syncthreads();
    if (threadIdx.x == 0) {
        __builtin_amdgcn_fence(__ATOMIC_RELEASE, "agent");
        asm volatile("s_waitcnt vmcnt(0)" ::: "memory");
        const unsigned target = (unsigned)(gen + 1) * gridDim.x;
        __hip_atomic_fetch_add(ctr, 1u, __ATOMIC_RELAXED, __HIP_MEMORY_SCOPE_AGENT);
        while (__hip_atomic_load(ctr, __ATOMIC_RELAXED, __HIP_MEMORY_SCOPE_AGENT) < target) __builtin_amdgcn_s_sleep(2);
        __builtin_amdgcn_fence(__ATOMIC_ACQUIRE, "agent");
        asm volatile("s_waitcnt vmcnt(0)" ::: "memory");
    }
    __syncthreads();
    ++gen;
}
#define PHASE_BEGIN if (ph >= ph_lo && ph < ph_hi) { int tid = threadIdx.x; asm volatile("" : "+v"(tid)); const int lane = tid & 63, wid = __builtin_amdgcn_readfirstlane(tid >> 6); const int gw = blockIdx.x * 8 + wid, ngw = gridDim.x * 8; (void)lane; (void)gw; (void)ngw;
#define PHASE_END   if (ph + 1 < ph_hi) { if (ph == 0) { grid.sync(); if (threadIdx.x == 0) (void)xb_add(&xbar.bar[XB_XCNT(xbar.x)], 1u); } else xcd_barrier(xbar); } } ++ph;
template <int layer> __device__ __forceinline__ void layer_phases(const Params& P, LAS unsigned char* lds, cg::grid_group& grid, int& ph, const XcdBarrier& xbar, int ph_lo, int ph_hi, bf16_t* W, bf16_t* A, bf16_t* B, bf16_t* C, float* xo, float* xo_s) {
        const float* nw = P.in[11] + layer * 6144;
        if constexpr (layer == 1) {
            PHASE_BEGIN { EpiPlain<0> E{B, 1024, 1.f, RSV}; run_gemm(lds, A, W + W_INC, R, 1024, 1024, E); } PHASE_END
            PHASE_BEGIN for (int rp_ = 0; rp_ < REP_S5; ++rp_) s5_phase(P, lds, 1, wid, lane); PHASE_END
            PHASE_BEGIN for (int rp_ = 0; rp_ < REP_S5; ++rp_) s5_phase(P, lds, 2, wid, lane); PHASE_END
            PHASE_BEGIN { EpiGlu E{C}; run_gemm(lds, B + B_X2, W + W_GLU, R, 2048, 1024, E); } PHASE_END
            PHASE_BEGIN resnorm_phase<1, 0>(C, nullptr, nullptr, A, nw + 1024, RSV, nullptr, gw, ngw, lane); PHASE_END
        }
        PHASE_BEGIN { EpiPlain<0> E{B, 1024, 0.0625f * LOG2E, RSV}; run_gemm(lds, A, W + W_XQ + (size_t)layer * 1048576, R, 1024, 1024, E); } PHASE_END
        PHASE_BEGIN for (int rp_ = 0; rp_ < REP_XA; ++rp_) xattn_phase(P, lds, layer, tid, wid, lane); PHASE_END
        PHASE_BEGIN { EpiPlain<0> E{C, 1024, 1.f, nullptr}; run_gemm(lds, B + B_X2, W + W_XO + (size_t)layer * 1048576, R, 1024, 1024, E); } PHASE_END
        PHASE_BEGIN resnorm_phase<1, 0>(C, nullptr, nullptr, A, nw + 3072, RSV, nullptr, gw, ngw, lane); PHASE_END
        PHASE_BEGIN { EpiPlain<1> E{B, 4096, 1.f, RSV}; run_gemm(lds, A, W + W_UP + (size_t)layer * 4194304, R, 4096, 1024, E); } PHASE_END
        PHASE_BEGIN { EpiPlain<0> E{C, 1024, 1.f, nullptr}; run_gemm(lds, B, W + W_DN + (size_t)layer * 4194304, R, 1024, 4096, E); } PHASE_END
        PHASE_BEGIN { if constexpr (layer == 0) resnorm_phase<1, 0>(C, nullptr, nullptr, A, nw + 5120, RSV, nullptr, gw, ngw, lane); else resnorm_phase<1, 1>(C, nullptr, nullptr, A, nw + 5120, nullptr, xo, gw, ngw, lane); } PHASE_END
    }
__global__ void __launch_bounds__(512) mega_fwd(Params P, int ph_lo, int ph_hi) {
    extern __shared__ __attribute__((aligned(16))) unsigned char lds_raw[];
    LAS unsigned char* lds = (LAS unsigned char*)lds_raw;
    cg::grid_group grid = cg::this_grid();
    bf16_t* W = (bf16_t*)(P.ws + WS_W);
    bf16_t* A = (bf16_t*)(P.ws + WS_A);
    bf16_t* B = (bf16_t*)(P.ws + WS_B);
    bf16_t* C = (bf16_t*)(P.ws + WS_C);
    float* xo = P.out; float* xo_s = P.out + (size_t)RP * 1024;
    int ph = 0;
    unsigned* barw = (unsigned*)(P.ws + 4096);
    if (blockIdx.x == 0) for (int i = threadIdx.x; i < XCD_BAR_WORDS; i += 512) __hip_atomic_store(barw + i, 0u, __ATOMIC_RELAXED, __HIP_MEMORY_SCOPE_AGENT);
    volatile LAS unsigned* bst = (volatile LAS unsigned*)(lds + LDS_BYTES - 64);
    if (threadIdx.x == 0) { bst[0] = 0u; bst[1] = 0u; }
    __syncthreads();
    XcdBarrier xbar; xbar.bar = barw; xbar.x = xb_xcc_id(); xbar.st = bst;

    PHASE_BEGIN for (int rp_ = 0; rp_ < REP_PRO; ++rp_) prologue(P, tid, wid, lane); PHASE_END
    PHASE_BEGIN {
        EpiAB E{B, (bf16_t*)(P.ws + WS_FKS), (bf16_t*)(P.ws + WS_FVTS), P.out, (const float*)(P.ws + WS_ROPE), P.in[13], RSV};
        run_gemm(lds, A, W + W_AB, R, 3840, 1024, E);
        for (int l = 0; l < 2; ++l) {
            EpiMemKV E2{P.out + O_MK, P.out + O_MV, (bf16_t*)(P.ws + WS_MEMK), (bf16_t*)(P.ws + WS_MEMVT), l};
            run_gemm(lds, (const bf16_t*)(P.ws + WS_MEMN) + (size_t)l * 2048 * 1024, W + W_XKV + (size_t)l * 2097152, 2048, 2048, 1024, E2);
        }
    } PHASE_END
    PHASE_BEGIN { for (int rp_ = 0; rp_ < REP_RET; ++rp_) { ret_passA(P, wid, lane); if (blockIdx.x < 16) cumsum_task(P, blockIdx.x * 8 + wid, lane); } } PHASE_END
    PHASE_BEGIN ret_passB(P, tid); PHASE_END
    PHASE_BEGIN {
        LAS float* red = (LAS float*)lds;
        for (int rp_ = 0; rp_ < REP_RET; ++rp_)
        for (int u = blockIdx.x; u < 4096 + 32; u += gridDim.x) { if (u < 4096) ret_unitC<64>(P, red, u >> 7, u & 127, wid, lane); else ret_unitC<32>(P, red, u - 4096, 0, wid, lane); }
        __syncthreads();
        for (int rp_ = 0; rp_ < REP_FOX; ++rp_) { fox_phase(P, lds, tid, wid, lane); __syncthreads(); }
    } PHASE_END
    PHASE_BEGIN { EpiPlain<0> E{C, 1024, 1.f, nullptr}; run_gemm(lds, MIXED, W + W_OUT, R, 1024, 1024, E); } PHASE_END
    PHASE_BEGIN resnorm_phase<0, 0>(C, P.in[0], P.in[1], A, P.in[11] + 1024, RSV, nullptr, gw, ngw, lane); PHASE_END
    layer_phases<0>(P, lds, grid, ph, xbar, ph_lo, ph_hi, W, A, B, C, xo, xo_s);
    layer_phases<1>(P, lds, grid, ph, xbar, ph_lo, ph_hi, W, A, B, C, xo, xo_s);
}

extern "C" void kernel_launch(void* const* d_in, const int* in_sizes, int n_in, void* d_out, int out_size, void* d_ws, size_t ws_size, hipStream_t stream) {
    static int grid = 0;
    if (grid == 0) {
        if (n_in != 33 || (size_t)out_size != O_END || ws_size < WS_END) { fprintf(stderr, "kernel_launch: unexpected shapes n_in %d out %d ws %zu\n", n_in, out_size, ws_size); grid = -1; return; }
        int dev = 0, cus = 0, per_cu = 0;
        hipGetDevice(&dev);
        hipDeviceGetAttribute(&cus, hipDeviceAttributeMultiprocessorCount, dev);
        if (hipFuncSetAttribute((const void*)mega_fwd, hipFuncAttributeMaxDynamicSharedMemorySize, LDS_BYTES) != hipSuccess) { fprintf(stderr, "kernel_launch: hipFuncSetAttribute failed\n"); grid = -1; return; }
        if (hipOccupancyMaxActiveBlocksPerMultiprocessor(&per_cu, (const void*)mega_fwd, 512, LDS_BYTES) != hipSuccess || per_cu < 1) { fprintf(stderr, "kernel_launch: occupancy query %d\n", per_cu); per_cu = 1; (void)hipGetLastError(); }
        grid = cus * per_cu;
    }
    if (grid < 0) return;
    Params p{};
    for (int i = 0; i < 33; ++i) p.in[i] = (const float*)d_in[i];
    p.out = (float*)d_out; p.ws = (unsigned char*)d_ws;
    int lo = 0, hi = 1000;
    void* args[] = {&p, &lo, &hi};
    hipError_t e = hipLaunchCooperativeKernel((const void*)mega_fwd, dim3(grid), dim3(512), args, LDS_BYTES, stream);
    if (e != hipSuccess) fprintf(stderr, "cooperative launch failed: %s (grid %d)\n", hipGetErrorString(e), grid);
}
```

```cpp
#include <hip/hip_runtime.h>
#include <hip/hip_cooperative_groups.h>
#include <cstdio>
#include <cstdint>
namespace cg = cooperative_groups;
namespace pg8 {
#define PG8_LAS __attribute__((address_space(3)))
typedef unsigned short bf16_t;
typedef short bf16x8 __attribute__((ext_vector_type(8)));
typedef float f32x4 __attribute__((ext_vector_type(4)));
typedef unsigned u32x4 __attribute__((ext_vector_type(4)));
constexpr int BM = 256, BK = 64, HALF = 128, HTB = HALF * BK * 2  , STAGE_BYTES = 8 * HTB, NXCD = 8, WGM = 8;

__host__ __device__ __forceinline__ int lds_byte(int r, int c) { const int st = (r >> 4) * 2 + (c >> 5), rr = r & 15, cc = c & 31, ob = rr * 64 + cc * 2; return st * 1024 + (ob ^ (((ob >> 9) & 1) << 5)); }
__host__ __device__ __forceinline__ void stage_rc(int b, int& R, int& C) { const int st = b / 1024, sb = b % 1024, swz = sb ^ (((sb >> 9) & 1) << 5); R = (st >> 1) * 16 + swz / 64; C = (st & 1) * 32 + (swz % 64) / 2; }
__host__ __device__ __forceinline__ int perm32(int rho) { const int n = rho >> 4, i = rho & 15; return 8 * (i >> 2) + 4 * n + (i & 3); }

struct Unit { int pm, pn; };
struct Gemm { const bf16_t* A; const bf16_t* Bt; int M, N, K; };

struct StaticOrder {
    int nM, nN, nwg, G, c;
    __host__ __device__ void init(int M, int N, int G_, int c_) { nM = M / BM; nN = N / BM; nwg = nM * nN; G = G_; c = c_; }
    __host__ __device__ bool next(int i, Unit& u) const {
        const long L = (long)i * G + c; if (L >= nwg) return false;
        int wgid = (int)L; { const int q = nwg / NXCD, r = nwg % NXCD, xcd = wgid % NXCD, off = wgid / NXCD; wgid = (xcd < r ? xcd * (q + 1) : r * (q + 1) + (xcd - r) * q) + off; }
        const int nig = WGM * nN, gid = wgid / nig, fm = gid * WGM, gsz = (nM - fm) < WGM ? (nM - fm) : WGM;
        u.pm = fm + ((wgid % nig) % gsz); u.pn = (wgid % nig) / gsz; return true;
    }
    __device__ __forceinline__ void a_ready(const Unit&) const {}
    __device__ __forceinline__ void done(const Unit&) const {}
};

template <class Epi, class Sched, bool ALIGN_EPI = false, bool SP2 = false>
__device__ __forceinline__ void gemm_phase(PG8_LAS unsigned char* lds, const Gemm g, const Sched& S, const Epi& E) {
    int tid_l = threadIdx.x; asm volatile("" : "+v"(tid_l)); const int tid = tid_l, wid = __builtin_amdgcn_readfirstlane(tid >> 6), lane = tid & 63, wr = wid >> 2, wc = wid & 3, fr = lane & 15, fq = lane >> 4;
    const int K = g.K, nt = K / BK;
    unsigned voffA[2], voffB[2];
#pragma unroll
    for (int i = 0; i < 2; ++i) { int R, C; stage_rc(tid * 16 + i * 8192, R, C); const int Rb = Epi::PERM ? ((R & ~31) + perm32(R & 31)) : R;
        voffA[i] = (unsigned)(R * K + C) * 2u; voffB[i] = (unsigned)(Rb * K + C) * 2u; }
    const size_t kstep = (size_t)(BK * 2);
    const size_t hstep = (size_t)HALF * K * 2;
    const size_t tstep = 2 * hstep;
    const unsigned ldsw = (unsigned)wid * 1024u;
    const int aoff = lds_byte(wr * 64 + fr, fq * 8), boff = lds_byte(wc * 32 + fr, fq * 8);
#define PG8_SA(b, h) (((b) * 2 + (h)) * HTB)
#define PG8_SB(b, h) ((4 + (b) * 2 + (h)) * HTB)
#define PG8_STAGE(bufoff, gbase, voff) do { _Pragma("unroll") for (int _i = 0; _i < 2; ++_i) \
        __builtin_amdgcn_global_load_lds((const unsigned*)((const char*)(gbase) + (voff)[_i]), (PG8_LAS unsigned*)(lds + (bufoff) + ldsw + _i * 8192), 16, 0, 0); } while (0)
#define PG8_LDA(dst, b, h) do { _Pragma("unroll") for (int m = 0; m < 4; ++m) _Pragma("unroll") for (int k = 0; k < 2; ++k) dst[m][k] = *(const PG8_LAS bf16x8*)(lds + PG8_SA(b, h) + aoff + m * 2048 + k * 1024); } while (0)
#define PG8_LDB(dst, b, h) do { _Pragma("unroll") for (int n = 0; n < 2; ++n) _Pragma("unroll") for (int k = 0; k < 2; ++k) dst[n][k] = *(const PG8_LAS bf16x8*)(lds + PG8_SB(b, h) + boff + n * 2048 + k * 1024); } while (0)
#define PG8_MMA(ai, bj, At, Bt) do { __builtin_amdgcn_s_setprio(1); _Pragma("unroll") for (int m = 0; m < 4; ++m) _Pragma("unroll") for (int n = 0; n < 2; ++n) _Pragma("unroll") for (int k = 0; k < 2; ++k) \
        acc[ai][bj][m][n] = __builtin_amdgcn_mfma_f32_16x16x32_bf16(Bt[n][k], At[m][k], acc[ai][bj][m][n], 0, 0, 0); __builtin_amdgcn_s_setprio(0); } while (0)
#define PG8_WAIT_V(n) asm volatile("s_waitcnt vmcnt(" #n ")" ::: "memory")
#define PG8_WAIT_L(n) asm volatile("s_waitcnt lgkmcnt(" #n ")" ::: "memory")
#define PG8_BAR __builtin_amdgcn_s_barrier()
#define PG8_SCHED __builtin_amdgcn_sched_barrier(0)
    Unit cur, nxt; int ui = 0;
    if (!S.next(0, cur)) return;
    f32x4 acc[2][2][4][2];
#pragma unroll
    for (int a = 0; a < 2; ++a)
#pragma unroll
        for (int b = 0; b < 2; ++b)
#pragma unroll
            for (int m = 0; m < 4; ++m)
#pragma unroll
                for (int n = 0; n < 2; ++n) acc[a][b][m][n] = (f32x4){0.f, 0.f, 0.f, 0.f};
    bf16x8 At[4][2], B0[2][2], B1[2][2];
    const char* cA = (const char*)g.A + (size_t)cur.pm * tstep; const char* cB = (const char*)g.Bt + (size_t)cur.pn * tstep;
    S.a_ready(cur);
    if constexpr (SP2) {
        PG8_STAGE(PG8_SB(0, 0), cB, voffB); PG8_STAGE(PG8_SB(0, 1), cB + hstep, voffB); PG8_STAGE(PG8_SA(0, 0), cA, voffA); PG8_STAGE(PG8_SA(0, 1), cA + hstep, voffA);
        if (wr == 1) PG8_BAR;
        PG8_WAIT_V(2); PG8_BAR;
        PG8_STAGE(PG8_SB(1, 0), cB + kstep, voffB); PG8_STAGE(PG8_SA(1, 0), cA + kstep, voffA); PG8_STAGE(PG8_SB(1, 1), cB + hstep + kstep, voffB);
        PG8_WAIT_V(6); PG8_BAR;
    } else {
        PG8_STAGE(PG8_SB(0, 0), cB, voffB); PG8_STAGE(PG8_SA(0, 0), cA, voffA); PG8_STAGE(PG8_SB(0, 1), cB + hstep, voffB); PG8_STAGE(PG8_SA(0, 1), cA + hstep, voffA);
        if (wr == 1) PG8_BAR;
        PG8_WAIT_V(4); PG8_BAR;
        PG8_STAGE(PG8_SB(1, 0), cB + kstep, voffB); PG8_STAGE(PG8_SA(1, 0), cA + kstep, voffA); PG8_STAGE(PG8_SB(1, 1), cB + hstep + kstep, voffB);
        PG8_WAIT_V(6); PG8_BAR;
    }
    for (;;) {
        const bool has_next = S.next(ui + 1, nxt);
        const char* nA = has_next ? (const char*)g.A + (size_t)nxt.pm * tstep : cA; const char* nB = has_next ? (const char*)g.Bt + (size_t)nxt.pn * tstep : cB;
        for (int t = 0; t < nt; t += 2) {
            const bool last = (t == nt - 2);
            const char* a1 = cA + (size_t)(t + 1) * kstep;
            const char* a2 = last ? nA : cA + (size_t)(t + 2) * kstep; const char* b2 = last ? nB : cB + (size_t)(t + 2) * kstep;
            const char* a3 = a2 + kstep; const char* b3 = b2 + kstep;
            if (last && has_next) S.a_ready(nxt);
            if constexpr (SP2) {
            PG8_LDB(B0, 0, 0); PG8_LDB(B1, 0, 1); PG8_SCHED; PG8_LDA(At, 0, 0); PG8_STAGE(PG8_SA(1, 1), a1 + hstep, voffA);
            PG8_WAIT_V(8); PG8_WAIT_L(0); PG8_BAR; PG8_MMA(0, 0, At, B0); PG8_MMA(0, 1, At, B1); PG8_BAR; PG8_SCHED;
            PG8_LDA(At, 0, 1); PG8_STAGE(PG8_SB(0, 0), b2, voffB); PG8_STAGE(PG8_SB(0, 1), b2 + hstep, voffB); PG8_STAGE(PG8_SA(0, 0), a2, voffA);
            PG8_WAIT_V(8); PG8_WAIT_L(0); PG8_BAR; PG8_MMA(1, 0, At, B0); PG8_MMA(1, 1, At, B1); PG8_BAR; PG8_SCHED;
            PG8_LDB(B0, 1, 0); PG8_LDB(B1, 1, 1); PG8_SCHED; PG8_LDA(At, 1, 0); PG8_STAGE(PG8_SA(0, 1), a2 + hstep, voffA);
            PG8_WAIT_V(8); PG8_WAIT_L(0); PG8_BAR; PG8_MMA(0, 0, At, B0); PG8_MMA(0, 1, At, B1); PG8_BAR; PG8_SCHED;
            PG8_LDA(At, 1, 1); PG8_STAGE(PG8_SB(1, 0), b3, voffB); PG8_STAGE(PG8_SB(1, 1), b3 + hstep, voffB); PG8_STAGE(PG8_SA(1, 0), a3, voffA);
            PG8_WAIT_V(8); PG8_WAIT_L(0); PG8_BAR; PG8_MMA(1, 0, At, B0); PG8_MMA(1, 1, At, B1); PG8_BAR; PG8_SCHED;
            } else {
            PG8_LDB(B0, 0, 0); PG8_SCHED; PG8_LDA(At, 0, 0); PG8_STAGE(PG8_SA(1, 1), a1 + hstep, voffA);
            PG8_WAIT_L(8); PG8_BAR; PG8_WAIT_L(0); PG8_MMA(0, 0, At, B0); PG8_BAR; PG8_SCHED;
            PG8_LDB(B1, 0, 1); PG8_STAGE(PG8_SB(0, 0), b2, voffB);
            PG8_BAR; PG8_WAIT_L(0); PG8_MMA(0, 1, At, B1); PG8_BAR;
            PG8_LDA(At, 0, 1); PG8_STAGE(PG8_SA(0, 0), a2, voffA);
            PG8_BAR; PG8_WAIT_L(0); PG8_MMA(1, 0, At, B0); PG8_BAR; PG8_SCHED;
            PG8_STAGE(PG8_SB(0, 1), b2 + hstep, voffB);
            PG8_WAIT_V(6); PG8_BAR; PG8_MMA(1, 1, At, B1); PG8_BAR;
            PG8_LDB(B0, 1, 0); PG8_SCHED; PG8_LDA(At, 1, 0); PG8_STAGE(PG8_SA(0, 1), a2 + hstep, voffA);
            PG8_WAIT_L(8); PG8_BAR; PG8_WAIT_L(0); PG8_MMA(0, 0, At, B0); PG8_BAR; PG8_SCHED;
            PG8_LDB(B1, 1, 1); PG8_STAGE(PG8_SB(1, 0), b3, voffB);
            PG8_BAR; PG8_WAIT_L(0); PG8_MMA(0, 1, At, B1); PG8_BAR;
            PG8_LDA(At, 1, 1); PG8_STAGE(PG8_SA(1, 0), a3, voffA);
            PG8_BAR; PG8_WAIT_L(0); PG8_MMA(1, 0, At, B0); PG8_BAR; PG8_SCHED;
            PG8_STAGE(PG8_SB(1, 1), b3 + hstep, voffB);
            PG8_WAIT_V(6); PG8_BAR; PG8_MMA(1, 1, At, B1); PG8_BAR;
            }
        }
        if constexpr (ALIGN_EPI) { if (wr == 0) PG8_BAR; }
        if constexpr (!Epi::AFTER_DRAIN) { E(acc, cur, wr, wc, fr, fq); S.done(cur); }
        if (!has_next) break;
#pragma unroll
        for (int a = 0; a < 2; ++a)
#pragma unroll
            for (int b = 0; b < 2; ++b)
#pragma unroll
                for (int m = 0; m < 4; ++m)
#pragma unroll
                    for (int n = 0; n < 2; ++n) acc[a][b][m][n] = (f32x4){0.f, 0.f, 0.f, 0.f};
        cur = nxt; cA = nA; cB = nB; ++ui;
        if constexpr (ALIGN_EPI) { if (wr == 1) PG8_BAR; }
    }
    PG8_WAIT_V(0);
    if constexpr (!ALIGN_EPI) { if (wr == 0) PG8_BAR; }
    PG8_BAR;
    if constexpr (Epi::AFTER_DRAIN) { E.fused(acc, cur, wr, wc, fr, fq, lds, wid, lane); S.done(cur); }
#undef PG8_SA
#undef PG8_SB
#undef PG8_STAGE
#undef PG8_LDA
#undef PG8_LDB
#undef PG8_MMA
#undef PG8_WAIT_V
#undef PG8_WAIT_L
#undef PG8_BAR
#undef PG8_SCHED
}
}
#ifndef REP_FOX
#define REP_FOX 1
#endif
#ifndef REP_PRO
#define REP_PRO 1
#endif
#ifndef REP_RET
#define REP_RET 1
#endif
#ifndef REP_XA
#define REP_XA 1
#endif
#ifndef REP_S5
#define REP_S5 1
#endif

#define LAS __attribute__((address_space(3)))
typedef unsigned short bf16_t;
typedef short bf16x8 __attribute__((ext_vector_type(8)));
typedef short s16x4 __attribute__((ext_vector_type(4)));
typedef float f32x4 __attribute__((ext_vector_type(4)));
typedef float f32x2 __attribute__((ext_vector_type(2)));
typedef float f32x16 __attribute__((ext_vector_type(16)));
typedef unsigned u32x4 __attribute__((ext_vector_type(4)));
typedef unsigned u32x2 __attribute__((ext_vector_type(2)));
typedef __bf16 bf16x2_t __attribute__((ext_vector_type(2)));
using pg8::Unit;

__device__ __forceinline__ unsigned pk2(float lo, float hi) { f32x2 v = {lo, hi}; bf16x2_t b = __builtin_convertvector(v, bf16x2_t); return __builtin_bit_cast(unsigned, b); }
__device__ __forceinline__ float bflo(unsigned w) { return __uint_as_float(w << 16); }
__device__ __forceinline__ float bfhi(unsigned w) { return __uint_as_float(w & 0xffff0000u); }
__device__ __forceinline__ bf16_t f2bf(float f) { return (bf16_t)(pk2(f, 0.f) & 0xffffu); }
__device__ __forceinline__ float ex2(float x) { return __builtin_amdgcn_exp2f(x); }
__device__ __forceinline__ float wave_sum(float v) {
#pragma unroll
    for (int o = 1; o < 64; o <<= 1) v += __shfl_xor(v, o);
    return v;
}
#define LDSBAR() asm volatile("s_waitcnt lgkmcnt(0)" ::: "memory")
#define MFMA32(a, b, c) __builtin_amdgcn_mfma_f32_32x32x16_bf16((a), (b), (c), 0, 0, 0)
#define MFMA16(a, b, c) __builtin_amdgcn_mfma_f32_16x16x32_bf16((a), (b), (c), 0, 0, 0)

constexpr int DM = 1024, RP = 65536, RS = 256, R = RP + RS, T = 8192, TS = 32, PAST = 4096, TKS = PAST + TS;
constexpr float LOG2E = 1.4426950408889634f;
constexpr float EPS = 1e-6f;
constexpr size_t O_Y = 0, O_RSP = (size_t)R * 1024, O_RSS = O_RSP + 524288, O_FKP = O_RSS + 524288, O_FVP = O_FKP + (size_t)RP * 512,
                 O_LFP = O_FVP + (size_t)RP * 512, O_FKS = O_LFP + (size_t)RP * 8, O_FVS = O_FKS + 131072, O_LFS = O_FVS + 131072,
                 O_S5RP = O_LFS + 2048, O_S5IP = O_S5RP + 32768, O_S5RS = O_S5IP + 32768, O_S5IS = O_S5RS + 32768, O_MK = O_S5IS + 32768,
                 O_MV = O_MK + 4194304, O_END = O_MV + 4194304;
constexpr size_t MiB = 1u << 20;
constexpr size_t WS_W = 1 * MiB, WS_ROPE = 65 * MiB, WS_C2P = 69 * MiB, WS_C2S = 71 * MiB, WS_MEMN = 73 * MiB, WS_MEMK = 81 * MiB, WS_MEMVT = 97 * MiB,
                 WS_S5T = 113 * MiB, WS_LE = 114 * MiB, WS_KVS = 118 * MiB, WS_A = 120 * MiB, WS_B = 249 * MiB, WS_C = 763 * MiB, WS_FKS = 892 * MiB,
                 WS_FVTS = 925 * MiB, WS_END = 960 * MiB;
constexpr size_t W_AB = 0, W_OUT = W_AB + 3840 * 1024, W_INC = W_OUT + 1048576, W_GLU = W_INC + 1048576, W_XQ = W_GLU + 2097152, W_XKV = W_XQ + 2097152,
                 W_XO = W_XKV + 4194304, W_UP = W_XO + 2097152, W_DN = W_UP + 8388608, W_ENDE = W_DN + 8388608;
static_assert(W_ENDE * 2 <= 64 * MiB, "weights region");
constexpr size_t B_RQ = 0, B_RK = (size_t)R * 512, B_RG = 2 * (size_t)R * 512, B_FQ = 3 * (size_t)R * 512, B_FK = 4 * (size_t)R * 512, B_KT = 5 * (size_t)R * 512,
                 B_VT = B_KT + (size_t)RP * 512, B_FVT = B_VT + (size_t)RP * 512, B_KTS = B_FVT + (size_t)RP * 512, B_VTS = B_KTS + 131072, B_ENDE = B_VTS + 131072;
static_assert(B_ENDE * 2 <= 514 * MiB, "region B");
constexpr size_t B_X2 = 129 * MiB / 2;
constexpr size_t WS_RS = 119 * MiB;
#define RSV ((float*)(P.ws + WS_RS))
#define MIXED ((bf16_t*)P.out)
constexpr int LDS_BYTES = 139264;

struct Params {
    const float* in[33];
    float* out;
    unsigned char* ws;
};

template <int ACT  > struct EpiPlain {
    static constexpr bool PERM = true, AFTER_DRAIN = false;
    bf16_t* O; int ldc; float scale; const float* rs;
    __device__ __forceinline__ void operator()(const f32x4 (&acc)[2][2][4][2], const Unit& u, int wr, int wc, int fr, int fq) const {
        asm volatile("" : "+v"(fr), "+v"(fq));
        bf16_t* base = O + (size_t)(u.pm * 256 + wr * 64 + fr) * ldc + u.pn * 256 + wc * 32 + fq * 8;
#pragma unroll
        for (int ai = 0; ai < 2; ++ai)
#pragma unroll
            for (int m = 0; m < 4; ++m) {
                bf16_t* rp = base + (size_t)(ai * 128 + m * 16) * ldc;
                const float rsc = rs ? rs[u.pm * 256 + wr * 64 + fr + ai * 128 + m * 16] * scale : scale;
#pragma unroll
                for (int bj = 0; bj < 2; ++bj) {
                    f32x4 v0 = acc[ai][bj][m][0] * rsc, v1 = acc[ai][bj][m][1] * rsc;
                    if (ACT == 1) { v0.x = fmaxf(v0.x, 0.f); v0.y = fmaxf(v0.y, 0.f); v0.z = fmaxf(v0.z, 0.f); v0.w = fmaxf(v0.w, 0.f); v0 = v0 * v0;
                                    v1.x = fmaxf(v1.x, 0.f); v1.y = fmaxf(v1.y, 0.f); v1.z = fmaxf(v1.z, 0.f); v1.w = fmaxf(v1.w, 0.f); v1 = v1 * v1; }
                    u32x4 w; w.x = pk2(v0.x, v0.y); w.y = pk2(v0.z, v0.w); w.z = pk2(v1.x, v1.y); w.w = pk2(v1.z, v1.w);
                    *(u32x4*)(rp + bj * 128) = w;
                }
            }
    }
};
struct EpiGlu {
    static constexpr bool PERM = false, AFTER_DRAIN = false;
    bf16_t* O;
    __device__ __forceinline__ void operator()(const f32x4 (&acc)[2][2][4][2], const Unit& u, int wr, int wc, int fr, int fq) const {
        asm volatile("" : "+v"(fr), "+v"(fq));
#pragma unroll
        for (int ai = 0; ai < 2; ++ai)
#pragma unroll
            for (int m = 0; m < 4; ++m) {
                const int row = u.pm * 256 + ai * 128 + wr * 64 + m * 16 + fr;
                bf16_t* rp = O + (size_t)row * 1024 + u.pn * 128 + wc * 32 + fq * 4;
#pragma unroll
                for (int n = 0; n < 2; ++n) {
                    const f32x4 a = acc[ai][0][m][n], g = acc[ai][1][m][n];
                    f32x4 v;
                    v.x = a.x / (1.f + __expf(-g.x)); v.y = a.y / (1.f + __expf(-g.y)); v.z = a.z / (1.f + __expf(-g.z)); v.w = a.w / (1.f + __expf(-g.w));
                    u32x2 w; w.x = pk2(v.x, v.y); w.y = pk2(v.z, v.w);
                    *(u32x2*)(rp + n * 16) = w;
                }
            }
    }
};
struct EpiMemKV {
    static constexpr bool PERM = false, AFTER_DRAIN = false;
    float* oK; float* oV; bf16_t* mk; bf16_t* mvt; int layer;
    __device__ __forceinline__ void operator()(const f32x4 (&acc)[2][2][4][2], const Unit& u, int wr, int wc, int fr, int fq) const {
        asm volatile("" : "+v"(fr), "+v"(fq));
        const bool isv = u.pn >= 4;
#pragma unroll
        for (int ai = 0; ai < 2; ++ai)
#pragma unroll
            for (int m = 0; m < 4; ++m) {
                const int row = u.pm * 256 + ai * 128 + wr * 64 + m * 16 + fr;
                const int b = row >> 8, mm = row & 255;
#pragma unroll
                for (int bj = 0; bj < 2; ++bj)
#pragma unroll
                    for (int n = 0; n < 2; ++n) {
                        const int col = (u.pn & 3) * 256 + bj * 128 + wc * 32 + n * 16 + fq * 4;
                        const f32x4 v = acc[ai][bj][m][n];
                        if (!isv) {
                            *(f32x4*)(oK + ((size_t)layer * 2048 + row) * 1024 + col) = v;
                            u32x2 w; w.x = pk2(v.x, v.y); w.y = pk2(v.z, v.w);
                            *(u32x2*)(mk + ((size_t)(layer * 16 + b) * 256 + mm) * 1024 + col) = w;
                        } else {
                            *(f32x4*)(oV + ((size_t)layer * 2048 + row) * 1024 + col) = v;
                            bf16_t* p = mvt + ((size_t)(layer * 16 + b) * 1024 + col) * 256 + mm;
                            p[0] = f2bf(v.x); p[256] = f2bf(v.y); p[512] = f2bf(v.z); p[768] = f2bf(v.w);
                        }
                    }
            }
    }
};
__device__ __forceinline__ float logsig(float x) { return x >= 0.f ? -log1pf(__expf(-x)) : x - log1pf(__expf(x)); }
struct EpiAB {
    static constexpr bool PERM = false, AFTER_DRAIN = false;
    bf16_t* B;
    bf16_t* fks; bf16_t* fvts;
    float* out; const float* rope; const float* bfox; const float* rs;
    __device__ __forceinline__ void operator()(const f32x4 (&acc)[2][2][4][2], const Unit& u, int wr, int wc, int fr, int fq) const {
        asm volatile("" : "+v"(fr), "+v"(fq));
        switch (u.pn >> 1) {
            case 0: body<0>(acc, u, wr, wc, fr, fq); break; case 1: body<1>(acc, u, wr, wc, fr, fq); break; case 2: body<2>(acc, u, wr, wc, fr, fq); break;
            case 3: body<3>(acc, u, wr, wc, fr, fq); break; case 4: body<4>(acc, u, wr, wc, fr, fq); break; case 5: body<5>(acc, u, wr, wc, fr, fq); break;
            case 6: body<6>(acc, u, wr, wc, fr, fq); break; default: body<7>(acc, u, wr, wc, fr, fq); break;
        }
    }
    template <int sect> __device__ __forceinline__ void body(const f32x4 (&acc)[2][2][4][2], const Unit& u, int wr, int wc, int fr, int fq) const {
        rowgrp<sect, 0, 0>(acc, u, wr, wc, fr, fq); rowgrp<sect, 0, 1>(acc, u, wr, wc, fr, fq); rowgrp<sect, 0, 2>(acc, u, wr, wc, fr, fq); rowgrp<sect, 0, 3>(acc, u, wr, wc, fr, fq);
        rowgrp<sect, 1, 0>(acc, u, wr, wc, fr, fq); rowgrp<sect, 1, 1>(acc, u, wr, wc, fr, fq); rowgrp<sect, 1, 2>(acc, u, wr, wc, fr, fq); rowgrp<sect, 1, 3>(acc, u, wr, wc, fr, fq);
    }
    template <int sect, int ai, int m> __device__ __forceinline__ void rowgrp(const f32x4 (&acc)[2][2][4][2], const Unit& u, int wr, int wc, int fr, int fq) const {
        const int pn = u.pn;
            {
                const int row = u.pm * 256 + ai * 128 + wr * 64 + m * 16 + fr;
                const bool samp = row >= RP;
                const int rr = row - RP;
                const int b = samp ? (rr >> 5) : (row >> 13);
                const int t = samp ? (rr & 31) : (row & 8191);
                const int pos = samp ? PAST + t : t;
                const float rsc = rs[row];
#pragma unroll
                for (int bj = 0; bj < 2; ++bj)
#pragma unroll
                    for (int n = 0; n < 2; ++n) {
                        const int sec = (pn & 1) * 256 + bj * 128 + wc * 32 + n * 16 + fq * 4;
                        f32x4 v = acc[ai][bj][m][n] * rsc;
                        if constexpr (sect <= 1) {
                            const int hd = sec >> 7, w = sec & 127, i0 = w >> 1;
                            const f32x4 cs = *(const f32x4*)(rope + ((size_t)pos * 64 + i0) * 2);
                            f32x4 o;
                            o.x = v.x * cs.x - v.y * cs.y; o.y = v.y * cs.x + v.x * cs.y;
                            o.z = v.z * cs.z - v.w * cs.w; o.w = v.w * cs.z + v.z * cs.w;
                            if constexpr (sect == 0) {
                                u32x2 wv; wv.x = pk2(o.x, o.y); wv.y = pk2(o.z, o.w);
                                *(u32x2*)(B + B_RQ + (size_t)row * 512 + sec) = wv;
                            } else {
                                o = o * 0.08838834764831845f;
                                u32x2 wv; wv.x = pk2(o.x, o.y); wv.y = pk2(o.z, o.w);
                                *(u32x2*)(B + B_RK + (size_t)row * 512 + sec) = wv;
                                const float lg2 = __log2f(1.f - ex2((float)(-5 - hd)));
                                if (!samp) {
                                    const int j = t & 63; const float wk = ex2(lg2 * (float)(63 - j));
                                    bf16_t* p = B + B_KT + ((size_t)((b * 4 + hd) * 128 + (t >> 6)) * 128 + w) * 64 + j;
                                    p[0] = f2bf(o.x * wk); p[64] = f2bf(o.y * wk); p[128] = f2bf(o.z * wk); p[192] = f2bf(o.w * wk);
                                } else {
                                    const float wk = ex2(lg2 * (float)(31 - t));
                                    bf16_t* p = B + B_KTS + ((size_t)(b * 4 + hd) * 128 + w) * 32 + t;
                                    p[0] = f2bf(o.x * wk); p[32] = f2bf(o.y * wk); p[64] = f2bf(o.z * wk); p[96] = f2bf(o.w * wk);
                                }
                            }
                        } else if constexpr (sect == 2) {
                            const int hd = sec >> 7, w = sec & 127;
                            if (!samp) {
                                bf16_t* p = B + B_VT + ((size_t)((b * 4 + hd) * 128 + (t >> 6)) * 128 + w) * 64 + (t & 63);
                                p[0] = f2bf(v.x); p[64] = f2bf(v.y); p[128] = f2bf(v.z); p[192] = f2bf(v.w);
                            } else {
                                bf16_t* p = B + B_VTS + ((size_t)(b * 4 + hd) * 128 + w) * 32 + t;
                                p[0] = f2bf(v.x); p[32] = f2bf(v.y); p[64] = f2bf(v.z); p[96] = f2bf(v.w);
                            }
                        } else if constexpr (sect == 3) {
                            f32x4 o; o.x = v.x / (1.f + __expf(-v.x)); o.y = v.y / (1.f + __expf(-v.y)); o.z = v.z / (1.f + __expf(-v.z)); o.w = v.w / (1.f + __expf(-v.w));
                            u32x2 wv; wv.x = pk2(o.x, o.y); wv.y = pk2(o.z, o.w);
                            *(u32x2*)(B + B_RG + (size_t)row * 512 + sec) = wv;
                        } else if constexpr (sect == 4) {
                            const f32x4 o = v * (0.125f * LOG2E);
                            u32x2 wv; wv.x = pk2(o.x, o.y); wv.y = pk2(o.z, o.w);
                            *(u32x2*)(B + B_FQ + (size_t)row * 512 + sec) = wv;
                        } else if constexpr (sect == 5) {
                            u32x2 wv; wv.x = pk2(v.x, v.y); wv.y = pk2(v.z, v.w);
                            if (!samp) { *(f32x4*)(out + O_FKP + (size_t)row * 512 + sec) = v; *(u32x2*)(B + B_FK + (size_t)row * 512 + sec) = wv; }
                            else { *(f32x4*)(out + O_FKS + (size_t)rr * 512 + sec) = v; *(u32x2*)(fks + ((size_t)b * TKS + PAST + t) * 512 + sec) = wv; }
                        } else if constexpr (sect == 6) {
                            if (!samp) {
                                *(f32x4*)(out + O_FVP + (size_t)row * 512 + sec) = v;
                                bf16_t* p = B + B_FVT + ((size_t)b * 512 + sec) * T + t;
                                p[0] = f2bf(v.x); p[T] = f2bf(v.y); p[2 * T] = f2bf(v.z); p[3 * T] = f2bf(v.w);
                            } else {
                                *(f32x4*)(out + O_FVS + (size_t)rr * 512 + sec) = v;
                                bf16_t* p = fvts + ((size_t)b * 512 + sec) * TKS + PAST + t;
                                p[0] = f2bf(v.x); p[TKS] = f2bf(v.y); p[2 * TKS] = f2bf(v.z); p[3 * TKS] = f2bf(v.w);
                            }
                        } else {
                            if (sec < 8) {
                                const f32x4 bb = *(const f32x4*)(bfox + sec);
                                f32x4 o; o.x = logsig(v.x + bb.x); o.y = logsig(v.y + bb.y); o.z = logsig(v.z + bb.z); o.w = logsig(v.w + bb.w);
                                if (!samp) *(f32x4*)(out + O_LFP + (size_t)row * 8 + sec) = o;
                                else *(f32x4*)(out + O_LFS + (size_t)rr * 8 + sec) = o;
                            }
                        }
                    }
                asm volatile("" ::: "memory");
            }
    }
};

__device__ __forceinline__ void wtrans(const float* __restrict__ src, int K, int Ns, bf16_t* dst, int Nd, int mode, int gtid, int gsz, const float* gk = nullptr) {
    const int nb = Nd >> 3, items = nb * (K >> 6) * 64;
    for (int it = gtid; it < items; it += gsz) {
        const int ln = it & 63, blk = it >> 6;
        const int n = (blk % nb) * 8 + (ln >> 3), k0 = (blk / nb) * 64 + (ln & 7) * 8;
        int col = n; bool z = false;
        if (mode == 1) { if (n < 1024) { const int w = n & 127; col = (n & ~127) + (w >> 1) + 64 * (w & 1); } else if (n >= 3592) z = true; }
        else if (mode == 2) { col = ((n >> 7) & 1) * 1024 + (n >> 8) * 128 + (n & 127); }
        const float* s = src + (size_t)k0 * Ns + (z ? 0 : col);
        float v0 = s[0], v1 = s[(size_t)Ns], v2 = s[2 * (size_t)Ns], v3 = s[3 * (size_t)Ns], v4 = s[4 * (size_t)Ns], v5 = s[5 * (size_t)Ns], v6 = s[6 * (size_t)Ns], v7 = s[7 * (size_t)Ns];
        if (gk) { const f32x4 ga_ = *(const f32x4*)(gk + k0), gb_ = *(const f32x4*)(gk + k0 + 4); v0 *= ga_.x; v1 *= ga_.y; v2 *= ga_.z; v3 *= ga_.w; v4 *= gb_.x; v5 *= gb_.y; v6 *= gb_.z; v7 *= gb_.w; }
        u32x4 o; o.x = pk2(v0, v1); o.y = pk2(v2, v3); o.z = pk2(v4, v5); o.w = pk2(v6, v7);
        if (z) o = (u32x4){0u, 0u, 0u, 0u};
        *(u32x4*)(dst + (size_t)n * K + k0) = o;
    }
}
__device__ __forceinline__ void ttrans(const float* __restrict__ src, int rows, int C, bf16_t* dst, size_t dpitch, int gtid, int gsz) {
    const int cb = C >> 3, items = cb * (rows >> 6) * 64;
    for (int it = gtid; it < items; it += gsz) {
        const int ln = it & 63, blk = it >> 6;
        const int c = (blk % cb) * 8 + (ln >> 3), r0 = (blk / cb) * 64 + (ln & 7) * 8;
        const float* s = src + (size_t)r0 * C + c;
        float v0 = s[0], v1 = s[(size_t)C], v2 = s[2 * (size_t)C], v3 = s[3 * (size_t)C], v4 = s[4 * (size_t)C], v5 = s[5 * (size_t)C], v6 = s[6 * (size_t)C], v7 = s[7 * (size_t)C];
        u32x4 o; o.x = pk2(v0, v1); o.y = pk2(v2, v3); o.z = pk2(v4, v5); o.w = pk2(v6, v7);
        *(u32x4*)(dst + (size_t)c * dpitch + r0) = o;
    }
}
__device__ __forceinline__ void cvt8(const float* __restrict__ s, bf16_t* d) {
    const f32x4 a = *(const f32x4*)s, b = *(const f32x4*)(s + 4);
    u32x4 o; o.x = pk2(a.x, a.y); o.y = pk2(a.z, a.w); o.z = pk2(b.x, b.y); o.w = pk2(b.z, b.w);
    *(u32x4*)d = o;
}
__device__ __forceinline__ void norm_row(const float* xr, const float* g, bf16_t* orow, int lane) {
    f32x4 v[4]; float s = 0.f;
#pragma unroll
    for (int j = 0; j < 4; ++j) { v[j] = ((const f32x4*)xr)[lane + 64 * j]; s += (v[j].x * v[j].x + v[j].y * v[j].y) + (v[j].z * v[j].z + v[j].w * v[j].w); }
    const float rstd = rsqrtf(wave_sum(s) * (1.f / 1024.f) + EPS);
#pragma unroll
    for (int j = 0; j < 4; ++j) { const f32x4 gg = ((const f32x4*)g)[lane + 64 * j]; const f32x4 o = v[j] * rstd * gg; u32x2 w; w.x = pk2(o.x, o.y); w.y = pk2(o.z, o.w); ((u32x2*)orow)[lane + 64 * j] = w; }
}
__device__ __forceinline__ void cvt_row(const float* xr, bf16_t* orow, float* rs, int lane) {
    f32x4 v[4]; float s = 0.f;
#pragma unroll
    for (int j = 0; j < 4; ++j) { v[j] = ((const f32x4*)xr)[lane + 64 * j]; s += (v[j].x * v[j].x + v[j].y * v[j].y) + (v[j].z * v[j].z + v[j].w * v[j].w); }
    const float rstd = rsqrtf(wave_sum(s) * (1.f / 1024.f) + EPS);
#pragma unroll
    for (int j = 0; j < 4; ++j) { u32x2 w; w.x = pk2(v[j].x, v[j].y); w.y = pk2(v[j].z, v[j].w); ((u32x2*)orow)[lane + 64 * j] = w; }
    if (lane == 0) *rs = rstd;
}
struct RnRow { f32x4 x[4]; u32x2 m[4]; };
template <int IN> __device__ __forceinline__ void rn_load(RnRow& r, const bf16_t* mix, const float* xp, const float* xs, const bf16_t* xb, int row, int lane) {
#pragma unroll
    for (int j = 0; j < 4; ++j) {
        if (IN == 0) { const float* xr = row < RP ? xp + (size_t)row * 1024 : xs + (size_t)(row - RP) * 1024; r.x[j] = __builtin_nontemporal_load((const f32x4*)xr + lane + 64 * j); }
        else { const u32x2 w = *((const u32x2*)(xb + (size_t)row * 1024) + lane + 64 * j); r.x[j] = (f32x4){bflo(w.x), bfhi(w.x), bflo(w.y), bfhi(w.y)}; }
        r.m[j] = __builtin_nontemporal_load((const u32x2*)(mix + (size_t)row * 1024) + lane + 64 * j);
    }
}
template <int OUT> __device__ __forceinline__ void rn_proc(const RnRow& r, const float* ga, bf16_t* xb, float* rs, float* yout, int row, int lane) {
    f32x4 xv[4], mv[4]; float s = 0.f;
#pragma unroll
    for (int j = 0; j < 4; ++j) {
        const u32x2 w = r.m[j];
        mv[j] = (f32x4){bflo(w.x), bfhi(w.x), bflo(w.y), bfhi(w.y)};
        s += (mv[j].x * mv[j].x + mv[j].y * mv[j].y) + (mv[j].z * mv[j].z + mv[j].w * mv[j].w);
    }
    const float rm = rsqrtf(wave_sum(s) * (1.f / 1024.f) + EPS);
    float s2 = 0.f;
#pragma unroll
    for (int j = 0; j < 4; ++j) {
        const f32x4 gg = ((const f32x4*)ga)[lane + 64 * j];
        xv[j] = r.x[j] + mv[j] * rm * gg;
        if (OUT == 1) ((f32x4*)(yout + (size_t)row * 1024))[lane + 64 * j] = xv[j];
        else { u32x2 w; w.x = pk2(xv[j].x, xv[j].y); w.y = pk2(xv[j].z, xv[j].w); ((u32x2*)(xb + (size_t)row * 1024))[lane + 64 * j] = w; }
        s2 += (xv[j].x * xv[j].x + xv[j].y * xv[j].y) + (xv[j].z * xv[j].z + xv[j].w * xv[j].w);
    }
    if (OUT == 0) { const float rx = rsqrtf(wave_sum(s2) * (1.f / 1024.f) + EPS); if (lane == 0) rs[row] = rx; }
}
template <int IN, int OUT> __device__ __forceinline__ void resnorm_rows(const bf16_t* mix, const float* xp, const float* xs, bf16_t* xb, const float* ga, float* rs, float* yout, int row_lo, int row_hi, int gw, int ngw, int lane) {
    int row = row_lo + gw * 2;
    if (row >= row_hi) return;
    RnRow a0, a1, b0, b1;
    rn_load<IN>(a0, mix, xp, xs, xb, row, lane); rn_load<IN>(a1, mix, xp, xs, xb, row + 1, lane);
    for (;;) {
        const int nrow = row + ngw * 2;
        const bool more = nrow < row_hi;
        if (more) { rn_load<IN>(b0, mix, xp, xs, xb, nrow, lane); rn_load<IN>(b1, mix, xp, xs, xb, nrow + 1, lane); }
        rn_proc<OUT>(a0, ga, xb, rs, yout, row, lane); rn_proc<OUT>(a1, ga, xb, rs, yout, row + 1, lane);
        if (!more) break;
        a0 = b0; a1 = b1; row = nrow;
    }
}

__device__ __forceinline__ float ret_lg2(int h) { return __log2f(1.f - ex2((float)(-5 - h))); }
__device__ __forceinline__ void ret_passA(const Params& P, int wid, int lane) {
    bf16_t* B = (bf16_t*)(P.ws + WS_B);
    bf16_t* KV = (bf16_t*)(P.ws + WS_C);
    bf16_t* KVS = (bf16_t*)(P.ws + WS_KVS);
    const int l32 = lane & 31, hh = lane >> 5;
    const int mt = wid >> 1, nt0 = (wid & 1) * 2;
    for (int u = blockIdx.x; u < 4096 + 32; u += gridDim.x) {
        const bool samp = u >= 4096;
        f32x16 d0 = {}, d1 = {};
        if (!samp) {
            const bf16_t* vt = B + B_VT + (size_t)u * 8192; const bf16_t* kt = B + B_KT + (size_t)u * 8192;
#pragma unroll
            for (int ks = 0; ks < 4; ++ks) {
                const bf16x8 a = *(const bf16x8*)(vt + (32 * mt + l32) * 64 + 16 * ks + 8 * hh);
                const bf16x8 b0 = *(const bf16x8*)(kt + (32 * nt0 + l32) * 64 + 16 * ks + 8 * hh);
                const bf16x8 b1 = *(const bf16x8*)(kt + (32 * nt0 + 32 + l32) * 64 + 16 * ks + 8 * hh);
                d0 = MFMA32(a, b0, d0); d1 = MFMA32(a, b1, d1);
            }
            bf16_t* o = KV + (size_t)u * 16384;
#pragma unroll
            for (int r = 0; r < 16; ++r) { const int e = 32 * mt + (r & 3) + 8 * (r >> 2) + 4 * hh; o[e * 128 + 32 * nt0 + l32] = f2bf(d0[r]); o[e * 128 + 32 * nt0 + 32 + l32] = f2bf(d1[r]); }
        } else {
            const int bh = u - 4096, hd = bh & 3;
            const bf16_t* vt = B + B_VTS + (size_t)bh * 4096; const bf16_t* kt = B + B_KTS + (size_t)bh * 4096;
#pragma unroll
            for (int ks = 0; ks < 2; ++ks) {
                const bf16x8 a = *(const bf16x8*)(vt + (32 * mt + l32) * 32 + 16 * ks + 8 * hh);
                const bf16x8 b0 = *(const bf16x8*)(kt + (32 * nt0 + l32) * 32 + 16 * ks + 8 * hh);
                const bf16x8 b1 = *(const bf16x8*)(kt + (32 * nt0 + 32 + l32) * 32 + 16 * ks + 8 * hh);
                d0 = MFMA32(a, b0, d0); d1 = MFMA32(a, b1, d1);
            }
            const float g32 = ex2(ret_lg2(hd) * 32.f);
            const float* s0 = P.in[2] + (size_t)bh * 16384; float* so = P.out + O_RSS + (size_t)bh * 16384; bf16_t* sb = KVS + (size_t)bh * 16384;
#pragma unroll
            for (int r = 0; r < 16; ++r) {
                const int e = 32 * mt + (r & 3) + 8 * (r >> 2) + 4 * hh;
#pragma unroll
                for (int q = 0; q < 2; ++q) {
                    const int dp = 32 * nt0 + 32 * q + l32, d = (dp >> 1) + 64 * (dp & 1);
                    const float s = s0[d * 128 + e];
                    so[d * 128 + e] = s * g32 + (q ? d1[r] : d0[r]);
                    sb[e * 128 + dp] = f2bf(s);
                }
            }
        }
    }
}
__device__ __forceinline__ void ret_passB(const Params& P, int tid) {
    unsigned* KV = (unsigned*)(P.ws + WS_C);
    for (int i = blockIdx.x * 512 + tid; i < 32 * 8192; i += gridDim.x * 512) {
        const int bh = i >> 13, idx = i & 8191;
        const float dec = ex2(ret_lg2(bh & 3) * 64.f);
        unsigned* p = KV + (size_t)bh * 128 * 8192 + idx;
        float s0 = 0.f, s1 = 0.f;
        for (int n0 = 0; n0 < 128; n0 += 16) {
            unsigned v[16];
#pragma unroll
            for (int k = 0; k < 16; ++k) v[k] = p[(size_t)(n0 + k) * 8192];
#pragma unroll
            for (int k = 0; k < 16; ++k) { p[(size_t)(n0 + k) * 8192] = pk2(s0, s1); s0 = s0 * dec + bflo(v[k]); s1 = s1 * dec + bfhi(v[k]); }
        }
        const int e = idx >> 6, dp = (idx & 63) * 2;
        float* so = P.out + O_RSP + (size_t)bh * 16384;
        so[(dp >> 1) * 128 + e] = s0;
        so[((dp >> 1) + 64) * 128 + e] = s1;
    }
}
template <int L> __device__ __forceinline__ void ret_unitC(const Params& P, LAS float* red, int bh, int n, int wid, int lane) {
    const bf16_t* B = (const bf16_t*)(P.ws + WS_B);
    const int l32 = lane & 31, hh = lane >> 5, hd = bh & 3, b = bh >> 2;
    const int et = wid >> 1, it = wid & 1;
    const bool act = (L == 64) || (it == 0);
    const int row0 = (L == 64) ? (b * T + n * 64) : (RP + b * 32);
    const bf16_t* sbef = (L == 64) ? (const bf16_t*)(P.ws + WS_C) + (size_t)(bh * 128 + n) * 16384 : (const bf16_t*)(P.ws + WS_KVS) + (size_t)bh * 16384;
    const bf16_t* vt = (L == 64) ? B + B_VT + (size_t)(bh * 128 + n) * 8192 : B + B_VTS + (size_t)bh * 4096;
    const float lg2 = ret_lg2(hd);
    const int i = 32 * it + l32;
    f32x16 acc = {};
    float s1 = 0.f, s2 = 0.f;
    if (act) {
        bf16x8 qf[8];
#pragma unroll
        for (int ks = 0; ks < 8; ++ks) qf[ks] = *(const bf16x8*)(B + B_RQ + (size_t)(row0 + i) * 512 + hd * 128 + 16 * ks + 8 * hh);
#pragma unroll
        for (int ks = 0; ks < 8; ++ks) { const bf16x8 a = *(const bf16x8*)(sbef + (32 * et + l32) * 128 + 16 * ks + 8 * hh); acc = MFMA32(a, qf[ks], acc); }
        acc = acc * ex2(lg2 * (float)(i + 1));
#pragma unroll
        for (int jt = 0; jt < L / 32; ++jt) {
            f32x16 sc = {};
#pragma unroll
            for (int ks = 0; ks < 8; ++ks) { const bf16x8 a = *(const bf16x8*)(B + B_RK + (size_t)(row0 + 32 * jt + l32) * 512 + hd * 128 + 16 * ks + 8 * hh); sc = MFMA32(a, qf[ks], sc); }
#pragma unroll
            for (int r = 0; r < 16; ++r) { const int j = 32 * jt + (r & 3) + 8 * (r >> 2) + 4 * hh; const int dd = i > j ? i - j : j - i; sc[r] = sc[r] * ex2(lg2 * (float)dd); }
#pragma unroll
            for (int s = 0; s < 2; ++s) {
                u32x4 pw; pw.x = pk2(sc[8 * s], sc[8 * s + 1]); pw.y = pk2(sc[8 * s + 2], sc[8 * s + 3]); pw.z = pk2(sc[8 * s + 4], sc[8 * s + 5]); pw.w = pk2(sc[8 * s + 6], sc[8 * s + 7]);
                const bf16x8 pf = __builtin_bit_cast(bf16x8, pw);
                const bf16_t* vb = vt + (32 * et + l32) * L + 32 * jt + 16 * s + 4 * hh;
                const u32x2 lo = *(const u32x2*)vb, hi = *(const u32x2*)(vb + 8);
                const u32x4 vw = {lo.x, lo.y, hi.x, hi.y};
                acc = MFMA32(__builtin_bit_cast(bf16x8, vw), pf, acc);
            }
        }
#pragma unroll
        for (int r = 0; r < 16; ++r) { s1 += acc[r]; s2 += acc[r] * acc[r]; }
        s1 += __shfl_xor(s1, 32); s2 += __shfl_xor(s2, 32);
        if (hh == 0) { red[et * 64 + i] = s1; red[256 + et * 64 + i] = s2; }
    }
    __syncthreads();
    if (act) {
        const float t1 = red[i] + red[64 + i] + red[128 + i] + red[192 + i];
        const float t2 = red[256 + i] + red[320 + i] + red[384 + i] + red[448 + i];
        const float mu = t1 * (1.f / 128.f), var = fmaxf(t2 * (1.f / 128.f) - mu * mu, 0.f), rstd = rsqrtf(var + EPS);
        const float* gw = P.in[14] + hd * 128;
        bf16_t* mixed = MIXED;
#pragma unroll
        for (int g = 0; g < 4; ++g) {
            const int e = 32 * et + 8 * g + 4 * hh;
            const f32x4 w4 = *(const f32x4*)(gw + e);
            const u32x2 gt = *(const u32x2*)(B + B_RG + (size_t)(row0 + i) * 512 + hd * 128 + e);
            f32x4 o;
            o.x = (acc[4 * g] - mu) * rstd * w4.x * bflo(gt.x); o.y = (acc[4 * g + 1] - mu) * rstd * w4.y * bfhi(gt.x);
            o.z = (acc[4 * g + 2] - mu) * rstd * w4.z * bflo(gt.y); o.w = (acc[4 * g + 3] - mu) * rstd * w4.w * bfhi(gt.y);
            u32x2 w; w.x = pk2(o.x, o.y); w.y = pk2(o.z, o.w);
            *(u32x2*)(mixed + (size_t)(row0 + i) * 1024 + hd * 128 + e) = w;
        }
    }
    __syncthreads();
}

struct FoxUnit { const bf16_t* Q; const bf16_t* K; const bf16_t* VT; const float* c2; bf16_t* O; int vtp, qpos0, nq, ntiles, Tk; };
constexpr int FOX_BUF = 18432, FOX_VOFF = 9216, FOX_COFF = 17920;
__device__ __forceinline__ void fox_unit(LAS unsigned char* lds, const FoxUnit U, int tid, int wid, int lane) {
    const int l32 = lane & 31, hh = lane >> 5;
    const int wrow = wid * 64;
    const bool active = wrow < U.nq;
    const bool act1 = wrow + 32 < U.nq;
    bf16x8 qf[2][4];
#pragma unroll
    for (int qt = 0; qt < 2; ++qt)
#pragma unroll
        for (int s = 0; s < 4; ++s) qf[qt][s] = (qt == 0 ? active : act1) ? *(const bf16x8*)(U.Q + (size_t)(wrow + 32 * qt + l32) * 512 + 16 * s + 8 * hh) : (bf16x8){0, 0, 0, 0, 0, 0, 0, 0};
    const int wq_lo = U.qpos0 + wrow, wq_hi = wq_lo + (act1 ? 63 : 31);
    float mrun[2] = {-INFINITY, -INFINITY}, lrun[2] = {0.f, 0.f};
    f32x16 o0[2] = {{}, {}}, o1[2] = {{}, {}};
    const int srow = tid >> 3, sch = tid & 7;
    u32x4 kr, vr; float cr = 0.f;
#define FOX_LOAD(t) do { int key_ = (t) * 64 + srow; key_ = key_ < U.Tk ? key_ : U.Tk - 1; kr = *(const u32x4*)(U.K + (size_t)key_ * 512 + sch * 8); \
        vr = *(const u32x4*)(U.VT + (size_t)srow * U.vtp + (t) * 64 + sch * 8); \
        if (tid < 64) { int kc_ = (t) * 64 + tid; kc_ = kc_ < U.Tk ? kc_ : U.Tk - 1; cr = U.c2[kc_]; } } while (0)
#define FOX_STORE(bi) do { LAS unsigned char* kb_ = lds + (bi) * FOX_BUF; *(LAS u32x4*)(kb_ + srow * 144 + sch * 16) = kr; \
        *(LAS u32x2*)(kb_ + FOX_VOFF + srow * 136 + sch * 16) = (u32x2){vr.x, vr.y}; *(LAS u32x2*)(kb_ + FOX_VOFF + srow * 136 + sch * 16 + 8) = (u32x2){vr.z, vr.w}; \
        if (tid < 64) *(LAS float*)(kb_ + FOX_COFF + tid * 4) = -cr; } while (0)
    FOX_LOAD(0); FOX_STORE(0);
    __syncthreads();
    for (int t = 0; t < U.ntiles; ++t) {
        const bool more = t + 1 < U.ntiles;
        if (more) FOX_LOAD(t + 1);
        if (active && t * 64 <= wq_hi) {
            LAS unsigned char* kb = lds + (t & 1) * FOX_BUF;
            bf16x8 pf[2][4];
#pragma unroll
            for (int qt = 0; qt < 2; ++qt) {
                __builtin_amdgcn_sched_barrier(0);
                f32x16 p0, p1;
#pragma unroll
                for (int g = 0; g < 4; ++g) {
                    const f32x4 c0 = *(LAS f32x4*)(kb + FOX_COFF + (8 * g + 4 * hh) * 4), c1 = *(LAS f32x4*)(kb + FOX_COFF + (32 + 8 * g + 4 * hh) * 4);
                    p0[4 * g] = c0.x; p0[4 * g + 1] = c0.y; p0[4 * g + 2] = c0.z; p0[4 * g + 3] = c0.w;
                    p1[4 * g] = c1.x; p1[4 * g + 1] = c1.y; p1[4 * g + 2] = c1.z; p1[4 * g + 3] = c1.w;
                }
#pragma unroll
                for (int s = 0; s < 4; ++s) {
                    const bf16x8 a0 = *(LAS bf16x8*)(kb + l32 * 144 + (2 * s + hh) * 16), a1 = *(LAS bf16x8*)(kb + (32 + l32) * 144 + (2 * s + hh) * 16);
                    p0 = MFMA32(a0, qf[qt][s], p0); p1 = MFMA32(a1, qf[qt][s], p1);
                }
                const int qpos = wq_lo + 32 * qt + l32;
                if (t * 64 + 63 > wq_lo + 32 * qt) {
#pragma unroll
                    for (int r = 0; r < 16; ++r) { const int key = t * 64 + (r & 3) + 8 * (r >> 2) + 4 * hh; if (key > qpos) p0[r] = -INFINITY; if (key + 32 > qpos) p1[r] = -INFINITY; }
                }
                float mx = fmaxf(p0[0], p1[0]);
#pragma unroll
                for (int r = 1; r < 16; ++r) mx = fmaxf(mx, fmaxf(p0[r], p1[r]));
                mx = fmaxf(mx, __shfl_xor(mx, 32));
                const float mn = fmaxf(mrun[qt], mx), alpha = ex2(mrun[qt] - mn); mrun[qt] = mn;
                float rs = 0.f;
#pragma unroll
                for (int r = 0; r < 16; ++r) { p0[r] = ex2(p0[r] - mn); p1[r] = ex2(p1[r] - mn); rs += p0[r] + p1[r]; }
                lrun[qt] = lrun[qt] * alpha + rs; o0[qt] = o0[qt] * alpha; o1[qt] = o1[qt] * alpha;
#pragma unroll
                for (int s = 0; s < 4; ++s) {
                    u32x4 pw;
                    if (s < 2) { pw.x = pk2(p0[8 * s], p0[8 * s + 1]); pw.y = pk2(p0[8 * s + 2], p0[8 * s + 3]); pw.z = pk2(p0[8 * s + 4], p0[8 * s + 5]); pw.w = pk2(p0[8 * s + 6], p0[8 * s + 7]); }
                    else { const int q = 8 * (s - 2); pw.x = pk2(p1[q], p1[q + 1]); pw.y = pk2(p1[q + 2], p1[q + 3]); pw.z = pk2(p1[q + 4], p1[q + 5]); pw.w = pk2(p1[q + 6], p1[q + 7]); }
                    pf[qt][s] = __builtin_bit_cast(bf16x8, pw);
                }
            }
#pragma unroll
            for (int s = 0; s < 4; ++s) {
                LAS unsigned char* vb = kb + FOX_VOFF + l32 * 136 + (16 * s + 4 * hh) * 2;
                const u32x2 a = *(LAS u32x2*)vb, b = *(LAS u32x2*)(vb + 16), c = *(LAS u32x2*)(vb + 32 * 136), d = *(LAS u32x2*)(vb + 32 * 136 + 16);
                const u32x4 v0 = {a.x, a.y, b.x, b.y}, v1 = {c.x, c.y, d.x, d.y};
#pragma unroll
                for (int qt = 0; qt < 2; ++qt) { o0[qt] = MFMA32(__builtin_bit_cast(bf16x8, v0), pf[qt][s], o0[qt]); o1[qt] = MFMA32(__builtin_bit_cast(bf16x8, v1), pf[qt][s], o1[qt]); }
            }
        }
        if (more) FOX_STORE((t + 1) & 1);
        __syncthreads();
    }
#undef FOX_LOAD
#undef FOX_STORE
#pragma unroll
    for (int qt = 0; qt < 2; ++qt) {
        if (qt == 0 ? active : act1) {
            const float inv = 1.f / (lrun[qt] + __shfl_xor(lrun[qt], 32));
            bf16_t* op = U.O + (size_t)(wrow + 32 * qt + l32) * 1024 + 4 * hh;
#pragma unroll
            for (int g = 0; g < 4; ++g) {
                u32x2 w; w.x = pk2(o0[qt][4 * g] * inv, o0[qt][4 * g + 1] * inv); w.y = pk2(o0[qt][4 * g + 2] * inv, o0[qt][4 * g + 3] * inv); *(u32x2*)(op + 8 * g) = w;
                w.x = pk2(o1[qt][4 * g] * inv, o1[qt][4 * g + 1] * inv); w.y = pk2(o1[qt][4 * g + 2] * inv, o1[qt][4 * g + 3] * inv); *(u32x2*)(op + 32 + 8 * g) = w;
            }
        }
    }
}
__device__ __forceinline__ void fox_phase(const Params& P, LAS unsigned char* lds, int tid, int wid, int lane) {
    const bf16_t* B = (const bf16_t*)(P.ws + WS_B);
    bf16_t* mixed = MIXED;
    for (int it2 = 2 * blockIdx.x; it2 < 1024 + 128; it2 += (it2 < 1024) ? (((it2 & 1) == 0) ? 1 : 2 * (int)gridDim.x - 1) : 2 * (int)gridDim.x) {
        FoxUnit U;
        if (it2 < 1024) {
            const int it = it2 >> 1, k = it2 & 1;
            const int bh = it >> 3, pi = it & 7, b = bh >> 3, hd = bh & 7;
            const int qb = k ? 15 - pi : pi;
            U.Q = B + B_FQ + (size_t)(b * T + qb * 512) * 512 + hd * 64; U.K = B + B_FK + (size_t)b * T * 512 + hd * 64;
            U.VT = B + B_FVT + (size_t)(b * 512 + hd * 64) * T; U.c2 = (const float*)(P.ws + WS_C2P) + (size_t)bh * T;
            U.O = mixed + (size_t)(b * T + qb * 512) * 1024 + 512 + hd * 64; U.vtp = T; U.qpos0 = qb * 512; U.nq = 512; U.ntiles = 8 * (qb + 1); U.Tk = T;
        } else {
            const int bh = (it2 - 1024) >> 1;
            const int b = bh >> 3, hd = bh & 7;
            U.Q = B + B_FQ + (size_t)(RP + b * 32) * 512 + hd * 64; U.K = (const bf16_t*)(P.ws + WS_FKS) + (size_t)b * TKS * 512 + hd * 64;
            U.VT = (const bf16_t*)(P.ws + WS_FVTS) + (size_t)(b * 512 + hd * 64) * TKS; U.c2 = (const float*)(P.ws + WS_C2S) + (size_t)bh * TKS;
            U.O = mixed + (size_t)(RP + b * 32) * 1024 + 512 + hd * 64; U.vtp = TKS; U.qpos0 = PAST; U.nq = 32; U.ntiles = 65; U.Tk = TKS;
        }
        int tid_ = tid; asm volatile("" : "+v"(tid_));
        fox_unit(lds, U, tid_, wid, tid_ & 63);
    }
}

constexpr int XA_BUF = 16896;
__device__ __forceinline__ void xattn_unit(LAS unsigned char* lds, const bf16_t* Q, const bf16_t* Kb, const bf16_t* VTb, bf16_t* O, int nwaves, int tid, int wid, int lane) {
    const int l32 = lane & 31, hh = lane >> 5;
    const bool active = wid < nwaves;
    bf16x8 qf[16];
#pragma unroll
    for (int s = 0; s < 16; ++s) qf[s] = active ? *(const bf16x8*)(Q + (size_t)(wid * 32 + l32) * 1024 + 16 * s + 8 * hh) : (bf16x8){0, 0, 0, 0, 0, 0, 0, 0};
    f32x16 S[4];
    bf16x8 pf[16];
    float m1 = 0.f, l1 = 0.f, a1 = 0.f, a2 = 0.f;
    u32x4 r0, r1;
    const int i0 = tid, i1 = tid + 512;
    const bf16_t* g0 = Kb + (size_t)(i0 >> 5) * 1024 + (i0 & 31) * 8; const bf16_t* g1 = Kb + (size_t)(i1 >> 5) * 1024 + (i1 & 31) * 8;
    const bf16_t* h0 = VTb + (size_t)(i0 >> 5) * 256 + (i0 & 31) * 8; const bf16_t* h1 = VTb + (size_t)(i1 >> 5) * 256 + (i1 & 31) * 8;
#define XA_LOAD(tt) do { if ((tt) < 8) { r0 = *(const u32x4*)g0; r1 = *(const u32x4*)g1; g0 += 32 * 1024; g1 += 32 * 1024; asm volatile("" : "+v"(g0), "+v"(g1)); } \
        else { r0 = *(const u32x4*)h0; r1 = *(const u32x4*)h1; h0 += 32 * 256; h1 += 32 * 256; asm volatile("" : "+v"(h0), "+v"(h1)); } } while (0)
#define XA_STORE(bi) do { LAS unsigned char* b_ = lds + (bi) * XA_BUF; *(LAS u32x4*)(b_ + (i0 >> 5) * 528 + (i0 & 31) * 16) = r0; *(LAS u32x4*)(b_ + (i1 >> 5) * 528 + (i1 & 31) * 16) = r1; } while (0)
#define XA_HALF(hf, mm, ll) do { float mx_ = S[0][0]; \
        _Pragma("unroll") for (int k = 0; k < 4; ++k) _Pragma("unroll") for (int r = 0; r < 16; ++r) mx_ = fmaxf(mx_, S[k][r]); \
        mx_ = fmaxf(mx_, __shfl_xor(mx_, 32)); float l_ = 0.f; \
        _Pragma("unroll") for (int k = 0; k < 4; ++k) { \
            _Pragma("unroll") for (int r = 0; r < 16; ++r) { S[k][r] = ex2(S[k][r] - mx_); l_ += S[k][r]; } \
            _Pragma("unroll") for (int s = 0; s < 2; ++s) { u32x4 pw; pw.x = pk2(S[k][8 * s], S[k][8 * s + 1]); pw.y = pk2(S[k][8 * s + 2], S[k][8 * s + 3]); pw.z = pk2(S[k][8 * s + 4], S[k][8 * s + 5]); pw.w = pk2(S[k][8 * s + 6], S[k][8 * s + 7]); \
                pf[8 * (hf) + 2 * k + s] = __builtin_bit_cast(bf16x8, pw); } } \
        mm = mx_; ll = l_ + __shfl_xor(l_, 32); } while (0)
    XA_LOAD(0); XA_STORE(0);
    __syncthreads();
#pragma unroll
    for (int tt = 0; tt < 16; ++tt) {
        if (tt + 1 < 16) XA_LOAD(tt + 1);
        LAS unsigned char* buf = lds + (tt & 1) * XA_BUF;
        if (active) {
            if (tt < 8) {
                f32x16 s = {};
#pragma unroll
                for (int k = 0; k < 16; ++k) { const bf16x8 a = *(LAS bf16x8*)(buf + l32 * 528 + (2 * k + hh) * 16); s = MFMA32(a, qf[k], s); }
                S[tt & 3] = s;
                if (tt == 3) XA_HALF(0, m1, l1);
                if (tt == 7) {
                    float m2, l2; XA_HALF(1, m2, l2);
                    const float mm = fmaxf(m1, m2); a1 = ex2(m1 - mm); a2 = ex2(m2 - mm);
                    const float inv = 1.f / (a1 * l1 + a2 * l2); a1 *= inv; a2 *= inv;
                }
            } else {
                f32x16 o1 = {}, o2 = {};
#pragma unroll
                for (int k = 0; k < 16; ++k) {
                    LAS unsigned char* vb = buf + l32 * 528 + (16 * k + 4 * hh) * 2;
                    const u32x2 a = *(LAS u32x2*)vb, b = *(LAS u32x2*)(vb + 16);
                    const u32x4 vw = {a.x, a.y, b.x, b.y};
                    if (k < 8) o1 = MFMA32(__builtin_bit_cast(bf16x8, vw), pf[k], o1); else o2 = MFMA32(__builtin_bit_cast(bf16x8, vw), pf[k], o2);
                }
                bf16_t* op = O + (size_t)(wid * 32 + l32) * 1024 + 32 * (tt - 8) + 4 * hh;
#pragma unroll
                for (int g = 0; g < 4; ++g) { u32x2 w; w.x = pk2(o1[4 * g] * a1 + o2[4 * g] * a2, o1[4 * g + 1] * a1 + o2[4 * g + 1] * a2); w.y = pk2(o1[4 * g + 2] * a1 + o2[4 * g + 2] * a2, o1[4 * g + 3] * a1 + o2[4 * g + 3] * a2); *(u32x2*)(op + 8 * g) = w; }
            }
        }
        if (tt + 1 < 16) XA_STORE((tt + 1) & 1);
        __syncthreads();
    }
#undef XA_HALF
#undef XA_LOAD
#undef XA_STORE
}
__device__ __forceinline__ void xattn_phase(const Params& P, LAS unsigned char* lds, int layer, int tid, int wid, int lane) {
    const bf16_t* XQ = (const bf16_t*)(P.ws + WS_B);
    bf16_t* XO = (bf16_t*)(P.ws + WS_B) + B_X2;
    const bf16_t* MK = (const bf16_t*)(P.ws + WS_MEMK); const bf16_t* MVT = (const bf16_t*)(P.ws + WS_MEMVT);
    for (int it = blockIdx.x; it < 1024 + 32; it += gridDim.x) {
        int row0, set, hd, nw;
        if (it < 1024) { const int pm = it >> 2; hd = it & 3; row0 = pm * 256; set = layer * 16 + (pm >> 5); nw = 8; }
        else { const int q = it - 1024, b = q >> 2; hd = q & 3; row0 = RP + b * 32; set = layer * 16 + 8 + b; nw = 1; }
        xattn_unit(lds, XQ + (size_t)row0 * 1024 + hd * 256, MK + (size_t)set * 262144 + hd * 256, MVT + ((size_t)set * 1024 + hd * 256) * 256, XO + (size_t)row0 * 1024 + hd * 256, nw, tid, wid, lane);
    }
}

__device__ __forceinline__ void s5_run(LAS unsigned char* wl, const bf16_t* U, bf16_t* Y, int row0, int L, int g, f32x2 a, float& xr, float& xi, bool outp,
                                       const bf16_t* SB5, const bf16_t* SC5, const float* s5d, int lane) {
    const int l32 = lane & 31, hh = lane >> 5, l16 = lane & 15, q4 = lane >> 4;
    bf16x8 bfr[4], cfr[4];
#pragma unroll
    for (int k = 0; k < 4; ++k) { bfr[k] = *(const bf16x8*)(SB5 + ((size_t)(g * 4 + k) * 64 + lane) * 8); cfr[k] = *(const bf16x8*)(SC5 + ((size_t)(g * 4 + k) * 64 + lane) * 8); }
    const f32x4 dv = *(const f32x4*)(s5d + g * 16 + 4 * q4);
    for (int sc0 = 0; sc0 < L / 32; sc0 += 4) {
      bf16x8 ufa[4];
#pragma unroll
      for (int q = 0; q < 4; ++q) ufa[q] = (sc0 + q < L / 32) ? *(const bf16x8*)(U + (size_t)(row0 + (sc0 + q) * 32 + l32) * 1024 + g * 16 + 8 * hh) : (bf16x8){0, 0, 0, 0, 0, 0, 0, 0};
#pragma unroll
      for (int q = 0; q < 4; ++q) {
        const int sc = sc0 + q;
        if (sc >= L / 32) break;
        const int r0 = row0 + sc * 32;
        const bf16x8 uf = ufa[q];
        const f32x16 z = {};
        const f32x16 d0 = MFMA32(uf, bfr[0], z), d1 = MFMA32(uf, bfr[1], z), d2 = MFMA32(uf, bfr[2], z), d3 = MFMA32(uf, bfr[3], z);
#pragma unroll
        for (int r = 0; r < 16; ++r) {
            const int tok = (r & 3) + 8 * (r >> 2) + 4 * hh;
            *(LAS f32x2*)(wl + tok * 528 + l32 * 8) = (f32x2){d0[r], d2[r]};
            *(LAS f32x2*)(wl + tok * 528 + (32 + l32) * 8) = (f32x2){d1[r], d3[r]};
        }
        LDSBAR();
#pragma unroll
        for (int t0 = 0; t0 < 32; t0 += 8) {
            f32x2 bu[8]; float xo_[8];
#pragma unroll
            for (int k = 0; k < 8; ++k) bu[k] = *(LAS f32x2*)(wl + (t0 + k) * 528 + lane * 8);
            LDSBAR();
#pragma unroll
            for (int k = 0; k < 8; ++k) {
                const float nr = a.x * xr - a.y * xi + bu[k].x, ni = a.x * xi + a.y * xr + bu[k].y;
                xr = nr; xi = ni; xo_[k] = __uint_as_float(pk2(xr, xi));
            }
            if (outp) {
#pragma unroll
                for (int k = 0; k < 8; ++k) *(LAS float*)(wl + (t0 + k) * 528 + lane * 4) = xo_[k];
            }
        }
        LDSBAR();
        if (outp) {
#pragma unroll
            for (int tb = 0; tb < 2; ++tb) {
                f32x4 acc = {0.f, 0.f, 0.f, 0.f};
#pragma unroll
                for (int ks = 0; ks < 4; ++ks) { const bf16x8 xf = *(LAS bf16x8*)(wl + (16 * tb + l16) * 528 + (32 * ks + 8 * q4) * 2); acc = MFMA16(cfr[ks], xf, acc); }
                const size_t off = (size_t)(r0 + 16 * tb + l16) * 1024 + g * 16 + 4 * q4;
                const u32x2 uu = *(const u32x2*)(U + off);
                f32x4 y; y.x = acc.x + dv.x * bflo(uu.x); y.y = acc.y + dv.y * bfhi(uu.x); y.z = acc.z + dv.z * bflo(uu.y); y.w = acc.w + dv.w * bfhi(uu.y);
                u32x2 w; w.x = pk2(y.x, y.y); w.y = pk2(y.z, y.w);
                *(u32x2*)(Y + off) = w;
            }
        }
        LDSBAR();
      }
    }
}
constexpr int S5_NSEG = 16, S5_LSEG = 512;
__device__ __forceinline__ void s5_phase(const Params& P, LAS unsigned char* lds, int pass, int wid, int lane) {
    const bf16_t* U = (const bf16_t*)(P.ws + WS_B);
    bf16_t* Y = (bf16_t*)(P.ws + WS_B) + B_X2;
    const f32x2* S5A = (const f32x2*)(P.ws + WS_S5T); const f32x2* S5AL = S5A + 4096;
    const bf16_t* SB5 = (const bf16_t*)(P.ws + WS_S5T + 65536); const bf16_t* SC5 = SB5 + 131072;
    f32x2* LE = (f32x2*)(P.ws + WS_LE);
    LAS unsigned char* wl = lds + wid * 16896;
    const int nunits = (pass == 1) ? 8 * (S5_NSEG - 1) * 8 : 8 * S5_NSEG * 8 + 64;
    for (int it = blockIdx.x; it < nunits; it += gridDim.x) {
        if (pass == 1) {
            const int g8 = it & 7, seg = (it >> 3) % (S5_NSEG - 1), b = (it >> 3) / (S5_NSEG - 1), g = g8 * 8 + wid;
            float xr = 0.f, xi = 0.f;
            s5_run(wl, U, Y, b * T + seg * S5_LSEG, S5_LSEG, g, S5A[g * 64 + lane], xr, xi, false, SB5, SC5, P.in[24], lane);
            LE[((size_t)(b * S5_NSEG + seg) * 64 + g) * 64 + lane] = (f32x2){xr, xi};
        } else if (it < 8 * S5_NSEG * 8) {
            const int g8 = it & 7, seg = (it >> 3) & (S5_NSEG - 1), b = it >> 7, g = g8 * 8 + wid;
            const f32x2 aL = S5AL[g * 64 + lane];
            float xr = 0.f, xi = 0.f;
            for (int s = 0; s < seg; ++s) { const f32x2 le = LE[((size_t)(b * S5_NSEG + s) * 64 + g) * 64 + lane]; const float nr = aL.x * xr - aL.y * xi + le.x, ni = aL.x * xi + aL.y * xr + le.y; xr = nr; xi = ni; }
            s5_run(wl, U, Y, b * T + seg * S5_LSEG, S5_LSEG, g, S5A[g * 64 + lane], xr, xi, true, SB5, SC5, P.in[24], lane);
            if (seg == S5_NSEG - 1) { P.out[O_S5RP + (size_t)(b * 64 + g) * 64 + lane] = xr; P.out[O_S5IP + (size_t)(b * 64 + g) * 64 + lane] = xi; }
        } else {
            const int q = it - 8 * S5_NSEG * 8, g8 = q & 7, b = q >> 3, g = g8 * 8 + wid;
            float xr = P.in[6][(size_t)(b * 64 + g) * 64 + lane], xi = P.in[7][(size_t)(b * 64 + g) * 64 + lane];
            s5_run(wl, U, Y, RP + b * 32, 32, g, S5A[g * 64 + lane], xr, xi, true, SB5, SC5, P.in[24], lane);
            P.out[O_S5RS + (size_t)(b * 64 + g) * 64 + lane] = xr; P.out[O_S5IS + (size_t)(b * 64 + g) * 64 + lane] = xi;
        }
    }
}

__device__ __forceinline__ void prologue(const Params& P, int tid, int wid, int lane) {
    const int gtid = blockIdx.x * 512 + tid, gsz = gridDim.x * 512;
    const int gw = blockIdx.x * 8 + wid, ngw = gridDim.x * 8;
    bf16_t* W = (bf16_t*)(P.ws + WS_W);
    wtrans(P.in[12], 1024, 3592, W + W_AB, 3840, 1, gtid, gsz, P.in[11]);
    wtrans(P.in[15], 1024, 1024, W + W_OUT, 1024, 0, gtid, gsz);
    wtrans(P.in[16], 1024, 1024, W + W_INC, 1024, 0, gtid, gsz, P.in[11] + 6144);
    wtrans(P.in[25], 1024, 2048, W + W_GLU, 2048, 2, gtid, gsz);
    for (int l = 0; l < 2; ++l) {
        wtrans(P.in[27] + (size_t)l * 1048576, 1024, 1024, W + W_XQ + (size_t)l * 1048576, 1024, 0, gtid, gsz, P.in[11] + l * 6144 + 2048);
        wtrans(P.in[28] + (size_t)l * 1048576, 1024, 1024, W + W_XKV + (size_t)l * 2097152, 1024, 0, gtid, gsz);
        wtrans(P.in[29] + (size_t)l * 1048576, 1024, 1024, W + W_XKV + (size_t)l * 2097152 + 1048576, 1024, 0, gtid, gsz);
        wtrans(P.in[30] + (size_t)l * 1048576, 1024, 1024, W + W_XO + (size_t)l * 1048576, 1024, 0, gtid, gsz);
        wtrans(P.in[31] + (size_t)l * 4194304, 1024, 4096, W + W_UP + (size_t)l * 4194304, 4096, 0, gtid, gsz, P.in[11] + l * 6144 + 4096);
        wtrans(P.in[32] + (size_t)l * 4194304, 4096, 1024, W + W_DN + (size_t)l * 4194304, 1024, 0, gtid, gsz);
    }
    {
        float* rope = (float*)(P.ws + WS_ROPE);
        for (int i = gtid; i < 8192 * 64; i += gsz) {
            const int pos = i >> 6, k = i & 63;
            const double inv = exp2(-(double)k * (13.287712379549449 / 64.0));
            const double ang = (double)pos * inv;
            rope[2 * i] = (float)cos(ang); rope[2 * i + 1] = (float)sin(ang);
        }
    }
    {
        f32x2* S5A = (f32x2*)(P.ws + WS_S5T); f32x2* S5AL = S5A + 4096;
        bf16_t* SB5 = (bf16_t*)(P.ws + WS_S5T + 65536); bf16_t* SC5 = SB5 + 131072;
        for (int i = gtid; i < 4096; i += gsz) {
            const int g = i >> 6, p = i & 63;
            const double lr = P.in[17][i], li = P.in[18][i], dt = exp((double)P.in[19][g]);
            const double mag = exp(lr * dt), ar = mag * cos(li * dt), ai = mag * sin(li * dt);
            S5A[i] = (f32x2){(float)ar, (float)ai};
            const double magL = exp(lr * dt * S5_LSEG);
            S5AL[i] = (f32x2){(float)(magL * cos(li * dt * S5_LSEG)), (float)(magL * sin(li * dt * S5_LSEG))};
            const double den = lr * lr + li * li, nre = ar - 1.0;
            const double fr = (nre * lr + ai * li) / den, fi = (ai * lr - nre * li) / den;
            const float* br = P.in[20] + (size_t)i * 16; const float* bi = P.in[21] + (size_t)i * 16;
#pragma unroll
            for (int part = 0; part < 2; ++part)
#pragma unroll
                for (int h2 = 0; h2 < 2; ++h2) {
                    float v[8];
#pragma unroll
                    for (int k = 0; k < 8; ++k) { const int c = 8 * h2 + k; v[k] = part == 0 ? (float)(fr * br[c] - fi * bi[c]) : (float)(fr * bi[c] + fi * br[c]); }
                    u32x4 o; o.x = pk2(v[0], v[1]); o.y = pk2(v[2], v[3]); o.z = pk2(v[4], v[5]); o.w = pk2(v[6], v[7]);
                    const int kb = 2 * part + (p >> 5), ln = (p & 31) + 32 * h2;
                    *(u32x4*)(SB5 + ((size_t)(g * 4 + kb) * 64 + ln) * 8) = o;
                }
        }
        for (int i = gtid; i < 64 * 4 * 64; i += gsz) {
            const int ln = i & 63, ks = (i >> 6) & 3, g = i >> 8;
            const int c = ln & 15;
            float v[8];
#pragma unroll
            for (int k = 0; k < 8; ++k) { const int kidx = 32 * ks + 8 * (ln >> 4) + k, p = kidx >> 1; v[k] = (kidx & 1) ? -P.in[23][((size_t)g * 16 + c) * 64 + p] : P.in[22][((size_t)g * 16 + c) * 64 + p]; }
            u32x4 o; o.x = pk2(v[0], v[1]); o.y = pk2(v[2], v[3]); o.z = pk2(v[4], v[5]); o.w = pk2(v[6], v[7]);
            *(u32x4*)(SC5 + (size_t)i * 8) = o;
        }
    }
    {
        bf16_t* FKS = (bf16_t*)(P.ws + WS_FKS); bf16_t* FVTS = (bf16_t*)(P.ws + WS_FVTS);
        for (int i = gtid; i < 8 * PAST * 64; i += gsz) { const int b = i / (PAST * 64), r = i % (PAST * 64); cvt8(P.in[3] + (size_t)i * 8, FKS + (size_t)b * TKS * 512 + (size_t)r * 8); }
        for (int b = 0; b < 8; ++b) ttrans(P.in[4] + (size_t)b * PAST * 512, PAST, 512, FVTS + (size_t)b * 512 * TKS, TKS, gtid, gsz);
        bf16_t* MK = (bf16_t*)(P.ws + WS_MEMK); bf16_t* MVT = (bf16_t*)(P.ws + WS_MEMVT);
        for (int i = gtid; i < 2 * 8 * 32768; i += gsz) { const int lb = i >> 15, r = i & 32767, l = lb >> 3, b = lb & 7; cvt8(P.in[8] + (size_t)i * 8, MK + (size_t)(l * 16 + 8 + b) * 262144 + (size_t)r * 8); }
        for (int lb = 0; lb < 16; ++lb) { const int l = lb >> 3, b = lb & 7; ttrans(P.in[9] + (size_t)lb * 262144, 256, 1024, MVT + (size_t)(l * 16 + 8 + b) * 262144, 256, gtid, gsz); }
    }
    {
        bf16_t* H = (bf16_t*)(P.ws + WS_A); bf16_t* MEMN = (bf16_t*)(P.ws + WS_MEMN);
        for (int row = gw; row < R + 4096; row += ngw) {
            if (row < R) { const float* xr = row < RP ? P.in[0] + (size_t)row * 1024 : P.in[1] + (size_t)(row - RP) * 1024; cvt_row(xr, H + (size_t)row * 1024, (float*)(P.ws + WS_RS) + row, lane); }
            else { const int q = row - R, l = q >> 11, r = q & 2047; norm_row(P.in[10] + (size_t)r * 1024, P.in[26] + l * 1024, MEMN + (size_t)q * 1024, lane); }
        }
    }
}
__device__ __forceinline__ void cumsum_task(const Params& P, int q, int lane) {
    const bool samp = q >= 64; const int bh = q & 63, b = bh >> 3, hd = bh & 7;
    const int n = samp ? TKS : T;
    float* dst = samp ? (float*)(P.ws + WS_C2S) + (size_t)bh * TKS : (float*)(P.ws + WS_C2P) + (size_t)bh * T;
    float carry = 0.f;
    for (int base0 = 0; base0 < n; base0 += 512) {
        float vv[8];
#pragma unroll
        for (int k = 0; k < 8; ++k) {
            const int idx = base0 + 64 * k + lane; float v = 0.f;
            if (idx < n) {
                if (!samp) v = P.out[O_LFP + ((size_t)b * T + idx) * 8 + hd];
                else v = idx < PAST ? P.in[5][((size_t)b * PAST + idx) * 8 + hd] : P.out[O_LFS + ((size_t)b * 32 + idx - PAST) * 8 + hd];
            }
            vv[k] = v;
        }
#pragma unroll
        for (int k = 0; k < 8; ++k) {
            const int idx = base0 + 64 * k + lane; float v = vv[k];
#pragma unroll
            for (int o = 1; o < 64; o <<= 1) { const float t = __shfl_up(v, o); if (lane >= o) v += t; }
            if (idx < n) dst[idx] = (carry + v) * LOG2E;
            carry += __shfl(v, 63);
        }
    }
}

template <class Epi> __device__ __forceinline__ void run_gemm(LAS unsigned char* lds, const bf16_t* A, const bf16_t* Bt, int M, int N, int K, const Epi& E) {
    pg8::Gemm g{A, Bt, M, N, K}; pg8::StaticOrder S; S.init(M, N, (int)gridDim.x, (int)blockIdx.x);
#ifndef GEMM_REP
#define GEMM_REP 1
#endif
#pragma unroll 1
    for (int rep_ = 0; rep_ < GEMM_REP; ++rep_)
    pg8::gemm_phase<Epi, pg8::StaticOrder, true, true>(lds, g, S, E);
}

#define XB_TMO      128
#define XB_XCNT(j)  (256  + 64 * (j))
#define XB_XSUB(j)  (1280 + 64 * (j))
#define XB_XGEN(j)  (2304 + 64 * (j))
#define XB_TOP      3328
#define XB_TOPGEN   3392
#define XCD_BAR_WORDS 3456
#define XB_SPIN_CAP (1u << 18)

__device__ __forceinline__ unsigned xb_ld(unsigned* p)              { return __hip_atomic_load(p, __ATOMIC_RELAXED, __HIP_MEMORY_SCOPE_AGENT); }
__device__ __forceinline__ unsigned xb_add(unsigned* p, unsigned v) { return __hip_atomic_fetch_add(p, v, __ATOMIC_RELAXED, __HIP_MEMORY_SCOPE_AGENT); }
__device__ __forceinline__ unsigned xb_xcc_id() { return (unsigned)__builtin_amdgcn_s_getreg((3 << 11) | 20) & 0xFu; }
#define XB_SPIN(cond, bar) do { unsigned _sp = 0; while (cond) { __builtin_amdgcn_s_sleep(1); \
    if ((++_sp & 255u) == 0u) { if (xb_ld(&(bar)[XB_TMO])) break; if (_sp > XB_SPIN_CAP) { atomicAdd(&(bar)[XB_TMO], 1u); break; } } } } while (0)

struct XcdBarrier {
    unsigned* bar; unsigned x;
    volatile LAS unsigned* st;
};

__device__ __forceinline__ XcdBarrier xcd_barrier_post(unsigned* bar, volatile LAS unsigned* st) {
    XcdBarrier b; b.bar = bar; b.x = xb_xcc_id(); b.st = st;
    if (threadIdx.x == 0) (void)xb_add(&bar[XB_XCNT(b.x)], 1u);
    return b;
}
__device__ __forceinline__ void xcd_barrier_complete(unsigned* bar, unsigned x, unsigned& nloc, unsigned& nx) {
    const unsigned G = gridDim.x * gridDim.y * gridDim.z;
    unsigned sum, cnt, mine, sp = 0u;
    for (;;) {
        sum = 0u; cnt = 0u; mine = 0u;
#pragma unroll
        for (unsigned j = 0; j < 16; ++j) { const unsigned c = xb_ld(&bar[XB_XCNT(j)]); sum += c; cnt += (c > 0u) ? 1u : 0u; mine = (j == x) ? c : mine; }
        if (sum == G) break;
        __builtin_amdgcn_s_sleep(1);
        if ((++sp & 255u) == 0u) { if (xb_ld(&bar[XB_TMO])) break; if (sp > XB_SPIN_CAP) { atomicAdd(&bar[XB_TMO], 1u); break; } }
    }
    nloc = mine > 0u ? mine : 1u; nx = cnt > 0u ? cnt : 1u;
}

__device__ __forceinline__ void xcd_barrier(const XcdBarrier& b) {
    asm volatile("s_waitcnt vmcnt(0)" ::: "memory");
    __syncthreads();
    if (threadIdx.x == 0) {
        unsigned* bar = b.bar;
        __builtin_amdgcn_s_waitcnt(0);
        unsigned nloc = b.st[0], nx = b.st[1];
        if (nloc == 0u) { xcd_barrier_complete(bar, b.x, nloc, nx); b.st[0] = nloc; b.st[1] = nx; }
        const unsigned old = xb_add(&bar[XB_XSUB(b.x)], 1u);
        const unsigned gen = old / nloc;
        if (old + 1u == (gen + 1u) * nloc) {
            __builtin_amdgcn_fence(__ATOMIC_RELEASE, "agent");
            asm volatile("s_waitcnt vmcnt(0)" ::: "memory");
            const unsigned og = xb_add(&bar[XB_TOP], 1u);
            const unsigned tg = og / nx;
            if (og + 1u == (tg + 1u) * nx) xb_add(&bar[XB_TOPGEN], 1u);
            else XB_SPIN(xb_ld(&bar[XB_TOPGEN]) == tg, bar);
            __builtin_amdgcn_fence(__ATOMIC_ACQUIRE, "agent");
            xb_add(&bar[XB_XGEN(b.x)], 1u);
            asm volatile("s_waitcnt vmcnt(0)" ::: "memory");
        } else {
            XB_SPIN(xb_ld(&bar[XB_XGEN(b.x)]) == gen, bar);
            __builtin_amdgcn_fence(__ATOMIC_ACQUIRE, "agent");
            asm volatile("s_waitcnt vmcnt(0)" ::: "memory");
        }
    }
    __syncthreads();
}

__device__ __forceinline__ void gbar(unsigned* ctr, int& gen) {
    asm volatile("s_waitcnt vmcnt(0) lgkmcnt(0)" ::: "memory");
    __syncthreads();
    if (threadIdx.x == 0) {
        __builtin_amdgcn_fence(__ATOMIC_RELEASE, "agent");
        asm volatile("s_waitcnt vmcnt(0)" ::: "memory");
        const unsigned target = (unsigned)(gen + 1) * gridDim.x;
        __hip_atomic_fetch_add(ctr, 1u, __ATOMIC_RELAXED, __HIP_MEMORY_SCOPE_AGENT);
        while (__hip_atomic_load(ctr, __ATOMIC_RELAXED, __HIP_MEMORY_SCOPE_AGENT) < target) __builtin_amdgcn_s_sleep(2);
        __builtin_amdgcn_fence(__ATOMIC_ACQUIRE, "agent");
        asm volatile("s_waitcnt vmcnt(0)" ::: "memory");
    }
    __syncthreads();
    ++gen;
}
__device__ __forceinline__ void mini_bar(unsigned* ctr, unsigned n) {
    asm volatile("s_waitcnt vmcnt(0) lgkmcnt(0)" ::: "memory");
    __syncthreads();
    if (threadIdx.x == 0) {
        __builtin_amdgcn_fence(__ATOMIC_RELEASE, "agent");
        asm volatile("s_waitcnt vmcnt(0)" ::: "memory");
        __hip_atomic_fetch_add(ctr, 1u, __ATOMIC_RELAXED, __HIP_MEMORY_SCOPE_AGENT);
        unsigned sp = 0u;
        while (__hip_atomic_load(ctr, __ATOMIC_RELAXED, __HIP_MEMORY_SCOPE_AGENT) < n) { __builtin_amdgcn_s_sleep(2); if (++sp > (1u << 20)) break; }
        __builtin_amdgcn_fence(__ATOMIC_ACQUIRE, "agent");
        asm volatile("s_waitcnt vmcnt(0)" ::: "memory");
    }
    __syncthreads();
}
#define MINI_CTR(i) ((unsigned*)(P.ws + 32768) + 64 * (i))
template <int IN, int OUT, class Epi>
__device__ __forceinline__ void tail_resnorm(LAS unsigned char* lds, const bf16_t* As, const bf16_t* Bt, int N, int K, const Epi& Es, unsigned* ctr,
                                             const bf16_t* mix, const float* xp, const float* xs, bf16_t* xb, const float* ga, float* rs, float* yout, int wid, int lane) {
    const int nblk = N >> 8;
    if ((int)blockIdx.x < nblk) {
        pg8::Gemm g{As, Bt, 256, N, K}; pg8::StaticOrder S; S.init(256, N, nblk, (int)blockIdx.x);
        pg8::gemm_phase<Epi, pg8::StaticOrder, true, true>(lds, g, S, Es);
        mini_bar(ctr, (unsigned)nblk);
        resnorm_rows<IN, OUT>(mix, xp, xs, xb, ga, rs, yout, RP, R, (int)blockIdx.x * 8 + wid, nblk * 8, lane);
    } else {
        resnorm_rows<IN, OUT>(mix, xp, xs, xb, ga, rs, yout, 0, RP, ((int)blockIdx.x - nblk) * 8 + wid, ((int)gridDim.x - nblk) * 8, lane);
    }
}
#define PHASE_BEGIN if (ph >= ph_lo && ph < ph_hi) { int tid = threadIdx.x; asm volatile("" : "+v"(tid)); const int lane = tid & 63, wid = __builtin_amdgcn_readfirstlane(tid >> 6); const int gw = blockIdx.x * 8 + wid, ngw = gridDim.x * 8; (void)lane; (void)gw; (void)ngw;
#define PHASE_END   if (ph + 1 < ph_hi) { if (ph == 0) { grid.sync(); if (threadIdx.x == 0) (void)xb_add(&xbar.bar[XB_XCNT(xbar.x)], 1u); } else xcd_barrier(xbar); } } ++ph;
template <int layer> __device__ __forceinline__ void layer_phases(const Params& P, LAS unsigned char* lds, cg::grid_group& grid, int& ph, const XcdBarrier& xbar, int ph_lo, int ph_hi, bf16_t* W, bf16_t* A, bf16_t* B, bf16_t* C, float* xo, float* xo_s) {
        const float* nw = P.in[11] + layer * 6144;
        if constexpr (layer == 1) {
            PHASE_BEGIN { EpiPlain<0> E{B, 1024, 1.f, RSV}; run_gemm(lds, A, W + W_INC, R, 1024, 1024, E); } PHASE_END
            PHASE_BEGIN for (int rp_ = 0; rp_ < REP_S5; ++rp_) s5_phase(P, lds, 1, wid, lane); PHASE_END
            PHASE_BEGIN for (int rp_ = 0; rp_ < REP_S5; ++rp_) s5_phase(P, lds, 2, wid, lane); PHASE_END
            PHASE_BEGIN { EpiGlu E{C}; run_gemm(lds, B + B_X2, W + W_GLU, RP, 2048, 1024, E); } PHASE_END
            PHASE_BEGIN { EpiGlu Es{C + (size_t)RP * 1024}; tail_resnorm<1, 0>(lds, B + B_X2 + (size_t)RP * 1024, W + W_GLU, 2048, 1024, Es, MINI_CTR(3), C, nullptr, nullptr, A, nw + 1024, RSV, nullptr, wid, lane); } PHASE_END
        }
        PHASE_BEGIN { EpiPlain<0> E{B, 1024, 0.0625f * LOG2E, RSV}; run_gemm(lds, A, W + W_XQ + (size_t)layer * 1048576, R, 1024, 1024, E); } PHASE_END
        PHASE_BEGIN for (int rp_ = 0; rp_ < REP_XA; ++rp_) xattn_phase(P, lds, layer, tid, wid, lane); PHASE_END
        PHASE_BEGIN { EpiPlain<0> E{C, 1024, 1.f, nullptr}; run_gemm(lds, B + B_X2, W + W_XO + (size_t)layer * 1048576, RP, 1024, 1024, E); } PHASE_END
        PHASE_BEGIN { EpiPlain<0> Es{C + (size_t)RP * 1024, 1024, 1.f, nullptr}; tail_resnorm<1, 0>(lds, B + B_X2 + (size_t)RP * 1024, W + W_XO + (size_t)layer * 1048576, 1024, 1024, Es, MINI_CTR(1 + 3 * layer), C, nullptr, nullptr, A, nw + 3072, RSV, nullptr, wid, lane); } PHASE_END
        PHASE_BEGIN { EpiPlain<1> E{B, 4096, 1.f, RSV}; run_gemm(lds, A, W + W_UP + (size_t)layer * 4194304, R, 4096, 1024, E); } PHASE_END
        PHASE_BEGIN { EpiPlain<0> E{C, 1024, 1.f, nullptr}; run_gemm(lds, B, W + W_DN + (size_t)layer * 4194304, RP, 1024, 4096, E); } PHASE_END
        PHASE_BEGIN { EpiPlain<0> Es{C + (size_t)RP * 1024, 1024, 1.f, nullptr};
            if constexpr (layer == 0) tail_resnorm<1, 0>(lds, B + (size_t)RP * 4096, W + W_DN + (size_t)layer * 4194304, 1024, 4096, Es, MINI_CTR(2 + 3 * layer), C, nullptr, nullptr, A, nw + 5120, RSV, nullptr, wid, lane);
            else tail_resnorm<1, 1>(lds, B + (size_t)RP * 4096, W + W_DN + (size_t)layer * 4194304, 1024, 4096, Es, MINI_CTR(2 + 3 * layer), C, nullptr, nullptr, A, nw + 5120, nullptr, xo, wid, lane); } PHASE_END
    }
__global__ void __launch_bounds__(512) mega_fwd(Params P, int ph_lo, int ph_hi) {
    extern __shared__ __attribute__((aligned(16))) unsigned char lds_raw[];
    LAS unsigned char* lds = (LAS unsigned char*)lds_raw;
    cg::grid_group grid = cg::this_grid();
    bf16_t* W = (bf16_t*)(P.ws + WS_W);
    bf16_t* A = (bf16_t*)(P.ws + WS_A);
    bf16_t* B = (bf16_t*)(P.ws + WS_B);
    bf16_t* C = (bf16_t*)(P.ws + WS_C);
    float* xo = P.out; float* xo_s = P.out + (size_t)RP * 1024;
    int ph = 0;
    unsigned* barw = (unsigned*)(P.ws + 4096);
    if (blockIdx.x == 0) for (int i = threadIdx.x; i < XCD_BAR_WORDS; i += 512) __hip_atomic_store(barw + i, 0u, __ATOMIC_RELAXED, __HIP_MEMORY_SCOPE_AGENT);
    if (blockIdx.x == 0 && threadIdx.x < 8) __hip_atomic_store(MINI_CTR(threadIdx.x), 0u, __ATOMIC_RELAXED, __HIP_MEMORY_SCOPE_AGENT);
    volatile LAS unsigned* bst = (volatile LAS unsigned*)(lds + LDS_BYTES - 64);
    if (threadIdx.x == 0) { bst[0] = 0u; bst[1] = 0u; }
    __syncthreads();
    XcdBarrier xbar; xbar.bar = barw; xbar.x = xb_xcc_id(); xbar.st = bst;

    PHASE_BEGIN for (int rp_ = 0; rp_ < REP_PRO; ++rp_) prologue(P, tid, wid, lane); PHASE_END
    PHASE_BEGIN {
        EpiAB E{B, (bf16_t*)(P.ws + WS_FKS), (bf16_t*)(P.ws + WS_FVTS), P.out, (const float*)(P.ws + WS_ROPE), P.in[13], RSV};
        run_gemm(lds, A, W + W_AB, R, 3840, 1024, E);
        for (int l = 0; l < 2; ++l) {
            EpiMemKV E2{P.out + O_MK, P.out + O_MV, (bf16_t*)(P.ws + WS_MEMK), (bf16_t*)(P.ws + WS_MEMVT), l};
            run_gemm(lds, (const bf16_t*)(P.ws + WS_MEMN) + (size_t)l * 2048 * 1024, W + W_XKV + (size_t)l * 2097152, 2048, 2048, 1024, E2);
        }
    } PHASE_END
    PHASE_BEGIN { for (int rp_ = 0; rp_ < REP_RET; ++rp_) { ret_passA(P, wid, lane); if (blockIdx.x < 16) cumsum_task(P, blockIdx.x * 8 + wid, lane); } } PHASE_END
    PHASE_BEGIN ret_passB(P, tid); PHASE_END
    PHASE_BEGIN {
        LAS float* red = (LAS float*)lds;
        for (int rp_ = 0; rp_ < REP_RET; ++rp_)
        for (int u = blockIdx.x; u < 4096 + 32; u += gridDim.x) { if (u < 4096) ret_unitC<64>(P, red, u >> 7, u & 127, wid, lane); else ret_unitC<32>(P, red, u - 4096, 0, wid, lane); }
        __syncthreads();
        for (int rp_ = 0; rp_ < REP_FOX; ++rp_) { fox_phase(P, lds, tid, wid, lane); __syncthreads(); }
    } PHASE_END
    PHASE_BEGIN { EpiPlain<0> E{C, 1024, 1.f, nullptr}; run_gemm(lds, MIXED, W + W_OUT, RP, 1024, 1024, E); } PHASE_END
    PHASE_BEGIN { EpiPlain<0> Es{C + (size_t)RP * 1024, 1024, 1.f, nullptr}; tail_resnorm<0, 0>(lds, MIXED + (size_t)RP * 1024, W + W_OUT, 1024, 1024, Es, MINI_CTR(0), C, P.in[0], P.in[1], A, P.in[11] + 1024, RSV, nullptr, wid, lane); } PHASE_END
    layer_phases<0>(P, lds, grid, ph, xbar, ph_lo, ph_hi, W, A, B, C, xo, xo_s);
    layer_phases<1>(P, lds, grid, ph, xbar, ph_lo, ph_hi, W, A, B, C, xo, xo_s);
}

extern "C" void kernel_launch(void* const* d_in, const int* in_sizes, int n_in, void* d_out, int out_size, void* d_ws, size_t ws_size, hipStream_t stream) {
    static int grid = 0;
    if (grid == 0) {
        if (n_in != 33 || (size_t)out_size != O_END || ws_size < WS_END) { fprintf(stderr, "kernel_launch: unexpected shapes n_in %d out %d ws %zu\n", n_in, out_size, ws_size); grid = -1; return; }
        int dev = 0, cus = 0, per_cu = 0;
        hipGetDevice(&dev);
        hipDeviceGetAttribute(&cus, hipDeviceAttributeMultiprocessorCount, dev);
        if (hipFuncSetAttribute((const void*)mega_fwd, hipFuncAttributeMaxDynamicSharedMemorySize, LDS_BYTES) != hipSuccess) { fprintf(stderr, "kernel_launch: hipFuncSetAttribute failed\n"); grid = -1; return; }
        if (hipOccupancyMaxActiveBlocksPerMultiprocessor(&per_cu, (const void*)mega_fwd, 512, LDS_BYTES) != hipSuccess || per_cu < 1) { fprintf(stderr, "kernel_launch: occupancy query %d\n", per_cu); per_cu = 1; (void)hipGetLastError(); }
        grid = cus * per_cu;
    }
    if (grid < 0) return;
    Params p{};
    for (int i = 0; i < 33; ++i) p.in[i] = (const float*)d_in[i];
    p.out = (float*)d_out; p.ws = (unsigned char*)d_ws;
    int lo = 0, hi = 1000;
    void* args[] = {&p, &lo, &hi};
    hipError_t e = hipLaunchCooperativeKernel((const void*)mega_fwd, dim3(grid), dim3(512), args, LDS_BYTES, stream);
    if (e != hipSuccess) fprintf(stderr, "cooperative launch failed: %s (grid %d)\n", hipGetErrorString(e), grid);
}
```

```cpp
#include <hip/hip_runtime.h>
#include <hip/hip_cooperative_groups.h>
#include <cstdio>
#include <cstdint>
namespace cg = cooperative_groups;
namespace pg8 {
#define PG8_LAS __attribute__((address_space(3)))
typedef unsigned short bf16_t;
typedef short bf16x8 __attribute__((ext_vector_type(8)));
typedef float f32x4 __attribute__((ext_vector_type(4)));
typedef unsigned u32x4 __attribute__((ext_vector_type(4)));
constexpr int BM = 256, BK = 64, HALF = 128, HTB = HALF * BK * 2  , STAGE_BYTES = 8 * HTB, NXCD = 8, WGM = 8;

__host__ __device__ __forceinline__ int lds_byte(int r, int c) { const int st = (r >> 4) * 2 + (c >> 5), rr = r & 15, cc = c & 31, ob = rr * 64 + cc * 2; return st * 1024 + (ob ^ (((ob >> 9) & 1) << 5)); }
__host__ __device__ __forceinline__ void stage_rc(int b, int& R, int& C) { const int st = b / 1024, sb = b % 1024, swz = sb ^ (((sb >> 9) & 1) << 5); R = (st >> 1) * 16 + swz / 64; C = (st & 1) * 32 + (swz % 64) / 2; }
__host__ __device__ __forceinline__ int perm32(int rho) { const int n = rho >> 4, i = rho & 15; return 8 * (i >> 2) + 4 * n + (i & 3); }

struct Unit { int pm, pn; };
struct Gemm { const bf16_t* A; const bf16_t* Bt; int M, N, K; };

struct StaticOrder {
    int nM, nN, nwg, G, c;
    __host__ __device__ void init(int M, int N, int G_, int c_) { nM = M / BM; nN = N / BM; nwg = nM * nN; G = G_; c = c_; }
    __host__ __device__ bool next(int i, Unit& u) const {
        const long L = (long)i * G + c; if (L >= nwg) return false;
        int wgid = (int)L; { const int q = nwg / NXCD, r = nwg % NXCD, xcd = wgid % NXCD, off = wgid / NXCD; wgid = (xcd < r ? xcd * (q + 1) : r * (q + 1) + (xcd - r) * q) + off; }
        const int nig = WGM * nN, gid = wgid / nig, fm = gid * WGM, gsz = (nM - fm) < WGM ? (nM - fm) : WGM;
        u.pm = fm + ((wgid % nig) % gsz); u.pn = (wgid % nig) / gsz; return true;
    }
    __device__ __forceinline__ void a_ready(const Unit&) const {}
    __device__ __forceinline__ void done(const Unit&) const {}
};

template <class Epi, class Sched, bool ALIGN_EPI = false, bool SP2 = false>
__device__ __forceinline__ void gemm_phase(PG8_LAS unsigned char* lds, const Gemm g, const Sched& S, const Epi& E) {
    int tid_l = threadIdx.x; asm volatile("" : "+v"(tid_l)); const int tid = tid_l, wid = __builtin_amdgcn_readfirstlane(tid >> 6), lane = tid & 63, wr = wid >> 2, wc = wid & 3, fr = lane & 15, fq = lane >> 4;
    const int K = g.K, nt = K / BK;
    unsigned voffA[2], voffB[2];
#pragma unroll
    for (int i = 0; i < 2; ++i) { int R, C; stage_rc(tid * 16 + i * 8192, R, C); const int Rb = Epi::PERM ? ((R & ~31) + perm32(R & 31)) : R;
        voffA[i] = (unsigned)(R * K + C) * 2u; voffB[i] = (unsigned)(Rb * K + C) * 2u; }
    const size_t kstep = (size_t)(BK * 2);
    const size_t hstep = (size_t)HALF * K * 2;
    const size_t tstep = 2 * hstep;
    const unsigned ldsw = (unsigned)wid * 1024u;
    const int aoff = lds_byte(wr * 64 + fr, fq * 8), boff = lds_byte(wc * 32 + fr, fq * 8);
#define PG8_SA(b, h) (((b) * 2 + (h)) * HTB)
#define PG8_SB(b, h) ((4 + (b) * 2 + (h)) * HTB)
#define PG8_STAGE(bufoff, gbase, voff) do { _Pragma("unroll") for (int _i = 0; _i < 2; ++_i) \
        __builtin_amdgcn_global_load_lds((const unsigned*)((const char*)(gbase) + (voff)[_i]), (PG8_LAS unsigned*)(lds + (bufoff) + ldsw + _i * 8192), 16, 0, 0); } while (0)
#define PG8_LDA(dst, b, h) do { _Pragma("unroll") for (int m = 0; m < 4; ++m) _Pragma("unroll") for (int k = 0; k < 2; ++k) dst[m][k] = *(const PG8_LAS bf16x8*)(lds + PG8_SA(b, h) + aoff + m * 2048 + k * 1024); } while (0)
#define PG8_LDB(dst, b, h) do { _Pragma("unroll") for (int n = 0; n < 2; ++n) _Pragma("unroll") for (int k = 0; k < 2; ++k) dst[n][k] = *(const PG8_LAS bf16x8*)(lds + PG8_SB(b, h) + boff + n * 2048 + k * 1024); } while (0)
#define PG8_MMA(ai, bj, At, Bt) do { __builtin_amdgcn_s_setprio(1); _Pragma("unroll") for (int m = 0; m < 4; ++m) _Pragma("unroll") for (int n = 0; n < 2; ++n) _Pragma("unroll") for (int k = 0; k < 2; ++k) \
        acc[ai][bj][m][n] = __builtin_amdgcn_mfma_f32_16x16x32_bf16(Bt[n][k], At[m][k], acc[ai][bj][m][n], 0, 0, 0); __builtin_amdgcn_s_setprio(0); } while (0)
#define PG8_WAIT_V(n) asm volatile("s_waitcnt vmcnt(" #n ")" ::: "memory")
#define PG8_WAIT_L(n) asm volatile("s_waitcnt lgkmcnt(" #n ")" ::: "memory")
#define PG8_BAR __builtin_amdgcn_s_barrier()
#define PG8_SCHED __builtin_amdgcn_sched_barrier(0)
    Unit cur, nxt; int ui = 0;
    if (!S.next(0, cur)) return;
    f32x4 acc[2][2][4][2];
#pragma unroll
    for (int a = 0; a < 2; ++a)
#pragma unroll
        for (int b = 0; b < 2; ++b)
#pragma unroll
            for (int m = 0; m < 4; ++m)
#pragma unroll
                for (int n = 0; n < 2; ++n) acc[a][b][m][n] = (f32x4){0.f, 0.f, 0.f, 0.f};
    bf16x8 At[4][2], B0[2][2], B1[2][2];
    const char* cA = (const char*)g.A + (size_t)cur.pm * tstep; const char* cB = (const char*)g.Bt + (size_t)cur.pn * tstep;
    S.a_ready(cur);
    if constexpr (SP2) {
        PG8_STAGE(PG8_SB(0, 0), cB, voffB); PG8_STAGE(PG8_SB(0, 1), cB + hstep, voffB); PG8_STAGE(PG8_SA(0, 0), cA, voffA); PG8_STAGE(PG8_SA(0, 1), cA + hstep, voffA);
        if (wr == 1) PG8_BAR;
        PG8_WAIT_V(2); PG8_BAR;
        PG8_STAGE(PG8_SB(1, 0), cB + kstep, voffB); PG8_STAGE(PG8_SA(1, 0), cA + kstep, voffA); PG8_STAGE(PG8_SB(1, 1), cB + hstep + kstep, voffB);
        PG8_WAIT_V(6); PG8_BAR;
    } else {
        PG8_STAGE(PG8_SB(0, 0), cB, voffB); PG8_STAGE(PG8_SA(0, 0), cA, voffA); PG8_STAGE(PG8_SB(0, 1), cB + hstep, voffB); PG8_STAGE(PG8_SA(0, 1), cA + hstep, voffA);
        if (wr == 1) PG8_BAR;
        PG8_WAIT_V(4); PG8_BAR;
        PG8_STAGE(PG8_SB(1, 0), cB + kstep, voffB); PG8_STAGE(PG8_SA(1, 0), cA + kstep, voffA); PG8_STAGE(PG8_SB(1, 1), cB + hstep + kstep, voffB);
        PG8_WAIT_V(6); PG8_BAR;
    }
    for (;;) {
        const bool has_next = S.next(ui + 1, nxt);
        const char* nA = has_next ? (const char*)g.A + (size_t)nxt.pm * tstep : cA; const char* nB = has_next ? (const char*)g.Bt + (size_t)nxt.pn * tstep : cB;
        for (int t = 0; t < nt; t += 2) {
            const bool last = (t == nt - 2);
            const char* a1 = cA + (size_t)(t + 1) * kstep;
            const char* a2 = last ? nA : cA + (size_t)(t + 2) * kstep; const char* b2 = last ? nB : cB + (size_t)(t + 2) * kstep;
            const char* a3 = a2 + kstep; const char* b3 = b2 + kstep;
            if (last && has_next) S.a_ready(nxt);
            if constexpr (SP2) {
            PG8_LDB(B0, 0, 0); PG8_LDB(B1, 0, 1); PG8_SCHED; PG8_LDA(At, 0, 0); PG8_STAGE(PG8_SA(1, 1), a1 + hstep, voffA);
            PG8_WAIT_V(8); PG8_WAIT_L(0); PG8_BAR; PG8_MMA(0, 0, At, B0); PG8_MMA(0, 1, At, B1); PG8_BAR; PG8_SCHED;
            PG8_LDA(At, 0, 1); PG8_STAGE(PG8_SB(0, 0), b2, voffB); PG8_STAGE(PG8_SB(0, 1), b2 + hstep, voffB); PG8_STAGE(PG8_SA(0, 0), a2, voffA);
            PG8_WAIT_V(8); PG8_WAIT_L(0); PG8_BAR; PG8_MMA(1, 0, At, B0); PG8_MMA(1, 1, At, B1); PG8_BAR; PG8_SCHED;
            PG8_LDB(B0, 1, 0); PG8_LDB(B1, 1, 1); PG8_SCHED; PG8_LDA(At, 1, 0); PG8_STAGE(PG8_SA(0, 1), a2 + hstep, voffA);
            PG8_WAIT_V(8); PG8_WAIT_L(0); PG8_BAR; PG8_MMA(0, 0, At, B0); PG8_MMA(0, 1, At, B1); PG8_BAR; PG8_SCHED;
            PG8_LDA(At, 1, 1); PG8_STAGE(PG8_SB(1, 0), b3, voffB); PG8_STAGE(PG8_SB(1, 1), b3 + hstep, voffB); PG8_STAGE(PG8_SA(1, 0), a3, voffA);
            PG8_WAIT_V(8); PG8_WAIT_L(0); PG8_BAR; PG8_MMA(1, 0, At, B0); PG8_MMA(1, 1, At, B1); PG8_BAR; PG8_SCHED;
            } else {
            PG8_LDB(B0, 0, 0); PG8_SCHED; PG8_LDA(At, 0, 0); PG8_STAGE(PG8_SA(1, 1), a1 + hstep, voffA);
            PG8_WAIT_L(8); PG8_BAR; PG8_WAIT_L(0); PG8_MMA(0, 0, At, B0); PG8_BAR; PG8_SCHED;
            PG8_LDB(B1, 0, 1); PG8_STAGE(PG8_SB(0, 0), b2, voffB);
            PG8_BAR; PG8_WAIT_L(0); PG8_MMA(0, 1, At, B1); PG8_BAR;
            PG8_LDA(At, 0, 1); PG8_STAGE(PG8_SA(0, 0), a2, voffA);
            PG8_BAR; PG8_WAIT_L(0); PG8_MMA(1, 0, At, B0); PG8_BAR; PG8_SCHED;
            PG8_STAGE(PG8_SB(0, 1), b2 + hstep, voffB);
            PG8_WAIT_V(6); PG8_BAR; PG8_MMA(1, 1, At, B1); PG8_BAR;
            PG8_LDB(B0, 1, 0); PG8_SCHED; PG8_LDA(At, 1, 0); PG8_STAGE(PG8_SA(0, 1), a2 + hstep, voffA);
            PG8_WAIT_L(8); PG8_BAR; PG8_WAIT_L(0); PG8_MMA(0, 0, At, B0); PG8_BAR; PG8_SCHED;
            PG8_LDB(B1, 1, 1); PG8_STAGE(PG8_SB(1, 0), b3, voffB);
            PG8_BAR; PG8_WAIT_L(0); PG8_MMA(0, 1, At, B1); PG8_BAR;
            PG8_LDA(At, 1, 1); PG8_STAGE(PG8_SA(1, 0), a3, voffA);
            PG8_BAR; PG8_WAIT_L(0); PG8_MMA(1, 0, At, B0); PG8_BAR; PG8_SCHED;
            PG8_STAGE(PG8_SB(1, 1), b3 + hstep, voffB);
            PG8_WAIT_V(6); PG8_BAR; PG8_MMA(1, 1, At, B1); PG8_BAR;
            }
        }
        if constexpr (ALIGN_EPI) { if (wr == 0) PG8_BAR; }
        if constexpr (!Epi::AFTER_DRAIN) { E(acc, cur, wr, wc, fr, fq); S.done(cur); }
        if (!has_next) break;
#pragma unroll
        for (int a = 0; a < 2; ++a)
#pragma unroll
            for (int b = 0; b < 2; ++b)
#pragma unroll
                for (int m = 0; m < 4; ++m)
#pragma unroll
                    for (int n = 0; n < 2; ++n) acc[a][b][m][n] = (f32x4){0.f, 0.f, 0.f, 0.f};
        cur = nxt; cA = nA; cB = nB; ++ui;
        if constexpr (ALIGN_EPI) { if (wr == 1) PG8_BAR; }
    }
    PG8_WAIT_V(0);
    if constexpr (!ALIGN_EPI) { if (wr == 0) PG8_BAR; }
    PG8_BAR;
    if constexpr (Epi::AFTER_DRAIN) { E.fused(acc, cur, wr, wc, fr, fq, lds, wid, lane); S.done(cur); }
#undef PG8_SA
#undef PG8_SB
#undef PG8_STAGE
#undef PG8_LDA
#undef PG8_LDB
#undef PG8_MMA
#undef PG8_WAIT_V
#undef PG8_WAIT_L
#undef PG8_BAR
#undef PG8_SCHED
}
}
#ifndef REP_FOX
#define REP_FOX 1
#endif
#ifndef REP_PRO
#define REP_PRO 1
#endif
#ifndef REP_RET
#define REP_RET 1
#endif
#ifndef REP_XA
#define REP_XA 1
#endif
#ifndef REP_S5
#define REP_S5 1
#endif

#define LAS __attribute__((address_space(3)))
typedef unsigned short bf16_t;
typedef short bf16x8 __attribute__((ext_vector_type(8)));
typedef short s16x4 __attribute__((ext_vector_type(4)));
typedef float f32x4 __attribute__((ext_vector_type(4)));
typedef float f32x2 __attribute__((ext_vector_type(2)));
typedef float f32x16 __attribute__((ext_vector_type(16)));
typedef unsigned u32x4 __attribute__((ext_vector_type(4)));
typedef unsigned u32x2 __attribute__((ext_vector_type(2)));
typedef __bf16 bf16x2_t __attribute__((ext_vector_type(2)));
using pg8::Unit;

__device__ __forceinline__ unsigned pk2(float lo, float hi) { f32x2 v = {lo, hi}; bf16x2_t b = __builtin_convertvector(v, bf16x2_t); return __builtin_bit_cast(unsigned, b); }
__device__ __forceinline__ float bflo(unsigned w) { return __uint_as_float(w << 16); }
__device__ __forceinline__ float bfhi(unsigned w) { return __uint_as_float(w & 0xffff0000u); }
__device__ __forceinline__ bf16_t f2bf(float f) { return (bf16_t)(pk2(f, 0.f) & 0xffffu); }
__device__ __forceinline__ float ex2(float x) { return __builtin_amdgcn_exp2f(x); }
__device__ __forceinline__ float wave_sum(float v) {
#pragma unroll
    for (int o = 1; o < 64; o <<= 1) v += __shfl_xor(v, o);
    return v;
}
#define LDSBAR() asm volatile("s_waitcnt lgkmcnt(0)" ::: "memory")
#define MFMA32(a, b, c) __builtin_amdgcn_mfma_f32_32x32x16_bf16((a), (b), (c), 0, 0, 0)
#define MFMA16(a, b, c) __builtin_amdgcn_mfma_f32_16x16x32_bf16((a), (b), (c), 0, 0, 0)

constexpr int DM = 1024, RP = 65536, RS = 256, R = RP + RS, T = 8192, TS = 32, PAST = 4096, TKS = PAST + TS;
constexpr float LOG2E = 1.4426950408889634f;
constexpr float EPS = 1e-6f;
constexpr size_t O_Y = 0, O_RSP = (size_t)R * 1024, O_RSS = O_RSP + 524288, O_FKP = O_RSS + 524288, O_FVP = O_FKP + (size_t)RP * 512,
                 O_LFP = O_FVP + (size_t)RP * 512, O_FKS = O_LFP + (size_t)RP * 8, O_FVS = O_FKS + 131072, O_LFS = O_FVS + 131072,
                 O_S5RP = O_LFS + 2048, O_S5IP = O_S5RP + 32768, O_S5RS = O_S5IP + 32768, O_S5IS = O_S5RS + 32768, O_MK = O_S5IS + 32768,
                 O_MV = O_MK + 4194304, O_END = O_MV + 4194304;
constexpr size_t MiB = 1u << 20;
constexpr size_t WS_W = 1 * MiB, WS_ROPE = 65 * MiB, WS_C2P = 69 * MiB, WS_C2S = 71 * MiB, WS_MEMN = 73 * MiB, WS_MEMK = 81 * MiB, WS_MEMVT = 97 * MiB,
                 WS_S5T = 113 * MiB, WS_LE = 114 * MiB, WS_KVS = 118 * MiB, WS_A = 120 * MiB, WS_B = 249 * MiB, WS_C = 763 * MiB, WS_FKS = 892 * MiB,
                 WS_FVTS = 925 * MiB, WS_END = 960 * MiB;
constexpr size_t W_AB = 0, W_OUT = W_AB + 3840 * 1024, W_INC = W_OUT + 1048576, W_GLU = W_INC + 1048576, W_XQ = W_GLU + 2097152, W_XKV = W_XQ + 2097152,
                 W_XO = W_XKV + 4194304, W_UP = W_XO + 2097152, W_DN = W_UP + 8388608, W_ENDE = W_DN + 8388608;
static_assert(W_ENDE * 2 <= 64 * MiB, "weights region");
constexpr size_t B_RQ = 0, B_RK = (size_t)R * 512, B_RG = 2 * (size_t)R * 512, B_FQ = 3 * (size_t)R * 512, B_FK = 4 * (size_t)R * 512, B_KT = 5 * (size_t)R * 512,
                 B_VT = B_KT + (size_t)RP * 512, B_FVT = B_VT + (size_t)RP * 512, B_KTS = B_FVT + (size_t)RP * 512, B_VTS = B_KTS + 131072, B_ENDE = B_VTS + 131072;
static_assert(B_ENDE * 2 <= 514 * MiB, "region B");
constexpr size_t B_X2 = 129 * MiB / 2;
constexpr size_t WS_RS = 119 * MiB;
#define RSV ((float*)(P.ws + WS_RS))
#define MIXED ((bf16_t*)P.out)
constexpr int LDS_BYTES = 139264;

struct Params {
    const float* in[33];
    float* out;
    unsigned char* ws;
};

template <int ACT  > struct EpiPlain {
    static constexpr bool PERM = true, AFTER_DRAIN = false;
    bf16_t* O; int ldc; float scale; const float* rs;
    __device__ __forceinline__ void operator()(const f32x4 (&acc)[2][2][4][2], const Unit& u, int wr, int wc, int fr, int fq) const {
        asm volatile("" : "+v"(fr), "+v"(fq));
        bf16_t* base = O + (size_t)(u.pm * 256 + wr * 64 + fr) * ldc + u.pn * 256 + wc * 32 + fq * 8;
#pragma unroll
        for (int ai = 0; ai < 2; ++ai)
#pragma unroll
            for (int m = 0; m < 4; ++m) {
                bf16_t* rp = base + (size_t)(ai * 128 + m * 16) * ldc;
                const float rsc = rs ? rs[u.pm * 256 + wr * 64 + fr + ai * 128 + m * 16] * scale : scale;
#pragma unroll
                for (int bj = 0; bj < 2; ++bj) {
                    f32x4 v0 = acc[ai][bj][m][0] * rsc, v1 = acc[ai][bj][m][1] * rsc;
                    if (ACT == 1) { v0.x = fmaxf(v0.x, 0.f); v0.y = fmaxf(v0.y, 0.f); v0.z = fmaxf(v0.z, 0.f); v0.w = fmaxf(v0.w, 0.f); v0 = v0 * v0;
                                    v1.x = fmaxf(v1.x, 0.f); v1.y = fmaxf(v1.y, 0.f); v1.z = fmaxf(v1.z, 0.f); v1.w = fmaxf(v1.w, 0.f); v1 = v1 * v1; }
                    u32x4 w; w.x = pk2(v0.x, v0.y); w.y = pk2(v0.z, v0.w); w.z = pk2(v1.x, v1.y); w.w = pk2(v1.z, v1.w);
                    *(u32x4*)(rp + bj * 128) = w;
                }
            }
    }
};
struct EpiGlu {
    static constexpr bool PERM = false, AFTER_DRAIN = false;
    bf16_t* O;
    __device__ __forceinline__ void operator()(const f32x4 (&acc)[2][2][4][2], const Unit& u, int wr, int wc, int fr, int fq) const {
        asm volatile("" : "+v"(fr), "+v"(fq));
#pragma unroll
        for (int ai = 0; ai < 2; ++ai)
#pragma unroll
            for (int m = 0; m < 4; ++m) {
                const int row = u.pm * 256 + ai * 128 + wr * 64 + m * 16 + fr;
                bf16_t* rp = O + (size_t)row * 1024 + u.pn * 128 + wc * 32 + fq * 4;
#pragma unroll
                for (int n = 0; n < 2; ++n) {
                    const f32x4 a = acc[ai][0][m][n], g = acc[ai][1][m][n];
                    f32x4 v;
                    v.x = a.x / (1.f + __expf(-g.x)); v.y = a.y / (1.f + __expf(-g.y)); v.z = a.z / (1.f + __expf(-g.z)); v.w = a.w / (1.f + __expf(-g.w));
                    u32x2 w; w.x = pk2(v.x, v.y); w.y = pk2(v.z, v.w);
                    *(u32x2*)(rp + n * 16) = w;
                }
            }
    }
};
struct EpiMemKV {
    static constexpr bool PERM = false, AFTER_DRAIN = false;
    float* oK; float* oV; bf16_t* mk; bf16_t* mvt;
    __device__ __forceinline__ void operator()(const f32x4 (&acc)[2][2][4][2], const Unit& uu, int wr, int wc, int fr, int fq) const {
        asm volatile("" : "+v"(fr), "+v"(fq));
        const int layer = uu.pm >> 3;
        Unit u; u.pm = uu.pm & 7; u.pn = uu.pn & 7;
        const bool isv = u.pn >= 4;
#pragma unroll
        for (int ai = 0; ai < 2; ++ai)
#pragma unroll
            for (int m = 0; m < 4; ++m) {
                const int row = u.pm * 256 + ai * 128 + wr * 64 + m * 16 + fr;
                const int b = row >> 8, mm = row & 255;
#pragma unroll
                for (int bj = 0; bj < 2; ++bj)
#pragma unroll
                    for (int n = 0; n < 2; ++n) {
                        const int col = (u.pn & 3) * 256 + bj * 128 + wc * 32 + n * 16 + fq * 4;
                        const f32x4 v = acc[ai][bj][m][n];
                        if (!isv) {
                            *(f32x4*)(oK + ((size_t)layer * 2048 + row) * 1024 + col) = v;
                            u32x2 w; w.x = pk2(v.x, v.y); w.y = pk2(v.z, v.w);
                            *(u32x2*)(mk + ((size_t)(layer * 16 + b) * 256 + mm) * 1024 + col) = w;
                        } else {
                            *(f32x4*)(oV + ((size_t)layer * 2048 + row) * 1024 + col) = v;
                            bf16_t* p = mvt + ((size_t)(layer * 16 + b) * 1024 + col) * 256 + mm;
                            p[0] = f2bf(v.x); p[256] = f2bf(v.y); p[512] = f2bf(v.z); p[768] = f2bf(v.w);
                        }
                    }
            }
    }
};
__device__ __forceinline__ float logsig(float x) { return x >= 0.f ? -log1pf(__expf(-x)) : x - log1pf(__expf(x)); }
struct EpiAB {
    static constexpr bool PERM = false, AFTER_DRAIN = false;
    bf16_t* B;
    bf16_t* fks; bf16_t* fvts;
    float* out; const float* rope; const float* bfox; const float* rs;
    __device__ __forceinline__ void operator()(const f32x4 (&acc)[2][2][4][2], const Unit& u, int wr, int wc, int fr, int fq) const {
        asm volatile("" : "+v"(fr), "+v"(fq));
        switch (u.pn >> 1) {
            case 0: body<0>(acc, u, wr, wc, fr, fq); break; case 1: body<1>(acc, u, wr, wc, fr, fq); break; case 2: body<2>(acc, u, wr, wc, fr, fq); break;
            case 3: body<3>(acc, u, wr, wc, fr, fq); break; case 4: body<4>(acc, u, wr, wc, fr, fq); break; case 5: body<5>(acc, u, wr, wc, fr, fq); break;
            case 6: body<6>(acc, u, wr, wc, fr, fq); break; default: body<7>(acc, u, wr, wc, fr, fq); break;
        }
    }
    template <int sect> __device__ __forceinline__ void body(const f32x4 (&acc)[2][2][4][2], const Unit& u, int wr, int wc, int fr, int fq) const {
        rowgrp<sect, 0, 0>(acc, u, wr, wc, fr, fq); rowgrp<sect, 0, 1>(acc, u, wr, wc, fr, fq); rowgrp<sect, 0, 2>(acc, u, wr, wc, fr, fq); rowgrp<sect, 0, 3>(acc, u, wr, wc, fr, fq);
        rowgrp<sect, 1, 0>(acc, u, wr, wc, fr, fq); rowgrp<sect, 1, 1>(acc, u, wr, wc, fr, fq); rowgrp<sect, 1, 2>(acc, u, wr, wc, fr, fq); rowgrp<sect, 1, 3>(acc, u, wr, wc, fr, fq);
    }
    template <int sect, int ai, int m> __device__ __forceinline__ void rowgrp(const f32x4 (&acc)[2][2][4][2], const Unit& u, int wr, int wc, int fr, int fq) const {
        const int pn = u.pn;
            {
                const int row = u.pm * 256 + ai * 128 + wr * 64 + m * 16 + fr;
                const bool samp = row >= RP;
                const int rr = row - RP;
                const int b = samp ? (rr >> 5) : (row >> 13);
                const int t = samp ? (rr & 31) : (row & 8191);
                const int pos = samp ? PAST + t : t;
                const float rsc = rs[row];
#pragma unroll
                for (int bj = 0; bj < 2; ++bj)
#pragma unroll
                    for (int n = 0; n < 2; ++n) {
                        const int sec = (pn & 1) * 256 + bj * 128 + wc * 32 + n * 16 + fq * 4;
                        f32x4 v = acc[ai][bj][m][n] * rsc;
                        if constexpr (sect <= 1) {
                            const int hd = sec >> 7, w = sec & 127, i0 = w >> 1;
                            const f32x4 cs = *(const f32x4*)(rope + ((size_t)pos * 64 + i0) * 2);
                            f32x4 o;
                            o.x = v.x * cs.x - v.y * cs.y; o.y = v.y * cs.x + v.x * cs.y;
                            o.z = v.z * cs.z - v.w * cs.w; o.w = v.w * cs.z + v.z * cs.w;
                            if constexpr (sect == 0) {
                                u32x2 wv; wv.x = pk2(o.x, o.y); wv.y = pk2(o.z, o.w);
                                *(u32x2*)(B + B_RQ + (size_t)row * 512 + sec) = wv;
                            } else {
                                o = o * 0.08838834764831845f;
                                u32x2 wv; wv.x = pk2(o.x, o.y); wv.y = pk2(o.z, o.w);
                                *(u32x2*)(B + B_RK + (size_t)row * 512 + sec) = wv;
                                const float lg2 = __log2f(1.f - ex2((float)(-5 - hd)));
                                if (!samp) {
                                    const int j = t & 63; const float wk = ex2(lg2 * (float)(63 - j));
                                    bf16_t* p = B + B_KT + ((size_t)((b * 4 + hd) * 128 + (t >> 6)) * 128 + w) * 64 + j;
                                    p[0] = f2bf(o.x * wk); p[64] = f2bf(o.y * wk); p[128] = f2bf(o.z * wk); p[192] = f2bf(o.w * wk);
                                } else {
                                    const float wk = ex2(lg2 * (float)(31 - t));
                                    bf16_t* p = B + B_KTS + ((size_t)(b * 4 + hd) * 128 + w) * 32 + t;
                                    p[0] = f2bf(o.x * wk); p[32] = f2bf(o.y * wk); p[64] = f2bf(o.z * wk); p[96] = f2bf(o.w * wk);
                                }
                            }
                        } else if constexpr (sect == 2) {
                            const int hd = sec >> 7, w = sec & 127;
                            if (!samp) {
                                bf16_t* p = B + B_VT + ((size_t)((b * 4 + hd) * 128 + (t >> 6)) * 128 + w) * 64 + (t & 63);
                                p[0] = f2bf(v.x); p[64] = f2bf(v.y); p[128] = f2bf(v.z); p[192] = f2bf(v.w);
                            } else {
                                bf16_t* p = B + B_VTS + ((size_t)(b * 4 + hd) * 128 + w) * 32 + t;
                                p[0] = f2bf(v.x); p[32] = f2bf(v.y); p[64] = f2bf(v.z); p[96] = f2bf(v.w);
                            }
                        } else if constexpr (sect == 3) {
                            f32x4 o; o.x = v.x / (1.f + __expf(-v.x)); o.y = v.y / (1.f + __expf(-v.y)); o.z = v.z / (1.f + __expf(-v.z)); o.w = v.w / (1.f + __expf(-v.w));
                            u32x2 wv; wv.x = pk2(o.x, o.y); wv.y = pk2(o.z, o.w);
                            *(u32x2*)(B + B_RG + (size_t)row * 512 + sec) = wv;
                        } else if constexpr (sect == 4) {
                            const f32x4 o = v * (0.125f * LOG2E);
                            u32x2 wv; wv.x = pk2(o.x, o.y); wv.y = pk2(o.z, o.w);
                            *(u32x2*)(B + B_FQ + (size_t)row * 512 + sec) = wv;
                        } else if constexpr (sect == 5) {
                            u32x2 wv; wv.x = pk2(v.x, v.y); wv.y = pk2(v.z, v.w);
                            if (!samp) { *(f32x4*)(out + O_FKP + (size_t)row * 512 + sec) = v; *(u32x2*)(B + B_FK + (size_t)row * 512 + sec) = wv; }
                            else { *(f32x4*)(out + O_FKS + (size_t)rr * 512 + sec) = v; *(u32x2*)(fks + ((size_t)b * TKS + PAST + t) * 512 + sec) = wv; }
                        } else if constexpr (sect == 6) {
                            if (!samp) {
                                *(f32x4*)(out + O_FVP + (size_t)row * 512 + sec) = v;
                                bf16_t* p = B + B_FVT + ((size_t)b * 512 + sec) * T + t;
                                p[0] = f2bf(v.x); p[T] = f2bf(v.y); p[2 * T] = f2bf(v.z); p[3 * T] = f2bf(v.w);
                            } else {
                                *(f32x4*)(out + O_FVS + (size_t)rr * 512 + sec) = v;
                                bf16_t* p = fvts + ((size_t)b * 512 + sec) * TKS + PAST + t;
                                p[0] = f2bf(v.x); p[TKS] = f2bf(v.y); p[2 * TKS] = f2bf(v.z); p[3 * TKS] = f2bf(v.w);
                            }
                        } else {
                            if (sec < 8) {
                                const f32x4 bb = *(const f32x4*)(bfox + sec);
                                f32x4 o; o.x = logsig(v.x + bb.x); o.y = logsig(v.y + bb.y); o.z = logsig(v.z + bb.z); o.w = logsig(v.w + bb.w);
                                if (!samp) *(f32x4*)(out + O_LFP + (size_t)row * 8 + sec) = o;
                                else *(f32x4*)(out + O_LFS + (size_t)rr * 8 + sec) = o;
                            }
                        }
                    }
                asm volatile("" ::: "memory");
            }
    }
};

__device__ __forceinline__ void wtrans(const float* __restrict__ src, int K, int Ns, bf16_t* dst, int Nd, int mode, int gtid, int gsz, const float* gk = nullptr) {
    const int nb = Nd >> 3, items = nb * (K >> 6) * 64;
    for (int it = gtid; it < items; it += gsz) {
        const int ln = it & 63, blk = it >> 6;
        const int n = (blk % nb) * 8 + (ln >> 3), k0 = (blk / nb) * 64 + (ln & 7) * 8;
        int col = n; bool z = false;
        if (mode == 1) { if (n < 1024) { const int w = n & 127; col = (n & ~127) + (w >> 1) + 64 * (w & 1); } else if (n >= 3592) z = true; }
        else if (mode == 2) { col = ((n >> 7) & 1) * 1024 + (n >> 8) * 128 + (n & 127); }
        const float* s = src + (size_t)k0 * Ns + (z ? 0 : col);
        float v0 = s[0], v1 = s[(size_t)Ns], v2 = s[2 * (size_t)Ns], v3 = s[3 * (size_t)Ns], v4 = s[4 * (size_t)Ns], v5 = s[5 * (size_t)Ns], v6 = s[6 * (size_t)Ns], v7 = s[7 * (size_t)Ns];
        if (gk) { const f32x4 ga_ = *(const f32x4*)(gk + k0), gb_ = *(const f32x4*)(gk + k0 + 4); v0 *= ga_.x; v1 *= ga_.y; v2 *= ga_.z; v3 *= ga_.w; v4 *= gb_.x; v5 *= gb_.y; v6 *= gb_.z; v7 *= gb_.w; }
        u32x4 o; o.x = pk2(v0, v1); o.y = pk2(v2, v3); o.z = pk2(v4, v5); o.w = pk2(v6, v7);
        if (z) o = (u32x4){0u, 0u, 0u, 0u};
        *(u32x4*)(dst + (size_t)n * K + k0) = o;
    }
}
__device__ __forceinline__ void ttrans(const float* __restrict__ src, int rows, int C, bf16_t* dst, size_t dpitch, int gtid, int gsz) {
    const int cb = C >> 3, items = cb * (rows >> 6) * 64;
    for (int it = gtid; it < items; it += gsz) {
        const int ln = it & 63, blk = it >> 6;
        const int c = (blk % cb) * 8 + (ln >> 3), r0 = (blk / cb) * 64 + (ln & 7) * 8;
        const float* s = src + (size_t)r0 * C + c;
        float v0 = s[0], v1 = s[(size_t)C], v2 = s[2 * (size_t)C], v3 = s[3 * (size_t)C], v4 = s[4 * (size_t)C], v5 = s[5 * (size_t)C], v6 = s[6 * (size_t)C], v7 = s[7 * (size_t)C];
        u32x4 o; o.x = pk2(v0, v1); o.y = pk2(v2, v3); o.z = pk2(v4, v5); o.w = pk2(v6, v7);
        *(u32x4*)(dst + (size_t)c * dpitch + r0) = o;
    }
}
__device__ __forceinline__ void cvt8(const float* __restrict__ s, bf16_t* d) {
    const f32x4 a = *(const f32x4*)s, b = *(const f32x4*)(s + 4);
    u32x4 o; o.x = pk2(a.x, a.y); o.y = pk2(a.z, a.w); o.z = pk2(b.x, b.y); o.w = pk2(b.z, b.w);
    *(u32x4*)d = o;
}
__device__ __forceinline__ void norm_row(const float* xr, const float* g, bf16_t* orow, int lane) {
    f32x4 v[4]; float s = 0.f;
#pragma unroll
    for (int j = 0; j < 4; ++j) { v[j] = ((const f32x4*)xr)[lane + 64 * j]; s += (v[j].x * v[j].x + v[j].y * v[j].y) + (v[j].z * v[j].z + v[j].w * v[j].w); }
    const float rstd = rsqrtf(wave_sum(s) * (1.f / 1024.f) + EPS);
#pragma unroll
    for (int j = 0; j < 4; ++j) { const f32x4 gg = ((const f32x4*)g)[lane + 64 * j]; const f32x4 o = v[j] * rstd * gg; u32x2 w; w.x = pk2(o.x, o.y); w.y = pk2(o.z, o.w); ((u32x2*)orow)[lane + 64 * j] = w; }
}
__device__ __forceinline__ void cvt_row(const float* xr, bf16_t* orow, float* rs, int lane) {
    f32x4 v[4]; float s = 0.f;
#pragma unroll
    for (int j = 0; j < 4; ++j) { v[j] = ((const f32x4*)xr)[lane + 64 * j]; s += (v[j].x * v[j].x + v[j].y * v[j].y) + (v[j].z * v[j].z + v[j].w * v[j].w); }
    const float rstd = rsqrtf(wave_sum(s) * (1.f / 1024.f) + EPS);
#pragma unroll
    for (int j = 0; j < 4; ++j) { u32x2 w; w.x = pk2(v[j].x, v[j].y); w.y = pk2(v[j].z, v[j].w); ((u32x2*)orow)[lane + 64 * j] = w; }
    if (lane == 0) *rs = rstd;
}
struct RnRow { f32x4 x[4]; u32x2 m[4]; };
template <int IN> __device__ __forceinline__ void rn_load(RnRow& r, const bf16_t* mix, const float* xp, const float* xs, const bf16_t* xb, int row, int lane) {
#pragma unroll
    for (int j = 0; j < 4; ++j) {
        if (IN == 0) { const float* xr = row < RP ? xp + (size_t)row * 1024 : xs + (size_t)(row - RP) * 1024; r.x[j] = __builtin_nontemporal_load((const f32x4*)xr + lane + 64 * j); }
        else { const u32x2 w = *((const u32x2*)(xb + (size_t)row * 1024) + lane + 64 * j); r.x[j] = (f32x4){bflo(w.x), bfhi(w.x), bflo(w.y), bfhi(w.y)}; }
        r.m[j] = __builtin_nontemporal_load((const u32x2*)(mix + (size_t)row * 1024) + lane + 64 * j);
    }
}
template <int OUT> __device__ __forceinline__ void rn_proc(const RnRow& r, const float* ga, bf16_t* xb, float* rs, float* yout, int row, int lane) {
    f32x4 xv[4], mv[4]; float s = 0.f;
#pragma unroll
    for (int j = 0; j < 4; ++j) {
        const u32x2 w = r.m[j];
        mv[j] = (f32x4){bflo(w.x), bfhi(w.x), bflo(w.y), bfhi(w.y)};
        s += (mv[j].x * mv[j].x + mv[j].y * mv[j].y) + (mv[j].z * mv[j].z + mv[j].w * mv[j].w);
    }
    const float rm = rsqrtf(wave_sum(s) * (1.f / 1024.f) + EPS);
    float s2 = 0.f;
#pragma unroll
    for (int j = 0; j < 4; ++j) {
        const f32x4 gg = ((const f32x4*)ga)[lane + 64 * j];
        xv[j] = r.x[j] + mv[j] * rm * gg;
        if (OUT == 1) ((f32x4*)(yout + (size_t)row * 1024))[lane + 64 * j] = xv[j];
        else { u32x2 w; w.x = pk2(xv[j].x, xv[j].y); w.y = pk2(xv[j].z, xv[j].w); ((u32x2*)(xb + (size_t)row * 1024))[lane + 64 * j] = w; }
        s2 += (xv[j].x * xv[j].x + xv[j].y * xv[j].y) + (xv[j].z * xv[j].z + xv[j].w * xv[j].w);
    }
    if (OUT == 0) { const float rx = rsqrtf(wave_sum(s2) * (1.f / 1024.f) + EPS); if (lane == 0) rs[row] = rx; }
}
template <int IN, int OUT> __device__ __forceinline__ void resnorm_rows(const bf16_t* mix, const float* xp, const float* xs, bf16_t* xb, const float* ga, float* rs, float* yout, int row_lo, int row_hi, int gw, int ngw, int lane) {
    int row = row_lo + gw * 2;
    if (row >= row_hi) return;
    RnRow a0, a1, b0, b1;
    rn_load<IN>(a0, mix, xp, xs, xb, row, lane); rn_load<IN>(a1, mix, xp, xs, xb, row + 1, lane);
    for (;;) {
        const int nrow = row + ngw * 2;
        const bool more = nrow < row_hi;
        if (more) { rn_load<IN>(b0, mix, xp, xs, xb, nrow, lane); rn_load<IN>(b1, mix, xp, xs, xb, nrow + 1, lane); }
        rn_proc<OUT>(a0, ga, xb, rs, yout, row, lane); rn_proc<OUT>(a1, ga, xb, rs, yout, row + 1, lane);
        if (!more) break;
        a0 = b0; a1 = b1; row = nrow;
    }
}

__device__ __forceinline__ float ret_lg2(int h) { return __log2f(1.f - ex2((float)(-5 - h))); }
__device__ __forceinline__ void ret_passA(const Params& P, int wid, int lane) {
    bf16_t* B = (bf16_t*)(P.ws + WS_B);
    bf16_t* KV = (bf16_t*)(P.ws + WS_C);
    bf16_t* KVS = (bf16_t*)(P.ws + WS_KVS);
    const int l32 = lane & 31, hh = lane >> 5;
    const int mt = wid >> 1, nt0 = (wid & 1) * 2;
    for (int u = blockIdx.x; u < 4096 + 32; u += gridDim.x) {
        const bool samp = u >= 4096;
        f32x16 d0 = {}, d1 = {};
        if (!samp) {
            const bf16_t* vt = B + B_VT + (size_t)u * 8192; const bf16_t* kt = B + B_KT + (size_t)u * 8192;
#pragma unroll
            for (int ks = 0; ks < 4; ++ks) {
                const bf16x8 a = *(const bf16x8*)(vt + (32 * mt + l32) * 64 + 16 * ks + 8 * hh);
                const bf16x8 b0 = *(const bf16x8*)(kt + (32 * nt0 + l32) * 64 + 16 * ks + 8 * hh);
                const bf16x8 b1 = *(const bf16x8*)(kt + (32 * nt0 + 32 + l32) * 64 + 16 * ks + 8 * hh);
                d0 = MFMA32(a, b0, d0); d1 = MFMA32(a, b1, d1);
            }
            bf16_t* o = KV + (size_t)u * 16384;
#pragma unroll
            for (int r = 0; r < 16; ++r) { const int e = 32 * mt + (r & 3) + 8 * (r >> 2) + 4 * hh; o[e * 128 + 32 * nt0 + l32] = f2bf(d0[r]); o[e * 128 + 32 * nt0 + 32 + l32] = f2bf(d1[r]); }
        } else {
            const int bh = u - 4096, hd = bh & 3;
            const bf16_t* vt = B + B_VTS + (size_t)bh * 4096; const bf16_t* kt = B + B_KTS + (size_t)bh * 4096;
#pragma unroll
            for (int ks = 0; ks < 2; ++ks) {
                const bf16x8 a = *(const bf16x8*)(vt + (32 * mt + l32) * 32 + 16 * ks + 8 * hh);
                const bf16x8 b0 = *(const bf16x8*)(kt + (32 * nt0 + l32) * 32 + 16 * ks + 8 * hh);
                const bf16x8 b1 = *(const bf16x8*)(kt + (32 * nt0 + 32 + l32) * 32 + 16 * ks + 8 * hh);
                d0 = MFMA32(a, b0, d0); d1 = MFMA32(a, b1, d1);
            }
            const float g32 = ex2(ret_lg2(hd) * 32.f);
            const float* s0 = P.in[2] + (size_t)bh * 16384; float* so = P.out + O_RSS + (size_t)bh * 16384; bf16_t* sb = KVS + (size_t)bh * 16384;
#pragma unroll
            for (int r = 0; r < 16; ++r) {
                const int e = 32 * mt + (r & 3) + 8 * (r >> 2) + 4 * hh;
#pragma unroll
                for (int q = 0; q < 2; ++q) {
                    const int dp = 32 * nt0 + 32 * q + l32, d = (dp >> 1) + 64 * (dp & 1);
                    const float s = s0[d * 128 + e];
                    so[d * 128 + e] = s * g32 + (q ? d1[r] : d0[r]);
                    sb[e * 128 + dp] = f2bf(s);
                }
            }
        }
    }
}
__device__ __forceinline__ void ret_passB(const Params& P, int tid) {
    unsigned* KV = (unsigned*)(P.ws + WS_C);
    for (int i = blockIdx.x * 512 + tid; i < 32 * 8192; i += gridDim.x * 512) {
        const int bh = i >> 13, idx = i & 8191;
        const float dec = ex2(ret_lg2(bh & 3) * 64.f);
        unsigned* p = KV + (size_t)bh * 128 * 8192 + idx;
        float s0 = 0.f, s1 = 0.f;
        for (int n0 = 0; n0 < 128; n0 += 32) {
            unsigned v[32];
#pragma unroll
            for (int k = 0; k < 32; ++k) v[k] = p[(size_t)(n0 + k) * 8192];
#pragma unroll
            for (int k = 0; k < 32; ++k) { p[(size_t)(n0 + k) * 8192] = pk2(s0, s1); s0 = s0 * dec + bflo(v[k]); s1 = s1 * dec + bfhi(v[k]); }
        }
        const int e = idx >> 6, dp = (idx & 63) * 2;
        float* so = P.out + O_RSP + (size_t)bh * 16384;
        so[(dp >> 1) * 128 + e] = s0;
        so[((dp >> 1) + 64) * 128 + e] = s1;
    }
}
template <int L> __device__ __forceinline__ void ret_unitC(const Params& P, LAS float* red, int bh, int n, int wid, int lane) {
    const bf16_t* B = (const bf16_t*)(P.ws + WS_B);
    const int l32 = lane & 31, hh = lane >> 5, hd = bh & 3, b = bh >> 2;
    const int et = wid >> 1, it = wid & 1;
    const bool act = (L == 64) || (it == 0);
    const int row0 = (L == 64) ? (b * T + n * 64) : (RP + b * 32);
    const bf16_t* sbef = (L == 64) ? (const bf16_t*)(P.ws + WS_C) + (size_t)(bh * 128 + n) * 16384 : (const bf16_t*)(P.ws + WS_KVS) + (size_t)bh * 16384;
    const bf16_t* vt = (L == 64) ? B + B_VT + (size_t)(bh * 128 + n) * 8192 : B + B_VTS + (size_t)bh * 4096;
    const float lg2 = ret_lg2(hd);
    const int i = 32 * it + l32;
    f32x16 acc = {};
    float s1 = 0.f, s2 = 0.f;
    if (act) {
        bf16x8 qf[8];
#pragma unroll
        for (int ks = 0; ks < 8; ++ks) qf[ks] = *(const bf16x8*)(B + B_RQ + (size_t)(row0 + i) * 512 + hd * 128 + 16 * ks + 8 * hh);
#pragma unroll
        for (int ks = 0; ks < 8; ++ks) { const bf16x8 a = *(const bf16x8*)(sbef + (32 * et + l32) * 128 + 16 * ks + 8 * hh); acc = MFMA32(a, qf[ks], acc); }
        acc = acc * ex2(lg2 * (float)(i + 1));
#pragma unroll
        for (int jt = 0; jt < L / 32; ++jt) {
            f32x16 sc = {};
#pragma unroll
            for (int ks = 0; ks < 8; ++ks) { const bf16x8 a = *(const bf16x8*)(B + B_RK + (size_t)(row0 + 32 * jt + l32) * 512 + hd * 128 + 16 * ks + 8 * hh); sc = MFMA32(a, qf[ks], sc); }
#pragma unroll
            for (int r = 0; r < 16; ++r) { const int j = 32 * jt + (r & 3) + 8 * (r >> 2) + 4 * hh; const int dd = i > j ? i - j : j - i; sc[r] = sc[r] * ex2(lg2 * (float)dd); }
#pragma unroll
            for (int s = 0; s < 2; ++s) {
                u32x4 pw; pw.x = pk2(sc[8 * s], sc[8 * s + 1]); pw.y = pk2(sc[8 * s + 2], sc[8 * s + 3]); pw.z = pk2(sc[8 * s + 4], sc[8 * s + 5]); pw.w = pk2(sc[8 * s + 6], sc[8 * s + 7]);
                const bf16x8 pf = __builtin_bit_cast(bf16x8, pw);
                const bf16_t* vb = vt + (32 * et + l32) * L + 32 * jt + 16 * s + 4 * hh;
                const u32x2 lo = *(const u32x2*)vb, hi = *(const u32x2*)(vb + 8);
                const u32x4 vw = {lo.x, lo.y, hi.x, hi.y};
                acc = MFMA32(__builtin_bit_cast(bf16x8, vw), pf, acc);
            }
        }
#pragma unroll
        for (int r = 0; r < 16; ++r) { s1 += acc[r]; s2 += acc[r] * acc[r]; }
        s1 += __shfl_xor(s1, 32); s2 += __shfl_xor(s2, 32);
        if (hh == 0) { red[et * 64 + i] = s1; red[256 + et * 64 + i] = s2; }
    }
    __syncthreads();
    if (act) {
        const float t1 = red[i] + red[64 + i] + red[128 + i] + red[192 + i];
        const float t2 = red[256 + i] + red[320 + i] + red[384 + i] + red[448 + i];
        const float mu = t1 * (1.f / 128.f), var = fmaxf(t2 * (1.f / 128.f) - mu * mu, 0.f), rstd = rsqrtf(var + EPS);
        const float* gw = P.in[14] + hd * 128;
        bf16_t* mixed = MIXED;
#pragma unroll
        for (int g = 0; g < 4; ++g) {
            const int e = 32 * et + 8 * g + 4 * hh;
            const f32x4 w4 = *(const f32x4*)(gw + e);
            const u32x2 gt = *(const u32x2*)(B + B_RG + (size_t)(row0 + i) * 512 + hd * 128 + e);
            f32x4 o;
            o.x = (acc[4 * g] - mu) * rstd * w4.x * bflo(gt.x); o.y = (acc[4 * g + 1] - mu) * rstd * w4.y * bfhi(gt.x);
            o.z = (acc[4 * g + 2] - mu) * rstd * w4.z * bflo(gt.y); o.w = (acc[4 * g + 3] - mu) * rstd * w4.w * bfhi(gt.y);
            u32x2 w; w.x = pk2(o.x, o.y); w.y = pk2(o.z, o.w);
            *(u32x2*)(mixed + (size_t)(row0 + i) * 1024 + hd * 128 + e) = w;
        }
    }
    __syncthreads();
}

struct FoxUnit { const bf16_t* Q; const bf16_t* K; const bf16_t* VT; const float* c2; bf16_t* O; int vtp, qpos0, nq, ntiles, Tk; };
constexpr int FOX_BUF = 18432, FOX_VOFF = 9216, FOX_COFF = 17920;
__device__ __forceinline__ void fox_unit(LAS unsigned char* lds, const FoxUnit U, int tid, int wid, int lane) {
    const int l32 = lane & 31, hh = lane >> 5;
    const int wrow = wid * 64;
    const bool active = wrow < U.nq;
    const bool act1 = wrow + 32 < U.nq;
    bf16x8 qf[2][4];
#pragma unroll
    for (int qt = 0; qt < 2; ++qt)
#pragma unroll
        for (int s = 0; s < 4; ++s) qf[qt][s] = (qt == 0 ? active : act1) ? *(const bf16x8*)(U.Q + (size_t)(wrow + 32 * qt + l32) * 512 + 16 * s + 8 * hh) : (bf16x8){0, 0, 0, 0, 0, 0, 0, 0};
    const int wq_lo = U.qpos0 + wrow, wq_hi = wq_lo + (act1 ? 63 : 31);
    float mrun[2] = {-INFINITY, -INFINITY}, lrun[2] = {0.f, 0.f};
    f32x16 o0[2] = {{}, {}}, o1[2] = {{}, {}};
    const int srow = tid >> 3, sch = tid & 7;
    u32x4 kr, vr; float cr = 0.f;
#define FOX_LOAD(t) do { int key_ = (t) * 64 + srow; key_ = key_ < U.Tk ? key_ : U.Tk - 1; kr = *(const u32x4*)(U.K + (size_t)key_ * 512 + sch * 8); \
        vr = *(const u32x4*)(U.VT + (size_t)srow * U.vtp + (t) * 64 + sch * 8); \
        if (tid < 64) { int kc_ = (t) * 64 + tid; kc_ = kc_ < U.Tk ? kc_ : U.Tk - 1; cr = U.c2[kc_]; } } while (0)
#define FOX_STORE(bi) do { LAS unsigned char* kb_ = lds + (bi) * FOX_BUF; *(LAS u32x4*)(kb_ + srow * 144 + sch * 16) = kr; \
        *(LAS u32x2*)(kb_ + FOX_VOFF + srow * 136 + sch * 16) = (u32x2){vr.x, vr.y}; *(LAS u32x2*)(kb_ + FOX_VOFF + srow * 136 + sch * 16 + 8) = (u32x2){vr.z, vr.w}; \
        if (tid < 64) *(LAS float*)(kb_ + FOX_COFF + tid * 4) = -cr; } while (0)
    FOX_LOAD(0); FOX_STORE(0);
    __syncthreads();
    for (int t = 0; t < U.ntiles; ++t) {
        const bool more = t + 1 < U.ntiles;
        if (more) FOX_LOAD(t + 1);
        if (active && t * 64 <= wq_hi) {
            LAS unsigned char* kb = lds + (t & 1) * FOX_BUF;
            bf16x8 pf[2][4];
#pragma unroll
            for (int qt = 0; qt < 2; ++qt) {
                __builtin_amdgcn_sched_barrier(0);
                f32x16 p0, p1;
#pragma unroll
                for (int g = 0; g < 4; ++g) {
                    const f32x4 c0 = *(LAS f32x4*)(kb + FOX_COFF + (8 * g + 4 * hh) * 4), c1 = *(LAS f32x4*)(kb + FOX_COFF + (32 + 8 * g + 4 * hh) * 4);
                    p0[4 * g] = c0.x; p0[4 * g + 1] = c0.y; p0[4 * g + 2] = c0.z; p0[4 * g + 3] = c0.w;
                    p1[4 * g] = c1.x; p1[4 * g + 1] = c1.y; p1[4 * g + 2] = c1.z; p1[4 * g + 3] = c1.w;
                }
#pragma unroll
                for (int s = 0; s < 4; ++s) {
                    const bf16x8 a0 = *(LAS bf16x8*)(kb + l32 * 144 + (2 * s + hh) * 16), a1 = *(LAS bf16x8*)(kb + (32 + l32) * 144 + (2 * s + hh) * 16);
                    p0 = MFMA32(a0, qf[qt][s], p0); p1 = MFMA32(a1, qf[qt][s], p1);
                }
                const int qpos = wq_lo + 32 * qt + l32;
                if (t * 64 + 63 > wq_lo + 32 * qt) {
#pragma unroll
                    for (int r = 0; r < 16; ++r) { const int key = t * 64 + (r & 3) + 8 * (r >> 2) + 4 * hh; if (key > qpos) p0[r] = -INFINITY; if (key + 32 > qpos) p1[r] = -INFINITY; }
                }
                float mx = fmaxf(p0[0], p1[0]);
#pragma unroll
                for (int r = 1; r < 16; ++r) mx = fmaxf(mx, fmaxf(p0[r], p1[r]));
                mx = fmaxf(mx, __shfl_xor(mx, 32));
                const float mn = fmaxf(mrun[qt], mx), alpha = ex2(mrun[qt] - mn); mrun[qt] = mn;
                float rs = 0.f;
#pragma unroll
                for (int r = 0; r < 16; ++r) { p0[r] = ex2(p0[r] - mn); p1[r] = ex2(p1[r] - mn); rs += p0[r] + p1[r]; }
                lrun[qt] = lrun[qt] * alpha + rs; o0[qt] = o0[qt] * alpha; o1[qt] = o1[qt] * alpha;
#pragma unroll
                for (int s = 0; s < 4; ++s) {
                    u32x4 pw;
                    if (s < 2) { pw.x = pk2(p0[8 * s], p0[8 * s + 1]); pw.y = pk2(p0[8 * s + 2], p0[8 * s + 3]); pw.z = pk2(p0[8 * s + 4], p0[8 * s + 5]); pw.w = pk2(p0[8 * s + 6], p0[8 * s + 7]); }
                    else { const int q = 8 * (s - 2); pw.x = pk2(p1[q], p1[q + 1]); pw.y = pk2(p1[q + 2], p1[q + 3]); pw.z = pk2(p1[q + 4], p1[q + 5]); pw.w = pk2(p1[q + 6], p1[q + 7]); }
                    pf[qt][s] = __builtin_bit_cast(bf16x8, pw);
                }
            }
#pragma unroll
            for (int s = 0; s < 4; ++s) {
                LAS unsigned char* vb = kb + FOX_VOFF + l32 * 136 + (16 * s + 4 * hh) * 2;
                const u32x2 a = *(LAS u32x2*)vb, b = *(LAS u32x2*)(vb + 16), c = *(LAS u32x2*)(vb + 32 * 136), d = *(LAS u32x2*)(vb + 32 * 136 + 16);
                const u32x4 v0 = {a.x, a.y, b.x, b.y}, v1 = {c.x, c.y, d.x, d.y};
#pragma unroll
                for (int qt = 0; qt < 2; ++qt) { o0[qt] = MFMA32(__builtin_bit_cast(bf16x8, v0), pf[qt][s], o0[qt]); o1[qt] = MFMA32(__builtin_bit_cast(bf16x8, v1), pf[qt][s], o1[qt]); }
            }
        }
        if (more) FOX_STORE((t + 1) & 1);
        __syncthreads();
    }
#undef FOX_LOAD
#undef FOX_STORE
#pragma unroll
    for (int qt = 0; qt < 2; ++qt) {
        if (qt == 0 ? active : act1) {
            const float inv = 1.f / (lrun[qt] + __shfl_xor(lrun[qt], 32));
            bf16_t* op = U.O + (size_t)(wrow + 32 * qt + l32) * 1024 + 4 * hh;
#pragma unroll
            for (int g = 0; g < 4; ++g) {
                u32x2 w; w.x = pk2(o0[qt][4 * g] * inv, o0[qt][4 * g + 1] * inv); w.y = pk2(o0[qt][4 * g + 2] * inv, o0[qt][4 * g + 3] * inv); *(u32x2*)(op + 8 * g) = w;
                w.x = pk2(o1[qt][4 * g] * inv, o1[qt][4 * g + 1] * inv); w.y = pk2(o1[qt][4 * g + 2] * inv, o1[qt][4 * g + 3] * inv); *(u32x2*)(op + 32 + 8 * g) = w;
            }
        }
    }
}
__device__ __forceinline__ void fox_phase(const Params& P, LAS unsigned char* lds, int tid, int wid, int lane) {
    const bf16_t* B = (const bf16_t*)(P.ws + WS_B);
    bf16_t* mixed = MIXED;
    for (int it2 = 2 * blockIdx.x; it2 < 1024 + 128; it2 += (it2 < 1024) ? (((it2 & 1) == 0) ? 1 : 2 * (int)gridDim.x - 1) : 2 * (int)gridDim.x) {
        FoxUnit U;
        if (it2 < 1024) {
            const int it = it2 >> 1, k = it2 & 1;
            const int bh = it >> 3, pi = it & 7, b = bh >> 3, hd = bh & 7;
            const int qb = k ? 15 - pi : pi;
            U.Q = B + B_FQ + (size_t)(b * T + qb * 512) * 512 + hd * 64; U.K = B + B_FK + (size_t)b * T * 512 + hd * 64;
            U.VT = B + B_FVT + (size_t)(b * 512 + hd * 64) * T; U.c2 = (const float*)(P.ws + WS_C2P) + (size_t)bh * T;
            U.O = mixed + (size_t)(b * T + qb * 512) * 1024 + 512 + hd * 64; U.vtp = T; U.qpos0 = qb * 512; U.nq = 512; U.ntiles = 8 * (qb + 1); U.Tk = T;
        } else {
            const int bh = (it2 - 1024) >> 1;
            const int b = bh >> 3, hd = bh & 7;
            U.Q = B + B_FQ + (size_t)(RP + b * 32) * 512 + hd * 64; U.K = (const bf16_t*)(P.ws + WS_FKS) + (size_t)b * TKS * 512 + hd * 64;
            U.VT = (const bf16_t*)(P.ws + WS_FVTS) + (size_t)(b * 512 + hd * 64) * TKS; U.c2 = (const float*)(P.ws + WS_C2S) + (size_t)bh * TKS;
            U.O = mixed + (size_t)(RP + b * 32) * 1024 + 512 + hd * 64; U.vtp = TKS; U.qpos0 = PAST; U.nq = 32; U.ntiles = 65; U.Tk = TKS;
        }
        int tid_ = tid; asm volatile("" : "+v"(tid_));
        fox_unit(lds, U, tid_, wid, tid_ & 63);
    }
}

constexpr int XA_BUF = 16896;
__device__ __forceinline__ void xattn_unit(LAS unsigned char* lds, const bf16_t* Q, const bf16_t* Kb, const bf16_t* VTb, bf16_t* O, int nwaves, int tid, int wid, int lane) {
    const int l32 = lane & 31, hh = lane >> 5;
    const bool active = wid < nwaves;
    bf16x8 qf[16];
#pragma unroll
    for (int s = 0; s < 16; ++s) qf[s] = active ? *(const bf16x8*)(Q + (size_t)(wid * 32 + l32) * 1024 + 16 * s + 8 * hh) : (bf16x8){0, 0, 0, 0, 0, 0, 0, 0};
    f32x16 S[4];
    bf16x8 pf[16];
    float m1 = 0.f, l1 = 0.f, a1 = 0.f, a2 = 0.f;
    u32x4 r0, r1;
    const int i0 = tid, i1 = tid + 512;
    const bf16_t* g0 = Kb + (size_t)(i0 >> 5) * 1024 + (i0 & 31) * 8; const bf16_t* g1 = Kb + (size_t)(i1 >> 5) * 1024 + (i1 & 31) * 8;
    const bf16_t* h0 = VTb + (size_t)(i0 >> 5) * 256 + (i0 & 31) * 8; const bf16_t* h1 = VTb + (size_t)(i1 >> 5) * 256 + (i1 & 31) * 8;
#define XA_LOAD(tt) do { if ((tt) < 8) { r0 = *(const u32x4*)g0; r1 = *(const u32x4*)g1; g0 += 32 * 1024; g1 += 32 * 1024; asm volatile("" : "+v"(g0), "+v"(g1)); } \
        else { r0 = *(const u32x4*)h0; r1 = *(const u32x4*)h1; h0 += 32 * 256; h1 += 32 * 256; asm volatile("" : "+v"(h0), "+v"(h1)); } } while (0)
#define XA_STORE(bi) do { LAS unsigned char* b_ = lds + (bi) * XA_BUF; *(LAS u32x4*)(b_ + (i0 >> 5) * 528 + (i0 & 31) * 16) = r0; *(LAS u32x4*)(b_ + (i1 >> 5) * 528 + (i1 & 31) * 16) = r1; } while (0)
#define XA_HALF(hf, mm, ll) do { float mx_ = S[0][0]; \
        _Pragma("unroll") for (int k = 0; k < 4; ++k) _Pragma("unroll") for (int r = 0; r < 16; ++r) mx_ = fmaxf(mx_, S[k][r]); \
        mx_ = fmaxf(mx_, __shfl_xor(mx_, 32)); float l_ = 0.f; \
        _Pragma("unroll") for (int k = 0; k < 4; ++k) { \
            _Pragma("unroll") for (int r = 0; r < 16; ++r) { S[k][r] = ex2(S[k][r] - mx_); l_ += S[k][r]; } \
            _Pragma("unroll") for (int s = 0; s < 2; ++s) { u32x4 pw; pw.x = pk2(S[k][8 * s], S[k][8 * s + 1]); pw.y = pk2(S[k][8 * s + 2], S[k][8 * s + 3]); pw.z = pk2(S[k][8 * s + 4], S[k][8 * s + 5]); pw.w = pk2(S[k][8 * s + 6], S[k][8 * s + 7]); \
                pf[8 * (hf) + 2 * k + s] = __builtin_bit_cast(bf16x8, pw); } } \
        mm = mx_; ll = l_ + __shfl_xor(l_, 32); } while (0)
    XA_LOAD(0); XA_STORE(0);
    __syncthreads();
#pragma unroll
    for (int tt = 0; tt < 16; ++tt) {
        if (tt + 1 < 16) XA_LOAD(tt + 1);
        LAS unsigned char* buf = lds + (tt & 1) * XA_BUF;
        if (active) {
            if (tt < 8) {
                f32x16 s = {};
#pragma unroll
                for (int k = 0; k < 16; ++k) { const bf16x8 a = *(LAS bf16x8*)(buf + l32 * 528 + (2 * k + hh) * 16); s = MFMA32(a, qf[k], s); }
                S[tt & 3] = s;
                if (tt == 3) XA_HALF(0, m1, l1);
                if (tt == 7) {
                    float m2, l2; XA_HALF(1, m2, l2);
                    const float mm = fmaxf(m1, m2); a1 = ex2(m1 - mm); a2 = ex2(m2 - mm);
                    const float inv = 1.f / (a1 * l1 + a2 * l2); a1 *= inv; a2 *= inv;
                }
            } else {
                f32x16 o1 = {}, o2 = {};
#pragma unroll
                for (int k = 0; k < 16; ++k) {
                    LAS unsigned char* vb = buf + l32 * 528 + (16 * k + 4 * hh) * 2;
                    const u32x2 a = *(LAS u32x2*)vb, b = *(LAS u32x2*)(vb + 16);
                    const u32x4 vw = {a.x, a.y, b.x, b.y};
                    if (k < 8) o1 = MFMA32(__builtin_bit_cast(bf16x8, vw), pf[k], o1); else o2 = MFMA32(__builtin_bit_cast(bf16x8, vw), pf[k], o2);
                }
                bf16_t* op = O + (size_t)(wid * 32 + l32) * 1024 + 32 * (tt - 8) + 4 * hh;
#pragma unroll
                for (int g = 0; g < 4; ++g) { u32x2 w; w.x = pk2(o1[4 * g] * a1 + o2[4 * g] * a2, o1[4 * g + 1] * a1 + o2[4 * g + 1] * a2); w.y = pk2(o1[4 * g + 2] * a1 + o2[4 * g + 2] * a2, o1[4 * g + 3] * a1 + o2[4 * g + 3] * a2); *(u32x2*)(op + 8 * g) = w; }
            }
        }
        if (tt + 1 < 16) XA_STORE((tt + 1) & 1);
        __syncthreads();
    }
#undef XA_HALF
#undef XA_LOAD
#undef XA_STORE
}
__device__ __forceinline__ void xattn_phase(const Params& P, LAS unsigned char* lds, int layer, int tid, int wid, int lane) {
    const bf16_t* XQ = (const bf16_t*)(P.ws + WS_B);
    bf16_t* XO = (bf16_t*)(P.ws + WS_B) + B_X2;
    const bf16_t* MK = (const bf16_t*)(P.ws + WS_MEMK); const bf16_t* MVT = (const bf16_t*)(P.ws + WS_MEMVT);
    for (int it = blockIdx.x; it < 1024 + 32; it += gridDim.x) {
        int row0, set, hd, nw;
        if (it < 1024) { const int pm = it >> 2; hd = it & 3; row0 = pm * 256; set = layer * 16 + (pm >> 5); nw = 8; }
        else { const int q = it - 1024, b = q >> 2; hd = q & 3; row0 = RP + b * 32; set = layer * 16 + 8 + b; nw = 1; }
        xattn_unit(lds, XQ + (size_t)row0 * 1024 + hd * 256, MK + (size_t)set * 262144 + hd * 256, MVT + ((size_t)set * 1024 + hd * 256) * 256, XO + (size_t)row0 * 1024 + hd * 256, nw, tid, wid, lane);
    }
}

__device__ __forceinline__ void s5_run(LAS unsigned char* wl, const bf16_t* U, bf16_t* Y, int row0, int L, int g, f32x2 a, float& xr, float& xi, bool outp,
                                       const bf16_t* SB5, const bf16_t* SC5, const float* s5d, int lane) {
    const int l32 = lane & 31, hh = lane >> 5, l16 = lane & 15, q4 = lane >> 4;
    bf16x8 bfr[4], cfr[4];
#pragma unroll
    for (int k = 0; k < 4; ++k) { bfr[k] = *(const bf16x8*)(SB5 + ((size_t)(g * 4 + k) * 64 + lane) * 8); cfr[k] = *(const bf16x8*)(SC5 + ((size_t)(g * 4 + k) * 64 + lane) * 8); }
    const f32x4 dv = *(const f32x4*)(s5d + g * 16 + 4 * q4);
    for (int sc0 = 0; sc0 < L / 32; sc0 += 4) {
      bf16x8 ufa[4];
#pragma unroll
      for (int q = 0; q < 4; ++q) ufa[q] = (sc0 + q < L / 32) ? *(const bf16x8*)(U + (size_t)(row0 + (sc0 + q) * 32 + l32) * 1024 + g * 16 + 8 * hh) : (bf16x8){0, 0, 0, 0, 0, 0, 0, 0};
#pragma unroll
      for (int q = 0; q < 4; ++q) {
        const int sc = sc0 + q;
        if (sc >= L / 32) break;
        const int r0 = row0 + sc * 32;
        const bf16x8 uf = ufa[q];
        const f32x16 z = {};
        const f32x16 d0 = MFMA32(uf, bfr[0], z), d1 = MFMA32(uf, bfr[1], z), d2 = MFMA32(uf, bfr[2], z), d3 = MFMA32(uf, bfr[3], z);
#pragma unroll
        for (int r = 0; r < 16; ++r) {
            const int tok = (r & 3) + 8 * (r >> 2) + 4 * hh;
            *(LAS f32x2*)(wl + tok * 528 + l32 * 8) = (f32x2){d0[r], d2[r]};
            *(LAS f32x2*)(wl + tok * 528 + (32 + l32) * 8) = (f32x2){d1[r], d3[r]};
        }
        LDSBAR();
#pragma unroll
        for (int t0 = 0; t0 < 32; t0 += 8) {
            f32x2 bu[8]; float xo_[8];
#pragma unroll
            for (int k = 0; k < 8; ++k) bu[k] = *(LAS f32x2*)(wl + (t0 + k) * 528 + lane * 8);
            LDSBAR();
#pragma unroll
            for (int k = 0; k < 8; ++k) {
                const float nr = a.x * xr - a.y * xi + bu[k].x, ni = a.x * xi + a.y * xr + bu[k].y;
                xr = nr; xi = ni; xo_[k] = __uint_as_float(pk2(xr, xi));
            }
            if (outp) {
#pragma unroll
                for (int k = 0; k < 8; ++k) *(LAS float*)(wl + (t0 + k) * 528 + lane * 4) = xo_[k];
            }
        }
        LDSBAR();
        if (outp) {
#pragma unroll
            for (int tb = 0; tb < 2; ++tb) {
                f32x4 acc = {0.f, 0.f, 0.f, 0.f};
#pragma unroll
                for (int ks = 0; ks < 4; ++ks) { const bf16x8 xf = *(LAS bf16x8*)(wl + (16 * tb + l16) * 528 + (32 * ks + 8 * q4) * 2); acc = MFMA16(cfr[ks], xf, acc); }
                const size_t off = (size_t)(r0 + 16 * tb + l16) * 1024 + g * 16 + 4 * q4;
                const u32x2 uu = *(const u32x2*)(U + off);
                f32x4 y; y.x = acc.x + dv.x * bflo(uu.x); y.y = acc.y + dv.y * bfhi(uu.x); y.z = acc.z + dv.z * bflo(uu.y); y.w = acc.w + dv.w * bfhi(uu.y);
                u32x2 w; w.x = pk2(y.x, y.y); w.y = pk2(y.z, y.w);
                *(u32x2*)(Y + off) = w;
            }
        }
        LDSBAR();
      }
    }
}
constexpr int S5_NSEG = 16, S5_LSEG = 512;
__device__ __forceinline__ void s5_phase(const Params& P, LAS unsigned char* lds, int pass, int wid, int lane) {
    const bf16_t* U = (const bf16_t*)(P.ws + WS_B);
    bf16_t* Y = (bf16_t*)(P.ws + WS_B) + B_X2;
    const f32x2* S5A = (const f32x2*)(P.ws + WS_S5T); const f32x2* S5AL = S5A + 4096;
    const bf16_t* SB5 = (const bf16_t*)(P.ws + WS_S5T + 65536); const bf16_t* SC5 = SB5 + 131072;
    f32x2* LE = (f32x2*)(P.ws + WS_LE);
    LAS unsigned char* wl = lds + wid * 16896;
    const int nunits = (pass == 1) ? 8 * (S5_NSEG - 1) * 8 : 8 * S5_NSEG * 8 + 64;
    for (int it = blockIdx.x; it < nunits; it += gridDim.x) {
        if (pass == 1) {
            const int g8 = it & 7, seg = (it >> 3) % (S5_NSEG - 1), b = (it >> 3) / (S5_NSEG - 1), g = g8 * 8 + wid;
            float xr = 0.f, xi = 0.f;
            s5_run(wl, U, Y, b * T + seg * S5_LSEG, S5_LSEG, g, S5A[g * 64 + lane], xr, xi, false, SB5, SC5, P.in[24], lane);
            LE[((size_t)(b * S5_NSEG + seg) * 64 + g) * 64 + lane] = (f32x2){xr, xi};
        } else if (it < 8 * S5_NSEG * 8) {
            const int g8 = it & 7, seg = (it >> 3) & (S5_NSEG - 1), b = it >> 7, g = g8 * 8 + wid;
            const f32x2 aL = S5AL[g * 64 + lane];
            float xr = 0.f, xi = 0.f;
            for (int s = 0; s < seg; ++s) { const f32x2 le = LE[((size_t)(b * S5_NSEG + s) * 64 + g) * 64 + lane]; const float nr = aL.x * xr - aL.y * xi + le.x, ni = aL.x * xi + aL.y * xr + le.y; xr = nr; xi = ni; }
            s5_run(wl, U, Y, b * T + seg * S5_LSEG, S5_LSEG, g, S5A[g * 64 + lane], xr, xi, true, SB5, SC5, P.in[24], lane);
            if (seg == S5_NSEG - 1) { P.out[O_S5RP + (size_t)(b * 64 + g) * 64 + lane] = xr; P.out[O_S5IP + (size_t)(b * 64 + g) * 64 + lane] = xi; }
        } else {
            const int q = it - 8 * S5_NSEG * 8, g8 = q & 7, b = q >> 3, g = g8 * 8 + wid;
            float xr = P.in[6][(size_t)(b * 64 + g) * 64 + lane], xi = P.in[7][(size_t)(b * 64 + g) * 64 + lane];
            s5_run(wl, U, Y, RP + b * 32, 32, g, S5A[g * 64 + lane], xr, xi, true, SB5, SC5, P.in[24], lane);
            P.out[O_S5RS + (size_t)(b * 64 + g) * 64 + lane] = xr; P.out[O_S5IS + (size_t)(b * 64 + g) * 64 + lane] = xi;
        }
    }
}

__device__ __forceinline__ void prologue(const Params& P, int tid, int wid, int lane) {
    const int gtid = blockIdx.x * 512 + tid, gsz = gridDim.x * 512;
    const int gw = blockIdx.x * 8 + wid, ngw = gridDim.x * 8;
    bf16_t* W = (bf16_t*)(P.ws + WS_W);
    wtrans(P.in[12], 1024, 3592, W + W_AB, 3840, 1, gtid, gsz, P.in[11]);
    wtrans(P.in[15], 1024, 1024, W + W_OUT, 1024, 0, gtid, gsz);
    wtrans(P.in[16], 1024, 1024, W + W_INC, 1024, 0, gtid, gsz, P.in[11] + 6144);
    wtrans(P.in[25], 1024, 2048, W + W_GLU, 2048, 2, gtid, gsz);
    for (int l = 0; l < 2; ++l) {
        wtrans(P.in[27] + (size_t)l * 1048576, 1024, 1024, W + W_XQ + (size_t)l * 1048576, 1024, 0, gtid, gsz, P.in[11] + l * 6144 + 2048);
        wtrans(P.in[28] + (size_t)l * 1048576, 1024, 1024, W + W_XKV + (size_t)l * 2097152, 1024, 0, gtid, gsz);
        wtrans(P.in[29] + (size_t)l * 1048576, 1024, 1024, W + W_XKV + (size_t)l * 2097152 + 1048576, 1024, 0, gtid, gsz);
        wtrans(P.in[30] + (size_t)l * 1048576, 1024, 1024, W + W_XO + (size_t)l * 1048576, 1024, 0, gtid, gsz);
        wtrans(P.in[31] + (size_t)l * 4194304, 1024, 4096, W + W_UP + (size_t)l * 4194304, 4096, 0, gtid, gsz, P.in[11] + l * 6144 + 4096);
        wtrans(P.in[32] + (size_t)l * 4194304, 4096, 1024, W + W_DN + (size_t)l * 4194304, 1024, 0, gtid, gsz);
    }
    {
        float* rope = (float*)(P.ws + WS_ROPE);
        for (int i = gtid; i < 8192 * 64; i += gsz) {
            const int pos = i >> 6, k = i & 63;
            const double inv = exp2(-(double)k * (13.287712379549449 / 64.0));
            const double ang = (double)pos * inv;
            rope[2 * i] = (float)cos(ang); rope[2 * i + 1] = (float)sin(ang);
        }
    }
    {
        f32x2* S5A = (f32x2*)(P.ws + WS_S5T); f32x2* S5AL = S5A + 4096;
        bf16_t* SB5 = (bf16_t*)(P.ws + WS_S5T + 65536); bf16_t* SC5 = SB5 + 131072;
        for (int i = gtid; i < 4096; i += gsz) {
            const int g = i >> 6, p = i & 63;
            const double lr = P.in[17][i], li = P.in[18][i], dt = exp((double)P.in[19][g]);
            const double mag = exp(lr * dt), ar = mag * cos(li * dt), ai = mag * sin(li * dt);
            S5A[i] = (f32x2){(float)ar, (float)ai};
            const double magL = exp(lr * dt * S5_LSEG);
            S5AL[i] = (f32x2){(float)(magL * cos(li * dt * S5_LSEG)), (float)(magL * sin(li * dt * S5_LSEG))};
            const double den = lr * lr + li * li, nre = ar - 1.0;
            const double fr = (nre * lr + ai * li) / den, fi = (ai * lr - nre * li) / den;
            const float* br = P.in[20] + (size_t)i * 16; const float* bi = P.in[21] + (size_t)i * 16;
#pragma unroll
            for (int part = 0; part < 2; ++part)
#pragma unroll
                for (int h2 = 0; h2 < 2; ++h2) {
                    float v[8];
#pragma unroll
                    for (int k = 0; k < 8; ++k) { const int c = 8 * h2 + k; v[k] = part == 0 ? (float)(fr * br[c] - fi * bi[c]) : (float)(fr * bi[c] + fi * br[c]); }
                    u32x4 o; o.x = pk2(v[0], v[1]); o.y = pk2(v[2], v[3]); o.z = pk2(v[4], v[5]); o.w = pk2(v[6], v[7]);
                    const int kb = 2 * part + (p >> 5), ln = (p & 31) + 32 * h2;
                    *(u32x4*)(SB5 + ((size_t)(g * 4 + kb) * 64 + ln) * 8) = o;
                }
        }
        for (int i = gtid; i < 64 * 4 * 64; i += gsz) {
            const int ln = i & 63, ks = (i >> 6) & 3, g = i >> 8;
            const int c = ln & 15;
            float v[8];
#pragma unroll
            for (int k = 0; k < 8; ++k) { const int kidx = 32 * ks + 8 * (ln >> 4) + k, p = kidx >> 1; v[k] = (kidx & 1) ? -P.in[23][((size_t)g * 16 + c) * 64 + p] : P.in[22][((size_t)g * 16 + c) * 64 + p]; }
            u32x4 o; o.x = pk2(v[0], v[1]); o.y = pk2(v[2], v[3]); o.z = pk2(v[4], v[5]); o.w = pk2(v[6], v[7]);
            *(u32x4*)(SC5 + (size_t)i * 8) = o;
        }
    }
    {
        bf16_t* FKS = (bf16_t*)(P.ws + WS_FKS); bf16_t* FVTS = (bf16_t*)(P.ws + WS_FVTS);
        for (int i = gtid; i < 8 * PAST * 64; i += gsz) { const int b = i / (PAST * 64), r = i % (PAST * 64); cvt8(P.in[3] + (size_t)i * 8, FKS + (size_t)b * TKS * 512 + (size_t)r * 8); }
        for (int b = 0; b < 8; ++b) ttrans(P.in[4] + (size_t)b * PAST * 512, PAST, 512, FVTS + (size_t)b * 512 * TKS, TKS, gtid, gsz);
        bf16_t* MK = (bf16_t*)(P.ws + WS_MEMK); bf16_t* MVT = (bf16_t*)(P.ws + WS_MEMVT);
        for (int i = gtid; i < 2 * 8 * 32768; i += gsz) { const int lb = i >> 15, r = i & 32767, l = lb >> 3, b = lb & 7; cvt8(P.in[8] + (size_t)i * 8, MK + (size_t)(l * 16 + 8 + b) * 262144 + (size_t)r * 8); }
        for (int lb = 0; lb < 16; ++lb) { const int l = lb >> 3, b = lb & 7; ttrans(P.in[9] + (size_t)lb * 262144, 256, 1024, MVT + (size_t)(l * 16 + 8 + b) * 262144, 256, gtid, gsz); }
    }
    {
        bf16_t* H = (bf16_t*)(P.ws + WS_A); bf16_t* MEMN = (bf16_t*)(P.ws + WS_MEMN);
        for (int row = gw; row < R + 4096; row += ngw) {
            if (row < R) { const float* xr = row < RP ? P.in[0] + (size_t)row * 1024 : P.in[1] + (size_t)(row - RP) * 1024; cvt_row(xr, H + (size_t)row * 1024, (float*)(P.ws + WS_RS) + row, lane); }
            else { const int q = row - R, l = q >> 11, r = q & 2047; norm_row(P.in[10] + (size_t)r * 1024, P.in[26] + l * 1024, MEMN + (size_t)q * 1024, lane); }
        }
    }
}
__device__ __forceinline__ void cumsum_task(const Params& P, int q, int lane) {
    const bool samp = q >= 64; const int bh = q & 63, b = bh >> 3, hd = bh & 7;
    const int n = samp ? TKS : T;
    float* dst = samp ? (float*)(P.ws + WS_C2S) + (size_t)bh * TKS : (float*)(P.ws + WS_C2P) + (size_t)bh * T;
    float carry = 0.f;
    for (int base0 = 0; base0 < n; base0 += 512) {
        float vv[8];
#pragma unroll
        for (int k = 0; k < 8; ++k) {
            const int idx = base0 + 64 * k + lane; float v = 0.f;
            if (idx < n) {
                if (!samp) v = P.out[O_LFP + ((size_t)b * T + idx) * 8 + hd];
                else v = idx < PAST ? P.in[5][((size_t)b * PAST + idx) * 8 + hd] : P.out[O_LFS + ((size_t)b * 32 + idx - PAST) * 8 + hd];
            }
            vv[k] = v;
        }
#pragma unroll
        for (int k = 0; k < 8; ++k) {
            const int idx = base0 + 64 * k + lane; float v = vv[k];
#pragma unroll
            for (int o = 1; o < 64; o <<= 1) { const float t = __shfl_up(v, o); if (lane >= o) v += t; }
            if (idx < n) dst[idx] = (carry + v) * LOG2E;
            carry += __shfl(v, 63);
        }
    }
}

struct MemKVOrder {
    int G, c;
    __device__ bool next(int i, Unit& u) const { const long L = (long)i * G + c; if (L >= 128) return false; const int layer = (int)L >> 6, r = (int)L & 63; u.pm = layer * 8 + (r & 7); u.pn = layer * 8 + (r >> 3); return true; }
    __device__ __forceinline__ void a_ready(const Unit&) const {}
    __device__ __forceinline__ void done(const Unit&) const {}
};
template <class Epi> __device__ __forceinline__ void run_gemm(LAS unsigned char* lds, const bf16_t* A, const bf16_t* Bt, int M, int N, int K, const Epi& E) {
    pg8::Gemm g{A, Bt, M, N, K}; pg8::StaticOrder S; S.init(M, N, (int)gridDim.x, (int)blockIdx.x);
#ifndef GEMM_REP
#define GEMM_REP 1
#endif
#pragma unroll 1
    for (int rep_ = 0; rep_ < GEMM_REP; ++rep_)
    pg8::gemm_phase<Epi, pg8::StaticOrder, true, true>(lds, g, S, E);
}

#define XB_TMO      128
#define XB_XCNT(j)  (256  + 64 * (j))
#define XB_XSUB(j)  (1280 + 64 * (j))
#define XB_XGEN(j)  (2304 + 64 * (j))
#define XB_TOP      3328
#define XB_TOPGEN   3392
#define XCD_BAR_WORDS 3456
#define XB_SPIN_CAP (1u << 18)

__device__ __forceinline__ unsigned xb_ld(unsigned* p)              { return __hip_atomic_load(p, __ATOMIC_RELAXED, __HIP_MEMORY_SCOPE_AGENT); }
__device__ __forceinline__ unsigned xb_add(unsigned* p, unsigned v) { return __hip_atomic_fetch_add(p, v, __ATOMIC_RELAXED, __HIP_MEMORY_SCOPE_AGENT); }
__device__ __forceinline__ unsigned xb_xcc_id() { return (unsigned)__builtin_amdgcn_s_getreg((3 << 11) | 20) & 0xFu; }
#define XB_SPIN(cond, bar) do { unsigned _sp = 0; while (cond) { __builtin_amdgcn_s_sleep(1); \
    if ((++_sp & 255u) == 0u) { if (xb_ld(&(bar)[XB_TMO])) break; if (_sp > XB_SPIN_CAP) { atomicAdd(&(bar)[XB_TMO], 1u); break; } } } } while (0)

struct XcdBarrier {
    unsigned* bar; unsigned x;
    volatile LAS unsigned* st;
};

__device__ __forceinline__ XcdBarrier xcd_barrier_post(unsigned* bar, volatile LAS unsigned* st) {
    XcdBarrier b; b.bar = bar; b.x = xb_xcc_id(); b.st = st;
    if (threadIdx.x == 0) (void)xb_add(&bar[XB_XCNT(b.x)], 1u);
    return b;
}
__device__ __forceinline__ void xcd_barrier_complete(unsigned* bar, unsigned x, unsigned& nloc, unsigned& nx) {
    const unsigned G = gridDim.x * gridDim.y * gridDim.z;
    unsigned sum, cnt, mine, sp = 0u;
    for (;;) {
        sum = 0u; cnt = 0u; mine = 0u;
#pragma unroll
        for (unsigned j = 0; j < 16; ++j) { const unsigned c = xb_ld(&bar[XB_XCNT(j)]); sum += c; cnt += (c > 0u) ? 1u : 0u; mine = (j == x) ? c : mine; }
        if (sum == G) break;
        __builtin_amdgcn_s_sleep(1);
        if ((++sp & 255u) == 0u) { if (xb_ld(&bar[XB_TMO])) break; if (sp > XB_SPIN_CAP) { atomicAdd(&bar[XB_TMO], 1u); break; } }
    }
    nloc = mine > 0u ? mine : 1u; nx = cnt > 0u ? cnt : 1u;
}

__device__ __forceinline__ void xcd_barrier(const XcdBarrier& b) {
    asm volatile("s_waitcnt vmcnt(0)" ::: "memory");
    __syncthreads();
    if (threadIdx.x == 0) {
        unsigned* bar = b.bar;
        __builtin_amdgcn_s_waitcnt(0);
        unsigned nloc = b.st[0], nx = b.st[1];
        if (nloc == 0u) { xcd_barrier_complete(bar, b.x, nloc, nx); b.st[0] = nloc; b.st[1] = nx; }
        const unsigned old = xb_add(&bar[XB_XSUB(b.x)], 1u);
        const unsigned gen = old / nloc;
        if (old + 1u == (gen + 1u) * nloc) {
            __builtin_amdgcn_fence(__ATOMIC_RELEASE, "agent");
            asm volatile("s_waitcnt vmcnt(0)" ::: "memory");
            const unsigned og = xb_add(&bar[XB_TOP], 1u);
            const unsigned tg = og / nx;
            if (og + 1u == (tg + 1u) * nx) xb_add(&bar[XB_TOPGEN], 1u);
            else XB_SPIN(xb_ld(&bar[XB_TOPGEN]) == tg, bar);
            __builtin_amdgcn_fence(__ATOMIC_ACQUIRE, "agent");
            xb_add(&bar[XB_XGEN(b.x)], 1u);
            asm volatile("s_waitcnt vmcnt(0)" ::: "memory");
        } else {
            XB_SPIN(xb_ld(&bar[XB_XGEN(b.x)]) == gen, bar);
            __builtin_amdgcn_fence(__ATOMIC_ACQUIRE, "agent");
            asm volatile("s_waitcnt vmcnt(0)" ::: "memory");
        }
    }
    __syncthreads();
}

__device__ __forceinline__ void gbar(unsigned* ctr, int& gen) {
    asm volatile("s_waitcnt vmcnt(0) lgkmcnt(0)" ::: "memory");
    __syncthreads();
    if (threadIdx.x == 0) {
        __builtin_amdgcn_fence(__ATOMIC_RELEASE, "agent");
        asm volatile("s_waitcnt vmcnt(0)" ::: "memory");
        const unsigned target = (unsigned)(gen + 1) * gridDim.x;
        __hip_atomic_fetch_add(ctr, 1u, __ATOMIC_RELAXED, __HIP_MEMORY_SCOPE_AGENT);
        while (__hip_atomic_load(ctr, __ATOMIC_RELAXED, __HIP_MEMORY_SCOPE_AGENT) < target) __builtin_amdgcn_s_sleep(2);
        __builtin_amdgcn_fence(__ATOMIC_ACQUIRE, "agent");
        asm volatile("s_waitcnt vmcnt(0)" ::: "memory");
    }
    __syncthreads();
    ++gen;
}
__device__ __forceinline__ void mini_bar(unsigned* ctr, unsigned n) {
    asm volatile("s_waitcnt vmcnt(0) lgkmcnt(0)" ::: "memory");
    __syncthreads();
    if (threadIdx.x == 0) {
        __builtin_amdgcn_fence(__ATOMIC_RELEASE, "agent");
        asm volatile("s_waitcnt vmcnt(0)" ::: "memory");
        __hip_atomic_fetch_add(ctr, 1u, __ATOMIC_RELAXED, __HIP_MEMORY_SCOPE_AGENT);
        unsigned sp = 0u;
        while (__hip_atomic_load(ctr, __ATOMIC_RELAXED, __HIP_MEMORY_SCOPE_AGENT) < n) { __builtin_amdgcn_s_sleep(2); if (++sp > (1u << 20)) break; }
        __builtin_amdgcn_fence(__ATOMIC_ACQUIRE, "agent");
        asm volatile("s_waitcnt vmcnt(0)" ::: "memory");
    }
    __syncthreads();
}
#define MINI_CTR(i) ((unsigned*)(P.ws + 32768) + 64 * (i))
template <int IN, int OUT, class Epi>
__device__ __forceinline__ void tail_resnorm(LAS unsigned char* lds, const bf16_t* As, const bf16_t* Bt, int N, int K, const Epi& Es, unsigned* ctr,
                                             const bf16_t* mix, const float* xp, const float* xs, bf16_t* xb, const float* ga, float* rs, float* yout, int wid, int lane) {
    const int nblk = N >> 8;
    if ((int)blockIdx.x < nblk) {
        pg8::Gemm g{As, Bt, 256, N, K}; pg8::StaticOrder S; S.init(256, N, nblk, (int)blockIdx.x);
        pg8::gemm_phase<Epi, pg8::StaticOrder, true, true>(lds, g, S, Es);
        mini_bar(ctr, (unsigned)nblk);
        resnorm_rows<IN, OUT>(mix, xp, xs, xb, ga, rs, yout, RP, R, (int)blockIdx.x * 8 + wid, nblk * 8, lane);
    } else {
        resnorm_rows<IN, OUT>(mix, xp, xs, xb, ga, rs, yout, 0, RP, ((int)blockIdx.x - nblk) * 8 + wid, ((int)gridDim.x - nblk) * 8, lane);
    }
}
#define PHASE_BEGIN if (ph >= ph_lo && ph < ph_hi) { int tid = threadIdx.x; asm volatile("" : "+v"(tid)); const int lane = tid & 63, wid = __builtin_amdgcn_readfirstlane(tid >> 6); const int gw = blockIdx.x * 8 + wid, ngw = gridDim.x * 8; (void)lane; (void)gw; (void)ngw;
#define PHASE_END   if (ph + 1 < ph_hi) { if (ph == 0) { grid.sync(); if (threadIdx.x == 0) (void)xb_add(&xbar.bar[XB_XCNT(xbar.x)], 1u); } else xcd_barrier(xbar); } } ++ph;
template <int layer> __device__ __forceinline__ void layer_phases(const Params& P, LAS unsigned char* lds, cg::grid_group& grid, int& ph, const XcdBarrier& xbar, int ph_lo, int ph_hi, bf16_t* W, bf16_t* A, bf16_t* B, bf16_t* C, float* xo, float* xo_s) {
        const float* nw = P.in[11] + layer * 6144;
        if constexpr (layer == 1) {
            PHASE_BEGIN { EpiPlain<0> E{B, 1024, 1.f, RSV}; run_gemm(lds, A, W + W_INC, R, 1024, 1024, E); } PHASE_END
            PHASE_BEGIN for (int rp_ = 0; rp_ < REP_S5; ++rp_) s5_phase(P, lds, 1, wid, lane); PHASE_END
            PHASE_BEGIN for (int rp_ = 0; rp_ < REP_S5; ++rp_) s5_phase(P, lds, 2, wid, lane); PHASE_END
            PHASE_BEGIN { EpiGlu E{C}; run_gemm(lds, B + B_X2, W + W_GLU, RP, 2048, 1024, E); } PHASE_END
            PHASE_BEGIN { EpiGlu Es{C + (size_t)RP * 1024}; tail_resnorm<1, 0>(lds, B + B_X2 + (size_t)RP * 1024, W + W_GLU, 2048, 1024, Es, MINI_CTR(3), C, nullptr, nullptr, A, nw + 1024, RSV, nullptr, wid, lane); } PHASE_END
        }
        PHASE_BEGIN { EpiPlain<0> E{B, 1024, 0.0625f * LOG2E, RSV}; run_gemm(lds, A, W + W_XQ + (size_t)layer * 1048576, R, 1024, 1024, E); } PHASE_END
        PHASE_BEGIN for (int rp_ = 0; rp_ < REP_XA; ++rp_) xattn_phase(P, lds, layer, tid, wid, lane); PHASE_END
        PHASE_BEGIN { EpiPlain<0> E{C, 1024, 1.f, nullptr}; run_gemm(lds, B + B_X2, W + W_XO + (size_t)layer * 1048576, RP, 1024, 1024, E); } PHASE_END
        PHASE_BEGIN { EpiPlain<0> Es{C + (size_t)RP * 1024, 1024, 1.f, nullptr}; tail_resnorm<1, 0>(lds, B + B_X2 + (size_t)RP * 1024, W + W_XO + (size_t)layer * 1048576, 1024, 1024, Es, MINI_CTR(1 + 3 * layer), C, nullptr, nullptr, A, nw + 3072, RSV, nullptr, wid, lane); } PHASE_END
        PHASE_BEGIN { EpiPlain<1> E{B, 4096, 1.f, RSV}; run_gemm(lds, A, W + W_UP + (size_t)layer * 4194304, R, 4096, 1024, E); } PHASE_END
        PHASE_BEGIN { EpiPlain<0> E{C, 1024, 1.f, nullptr}; run_gemm(lds, B, W + W_DN + (size_t)layer * 4194304, RP, 1024, 4096, E); } PHASE_END
        PHASE_BEGIN { EpiPlain<0> Es{C + (size_t)RP * 1024, 1024, 1.f, nullptr};
            if constexpr (layer == 0) tail_resnorm<1, 0>(lds, B + (size_t)RP * 4096, W + W_DN + (size_t)layer * 4194304, 1024, 4096, Es, MINI_CTR(2 + 3 * layer), C, nullptr, nullptr, A, nw + 5120, RSV, nullptr, wid, lane);
            else tail_resnorm<1, 1>(lds, B + (size_t)RP * 4096, W + W_DN + (size_t)layer * 4194304, 1024, 4096, Es, MINI_CTR(2 + 3 * layer), C, nullptr, nullptr, A, nw + 5120, nullptr, xo, wid, lane); } PHASE_END
    }
__global__ void __launch_bounds__(512) mega_fwd(Params P, int ph_lo, int ph_hi) {
    extern __shared__ __attribute__((aligned(16))) unsigned char lds_raw[];
    LAS unsigned char* lds = (LAS unsigned char*)lds_raw;
    cg::grid_group grid = cg::this_grid();
    bf16_t* W = (bf16_t*)(P.ws + WS_W);
    bf16_t* A = (bf16_t*)(P.ws + WS_A);
    bf16_t* B = (bf16_t*)(P.ws + WS_B);
    bf16_t* C = (bf16_t*)(P.ws + WS_C);
    float* xo = P.out; float* xo_s = P.out + (size_t)RP * 1024;
    int ph = 0;
    unsigned* barw = (unsigned*)(P.ws + 4096);
    if (blockIdx.x == 0) for (int i = threadIdx.x; i < XCD_BAR_WORDS; i += 512) __hip_atomic_store(barw + i, 0u, __ATOMIC_RELAXED, __HIP_MEMORY_SCOPE_AGENT);
    if (blockIdx.x == 0 && threadIdx.x < 8) __hip_atomic_store(MINI_CTR(threadIdx.x), 0u, __ATOMIC_RELAXED, __HIP_MEMORY_SCOPE_AGENT);
    volatile LAS unsigned* bst = (volatile LAS unsigned*)(lds + LDS_BYTES - 64);
    if (threadIdx.x == 0) { bst[0] = 0u; bst[1] = 0u; }
    __syncthreads();
    XcdBarrier xbar; xbar.bar = barw; xbar.x = xb_xcc_id(); xbar.st = bst;

    PHASE_BEGIN for (int rp_ = 0; rp_ < REP_PRO; ++rp_) prologue(P, tid, wid, lane); PHASE_END
    PHASE_BEGIN {
        EpiAB E{B, (bf16_t*)(P.ws + WS_FKS), (bf16_t*)(P.ws + WS_FVTS), P.out, (const float*)(P.ws + WS_ROPE), P.in[13], RSV};
        run_gemm(lds, A, W + W_AB, R, 3840, 1024, E);
        {
            EpiMemKV E2{P.out + O_MK, P.out + O_MV, (bf16_t*)(P.ws + WS_MEMK), (bf16_t*)(P.ws + WS_MEMVT)};
            pg8::Gemm g2{(const bf16_t*)(P.ws + WS_MEMN), W + W_XKV, 4096, 4096, 1024}; MemKVOrder S2{(int)gridDim.x, (int)blockIdx.x};
            pg8::gemm_phase<EpiMemKV, MemKVOrder, true, true>(lds, g2, S2, E2);
        }
    } PHASE_END
    PHASE_BEGIN { for (int rp_ = 0; rp_ < REP_RET; ++rp_) { ret_passA(P, wid, lane); if (blockIdx.x < 16) cumsum_task(P, blockIdx.x * 8 + wid, lane); } } PHASE_END
    PHASE_BEGIN ret_passB(P, tid); PHASE_END
    PHASE_BEGIN {
        LAS float* red = (LAS float*)lds;
        for (int rp_ = 0; rp_ < REP_RET; ++rp_)
        for (int u = blockIdx.x; u < 4096 + 32; u += gridDim.x) { if (u < 4096) ret_unitC<64>(P, red, u >> 7, u & 127, wid, lane); else ret_unitC<32>(P, red, u - 4096, 0, wid, lane); }
        __syncthreads();
        for (int rp_ = 0; rp_ < REP_FOX; ++rp_) { fox_phase(P, lds, tid, wid, lane); __syncthreads(); }
    } PHASE_END
    PHASE_BEGIN { EpiPlain<0> E{C, 1024, 1.f, nullptr}; run_gemm(lds, MIXED, W + W_OUT, RP, 1024, 1024, E); } PHASE_END
    PHASE_BEGIN { EpiPlain<0> Es{C + (size_t)RP * 1024, 1024, 1.f, nullptr}; tail_resnorm<0, 0>(lds, MIXED + (size_t)RP * 1024, W + W_OUT, 1024, 1024, Es, MINI_CTR(0), C, P.in[0], P.in[1], A, P.in[11] + 1024, RSV, nullptr, wid, lane); } PHASE_END
    layer_phases<0>(P, lds, grid, ph, xbar, ph_lo, ph_hi, W, A, B, C, xo, xo_s);
    layer_phases<1>(P, lds, grid, ph, xbar, ph_lo, ph_hi, W, A, B, C, xo, xo_s);
}

extern "C" void kernel_launch(void* const* d_in, const int* in_sizes, int n_in, void* d_out, int out_size, void* d_ws, size_t ws_size, hipStream_t stream) {
    static int grid = 0;
    if (grid == 0) {
        if (n_in != 33 || (size_t)out_size != O_END || ws_size < WS_END) { fprintf(stderr, "kernel_launch: unexpected shapes n_in %d out %d ws %zu\n", n_in, out_size, ws_size); grid = -1; return; }
        int dev = 0, cus = 0, per_cu = 0;
        hipGetDevice(&dev);
        hipDeviceGetAttribute(&cus, hipDeviceAttributeMultiprocessorCount, dev);
        if (hipFuncSetAttribute((const void*)mega_fwd, hipFuncAttributeMaxDynamicSharedMemorySize, LDS_BYTES) != hipSuccess) { fprintf(stderr, "kernel_launch: hipFuncSetAttribute failed\n"); grid = -1; return; }
        if (hipOccupancyMaxActiveBlocksPerMultiprocessor(&per_cu, (const void*)mega_fwd, 512, LDS_BYTES) != hipSuccess || per_cu < 1) { fprintf(stderr, "kernel_launch: occupancy query %d\n", per_cu); per_cu = 1; (void)hipGetLastError(); }
        grid = cus * per_cu;
    }
    if (grid < 0) return;
    Params p{};
    for (int i = 0; i < 33; ++i) p.in[i] = (const float*)d_in[i];
    p.out = (float*)d_out; p.ws = (unsigned char*)d_ws;
    int lo = 0, hi = 1000;
    void* args[] = {&p, &lo, &hi};
    hipError_t e = hipLaunchCooperativeKernel((const void*)mega_fwd, dim3(grid), dim3(512), args, LDS_BYTES, stream);
    if (e != hipSuccess) fprintf(stderr, "cooperative launch failed: %s (grid %d)\n", hipGetErrorString(e), grid);
}
```
